# Optimizing an MI355X kernel written in HIP

```python
import math
import jax
import jax.numpy as jnp
from jax import lax
import numpy as np

D_MODEL = 1024
BATCH = 4
SEQ = 4096
DEPTH = 4

GRID_W = 64
CTX_LEN = 256
N_MOD = 9
MACARON = 0.5
ALPHA = (2 * DEPTH) ** 0.25
BETA = (8 * DEPTH) ** -0.25
LN_EPS = 1e-5
RMS_EPS = 1e-6
F_TINY = 1e-20
FFN_HIDDEN = 2816

HG_DK = 128
HG_DV = 128
HG_HEADS = (D_MODEL // 2) // HG_DV
HG_K = HG_HEADS * HG_DK
HG_V = HG_HEADS * HG_DV
HG_CHUNK = 64
POOL_WINDOWS = (2, 4, 8, 16)
POOL_GROUPS = 4
POOL_WIDTH = D_MODEL // 2
POOL_GC = POOL_WIDTH // POOL_GROUPS
EVEN_SIZES = (HG_K, HG_V, HG_V, HG_K, HG_K, POOL_WIDTH)
EVEN_IN = sum(EVEN_SIZES)
EVEN_SPLITS = tuple(sum(EVEN_SIZES[:i + 1]) for i in range(len(EVEN_SIZES) - 1))
EVEN_MIX = HG_V + POOL_WIDTH

DA_HD = 64
DA_VD = 2 * DA_HD
DA_HEADS = D_MODEL // DA_VD
DA_QK = DA_HEADS * 2 * DA_HD
ODD_IN = 2 * DA_QK + DA_HEADS * DA_VD
ODD_MIX = DA_HEADS * DA_VD
Q_BLOCK = 128
ROPE_BASE = 10000.0
ROPE_AXIS = DA_HD // 2

N_EVEN = (DEPTH + 1) // 2
N_ODD = DEPTH // 2

kernel_name = 'hybrid_hgrn2_pool_diffattn_macaron'


def layer_norm(x, g, b):
    xf = x.astype(jnp.float32)
    mu = jnp.mean(xf, axis=-1, keepdims=True)
    xc = xf - mu
    var = jnp.mean(xc * xc, axis=-1, keepdims=True)
    y = xc * lax.rsqrt(var + LN_EPS) * g.astype(jnp.float32) + b.astype(jnp.float32)
    return y.astype(x.dtype)


def rms_norm(x, w):
    xf = x.astype(jnp.float32)
    y = xf * lax.rsqrt(jnp.mean(xf * xf, axis=-1, keepdims=True) + RMS_EPS)
    return (y * w.astype(jnp.float32)).astype(x.dtype)


def modulate(x, shift, scale):
    return x * (1.0 + scale) + shift


def swiglu(h, w_in, w_out):
    a, b = jnp.split(h @ w_in, 2, axis=-1)
    return (jax.nn.silu(a) * b) @ w_out


def ffn_substep(x, mods, w_in, w_out, g, b):
    shift, scale, gate = mods
    y = swiglu(modulate(x, shift, scale), w_in, w_out)
    return layer_norm(ALPHA * x + MACARON * gate * y, g, b)


def to_heads(a, hd):
    bsz, n, _ = a.shape
    return a.reshape(bsz, n, -1, hd).transpose(0, 2, 1, 3)


def from_heads(a):
    bsz, nh, n, hd = a.shape
    return a.transpose(0, 2, 1, 3).reshape(bsz, n, nh * hd)


def gla_chunk_scan(q, k, v, log_f, s0):
    bsz, nh, t, _ = q.shape
    dv = v.shape[-1]
    n = t // HG_CHUNK

    def to_chunks(a):
        return jnp.moveaxis(a.reshape(bsz, nh, n, HG_CHUNK, a.shape[-1]), 2, 0)

    causal = jnp.tril(jnp.ones((HG_CHUNK, HG_CHUNK), dtype=bool))

    def step(s, inp):
        qi, ki, vi, gi = inp
        b = jnp.cumsum(gi.astype(jnp.float32), axis=-2)
        diff = b[..., :, None, :] - b[..., None, :, :]
        decay = jnp.where(causal[:, :, None], jnp.exp(jnp.minimum(diff, 0.0)), 0.0)
        scores = jnp.einsum('bhtd,bhsd,bhtsd->bhts', qi, ki, decay)
        o = (jnp.einsum('bhts,bhsv->bhtv', scores, vi)
             + jnp.einsum('bhtd,bhdv->bhtv', qi * jnp.exp(b), s))
        b_last = b[..., -1:, :]
        s_new = (jnp.exp(b_last[..., 0, :])[..., None] * s
                 + jnp.einsum('bhsd,bhsv->bhdv', ki * jnp.exp(b_last - b), vi))
        return s_new, o

    s_fin, o = lax.scan(step, s0, (to_chunks(q), to_chunks(k), to_chunks(v), to_chunks(log_f)))
    o = jnp.moveaxis(o, 0, 2).reshape(bsz, nh, t, dv)
    return o, s_fin


def hgrn2_gates(f_raw, lb):
    z = to_heads(f_raw, HG_DK).astype(jnp.float32)
    lbh = lb.reshape(HG_HEADS, 1, HG_DK)
    f = lbh + (1.0 - lbh) * jax.nn.sigmoid(z)
    log_f = jnp.log(jnp.maximum(f, F_TINY))
    return log_f, 1.0 - f


def hgrn2_bidir(q_c, i_c, f_c, q_l, i_l, f_l, lb):
    flip = lambda a: jnp.flip(a, axis=2)
    bsz = q_c.shape[0]
    zero = jnp.zeros((bsz, HG_HEADS, HG_DK, HG_DV), jnp.float32)
    lf, k = hgrn2_gates(f_c[0], lb[0])
    o_cf, s_cf = gla_chunk_scan(q_c, k, i_c, lf, zero)
    lf, k = hgrn2_gates(f_l[0], lb[0])
    o_lf, _ = gla_chunk_scan(q_l, k, i_l, lf, s_cf)
    lf, k = hgrn2_gates(f_c[1], lb[1])
    o_cb, s_cb = gla_chunk_scan(flip(q_c), flip(k), flip(i_c), flip(lf), zero)
    lf, k = hgrn2_gates(f_l[1], lb[1])
    o_lb, _ = gla_chunk_scan(flip(q_l), flip(k), flip(i_l), flip(lf), s_cb)
    return o_cf + flip(o_cb), o_lf + flip(o_lb)


def multiscale_pool(u, pool_w, pool_scale):
    bsz, n, _ = u.shape
    uf = u.astype(jnp.float32)
    csum = jnp.concatenate([jnp.zeros((bsz, 1, POOL_WIDTH), jnp.float32), jnp.cumsum(uf, axis=1)], axis=1)
    pos = jnp.arange(n)
    groups = []
    for gi, w in enumerate(POOL_WINDOWS):
        lo = jnp.clip(pos - w // 2, 0, n)
        hi = jnp.clip(pos + (w - w // 2), 0, n)
        sl = slice(gi * POOL_GC, (gi + 1) * POOL_GC)
        win_sum = csum[:, hi, sl] - csum[:, lo, sl]
        count = (hi - lo).astype(jnp.float32)[None, :, None]
        groups.append(win_sum / count - uf[:, :, sl])
    pooled = jnp.stack(groups, axis=2)
    y = jnp.einsum('bngc,gcd->bngd', pooled, pool_w.astype(jnp.float32)).reshape(bsz, n, POOL_WIDTH)
    return (y * pool_scale.astype(jnp.float32)).astype(u.dtype)


def hgrn2_pool_mixer(h_lat, h_ctx, w_in, w_out, lb, norm_w, pool_w, pool_scale, need_ctx):
    def split(h):
        q, i, g, f_fw, f_bw, u = jnp.split(h @ w_in, EVEN_SPLITS, axis=-1)
        return to_heads(q, HG_DK) * HG_DK ** -0.5, to_heads(i, HG_DV), g, (f_fw, f_bw), u

    q_l, i_l, g_l, f_l, u_l = split(h_lat)
    q_c, i_c, g_c, f_c, u_c = split(h_ctx)
    o_c, o_l = hgrn2_bidir(q_c, i_c, f_c, q_l, i_l, f_l, lb)

    def readout(o, g, u):
        rec = from_heads(rms_norm(o, norm_w)).astype(u.dtype) * jax.nn.silu(g)
        return jnp.concatenate([rec, multiscale_pool(u, pool_w, pool_scale)], axis=-1) @ w_out

    y_lat = readout(o_l, g_l, u_l)
    y_ctx = readout(o_c, g_c, u_c) if need_ctx else None
    return y_lat, y_ctx


def axial_rope_tables(t):
    rows = t // GRID_W
    row = jnp.repeat(jnp.arange(rows, dtype=jnp.float32), GRID_W)
    col = jnp.tile(jnp.arange(GRID_W, dtype=jnp.float32), rows)
    inv_freq = ROPE_BASE ** (-jnp.arange(0, ROPE_AXIS, 2, dtype=jnp.float32) / ROPE_AXIS)
    ang_r = row[:, None] * inv_freq
    ang_c = col[:, None] * inv_freq
    ang = jnp.concatenate([ang_r, ang_r, ang_c, ang_c], axis=-1)
    return jnp.cos(ang), jnp.sin(ang)


def rotate_half(a):
    a1, a2 = jnp.split(a, 2, axis=-1)
    return jnp.concatenate([-a2, a1], axis=-1)


def apply_axial_rope(a, cos, sin):
    a_r, a_c = jnp.split(a, 2, axis=-1)
    return a * cos + jnp.concatenate([rotate_half(a_r), rotate_half(a_c)], axis=-1) * sin


def lambda_init(layer):
    return 0.8 - 0.6 * math.exp(-0.3 * layer)


def diff_attention_mixer(h_lat, h_ctx, w_in, w_out, lam_vec, sub_w, lam_init, need_ctx):
    bsz, t, _ = h_lat.shape

    def project(h):
        n = h.shape[1]
        q, k, v = jnp.split(h @ w_in, (DA_QK, 2 * DA_QK), axis=-1)
        q = q.reshape(bsz, n, DA_HEADS, 2, DA_HD).transpose(0, 2, 3, 1, 4) * DA_HD ** -0.5
        k = k.reshape(bsz, n, DA_HEADS, 2, DA_HD).transpose(0, 2, 3, 1, 4)
        return q, k, to_heads(v, DA_VD)

    q_l, k_l, v_l = project(h_lat)
    q_c, k_c, v_c = project(h_ctx)
    cos, sin = axial_rope_tables(t)
    q_l = apply_axial_rope(q_l, cos, sin).astype(h_lat.dtype)
    k_l = apply_axial_rope(k_l, cos, sin).astype(h_lat.dtype)
    lv = lam_vec.astype(jnp.float32)
    lam = jnp.exp(jnp.sum(lv[0] * lv[1])) - jnp.exp(jnp.sum(lv[2] * lv[3])) + lam_init

    def diff_attend(q, k, v):
        s = jnp.einsum('bhmqd,bhmkd->bhmqk', q, k).astype(jnp.float32)
        p = jax.nn.softmax(s, axis=-1)
        w = p[:, :, 0] - lam * p[:, :, 1]
        return jnp.einsum('bhqk,bhkv->bhqv', w.astype(v.dtype), v)

    k_all = jnp.concatenate([k_c, k_l], axis=3)
    v_all = jnp.concatenate([v_c, v_l], axis=2)
    n_blk = t // Q_BLOCK
    q_blocks = jnp.moveaxis(q_l.reshape(bsz, DA_HEADS, 2, n_blk, Q_BLOCK, DA_HD), 3, 0)
    o_l = lax.map(lambda qb: diff_attend(qb, k_all, v_all), q_blocks)
    o_l = jnp.moveaxis(o_l, 0, 2).reshape(bsz, DA_HEADS, t, DA_VD)

    def readout(o):
        return from_heads(rms_norm(o, sub_w) * (1.0 - lam_init)) @ w_out

    y_lat = readout(o_l)
    y_ctx = readout(diff_attend(q_c, k_c, v_c)) if need_ctx else None
    return y_lat, y_ctx


def setup_inputs(seed: int = 0) -> dict:
    key = jax.random.key(seed)
    ks = jax.random.split(key, 20)
    D = D_MODEL

    def nrm(k, shape, s):
        return jax.random.normal(k, shape, jnp.float32) * s

    return {
        'x': nrm(ks[0], (BATCH, SEQ, D), 1.0),
        'c': nrm(ks[1], (BATCH, D), 1.0),
        'ctx': nrm(ks[2], (BATCH, CTX_LEN, D), 1.0),
        'c_ctx': nrm(ks[3], (D,), 1.0),
        'w_ada': nrm(ks[4], (DEPTH, D, N_MOD * D), 0.5 * D ** -0.5),
        'b_ada': nrm(ks[5], (DEPTH, N_MOD * D), 0.02),
        'ln_g': 1.0 + nrm(ks[6], (DEPTH, 3, D), 0.02),
        'ln_b': nrm(ks[7], (DEPTH, 3, D), 0.02),
        'w_ffn_in': nrm(ks[8], (DEPTH, 2, D, 2 * FFN_HIDDEN), D ** -0.5),
        'w_ffn_out': nrm(ks[9], (DEPTH, 2, FFN_HIDDEN, D), BETA * FFN_HIDDEN ** -0.5),
        'w_in_even': nrm(ks[10], (N_EVEN, D, EVEN_IN), D ** -0.5),
        'w_out_even': nrm(ks[11], (N_EVEN, EVEN_MIX, D), BETA * EVEN_MIX ** -0.5),
        'hg_lb': nrm(ks[12], (N_EVEN, 2, HG_K), 0.5),
        'hg_norm_w': 1.0 + nrm(ks[13], (N_EVEN, HG_DV), 0.02),
        'pool_w': nrm(ks[14], (N_EVEN, POOL_GROUPS, POOL_GC, POOL_GC), POOL_GC ** -0.5),
        'pool_scale': 1.0 + nrm(ks[15], (N_EVEN, POOL_WIDTH), 0.1),
        'w_in_odd': nrm(ks[16], (N_ODD, D, ODD_IN), D ** -0.5),
        'w_out_odd': nrm(ks[17], (N_ODD, ODD_MIX, D), BETA * ODD_MIX ** -0.5),
        'da_lambda': nrm(ks[18], (N_ODD, 4, DA_HD), 0.1),
        'da_sub_w': 1.0 + nrm(ks[19], (N_ODD, DA_VD), 0.02),
    }


def reference(x, c, ctx, c_ctx, w_ada, b_ada, ln_g, ln_b, w_ffn_in, w_ffn_out,
              w_in_even, w_out_even, hg_lb, hg_norm_w, pool_w, pool_scale,
              w_in_odd, w_out_odd, da_lambda, da_sub_w):
    lb_soft = jax.nn.softmax(hg_lb.astype(jnp.float32), axis=0)
    lb_all = jnp.cumsum(lb_soft, axis=0) - lb_soft[0]
    c_act = jax.nn.silu(c)
    cc_act = jax.nn.silu(c_ctx)
    for layer in range(DEPTH):
        last = layer == DEPTH - 1
        m_lat = jnp.split((c_act @ w_ada[layer] + b_ada[layer])[:, None, :], N_MOD, axis=-1)
        m_ctx = jnp.split(cc_act @ w_ada[layer] + b_ada[layer], N_MOD, axis=-1)
        x = ffn_substep(x, m_lat[0:3], w_ffn_in[layer, 0], w_ffn_out[layer, 0], ln_g[layer, 0], ln_b[layer, 0])
        ctx = ffn_substep(ctx, m_ctx[0:3], w_ffn_in[layer, 0], w_ffn_out[layer, 0], ln_g[layer, 0], ln_b[layer, 0])
        h_lat = modulate(x, m_lat[3], m_lat[4])
        h_ctx = modulate(ctx, m_ctx[3], m_ctx[4])
        if layer % 2 == 0:
            e = layer // 2
            y_lat, y_ctx = hgrn2_pool_mixer(h_lat, h_ctx, w_in_even[e], w_out_even[e], lb_all[e],
                                            hg_norm_w[e], pool_w[e], pool_scale[e], not last)
        else:
            o = layer // 2
            y_lat, y_ctx = diff_attention_mixer(h_lat, h_ctx, w_in_odd[o], w_out_odd[o], da_lambda[o],
                                                da_sub_w[o], lambda_init(layer), not last)
        x = layer_norm(ALPHA * x + m_lat[5] * y_lat, ln_g[layer, 1], ln_b[layer, 1])
        x = ffn_substep(x, m_lat[6:9], w_ffn_in[layer, 1], w_ffn_out[layer, 1], ln_g[layer, 2], ln_b[layer, 2])
        if not last:
            ctx = layer_norm(ALPHA * ctx + m_ctx[5] * y_ctx, ln_g[layer, 1], ln_b[layer, 1])
            ctx = ffn_substep(ctx, m_ctx[6:9], w_ffn_in[layer, 1], w_ffn_out[layer, 1], ln_g[layer, 2], ln_b[layer, 2])
    return x
```

```cpp
#include <hip/hip_runtime.h>
#include <hip/hip_cooperative_groups.h>
#include <cstdio>
namespace cg = cooperative_groups;

typedef __attribute__((ext_vector_type(8))) short bf16x8;
typedef __attribute__((ext_vector_type(4))) float f32x4;
typedef unsigned short u16;

#ifndef MULTI_LAUNCH
#define MULTI_LAUNCH 0
#endif

constexpr int D = 1024, NB = 4, SEQ = 4096, CTX = 256, FH = 2816;
constexpr int ML = NB * SEQ, MC = NB * CTX, MT = ML + MC;
constexpr int TK = CTX + SEQ;
constexpr int NCH = TK / 64;
constexpr float ALPHA = 1.6817928305074290f;
constexpr float LOG2E = 1.4426950408889634f;

constexpr size_t al256(size_t x) { return (x + 255) & ~(size_t)255; }
constexpr size_t OFF_WFI = 0;
constexpr size_t OFF_WFO = OFF_WFI + al256((size_t)4 * 2 * 5632 * 1024 * 2);
constexpr size_t OFF_WMI = OFF_WFO + al256((size_t)4 * 2 * 1024 * 2816 * 2);
constexpr size_t OFF_WMO = OFF_WMI + al256((size_t)4 * 3072 * 1024 * 2);
constexpr size_t OFF_WPL = OFF_WMO + al256((size_t)4 * 1024 * 1024 * 2);
constexpr size_t OFF_MODS = OFF_WPL + al256((size_t)2 * 4 * 128 * 128 * 2);
constexpr size_t OFF_LB = OFF_MODS + al256((size_t)4 * 5 * 9216 * 4);
constexpr size_t OFF_LAM = OFF_LB + al256((size_t)2 * 2 * 512 * 4);
constexpr size_t OFF_ROPE = OFF_LAM + 256;
constexpr size_t OFF_DEC = OFF_ROPE + al256((size_t)64 * 16 * 2 * 4);
constexpr size_t OFF_X = OFF_DEC + al256((size_t)32 * NCH * 128 * 4);
constexpr size_t OFF_H = OFF_X + al256((size_t)MT * 1024 * 4);
constexpr size_t OFF_PROJ = OFF_H + al256((size_t)MT * 1024 * 2);
constexpr size_t OFF_VT = OFF_PROJ + al256((size_t)MT * 3072 * 2);
constexpr size_t OFF_MIX = OFF_VT + al256((size_t)NB * 8 * 128 * TK * 2);
constexpr size_t OFF_POOLED = OFF_MIX + al256((size_t)MT * 1024 * 2);
constexpr size_t OFF_HID = OFF_POOLED + al256((size_t)MT * 512 * 2);
constexpr size_t OFF_Y = OFF_HID + al256((size_t)MT * FH * 2);
constexpr size_t OFF_END = OFF_Y + al256((size_t)MT * 1024 * 4);
constexpr size_t OFF_U = OFF_HID;
static_assert((size_t)32 * NCH * 16384 * 4 <= OFF_END - OFF_HID, "U alias too big");

struct P {
  const float *x, *c, *ctx, *c_ctx, *w_ada, *b_ada, *ln_g, *ln_b, *w_ffn_in, *w_ffn_out, *w_in_even, *w_out_even,
      *hg_lb, *hg_norm_w, *pool_w, *pool_scale, *w_in_odd, *w_out_odd, *da_lambda, *da_sub_w;
  float* out;
  char* ws;
};

__device__ __forceinline__ u16 f2bf(float f) {
  unsigned u = __float_as_uint(f);
  u += 0x7fffu + ((u >> 16) & 1u);
  return (u16)(u >> 16);
}
__device__ __forceinline__ float bf2f(u16 h) { return __uint_as_float(((unsigned)h) << 16); }
__device__ __forceinline__ unsigned pk2(float a, float b) { return (unsigned)f2bf(a) | ((unsigned)f2bf(b) << 16); }
__device__ __forceinline__ float sigm(float z) { return 1.f / (1.f + __expf(-z)); }
__device__ __forceinline__ float silu(float z) { return z / (1.f + __expf(-z)); }
__device__ __forceinline__ float ex2(float x) { return __builtin_amdgcn_exp2f(x); }
__device__ __forceinline__ void glds16(const void* g, void* l) {
  __builtin_amdgcn_global_load_lds((const unsigned*)g, (unsigned*)l, 16, 0, 0);
}
__device__ __forceinline__ int get_tid() { int t = threadIdx.x; asm volatile("" : "+v"(t)); return t; }
__device__ __forceinline__ int swz128(int row, int ch) { return row * 128 + ((ch ^ ((row >> 1) & 7)) << 4); }
__device__ __forceinline__ int swz256(int row, int ch) { return row * 256 + ((ch ^ (row & 15)) << 4); }
__device__ __forceinline__ f32x4 mfma16(bf16x8 a, bf16x8 b, f32x4 c) {
  return __builtin_amdgcn_mfma_f32_16x16x32_bf16(a, b, c, 0, 0, 0);
}
__device__ __forceinline__ float xor_sum(float v, int m) { return v + __shfl_xor(v, m, 64); }
__device__ __forceinline__ float xor_max(float v, int m) { return fmaxf(v, __shfl_xor(v, m, 64)); }
__device__ __forceinline__ void row_bpos(int row, int& b, int& pos) {
  if (row < ML) { b = row >> 12; pos = CTX + (row & 4095); }
  else { int r = row - ML; b = r >> 8; pos = r & 255; }
}
__device__ __forceinline__ int mod_row(int row) { return row < ML ? (row >> 12) : 4; }

constexpr int BM = 128, BN = 128, BK = 64;

template <class Epi>
__device__ __forceinline__ void gemm_tile(const u16* __restrict__ A, int lda, const u16* __restrict__ Bt, int ldb, int K,
                                          int m0, int n0, char* smem, const Epi& epi) {
  const int tid = get_tid(), lane = tid & 63, wid = tid >> 6, wr = wid >> 1, wc = wid & 1, fr = lane & 15, fq = lane >> 4;
  f32x4 acc[4][4];
#pragma unroll
  for (int m = 0; m < 4; ++m)
#pragma unroll
    for (int n = 0; n < 4; ++n) acc[m][n] = f32x4{0.f, 0.f, 0.f, 0.f};
  const int nk = K / BK;
  const u16* ga[4];
  const u16* gb[4];
#pragma unroll
  for (int i = 0; i < 4; ++i) {
    int q = tid + i * 256, row = q >> 3, ch = (q & 7) ^ ((row >> 1) & 7);
    ga[i] = A + (size_t)(m0 + row) * lda + ch * 8;
    gb[i] = Bt + (size_t)(n0 + row) * ldb + ch * 8;
  }
  __syncthreads();
#pragma unroll
  for (int i = 0; i < 4; ++i) {
    glds16(ga[i], smem + (tid + i * 256) * 16);
    glds16(gb[i], smem + 16384 + (tid + i * 256) * 16);
  }
  for (int kt = 0; kt < nk; ++kt) {
    __syncthreads();
    char* cur = smem + (kt & 1) * 32768;
    if (kt + 1 < nk) {
      char* nxt = smem + ((kt + 1) & 1) * 32768;
#pragma unroll
      for (int i = 0; i < 4; ++i) {
        glds16(ga[i] + (kt + 1) * BK, nxt + (tid + i * 256) * 16);
        glds16(gb[i] + (kt + 1) * BK, nxt + 16384 + (tid + i * 256) * 16);
      }
    }
#pragma unroll
    for (int ks = 0; ks < 2; ++ks) {
      bf16x8 a[4], b[4];
#pragma unroll
      for (int m = 0; m < 4; ++m) a[m] = *(const bf16x8*)(cur + swz128(wr * 64 + m * 16 + fr, ks * 4 + fq));
#pragma unroll
      for (int n = 0; n < 4; ++n) b[n] = *(const bf16x8*)(cur + 16384 + swz128(wc * 64 + n * 16 + fr, ks * 4 + fq));
#pragma unroll
      for (int m = 0; m < 4; ++m)
#pragma unroll
        for (int n = 0; n < 4; ++n) acc[m][n] = mfma16(a[m], b[n], acc[m][n]);
    }
  }
  epi(acc, m0 + wr * 64, n0 + wc * 64, fr, fq);
}

template <class Epi>
__device__ __forceinline__ void gemm_phase(const u16* A, int lda, const u16* Bt, int M, int N, int K, char* smem,
                                           const Epi& epi) {
  const int nM = M / BM, nN = N / BN, ntile = nM * nN;
  constexpr int WGM = 16;
  for (int t = blockIdx.x; t < ntile; t += gridDim.x) {
    int nig = WGM * nN, gid = t / nig, fm = gid * WGM, gsz = min(nM - fm, WGM);
    int pm = fm + (t % nig) % gsz, pn = (t % nig) / gsz;
    gemm_tile(A, lda, Bt, K, K, pm * BM, pn * BN, smem, epi);
  }
}

struct EpiSwiglu {
  u16* hid;
  __device__ __forceinline__ void operator()(f32x4 (&acc)[4][4], int rb, int cb, int fr, int fq) const {
#pragma unroll
    for (int m = 0; m < 4; ++m)
#pragma unroll
      for (int n = 0; n < 4; n += 2)
#pragma unroll
        for (int j = 0; j < 4; ++j) {
          int row = rb + m * 16 + fq * 4 + j, hc = (cb >> 1) + (n >> 1) * 16 + fr;
          hid[(size_t)row * FH + hc] = f2bf(silu(acc[m][n][j]) * acc[m][n + 1][j]);
        }
  }
};
struct EpiF32 {
  float* y;
  __device__ __forceinline__ void operator()(f32x4 (&acc)[4][4], int rb, int cb, int fr, int fq) const {
#pragma unroll
    for (int m = 0; m < 4; ++m)
#pragma unroll
      for (int n = 0; n < 4; ++n)
#pragma unroll
        for (int j = 0; j < 4; ++j) y[(size_t)(rb + m * 16 + fq * 4 + j) * D + cb + n * 16 + fr] = acc[m][n][j];
  }
};
struct EpiPool {
  u16* mix; const float* scale; int g;
  __device__ __forceinline__ void operator()(f32x4 (&acc)[4][4], int rb, int cb, int fr, int fq) const {
#pragma unroll
    for (int m = 0; m < 4; ++m)
#pragma unroll
      for (int n = 0; n < 4; ++n) {
        int col = g * 128 + cb + n * 16 + fr;
        float sc = scale[col];
#pragma unroll
        for (int j = 0; j < 4; ++j) mix[(size_t)(rb + m * 16 + fq * 4 + j) * D + 512 + col] = f2bf(acc[m][n][j] * sc);
      }
  }
};
__device__ __forceinline__ void store_vt(u16* vt, int nh, f32x4 (&acc)[4][4], int rb, int fcol0, int fr, int fq) {
#pragma unroll
  for (int m = 0; m < 4; ++m) {
    int row = rb + m * 16 + fq * 4, b, pos;
    row_bpos(row, b, pos);
#pragma unroll
    for (int n = 0; n < 4; ++n) {
      int fc = fcol0 + n * 16 + fr, h = fc >> 7, f = fc & 127;
      uint2 v = {pk2(acc[m][n][0], acc[m][n][1]), pk2(acc[m][n][2], acc[m][n][3])};
      *(uint2*)(vt + ((size_t)((b * nh + h) * 128 + f)) * TK + pos) = v;
    }
  }
}
struct EpiProjEven {
  u16* proj; u16* vt;
  __device__ __forceinline__ void operator()(f32x4 (&acc)[4][4], int rb, int cb, int fr, int fq) const {
    if (cb >= 512 && cb < 1024) { store_vt(vt, 4, acc, rb, cb - 512, fr, fq); return; }
    const float sc = (cb < 512) ? 0.08838834764831845f : 1.f;
#pragma unroll
    for (int m = 0; m < 4; ++m)
#pragma unroll
      for (int n = 0; n < 4; ++n)
#pragma unroll
        for (int j = 0; j < 4; ++j)
          proj[(size_t)(rb + m * 16 + fq * 4 + j) * 3072 + cb + n * 16 + fr] = f2bf(acc[m][n][j] * sc);
  }
};
struct EpiProjOdd {
  u16* proj; u16* vt; const float* rope;
  __device__ __forceinline__ void operator()(f32x4 (&acc)[4][4], int rb, int cb, int fr, int fq) const {
    if (cb >= 2048) { store_vt(vt, 8, acc, rb, cb - 2048, fr, fq); return; }
    const float sc = (cb < 1024) ? 0.125f * LOG2E : 1.f;
#pragma unroll
    for (int m = 0; m < 4; ++m)
#pragma unroll
      for (int j = 0; j < 4; ++j) {
        int row = rb + m * 16 + fq * 4 + j;
        float v0 = acc[m][0][j], v1 = acc[m][1][j], v2 = acc[m][2][j], v3 = acc[m][3][j];
        if (row < ML) {
          int t = row & 4095, pr = t >> 6, pc = t & 63;
          float2 cr = *(const float2*)(rope + (pr * 16 + fr) * 2), cc = *(const float2*)(rope + (pc * 16 + fr) * 2);
          float a0 = v0 * cr.x - v1 * cr.y, a1 = v1 * cr.x + v0 * cr.y;
          float a2 = v2 * cc.x - v3 * cc.y, a3 = v3 * cc.x + v2 * cc.y;
          v0 = a0; v1 = a1; v2 = a2; v3 = a3;
        }
        u16* o = proj + (size_t)row * 3072 + cb + fr;
        o[0] = f2bf(v0 * sc); o[16] = f2bf(v1 * sc); o[32] = f2bf(v2 * sc); o[48] = f2bf(v3 * sc);
      }
  }
};

__device__ __forceinline__ void convert_tile(const float* __restrict__ src, int K, int N, u16* __restrict__ dst, int tile,
                                             bool swiglu, char* smem) {
  float* t = (float*)smem;
  const int tid = get_tid();
  const int nN = N / 64, nt = tile % nN, kt = tile / nN, k0 = kt * 64, n0 = nt * 64;
  __syncthreads();
#pragma unroll
  for (int i = 0; i < 16; ++i) {
    int k = (tid >> 6) + 4 * i, n = tid & 63;
    t[k * 65 + n] = src[(size_t)(k0 + k) * N + n0 + n];
  }
  __syncthreads();
#pragma unroll
  for (int i = 0; i < 8; ++i) {
    int n = (tid >> 5) + 8 * i, k2 = (tid & 31) * 2;
    int c = n0 + n, nr = c;
    if (swiglu) nr = (c < FH) ? (32 * (c >> 4) + (c & 15)) : (32 * ((c - FH) >> 4) + 16 + ((c - FH) & 15));
    *(unsigned*)(dst + (size_t)nr * K + k0 + k2) = pk2(t[k2 * 65 + n], t[(k2 + 1) * 65 + n]);
  }
}

__device__ void phase_prep(const P& p, char* smem) {
  const int tid = get_tid();
  constexpr int N_ADA = 576, N_TR = 4 * 5248 + 32;
  for (int item = blockIdx.x; item < N_ADA + N_TR + 1; item += gridDim.x) {
    if (item < N_ADA) {
      float* act = (float*)smem;
      float* red = (float*)(smem + 20480);
      const int l = item / 144, cb = (item % 144) * 64;
      __syncthreads();
      for (int i = tid; i < 5120; i += 256) {
        int r = i >> 10, k = i & 1023;
        float v = r < 4 ? p.c[r * 1024 + k] : p.c_ctx[k];
        act[i] = silu(v);
      }
      __syncthreads();
      const int tx = tid & 63, kg = tid >> 6;
      float a0 = 0, a1 = 0, a2 = 0, a3 = 0, a4 = 0;
      const float* w = p.w_ada + ((size_t)l * 1024 + kg * 256) * 9216 + cb + tx;
#pragma unroll 8
      for (int k = 0; k < 256; ++k) {
        float wv = w[(size_t)k * 9216];
        int kk = kg * 256 + k;
        a0 += act[kk] * wv; a1 += act[1024 + kk] * wv; a2 += act[2048 + kk] * wv; a3 += act[3072 + kk] * wv;
        a4 += act[4096 + kk] * wv;
      }
      red[(kg * 5 + 0) * 64 + tx] = a0; red[(kg * 5 + 1) * 64 + tx] = a1; red[(kg * 5 + 2) * 64 + tx] = a2;
      red[(kg * 5 + 3) * 64 + tx] = a3; red[(kg * 5 + 4) * 64 + tx] = a4;
      __syncthreads();
      for (int i = tid; i < 320; i += 256) {
        int r = i >> 6, x = i & 63;
        float s = red[(0 * 5 + r) * 64 + x] + red[(1 * 5 + r) * 64 + x] + red[(2 * 5 + r) * 64 + x] + red[(3 * 5 + r) * 64 + x];
        ((float*)(p.ws + OFF_MODS))[(size_t)(l * 5 + r) * 9216 + cb + x] = s + p.b_ada[l * 9216 + cb + x];
      }
    } else if (item < N_ADA + N_TR) {
      int idx = item - N_ADA;
      if (idx < 4 * 5248) {
        int l = idx / 5248, r = idx % 5248;
        if (r < 2816) {
          int f = r / 1408, tile = r % 1408;
          convert_tile(p.w_ffn_in + (size_t)(l * 2 + f) * 1024 * 5632, 1024, 5632,
                       (u16*)(p.ws + OFF_WFI) + (size_t)(l * 2 + f) * 5632 * 1024, tile, true, smem);
        } else if (r < 4224) {
          int f = (r - 2816) / 704, tile = (r - 2816) % 704;
          convert_tile(p.w_ffn_out + (size_t)(l * 2 + f) * 2816 * 1024, 2816, 1024,
                       (u16*)(p.ws + OFF_WFO) + (size_t)(l * 2 + f) * 1024 * 2816, tile, false, smem);
        } else if (r < 4992) {
          const float* src = (l & 1) ? p.w_in_odd + (size_t)(l >> 1) * 1024 * 3072 : p.w_in_even + (size_t)(l >> 1) * 1024 * 3072;
          convert_tile(src, 1024, 3072, (u16*)(p.ws + OFF_WMI) + (size_t)l * 3072 * 1024, r - 4224, false, smem);
        } else {
          const float* src = (l & 1) ? p.w_out_odd + (size_t)(l >> 1) * 1024 * 1024 : p.w_out_even + (size_t)(l >> 1) * 1024 * 1024;
          convert_tile(src, 1024, 1024, (u16*)(p.ws + OFF_WMO) + (size_t)l * 1024 * 1024, r - 4992, false, smem);
        }
      } else {
        int i2 = idx - 4 * 5248, eg = i2 >> 2, tile = i2 & 3;
        convert_tile(p.pool_w + (size_t)eg * 128 * 128, 128, 128, (u16*)(p.ws + OFF_WPL) + (size_t)eg * 128 * 128, tile, false, smem);
      }
    } else {
      float* LB = (float*)(p.ws + OFF_LB);
      for (int i = tid; i < 1024; i += 256) {
        float a0 = p.hg_lb[i], a1 = p.hg_lb[1024 + i];
        float mx = fmaxf(a0, a1), e0 = __expf(a0 - mx), e1 = __expf(a1 - mx);
        LB[i] = 0.f;
        LB[1024 + i] = e1 / (e0 + e1);
      }
      if (tid < 2) {
        const float* lv = p.da_lambda + tid * 256;
        float s0 = 0, s1 = 0;
        for (int i = 0; i < 64; ++i) { s0 += lv[i] * lv[64 + i]; s1 += lv[128 + i] * lv[192 + i]; }
        float li = 0.8f - 0.6f * expf(-0.3f * (float)(2 * tid + 1));
        ((float*)(p.ws + OFF_LAM))[tid] = expf(s0) - expf(s1) + li;
      }
      float* rope = (float*)(p.ws + OFF_ROPE);
      for (int i = tid; i < 1024; i += 256) {
        int pos = i >> 4, fi = i & 15;
        float inv = exp2f(-(float)fi * (13.287712379549449f / 16.f));
        float ang = (float)pos * inv;
        float k = rintf(ang * 0.15915494309189535f);
        float r = fmaf(-k, 6.28125f, ang);
        r = fmaf(-k, 1.9353071795864769e-3f, r);
        rope[i * 2] = cosf(r);
        rope[i * 2 + 1] = sinf(r);
      }
    }
  }
}

__device__ void phase_rows(const P& p, int mode, int l, int sub, int M, bool final_out) {
  const int tid = get_tid(), lane = tid & 63, wid = tid >> 6;
  float* X = (float*)(p.ws + OFF_X);
  const float* Y = (const float*)(p.ws + OFF_Y);
  u16* H = (u16*)(p.ws + OFF_H);
  const float* MODS = (const float*)(p.ws + OFF_MODS);
  int nl, si;
  if (mode == 0) { nl = 0; si = 0; }
  else if (sub == 0) { nl = l; si = 3; }
  else if (sub == 1) { nl = l; si = 6; }
  else { nl = l + 1; si = 0; }
  const float gs = (sub == 1) ? 1.f : 0.5f;
  for (int row = blockIdx.x * 4 + wid; row < M; row += gridDim.x * 4) {
    const int mr = mod_row(row);
    float v[16];
    if (mode == 0) {
      const float* src = row < ML ? p.x + (size_t)row * D : p.ctx + (size_t)(row - ML) * D;
#pragma unroll
      for (int i = 0; i < 4; ++i) {
        float4 t = *(const float4*)(src + i * 256 + lane * 4);
        v[i * 4] = t.x; v[i * 4 + 1] = t.y; v[i * 4 + 2] = t.z; v[i * 4 + 3] = t.w;
      }
    } else {
      const float* gate = MODS + (size_t)(l * 5 + mr) * 9216 + (2 + 3 * sub) * 1024;
      float s = 0.f;
#pragma unroll
      for (int i = 0; i < 4; ++i) {
        int c = i * 256 + lane * 4;
        float4 xv = *(const float4*)(X + (size_t)row * D + c), yv = *(const float4*)(Y + (size_t)row * D + c);
        float4 gv = *(const float4*)(gate + c);
        v[i * 4] = ALPHA * xv.x + gs * gv.x * yv.x; v[i * 4 + 1] = ALPHA * xv.y + gs * gv.y * yv.y;
        v[i * 4 + 2] = ALPHA * xv.z + gs * gv.z * yv.z; v[i * 4 + 3] = ALPHA * xv.w + gs * gv.w * yv.w;
        s += v[i * 4] + v[i * 4 + 1] + v[i * 4 + 2] + v[i * 4 + 3];
      }
#pragma unroll
      for (int o = 1; o < 64; o <<= 1) s = xor_sum(s, o);
      const float mu = s * (1.f / 1024.f);
      float q = 0.f;
#pragma unroll
      for (int i = 0; i < 16; ++i) { v[i] -= mu; q += v[i] * v[i]; }
#pragma unroll
      for (int o = 1; o < 64; o <<= 1) q = xor_sum(q, o);
      const float rstd = rsqrtf(q * (1.f / 1024.f) + 1e-5f);
      const float* lg = p.ln_g + (size_t)(l * 3 + sub) * D;
      const float* lbp = p.ln_b + (size_t)(l * 3 + sub) * D;
#pragma unroll
      for (int i = 0; i < 4; ++i) {
        int c = i * 256 + lane * 4;
        float4 g4 = *(const float4*)(lg + c), b4 = *(const float4*)(lbp + c);
        v[i * 4] = v[i * 4] * rstd * g4.x + b4.x; v[i * 4 + 1] = v[i * 4 + 1] * rstd * g4.y + b4.y;
        v[i * 4 + 2] = v[i * 4 + 2] * rstd * g4.z + b4.z; v[i * 4 + 3] = v[i * 4 + 3] * rstd * g4.w + b4.w;
      }
    }
    if (final_out) {
#pragma unroll
      for (int i = 0; i < 4; ++i)
        *(float4*)(p.out + (size_t)row * D + i * 256 + lane * 4) = float4{v[i * 4], v[i * 4 + 1], v[i * 4 + 2], v[i * 4 + 3]};
      continue;
    }
    const float* sh = MODS + (size_t)(nl * 5 + mr) * 9216 + si * 1024;
#pragma unroll
    for (int i = 0; i < 4; ++i) {
      int c = i * 256 + lane * 4;
      *(float4*)(X + (size_t)row * D + c) = float4{v[i * 4], v[i * 4 + 1], v[i * 4 + 2], v[i * 4 + 3]};
      float4 s4 = *(const float4*)(sh + c), c4 = *(const float4*)(sh + 1024 + c);
      uint2 hv = {pk2(v[i * 4] * (1.f + c4.x) + s4.x, v[i * 4 + 1] * (1.f + c4.y) + s4.y),
                  pk2(v[i * 4 + 2] * (1.f + c4.z) + s4.z, v[i * 4 + 3] * (1.f + c4.w) + s4.w)};
      *(uint2*)(H + (size_t)row * D + c) = hv;
    }
  }
}

__device__ void phase_attn(const P& p, int l, char* smem) {
  const int tid = get_tid(), lane = tid & 63, w = tid >> 6, fr = lane & 15, fq = lane >> 4;
  const u16* PROJ = (const u16*)(p.ws + OFF_PROJ);
  const u16* VT = (const u16*)(p.ws + OFF_VT);
  u16* MIX = (u16*)(p.ws + OFF_MIX);
  const float lam = ((const float*)(p.ws + OFF_LAM))[l >> 1];
  const float lam_init = 0.8f - 0.6f * expf(-0.3f * (float)l);
  const float* subw = p.da_sub_w + (l >> 1) * 128;
  const int n_items = (l == 3) ? 2048 : 2176;
  for (int item = blockIdx.x; item < n_items; item += gridDim.x) {
    int b, h, qrow0, nkt;
    if (item < 2048) { b = item >> 9; h = (item >> 6) & 7; qrow0 = b * 4096 + (item & 63) * 64; nkt = 68; }
    else { int it = item - 2048; b = it >> 5; h = (it >> 2) & 7; qrow0 = ML + b * 256 + (it & 3) * 64; nkt = 4; }
    bf16x8 qf[2][2];
    {
      const u16* qp = PROJ + (size_t)(qrow0 + w * 16 + fr) * 3072 + h * 128 + fq * 8;
#pragma unroll
      for (int m = 0; m < 2; ++m)
#pragma unroll
        for (int ks = 0; ks < 2; ++ks) qf[m][ks] = *(const bf16x8*)(qp + m * 64 + ks * 32);
    }
    f32x4 O[2][8];
#pragma unroll
    for (int m = 0; m < 2; ++m)
#pragma unroll
      for (int v = 0; v < 8; ++v) O[m][v] = f32x4{0.f, 0.f, 0.f, 0.f};
    float mrun[2] = {-1e30f, -1e30f}, lsum[2] = {0.f, 0.f};
    const u16* vbase = VT + (size_t)((b * 8 + h) * 128) * TK;
    auto stage = [&](int kt, char* buf) {
      const int krow0 = kt < 4 ? ML + b * 256 + kt * 64 : b * 4096 + (kt - 4) * 64;
#pragma unroll
      for (int i = 0; i < 4; ++i) {
        int q = tid + i * 256;
        int key = q >> 4, ch = (q & 15) ^ (key & 15);
        glds16(PROJ + (size_t)(krow0 + key) * 3072 + 1024 + h * 128 + ch * 8, buf + q * 16);
        int dv = q >> 3, c2 = (q & 7) ^ ((dv >> 1) & 7);
        glds16(vbase + (size_t)dv * TK + kt * 64 + c2 * 8, buf + 16384 + q * 16);
      }
    };
    __syncthreads();
    stage(0, smem);
    for (int kt = 0; kt < nkt; ++kt) {
      __syncthreads();
      char* cur = smem + (kt & 1) * 32768;
      if (kt + 1 < nkt) stage(kt + 1, smem + ((kt + 1) & 1) * 32768);
      bf16x8 pb[2][2];
#pragma unroll
      for (int m = 0; m < 2; ++m) {
        f32x4 s[4];
#pragma unroll
        for (int sf = 0; sf < 4; ++sf) {
          s[sf] = f32x4{0.f, 0.f, 0.f, 0.f};
#pragma unroll
          for (int ks = 0; ks < 2; ++ks) {
            bf16x8 a = *(const bf16x8*)(cur + swz256(sf * 16 + fr, m * 8 + ks * 4 + fq));
            s[sf] = mfma16(a, qf[m][ks], s[sf]);
          }
        }
        float tm = -1e30f;
#pragma unroll
        for (int sf = 0; sf < 4; ++sf)
#pragma unroll
          for (int j = 0; j < 4; ++j) tm = fmaxf(tm, s[sf][j]);
        tm = xor_max(tm, 16); tm = xor_max(tm, 32);
        const float mn = fmaxf(mrun[m], tm), sc = ex2(mrun[m] - mn);
        mrun[m] = mn;
        float ps = 0.f;
#pragma unroll
        for (int sf = 0; sf < 4; ++sf)
#pragma unroll
          for (int j = 0; j < 4; ++j) { s[sf][j] = ex2(s[sf][j] - mn); ps += s[sf][j]; }
        lsum[m] = lsum[m] * sc + ps;
#pragma unroll
        for (int v = 0; v < 8; ++v) O[m][v] *= sc;
#pragma unroll
        for (int k2 = 0; k2 < 2; ++k2) {
          union { bf16x8 v; unsigned u[4]; } t;
          t.u[0] = pk2(s[2 * k2][0], s[2 * k2][1]); t.u[1] = pk2(s[2 * k2][2], s[2 * k2][3]);
          t.u[2] = pk2(s[2 * k2 + 1][0], s[2 * k2 + 1][1]); t.u[3] = pk2(s[2 * k2 + 1][2], s[2 * k2 + 1][3]);
          pb[m][k2] = t.v;
        }
      }
#pragma unroll
      for (int v = 0; v < 8; ++v) {
        const int dv = v * 16 + fr;
        union { bf16x8 v; uint2 u[2]; } a0, a1;
        a0.u[0] = *(const uint2*)(cur + 16384 + swz128(dv, (fq >> 1)) + (fq & 1) * 8);
        a0.u[1] = *(const uint2*)(cur + 16384 + swz128(dv, 2 + (fq >> 1)) + (fq & 1) * 8);
        a1.u[0] = *(const uint2*)(cur + 16384 + swz128(dv, 4 + (fq >> 1)) + (fq & 1) * 8);
        a1.u[1] = *(const uint2*)(cur + 16384 + swz128(dv, 6 + (fq >> 1)) + (fq & 1) * 8);
        O[0][v] = mfma16(a0.v, pb[0][0], O[0][v]);
        O[1][v] = mfma16(a0.v, pb[1][0], O[1][v]);
        O[0][v] = mfma16(a1.v, pb[0][1], O[0][v]);
        O[1][v] = mfma16(a1.v, pb[1][1], O[1][v]);
        if (v & 1) __builtin_amdgcn_sched_barrier(0);
      }
    }
    float l0 = xor_sum(xor_sum(lsum[0], 16), 32), l1 = xor_sum(xor_sum(lsum[1], 16), 32);
    const float i0 = 1.f / l0, i1 = lam / l1;
    float ssq = 0.f;
#pragma unroll
    for (int v = 0; v < 8; ++v)
#pragma unroll
      for (int j = 0; j < 4; ++j) { float o = O[0][v][j] * i0 - O[1][v][j] * i1; O[0][v][j] = o; ssq += o * o; }
    ssq = xor_sum(xor_sum(ssq, 16), 32);
    const float rs = rsqrtf(ssq * (1.f / 128.f) + 1e-6f) * (1.f - lam_init);
    u16* op = MIX + (size_t)(qrow0 + w * 16 + fr) * D + h * 128;
#pragma unroll
    for (int v = 0; v < 8; ++v) {
      int dv = v * 16 + fq * 4;
      float4 sw = *(const float4*)(subw + dv);
      uint2 o = {pk2(O[0][v][0] * rs * sw.x, O[0][v][1] * rs * sw.y), pk2(O[0][v][2] * rs * sw.z, O[0][v][3] * rs * sw.w)};
      *(uint2*)(op + dv) = o;
    }
  }
}

__device__ __forceinline__ void chunk_rows(int b, int cc_seq, int& row0, int& pos0) {
  if (cc_seq < 4) { row0 = ML + b * 256 + cc_seq * 64; pos0 = cc_seq * 64; }
  else { row0 = b * 4096 + (cc_seq - 4) * 64; pos0 = CTX + (cc_seq - 4) * 64; }
}
__device__ __forceinline__ int scan2tok(int c, int dir) {
  if (!dir) return c;
  return c < 4 ? 3 - c : 4 + 63 - (c - 4);
}

__device__ void hg_u_item(const P& p, int e, int item, char* smem) {
  const int tid = get_tid(), lane = tid & 63, wid = tid >> 6, wr = wid >> 1, wc = wid & 1, fr = lane & 15, fq = lane >> 4;
  const u16* PROJ = (const u16*)(p.ws + OFF_PROJ);
  const u16* IT = (const u16*)(p.ws + OFF_VT);
  float* U = (float*)(p.ws + OFF_U);
  float* DEC = (float*)(p.ws + OFF_DEC);
  const float* LB = (const float*)(p.ws + OFF_LB);
  const int c = item % NCH, seq = item / NCH, dir = seq & 1, h = (seq >> 1) & 3, b = seq >> 3;
  int row0, pos0;
  chunk_rows(b, scan2tok(c, dir), row0, pos0);
  float* tot = (float*)(smem + 16384);
  const int d = tid & 127, half = tid >> 7;
  const float lb = LB[(e * 2 + dir) * 512 + h * 128 + d];
  const u16* zp = PROJ + (size_t)row0 * 3072 + 1536 + dir * 512 + h * 128 + d;
  __syncthreads();
  float sum = 0.f;
#pragma unroll 8
  for (int i = 0; i < 32; ++i) {
    int tau = half * 32 + i, t = dir ? 63 - tau : tau;
    float f = lb + (1.f - lb) * sigm(bf2f(zp[(size_t)t * 3072]));
    sum += __logf(fmaxf(f, 1e-20f));
  }
  tot[half * 128 + d] = sum;
  __syncthreads();
  float rel = half ? 0.f : tot[128 + d];
#pragma unroll 8
  for (int i = 31; i >= 0; --i) {
    int tau = half * 32 + i, t = dir ? 63 - tau : tau;
    float f = lb + (1.f - lb) * sigm(bf2f(zp[(size_t)t * 3072]));
    float lf = __logf(fmaxf(f, 1e-20f));
    *(u16*)(smem + swz128(d, t >> 3) + (t & 7) * 2) = f2bf((1.f - f) * __expf(rel));
    rel += lf;
  }
  if (!half) DEC[(size_t)(seq * NCH + c) * 128 + d] = __expf(rel);
  __syncthreads();
  f32x4 acc[4][4];
#pragma unroll
  for (int m = 0; m < 4; ++m)
#pragma unroll
    for (int n = 0; n < 4; ++n) acc[m][n] = f32x4{0.f, 0.f, 0.f, 0.f};
  const u16* vb = IT + (size_t)((b * 4 + h) * 128) * TK + pos0;
#pragma unroll
  for (int ks = 0; ks < 2; ++ks) {
    bf16x8 a[4], bb[4];
#pragma unroll
    for (int m = 0; m < 4; ++m) a[m] = *(const bf16x8*)(vb + (size_t)(wr * 64 + m * 16 + fr) * TK + ks * 32 + fq * 8);
#pragma unroll
    for (int n = 0; n < 4; ++n) bb[n] = *(const bf16x8*)(smem + swz128(wc * 64 + n * 16 + fr, ks * 4 + fq));
#pragma unroll
    for (int m = 0; m < 4; ++m)
#pragma unroll
      for (int n = 0; n < 4; ++n) acc[m][n] = mfma16(a[m], bb[n], acc[m][n]);
  }
  float* up = U + (size_t)(seq * NCH + c) * 16384;
#pragma unroll
  for (int m = 0; m < 4; ++m)
#pragma unroll
    for (int n = 0; n < 4; ++n)
#pragma unroll
      for (int j = 0; j < 4; ++j) up[(wr * 64 + m * 16 + fq * 4 + j) * 128 + wc * 64 + n * 16 + fr] = acc[m][n][j];
}

__device__ void pool_item(const P& p, int item) {
  const int tid = get_tid();
  const u16* PROJ = (const u16*)(p.ws + OFF_PROJ);
  u16* PO = (u16*)(p.ws + OFF_POOLED);
  const int ch = tid * 2, g = ch >> 7, w = 2 << g;
  for (int i = 0; i < 32; ++i) {
    const int row = item * 32 + i;
    int base, n, pos;
    if (row < ML) { base = row & ~4095; n = 4096; pos = row & 4095; }
    else { base = ML + ((row - ML) & ~255); n = 256; pos = (row - ML) & 255; }
    const int lo = max(pos - w / 2, 0), hi = min(pos + w - w / 2, n);
    float s0 = 0.f, s1 = 0.f;
    for (int r = lo; r < hi; ++r) {
      unsigned v = *(const unsigned*)(PROJ + (size_t)(base + r) * 3072 + 2560 + ch);
      s0 += bf2f((u16)(v & 0xffff)); s1 += bf2f((u16)(v >> 16));
    }
    unsigned v = *(const unsigned*)(PROJ + (size_t)row * 3072 + 2560 + ch);
    const float ic = 1.f / (float)(hi - lo);
    *(unsigned*)(PO + (size_t)row * 512 + ch) = pk2(s0 * ic - bf2f((u16)(v & 0xffff)), s1 * ic - bf2f((u16)(v >> 16)));
  }
}

__device__ void hg_scan_item(const P& p, int item) {
  float* U = (float*)(p.ws + OFF_U);
  const float* DEC = (const float*)(p.ws + OFF_DEC);
  const int ei = item * 256 + get_tid(), seq = ei >> 14, vd = ei & 16383, d = vd & 127;
  float* up = U + (size_t)seq * NCH * 16384 + vd;
  const float* dp = DEC + (size_t)seq * NCH * 128 + d;
  float s = 0.f;
  for (int c = 0; c < NCH; c += 4) {
    float u0 = up[(size_t)c * 16384], u1 = up[(size_t)(c + 1) * 16384], u2 = up[(size_t)(c + 2) * 16384], u3 = up[(size_t)(c + 3) * 16384];
    float d0 = dp[c * 128], d1 = dp[(c + 1) * 128], d2 = dp[(c + 2) * 128], d3 = dp[(c + 3) * 128];
    up[(size_t)c * 16384] = s; s = d0 * s + u0;
    up[(size_t)(c + 1) * 16384] = s; s = d1 * s + u1;
    up[(size_t)(c + 2) * 16384] = s; s = d2 * s + u2;
    up[(size_t)(c + 3) * 16384] = s; s = d3 * s + u3;
  }
}

__device__ void hg_o_item(const P& p, int e, int item, char* smem) {
  const int tid = get_tid(), lane = tid & 63, w = tid >> 6, fr = lane & 15, fq = lane >> 4;
  const u16* PROJ = (const u16*)(p.ws + OFF_PROJ);
  const u16* IT = (const u16*)(p.ws + OFF_VT);
  const float* S = (const float*)(p.ws + OFF_U);
  const float* LB = (const float*)(p.ws + OFF_LB);
  u16* MIX = (u16*)(p.ws + OFF_MIX);
  const int tc = item % NCH, bh = item / NCH, h = bh & 3, b = bh >> 2;
  int row0, pos0;
  chunk_rows(b, tc, row0, pos0);
  char* qh = smem;
  char* kh = smem + 16384;
  char* vt = smem + 32768;
  float* eref = (float*)(smem + 49152);
  __syncthreads();
  {
    const u16* vb = IT + (size_t)((b * 4 + h) * 128) * TK + pos0;
#pragma unroll
    for (int i = 0; i < 4; ++i) {
      int q = tid + i * 256, dv = q >> 3, c2 = (q & 7) ^ ((dv >> 1) & 7);
      glds16(vb + (size_t)dv * TK + c2 * 8, vt + q * 16);
    }
  }
  f32x4 O[8];
#pragma unroll
  for (int v = 0; v < 8; ++v) O[v] = f32x4{0.f, 0.f, 0.f, 0.f};
  const int d = tid & 127, half = tid >> 7;
  for (int dir = 0; dir < 2; ++dir) {
    const int c = dir ? (tc < 4 ? 3 - tc : 4 + 63 - (tc - 4)) : tc;
    const int seq = (b * 4 + h) * 2 + dir;
    const float lb = LB[(e * 2 + dir) * 512 + h * 128 + d];
    const u16* zp = PROJ + (size_t)row0 * 3072 + 1536 + dir * 512 + h * 128 + d;
    const u16* qp = PROJ + (size_t)row0 * 3072 + h * 128 + d;
    if (dir) __syncthreads();
    float rel = 0.f;
    if (!half) {
#pragma unroll 8
      for (int tau = 31; tau >= 0; --tau) {
        int t = dir ? 63 - tau : tau;
        float f = lb + (1.f - lb) * sigm(bf2f(zp[(size_t)t * 3072]));
        float lf = __logf(fmaxf(f, 1e-20f));
        float q = bf2f(qp[(size_t)t * 3072]);
        int off = swz256(t, d >> 3) + (d & 7) * 2;
        *(u16*)(qh + off) = f2bf(q * __expf(rel));
        *(u16*)(kh + off) = f2bf((1.f - f) * __expf(-rel));
        rel -= lf;
      }
      eref[d] = __expf(-rel);
    } else {
#pragma unroll 8
      for (int tau = 32; tau < 64; ++tau) {
        int t = dir ? 63 - tau : tau;
        float f = lb + (1.f - lb) * sigm(bf2f(zp[(size_t)t * 3072]));
        float lf = __logf(fmaxf(f, 1e-20f));
        float q = bf2f(qp[(size_t)t * 3072]);
        rel += lf;
        int off = swz256(t, d >> 3) + (d & 7) * 2;
        *(u16*)(qh + off) = f2bf(q * __expf(rel));
        *(u16*)(kh + off) = f2bf((1.f - f) * __expf(-rel));
      }
    }
    __syncthreads();
    bf16x8 qf[4];
#pragma unroll
    for (int ks = 0; ks < 4; ++ks) qf[ks] = *(const bf16x8*)(qh + swz256(w * 16 + fr, ks * 4 + fq));
    f32x4 s[4];
#pragma unroll
    for (int sf = 0; sf < 4; ++sf) {
      s[sf] = f32x4{0.f, 0.f, 0.f, 0.f};
#pragma unroll
      for (int ks = 0; ks < 4; ++ks) {
        bf16x8 a = *(const bf16x8*)(kh + swz256(sf * 16 + fr, ks * 4 + fq));
        s[sf] = mfma16(a, qf[ks], s[sf]);
      }
    }
    const int tq = w * 16 + fr;
#pragma unroll
    for (int sf = 0; sf < 4; ++sf)
#pragma unroll
      for (int j = 0; j < 4; ++j) {
        int ss = sf * 16 + fq * 4 + j;
        bool keep = dir ? (ss >= tq) : (ss <= tq);
        s[sf][j] = keep ? s[sf][j] : 0.f;
      }
    bf16x8 pb[2];
#pragma unroll
    for (int k2 = 0; k2 < 2; ++k2) {
      union { bf16x8 v; unsigned u[4]; } t;
      t.u[0] = pk2(s[2 * k2][0], s[2 * k2][1]); t.u[1] = pk2(s[2 * k2][2], s[2 * k2][3]);
      t.u[2] = pk2(s[2 * k2 + 1][0], s[2 * k2 + 1][1]); t.u[3] = pk2(s[2 * k2 + 1][2], s[2 * k2 + 1][3]);
      pb[k2] = t.v;
    }
#pragma unroll
    for (int v = 0; v < 8; ++v)
#pragma unroll
      for (int k2 = 0; k2 < 2; ++k2) {
        const int dv = v * 16 + fr;
        union { bf16x8 v; uint2 u[2]; } a;
        a.u[0] = *(const uint2*)(vt + swz128(dv, k2 * 4 + (fq >> 1)) + (fq & 1) * 8);
        a.u[1] = *(const uint2*)(vt + swz128(dv, k2 * 4 + 2 + (fq >> 1)) + (fq & 1) * 8);
        O[v] = mfma16(a.v, pb[k2], O[v]);
      }
    const float* sp = S + (size_t)(seq * NCH + c) * 16384;
#pragma unroll
    for (int ks = 0; ks < 4; ++ks) {
      union { bf16x8 v; u16 h[8]; unsigned u[4]; } qq, qs;
      qq.v = qf[ks];
      const float* er = eref + ks * 32 + fq * 8;
#pragma unroll
      for (int i = 0; i < 4; ++i) qs.u[i] = pk2(bf2f(qq.h[2 * i]) * er[2 * i], bf2f(qq.h[2 * i + 1]) * er[2 * i + 1]);
#pragma unroll
      for (int v = 0; v < 8; ++v) {
        const float* g = sp + (v * 16 + fr) * 128 + ks * 32 + fq * 8;
        float4 x0 = *(const float4*)g, x1 = *(const float4*)(g + 4);
        union { bf16x8 v; unsigned u[4]; } a;
        a.u[0] = pk2(x0.x, x0.y); a.u[1] = pk2(x0.z, x0.w); a.u[2] = pk2(x1.x, x1.y); a.u[3] = pk2(x1.z, x1.w);
        O[v] = mfma16(a.v, qs.v, O[v]);
      }
    }
  }
  float ssq = 0.f;
#pragma unroll
  for (int v = 0; v < 8; ++v)
#pragma unroll
    for (int j = 0; j < 4; ++j) ssq += O[v][j] * O[v][j];
  ssq = xor_sum(xor_sum(ssq, 16), 32);
  const float rs = rsqrtf(ssq * (1.f / 128.f) + 1e-6f);
  const int row = row0 + w * 16 + fr;
  const float* nw = p.hg_norm_w + e * 128;
#pragma unroll
  for (int v = 0; v < 8; ++v) {
    int dv = v * 16 + fq * 4;
    uint2 gv = *(const uint2*)(PROJ + (size_t)row * 3072 + 1024 + h * 128 + dv);
    float4 n4 = *(const float4*)(nw + dv);
    float g0 = bf2f((u16)(gv.x & 0xffff)), g1 = bf2f((u16)(gv.x >> 16)), g2 = bf2f((u16)(gv.y & 0xffff)), g3 = bf2f((u16)(gv.y >> 16));
    uint2 o = {pk2(O[v][0] * rs * n4.x * silu(g0), O[v][1] * rs * n4.y * silu(g1)),
               pk2(O[v][2] * rs * n4.z * silu(g2), O[v][3] * rs * n4.w * silu(g3))};
    *(uint2*)(MIX + (size_t)row * D + h * 128 + dv) = o;
  }
}

constexpr int PH_PER_EVEN = 12, PH_PER_ODD = 10;
constexpr int N_PHASES = 2 + 2 * PH_PER_EVEN + 2 * PH_PER_ODD;

__device__ __forceinline__ void run_phase(const P& pin, int ph, char* smem) {
  P p = pin;
  asm volatile("" : "+s"(p.ws));
  asm volatile("" : "+s"(p.out));
  u16* H = (u16*)(p.ws + OFF_H);
  u16* HID = (u16*)(p.ws + OFF_HID);
  float* Y = (float*)(p.ws + OFF_Y);
  u16* PROJ = (u16*)(p.ws + OFF_PROJ);
  u16* VT = (u16*)(p.ws + OFF_VT);
  u16* MIX = (u16*)(p.ws + OFF_MIX);
  if (ph == 0) { phase_prep(p, smem); return; }
  if (ph == 1) { phase_rows(p, 0, 0, 0, MT, false); return; }
  int q = ph - 2, l;
  if (q < PH_PER_EVEN) l = 0;
  else if (q < PH_PER_EVEN + PH_PER_ODD) { l = 1; q -= PH_PER_EVEN; }
  else if (q < 2 * PH_PER_EVEN + PH_PER_ODD) { l = 2; q -= PH_PER_EVEN + PH_PER_ODD; }
  else { l = 3; q -= 2 * PH_PER_EVEN + PH_PER_ODD; }
  const bool even = !(l & 1), last = (l == 3);
  int step = q;
  if (!even && q >= 5) step = q + 2;
  const int Mpost = last ? ML : MT;
  const u16* WFI = (const u16*)(p.ws + OFF_WFI);
  const u16* WFO = (const u16*)(p.ws + OFF_WFO);
  switch (step) {
    case 0: gemm_phase(H, D, WFI + (size_t)(l * 2 + 0) * 5632 * 1024, MT, 5632, 1024, smem, EpiSwiglu{HID}); break;
    case 1: gemm_phase(HID, FH, WFO + (size_t)(l * 2 + 0) * 1024 * 2816, MT, 1024, 2816, smem, EpiF32{Y}); break;
    case 2: phase_rows(p, 1, l, 0, MT, false); break;
    case 3:
      if (even) gemm_phase(H, D, (const u16*)(p.ws + OFF_WMI) + (size_t)l * 3072 * 1024, MT, 3072, 1024, smem, EpiProjEven{PROJ, VT});
      else gemm_phase(H, D, (const u16*)(p.ws + OFF_WMI) + (size_t)l * 3072 * 1024, MT, 3072, 1024, smem,
                      EpiProjOdd{PROJ, VT, (const float*)(p.ws + OFF_ROPE)});
      break;
    case 4:
      if (even) {
        for (int it = blockIdx.x; it < 32 * NCH + MT / 32; it += gridDim.x) {
          if (it < 32 * NCH) hg_u_item(p, l >> 1, it, smem);
          else pool_item(p, it - 32 * NCH);
        }
      } else phase_attn(p, l, smem);
      break;
    case 5: {
      for (int it = blockIdx.x; it < 2048 + 4 * (MT / 128); it += gridDim.x) {
        if (it < 2048) hg_scan_item(p, it);
        else {
          int t = it - 2048, g = t / (MT / 128), mt = t % (MT / 128);
          gemm_tile((const u16*)(p.ws + OFF_POOLED) + g * 128, 512,
                    (const u16*)(p.ws + OFF_WPL) + (size_t)((l >> 1) * 4 + g) * 128 * 128, 128, 128, mt * 128, 0, smem,
                    EpiPool{MIX, p.pool_scale + (l >> 1) * 512, g});
        }
      }
    } break;
    case 6:
      for (int it = blockIdx.x; it < 16 * NCH; it += gridDim.x) hg_o_item(p, l >> 1, it, smem);
      break;
    case 7: gemm_phase(MIX, D, (const u16*)(p.ws + OFF_WMO) + (size_t)l * 1024 * 1024, Mpost, 1024, 1024, smem, EpiF32{Y}); break;
    case 8: phase_rows(p, 1, l, 1, Mpost, false); break;
    case 9: gemm_phase(H, D, WFI + (size_t)(l * 2 + 1) * 5632 * 1024, Mpost, 5632, 1024, smem, EpiSwiglu{HID}); break;
    case 10: gemm_phase(HID, FH, WFO + (size_t)(l * 2 + 1) * 1024 * 2816, Mpost, 1024, 2816, smem, EpiF32{Y}); break;
    case 11: phase_rows(p, 1, l, 2, Mpost, last); break;
  }
}

__global__ void __launch_bounds__(256, 2) mega(P p, int ph_lo, int ph_hi) {
  __shared__ __attribute__((aligned(16))) char smem[65536];
  for (int ph = ph_lo; ph < ph_hi; ++ph) {
    run_phase(p, ph, smem);
    if (ph + 1 < ph_hi) cg::this_grid().sync();
  }
}

extern "C" void kernel_launch(void* const* d_in, const int* in_sizes, int n_in, void* d_out, int out_size, void* d_ws,
                              size_t ws_size, hipStream_t stream) {
  static int grid_blocks = 0;
  if (!grid_blocks) {
    int dev = 0, cus = 0, per_cu = 0;
    hipGetDevice(&dev);
    hipDeviceGetAttribute(&cus, hipDeviceAttributeMultiprocessorCount, dev);
    hipOccupancyMaxActiveBlocksPerMultiprocessor(&per_cu, mega, 256, 0);
    if (per_cu > 2) per_cu = 2;
    grid_blocks = cus * per_cu;
  }
  if (ws_size < OFF_END) { fprintf(stderr, "workspace too small: %zu < %zu\n", ws_size, (size_t)OFF_END); return; }
  P p{};
  const float** f = (const float**)&p;
  for (int i = 0; i < 20; ++i) f[i] = (const float*)d_in[i];
  p.out = (float*)d_out;
  p.ws = (char*)d_ws;
#if MULTI_LAUNCH
  for (int ph = 0; ph < N_PHASES; ++ph) hipLaunchKernelGGL(mega, dim3(grid_blocks), dim3(256), 0, stream, p, ph, ph + 1);
#else
  int lo = 0, hi = N_PHASES;
  void* args[] = {&p, &lo, &hi};
  hipError_t e = hipLaunchCooperativeKernel((void*)mega, dim3(grid_blocks), dim3(256), args, 0, stream);
  if (e != hipSuccess) fprintf(stderr, "cooperative launch failed: %s (grid %d)\n", hipGetErrorString(e), grid_blocks);
#endif
}
```

```cpp
#include <hip/hip_runtime.h>
#include <hip/hip_cooperative_groups.h>
#include <cstdio>
namespace cg = cooperative_groups;

typedef __attribute__((ext_vector_type(8))) short bf16x8;
typedef __attribute__((ext_vector_type(4))) float f32x4;
typedef unsigned short u16;

#ifndef MULTI_LAUNCH
#define MULTI_LAUNCH 0
#endif

constexpr int D = 1024, NB = 4, SEQ = 4096, CTX = 256, FH = 2816;
constexpr int ML = NB * SEQ, MC = NB * CTX, MT = ML + MC;
constexpr int TK = CTX + SEQ;
constexpr int NCH = TK / 64;
constexpr float ALPHA = 1.6817928305074290f;
constexpr float LOG2E = 1.4426950408889634f;

constexpr size_t al256(size_t x) { return (x + 255) & ~(size_t)255; }
constexpr size_t OFF_WFI = 0;
constexpr size_t OFF_WFO = OFF_WFI + al256((size_t)4 * 2 * 5632 * 1024 * 2);
constexpr size_t OFF_WMI = OFF_WFO + al256((size_t)4 * 2 * 1024 * 2816 * 2);
constexpr size_t OFF_WMO = OFF_WMI + al256((size_t)4 * 3072 * 1024 * 2);
constexpr size_t OFF_WPL = OFF_WMO + al256((size_t)4 * 1024 * 1024 * 2);
constexpr size_t OFF_MODS = OFF_WPL + al256((size_t)2 * 4 * 128 * 128 * 2);
constexpr size_t OFF_LB = OFF_MODS + al256((size_t)4 * 5 * 9216 * 4);
constexpr size_t OFF_LAM = OFF_LB + al256((size_t)2 * 2 * 512 * 4);
constexpr size_t OFF_ROPE = OFF_LAM + 256;
constexpr size_t OFF_DEC = OFF_ROPE + al256((size_t)64 * 16 * 2 * 4);
constexpr size_t OFF_X = OFF_DEC + al256((size_t)32 * NCH * 128 * 4);
constexpr size_t OFF_H = OFF_X + al256((size_t)MT * 1024 * 4);
constexpr size_t OFF_PROJ = OFF_H + al256((size_t)MT * 1024 * 2);
constexpr size_t OFF_VT = OFF_PROJ + al256((size_t)MT * 3072 * 2);
constexpr size_t OFF_MIX = OFF_VT + al256((size_t)NB * 8 * 128 * TK * 2);
constexpr size_t OFF_POOLED = OFF_MIX + al256((size_t)MT * 1024 * 2);
constexpr size_t OFF_HID = OFF_POOLED + al256((size_t)MT * 512 * 2);
constexpr size_t OFF_Y = OFF_HID + al256((size_t)MT * FH * 2);
constexpr size_t OFF_END = OFF_Y + al256((size_t)MT * 1024 * 4);
constexpr size_t OFF_BAR = OFF_END;
constexpr size_t OFF_END2 = OFF_BAR + al256((size_t)3456 * 4);
constexpr size_t OFF_U = OFF_HID;
static_assert((size_t)32 * NCH * 16384 * 4 <= OFF_END - OFF_HID, "U alias too big");

struct P {
  const float *x, *c, *ctx, *c_ctx, *w_ada, *b_ada, *ln_g, *ln_b, *w_ffn_in, *w_ffn_out, *w_in_even, *w_out_even,
      *hg_lb, *hg_norm_w, *pool_w, *pool_scale, *w_in_odd, *w_out_odd, *da_lambda, *da_sub_w;
  float* out;
  char* ws;
};

__device__ __forceinline__ u16 f2bf(float f) {
  unsigned u = __float_as_uint(f);
  u += 0x7fffu + ((u >> 16) & 1u);
  return (u16)(u >> 16);
}
__device__ __forceinline__ float bf2f(u16 h) { return __uint_as_float(((unsigned)h) << 16); }
__device__ __forceinline__ unsigned pk2(float a, float b) { return (unsigned)f2bf(a) | ((unsigned)f2bf(b) << 16); }
__device__ __forceinline__ float sigm(float z) { return 1.f / (1.f + __expf(-z)); }
__device__ __forceinline__ float silu(float z) { return z / (1.f + __expf(-z)); }
__device__ __forceinline__ float ex2(float x) { return __builtin_amdgcn_exp2f(x); }
__device__ __forceinline__ void glds16(const void* g, void* l) {
  __builtin_amdgcn_global_load_lds((const unsigned*)g, (unsigned*)l, 16, 0, 0);
}
__device__ __forceinline__ int get_tid() { int t = threadIdx.x; asm volatile("" : "+v"(t)); return t; }
__device__ __forceinline__ int swz128(int row, int ch) { return row * 128 + ((ch ^ ((row >> 1) & 7)) << 4); }
__device__ __forceinline__ int swz256(int row, int ch) { return row * 256 + ((ch ^ (row & 15)) << 4); }
__device__ __forceinline__ f32x4 mfma16(bf16x8 a, bf16x8 b, f32x4 c) {
  return __builtin_amdgcn_mfma_f32_16x16x32_bf16(a, b, c, 0, 0, 0);
}
__device__ __forceinline__ float xor_sum(float v, int m) { return v + __shfl_xor(v, m, 64); }
__device__ __forceinline__ float xor_max(float v, int m) { return fmaxf(v, __shfl_xor(v, m, 64)); }
__device__ __forceinline__ void row_bpos(int row, int& b, int& pos) {
  if (row < ML) { b = row >> 12; pos = CTX + (row & 4095); }
  else { int r = row - ML; b = r >> 8; pos = r & 255; }
}
__device__ __forceinline__ int mod_row(int row) { return row < ML ? (row >> 12) : 4; }

constexpr int BM = 128, BN = 128, BK = 64;

template <class Epi>
__device__ __forceinline__ void gemm_tile(const u16* __restrict__ A, int lda, const u16* __restrict__ Bt, int ldb, int K,
                                          int m0, int n0, char* smem, const Epi& epi) {
  const int tid = get_tid(), lane = tid & 63, wid = tid >> 6, wr = wid >> 1, wc = wid & 1, fr = lane & 15, fq = lane >> 4;
  f32x4 acc[4][4];
#pragma unroll
  for (int m = 0; m < 4; ++m)
#pragma unroll
    for (int n = 0; n < 4; ++n) acc[m][n] = f32x4{0.f, 0.f, 0.f, 0.f};
  const int nk = K / BK;
  const u16* ga[4];
  const u16* gb[4];
#pragma unroll
  for (int i = 0; i < 4; ++i) {
    int q = tid + i * 256, row = q >> 3, ch = (q & 7) ^ ((row >> 1) & 7);
    ga[i] = A + (size_t)(m0 + row) * lda + ch * 8;
    gb[i] = Bt + (size_t)(n0 + row) * ldb + ch * 8;
  }
  __syncthreads();
#pragma unroll
  for (int i = 0; i < 4; ++i) {
    glds16(ga[i], smem + (tid + i * 256) * 16);
    glds16(gb[i], smem + 16384 + (tid + i * 256) * 16);
  }
  for (int kt = 0; kt < nk; ++kt) {
    __syncthreads();
    char* cur = smem + (kt & 1) * 32768;
    if (kt + 1 < nk) {
      char* nxt = smem + ((kt + 1) & 1) * 32768;
#pragma unroll
      for (int i = 0; i < 4; ++i) {
        glds16(ga[i] + (kt + 1) * BK, nxt + (tid + i * 256) * 16);
        glds16(gb[i] + (kt + 1) * BK, nxt + 16384 + (tid + i * 256) * 16);
      }
    }
#pragma unroll
    for (int ks = 0; ks < 2; ++ks) {
      bf16x8 a[4], b[4];
#pragma unroll
      for (int m = 0; m < 4; ++m) a[m] = *(const bf16x8*)(cur + swz128(wr * 64 + m * 16 + fr, ks * 4 + fq));
#pragma unroll
      for (int n = 0; n < 4; ++n) b[n] = *(const bf16x8*)(cur + 16384 + swz128(wc * 64 + n * 16 + fr, ks * 4 + fq));
#pragma unroll
      for (int m = 0; m < 4; ++m)
#pragma unroll
        for (int n = 0; n < 4; ++n) acc[m][n] = mfma16(b[n], a[m], acc[m][n]);
    }
  }
  epi(acc, m0 + wr * 64, n0 + wc * 64, fr, fq);
}

template <class Epi>
__device__ __forceinline__ void gemm_phase(const u16* A, int lda, const u16* Bt, int M, int N, int K, char* smem,
                                           const Epi& epi) {
  const int nM = M / BM, nN = N / BN, ntile = nM * nN;
  constexpr int WGM = 16;
  for (int t = blockIdx.x; t < ntile; t += gridDim.x) {
    int nig = WGM * nN, gid = t / nig, fm = gid * WGM, gsz = min(nM - fm, WGM);
    int pm = fm + (t % nig) % gsz, pn = (t % nig) / gsz;
    gemm_tile(A, lda, Bt, K, K, pm * BM, pn * BN, smem, epi);
  }
}

struct EpiSwiglu {
  u16* hid;
  __device__ __forceinline__ void operator()(f32x4 (&acc)[4][4], int rb, int cb, int fr, int fq) const {
#pragma unroll
    for (int m = 0; m < 4; ++m)
#pragma unroll
      for (int n = 0; n < 4; n += 2) {
        int row = rb + m * 16 + fr, hc = (cb >> 1) + (n >> 1) * 16 + fq * 4;
        uint2 v = {pk2(silu(acc[m][n][0]) * acc[m][n + 1][0], silu(acc[m][n][1]) * acc[m][n + 1][1]),
                   pk2(silu(acc[m][n][2]) * acc[m][n + 1][2], silu(acc[m][n][3]) * acc[m][n + 1][3])};
        *(uint2*)(hid + (size_t)row * FH + hc) = v;
      }
  }
};
struct EpiF32 {
  float* y;
  __device__ __forceinline__ void operator()(f32x4 (&acc)[4][4], int rb, int cb, int fr, int fq) const {
#pragma unroll
    for (int m = 0; m < 4; ++m)
#pragma unroll
      for (int n = 0; n < 4; ++n)
        *(float4*)(y + (size_t)(rb + m * 16 + fr) * D + cb + n * 16 + fq * 4) =
            float4{acc[m][n][0], acc[m][n][1], acc[m][n][2], acc[m][n][3]};
  }
};
struct EpiPool {
  u16* mix; const float* scale; int g;
  __device__ __forceinline__ void operator()(f32x4 (&acc)[4][4], int rb, int cb, int fr, int fq) const {
#pragma unroll
    for (int n = 0; n < 4; ++n) {
      int col = g * 128 + cb + n * 16 + fq * 4;
      float4 sc = *(const float4*)(scale + col);
#pragma unroll
      for (int m = 0; m < 4; ++m) {
        uint2 v = {pk2(acc[m][n][0] * sc.x, acc[m][n][1] * sc.y), pk2(acc[m][n][2] * sc.z, acc[m][n][3] * sc.w)};
        *(uint2*)(mix + (size_t)(rb + m * 16 + fr) * D + 512 + col) = v;
      }
    }
  }
};
__device__ __forceinline__ void store_vt(u16* vt, int nh, f32x4 (&acc)[4][4], int rb, int fcol0, int fr, int fq) {
#pragma unroll
  for (int m = 0; m < 4; ++m) {
    int row = rb + m * 16 + fr, b, pos;
    row_bpos(row, b, pos);
#pragma unroll
    for (int n = 0; n < 4; ++n) {
      int fc = fcol0 + n * 16 + fq * 4, h = fc >> 7, f = fc & 127;
      u16* o = vt + ((size_t)((b * nh + h) * 128 + f)) * TK + pos;
#pragma unroll
      for (int j = 0; j < 4; ++j) o[(size_t)j * TK] = f2bf(acc[m][n][j]);
    }
  }
}
struct EpiProjEven {
  u16* proj; u16* vt;
  __device__ __forceinline__ void operator()(f32x4 (&acc)[4][4], int rb, int cb, int fr, int fq) const {
    if (cb >= 512 && cb < 1024) { store_vt(vt, 4, acc, rb, cb - 512, fr, fq); return; }
    const float sc = (cb < 512) ? 0.08838834764831845f : 1.f;
#pragma unroll
    for (int m = 0; m < 4; ++m)
#pragma unroll
      for (int n = 0; n < 4; ++n) {
        uint2 v = {pk2(acc[m][n][0] * sc, acc[m][n][1] * sc), pk2(acc[m][n][2] * sc, acc[m][n][3] * sc)};
        *(uint2*)(proj + (size_t)(rb + m * 16 + fr) * 3072 + cb + n * 16 + fq * 4) = v;
      }
  }
};
struct EpiProjOdd {
  u16* proj; u16* vt; const float* rope;
  __device__ __forceinline__ void operator()(f32x4 (&acc)[4][4], int rb, int cb, int fr, int fq) const {
    if (cb >= 2048) { store_vt(vt, 8, acc, rb, cb - 2048, fr, fq); return; }
    const float sc = (cb < 1024) ? 0.125f * LOG2E : 1.f;
#pragma unroll
    for (int m = 0; m < 4; ++m) {
      int row = rb + m * 16 + fr;
      f32x4 v0 = acc[m][0], v1 = acc[m][1], v2 = acc[m][2], v3 = acc[m][3];
      if (row < ML) {
        int t = row & 4095, pr = t >> 6, pc = t & 63;
        const float* rr = rope + (pr * 16 + fq * 4) * 2;
        const float* rc = rope + (pc * 16 + fq * 4) * 2;
        float4 r0 = *(const float4*)rr, r1 = *(const float4*)(rr + 4), c0 = *(const float4*)rc, c1 = *(const float4*)(rc + 4);
        float cs[4] = {r0.x, r0.z, r1.x, r1.z}, sn[4] = {r0.y, r0.w, r1.y, r1.w};
        float cs2[4] = {c0.x, c0.z, c1.x, c1.z}, sn2[4] = {c0.y, c0.w, c1.y, c1.w};
#pragma unroll
        for (int j = 0; j < 4; ++j) {
          float a0 = v0[j] * cs[j] - v1[j] * sn[j], a1 = v1[j] * cs[j] + v0[j] * sn[j];
          float a2 = v2[j] * cs2[j] - v3[j] * sn2[j], a3 = v3[j] * cs2[j] + v2[j] * sn2[j];
          v0[j] = a0; v1[j] = a1; v2[j] = a2; v3[j] = a3;
        }
      }
      u16* o = proj + (size_t)row * 3072 + cb + fq * 4;
      *(uint2*)(o) = uint2{pk2(v0[0] * sc, v0[1] * sc), pk2(v0[2] * sc, v0[3] * sc)};
      *(uint2*)(o + 16) = uint2{pk2(v1[0] * sc, v1[1] * sc), pk2(v1[2] * sc, v1[3] * sc)};
      *(uint2*)(o + 32) = uint2{pk2(v2[0] * sc, v2[1] * sc), pk2(v2[2] * sc, v2[3] * sc)};
      *(uint2*)(o + 48) = uint2{pk2(v3[0] * sc, v3[1] * sc), pk2(v3[2] * sc, v3[3] * sc)};
    }
  }
};

__device__ __forceinline__ void convert_tile(const float* __restrict__ src, int K, int N, u16* __restrict__ dst, int tile,
                                             bool swiglu, char* smem) {
  float* t = (float*)smem;
  const int tid = get_tid();
  const int nN = N / 64, nt = tile % nN, kt = tile / nN, k0 = kt * 64, n0 = nt * 64;
  __syncthreads();
#pragma unroll
  for (int i = 0; i < 16; ++i) {
    int k = (tid >> 6) + 4 * i, n = tid & 63;
    t[k * 65 + n] = src[(size_t)(k0 + k) * N + n0 + n];
  }
  __syncthreads();
#pragma unroll
  for (int i = 0; i < 8; ++i) {
    int n = (tid >> 5) + 8 * i, k2 = (tid & 31) * 2;
    int c = n0 + n, nr = c;
    if (swiglu) nr = (c < FH) ? (32 * (c >> 4) + (c & 15)) : (32 * ((c - FH) >> 4) + 16 + ((c - FH) & 15));
    *(unsigned*)(dst + (size_t)nr * K + k0 + k2) = pk2(t[k2 * 65 + n], t[(k2 + 1) * 65 + n]);
  }
}

__device__ void phase_prep(const P& p, char* smem) {
  const int tid = get_tid();
  constexpr int N_ADA = 576, N_TR = 4 * 5248 + 32;
  for (int item = blockIdx.x; item < N_ADA + N_TR + 1; item += gridDim.x) {
    if (item < N_ADA) {
      float* act = (float*)smem;
      float* red = (float*)(smem + 20480);
      const int l = item / 144, cb = (item % 144) * 64;
      __syncthreads();
      for (int i = tid; i < 5120; i += 256) {
        int r = i >> 10, k = i & 1023;
        float v = r < 4 ? p.c[r * 1024 + k] : p.c_ctx[k];
        act[i] = silu(v);
      }
      __syncthreads();
      const int tx = tid & 63, kg = tid >> 6;
      float a0 = 0, a1 = 0, a2 = 0, a3 = 0, a4 = 0;
      const float* w = p.w_ada + ((size_t)l * 1024 + kg * 256) * 9216 + cb + tx;
#pragma unroll 8
      for (int k = 0; k < 256; ++k) {
        float wv = w[(size_t)k * 9216];
        int kk = kg * 256 + k;
        a0 += act[kk] * wv; a1 += act[1024 + kk] * wv; a2 += act[2048 + kk] * wv; a3 += act[3072 + kk] * wv;
        a4 += act[4096 + kk] * wv;
      }
      red[(kg * 5 + 0) * 64 + tx] = a0; red[(kg * 5 + 1) * 64 + tx] = a1; red[(kg * 5 + 2) * 64 + tx] = a2;
      red[(kg * 5 + 3) * 64 + tx] = a3; red[(kg * 5 + 4) * 64 + tx] = a4;
      __syncthreads();
      for (int i = tid; i < 320; i += 256) {
        int r = i >> 6, x = i & 63;
        float s = red[(0 * 5 + r) * 64 + x] + red[(1 * 5 + r) * 64 + x] + red[(2 * 5 + r) * 64 + x] + red[(3 * 5 + r) * 64 + x];
        ((float*)(p.ws + OFF_MODS))[(size_t)(l * 5 + r) * 9216 + cb + x] = s + p.b_ada[l * 9216 + cb + x];
      }
    } else if (item < N_ADA + N_TR) {
      int idx = item - N_ADA;
      if (idx < 4 * 5248) {
        int l = idx / 5248, r = idx % 5248;
        if (r < 2816) {
          int f = r / 1408, tile = r % 1408;
          convert_tile(p.w_ffn_in + (size_t)(l * 2 + f) * 1024 * 5632, 1024, 5632,
                       (u16*)(p.ws + OFF_WFI) + (size_t)(l * 2 + f) * 5632 * 1024, tile, true, smem);
        } else if (r < 4224) {
          int f = (r - 2816) / 704, tile = (r - 2816) % 704;
          convert_tile(p.w_ffn_out + (size_t)(l * 2 + f) * 2816 * 1024, 2816, 1024,
                       (u16*)(p.ws + OFF_WFO) + (size_t)(l * 2 + f) * 1024 * 2816, tile, false, smem);
        } else if (r < 4992) {
          const float* src = (l & 1) ? p.w_in_odd + (size_t)(l >> 1) * 1024 * 3072 : p.w_in_even + (size_t)(l >> 1) * 1024 * 3072;
          convert_tile(src, 1024, 3072, (u16*)(p.ws + OFF_WMI) + (size_t)l * 3072 * 1024, r - 4224, false, smem);
        } else {
          const float* src = (l & 1) ? p.w_out_odd + (size_t)(l >> 1) * 1024 * 1024 : p.w_out_even + (size_t)(l >> 1) * 1024 * 1024;
          convert_tile(src, 1024, 1024, (u16*)(p.ws + OFF_WMO) + (size_t)l * 1024 * 1024, r - 4992, false, smem);
        }
      } else {
        int i2 = idx - 4 * 5248, eg = i2 >> 2, tile = i2 & 3;
        convert_tile(p.pool_w + (size_t)eg * 128 * 128, 128, 128, (u16*)(p.ws + OFF_WPL) + (size_t)eg * 128 * 128, tile, false, smem);
      }
    } else {
      float* LB = (float*)(p.ws + OFF_LB);
      for (int i = tid; i < 1024; i += 256) {
        float a0 = p.hg_lb[i], a1 = p.hg_lb[1024 + i];
        float mx = fmaxf(a0, a1), e0 = __expf(a0 - mx), e1 = __expf(a1 - mx);
        LB[i] = 0.f;
        LB[1024 + i] = e1 / (e0 + e1);
      }
      if (tid < 2) {
        const float* lv = p.da_lambda + tid * 256;
        float s0 = 0, s1 = 0;
        for (int i = 0; i < 64; ++i) { s0 += lv[i] * lv[64 + i]; s1 += lv[128 + i] * lv[192 + i]; }
        float li = 0.8f - 0.6f * expf(-0.3f * (float)(2 * tid + 1));
        ((float*)(p.ws + OFF_LAM))[tid] = expf(s0) - expf(s1) + li;
      }
      float* rope = (float*)(p.ws + OFF_ROPE);
      for (int i = tid; i < 1024; i += 256) {
        int pos = i >> 4, fi = i & 15;
        float inv = exp2f(-(float)fi * (13.287712379549449f / 16.f));
        float ang = (float)pos * inv;
        float k = rintf(ang * 0.15915494309189535f);
        float r = fmaf(-k, 6.28125f, ang);
        r = fmaf(-k, 1.9353071795864769e-3f, r);
        rope[i * 2] = cosf(r);
        rope[i * 2 + 1] = sinf(r);
      }
    }
  }
}

__device__ void phase_rows(const P& p, int mode, int l, int sub, int M, bool final_out) {
  const int tid = get_tid(), lane = tid & 63, wid = tid >> 6;
  float* X = (float*)(p.ws + OFF_X);
  const float* Y = (const float*)(p.ws + OFF_Y);
  u16* H = (u16*)(p.ws + OFF_H);
  const float* MODS = (const float*)(p.ws + OFF_MODS);
  int nl, si;
  if (mode == 0) { nl = 0; si = 0; }
  else if (sub == 0) { nl = l; si = 3; }
  else if (sub == 1) { nl = l; si = 6; }
  else { nl = l + 1; si = 0; }
  const float gs = (sub == 1) ? 1.f : 0.5f;
  for (int row = blockIdx.x * 4 + wid; row < M; row += gridDim.x * 4) {
    const int mr = mod_row(row);
    float v[16];
    if (mode == 0) {
      const float* src = row < ML ? p.x + (size_t)row * D : p.ctx + (size_t)(row - ML) * D;
#pragma unroll
      for (int i = 0; i < 4; ++i) {
        float4 t = *(const float4*)(src + i * 256 + lane * 4);
        v[i * 4] = t.x; v[i * 4 + 1] = t.y; v[i * 4 + 2] = t.z; v[i * 4 + 3] = t.w;
      }
    } else {
      const float* gate = MODS + (size_t)(l * 5 + mr) * 9216 + (2 + 3 * sub) * 1024;
      float s = 0.f;
#pragma unroll
      for (int i = 0; i < 4; ++i) {
        int c = i * 256 + lane * 4;
        float4 xv = *(const float4*)(X + (size_t)row * D + c), yv = *(const float4*)(Y + (size_t)row * D + c);
        float4 gv = *(const float4*)(gate + c);
        v[i * 4] = ALPHA * xv.x + gs * gv.x * yv.x; v[i * 4 + 1] = ALPHA * xv.y + gs * gv.y * yv.y;
        v[i * 4 + 2] = ALPHA * xv.z + gs * gv.z * yv.z; v[i * 4 + 3] = ALPHA * xv.w + gs * gv.w * yv.w;
        s += v[i * 4] + v[i * 4 + 1] + v[i * 4 + 2] + v[i * 4 + 3];
      }
#pragma unroll
      for (int o = 1; o < 64; o <<= 1) s = xor_sum(s, o);
      const float mu = s * (1.f / 1024.f);
      float q = 0.f;
#pragma unroll
      for (int i = 0; i < 16; ++i) { v[i] -= mu; q += v[i] * v[i]; }
#pragma unroll
      for (int o = 1; o < 64; o <<= 1) q = xor_sum(q, o);
      const float rstd = rsqrtf(q * (1.f / 1024.f) + 1e-5f);
      const float* lg = p.ln_g + (size_t)(l * 3 + sub) * D;
      const float* lbp = p.ln_b + (size_t)(l * 3 + sub) * D;
#pragma unroll
      for (int i = 0; i < 4; ++i) {
        int c = i * 256 + lane * 4;
        float4 g4 = *(const float4*)(lg + c), b4 = *(const float4*)(lbp + c);
        v[i * 4] = v[i * 4] * rstd * g4.x + b4.x; v[i * 4 + 1] = v[i * 4 + 1] * rstd * g4.y + b4.y;
        v[i * 4 + 2] = v[i * 4 + 2] * rstd * g4.z + b4.z; v[i * 4 + 3] = v[i * 4 + 3] * rstd * g4.w + b4.w;
      }
    }
    if (final_out) {
#pragma unroll
      for (int i = 0; i < 4; ++i)
        *(float4*)(p.out + (size_t)row * D + i * 256 + lane * 4) = float4{v[i * 4], v[i * 4 + 1], v[i * 4 + 2], v[i * 4 + 3]};
      continue;
    }
    const float* sh = MODS + (size_t)(nl * 5 + mr) * 9216 + si * 1024;
#pragma unroll
    for (int i = 0; i < 4; ++i) {
      int c = i * 256 + lane * 4;
      *(float4*)(X + (size_t)row * D + c) = float4{v[i * 4], v[i * 4 + 1], v[i * 4 + 2], v[i * 4 + 3]};
      float4 s4 = *(const float4*)(sh + c), c4 = *(const float4*)(sh + 1024 + c);
      uint2 hv = {pk2(v[i * 4] * (1.f + c4.x) + s4.x, v[i * 4 + 1] * (1.f + c4.y) + s4.y),
                  pk2(v[i * 4 + 2] * (1.f + c4.z) + s4.z, v[i * 4 + 3] * (1.f + c4.w) + s4.w)};
      *(uint2*)(H + (size_t)row * D + c) = hv;
    }
  }
}

__device__ void phase_attn(const P& p, int l, char* smem) {
  const int tid = get_tid(), lane = tid & 63, w = tid >> 6, fr = lane & 15, fq = lane >> 4;
  const u16* PROJ = (const u16*)(p.ws + OFF_PROJ);
  const u16* VT = (const u16*)(p.ws + OFF_VT);
  u16* MIX = (u16*)(p.ws + OFF_MIX);
  const float lam = ((const float*)(p.ws + OFF_LAM))[l >> 1];
  const float lam_init = 0.8f - 0.6f * expf(-0.3f * (float)l);
  const float* subw = p.da_sub_w + (l >> 1) * 128;
  const int n_items = (l == 3) ? 2048 : 2176;
  for (int item = blockIdx.x; item < n_items; item += gridDim.x) {
    int b, h, qrow0, nkt;
    if (item < 2048) { b = item >> 9; h = (item >> 6) & 7; qrow0 = b * 4096 + (item & 63) * 64; nkt = 68; }
    else { int it = item - 2048; b = it >> 5; h = (it >> 2) & 7; qrow0 = ML + b * 256 + (it & 3) * 64; nkt = 4; }
    bf16x8 qf[2][2];
    {
      const u16* qp = PROJ + (size_t)(qrow0 + w * 16 + fr) * 3072 + h * 128 + fq * 8;
#pragma unroll
      for (int m = 0; m < 2; ++m)
#pragma unroll
        for (int ks = 0; ks < 2; ++ks) qf[m][ks] = *(const bf16x8*)(qp + m * 64 + ks * 32);
    }
    f32x4 O[2][8];
#pragma unroll
    for (int m = 0; m < 2; ++m)
#pragma unroll
      for (int v = 0; v < 8; ++v) O[m][v] = f32x4{0.f, 0.f, 0.f, 0.f};
    float mrun[2] = {-1e30f, -1e30f}, lsum[2] = {0.f, 0.f};
    const u16* vbase = VT + (size_t)((b * 8 + h) * 128) * TK;
    auto stage = [&](int kt, char* buf) {
      const int krow0 = kt < 4 ? ML + b * 256 + kt * 64 : b * 4096 + (kt - 4) * 64;
#pragma unroll
      for (int i = 0; i < 4; ++i) {
        int q = tid + i * 256;
        int key = q >> 4, ch = (q & 15) ^ (key & 15);
        glds16(PROJ + (size_t)(krow0 + key) * 3072 + 1024 + h * 128 + ch * 8, buf + q * 16);
        int dv = q >> 3, c2 = (q & 7) ^ ((dv >> 1) & 7);
        glds16(vbase + (size_t)dv * TK + kt * 64 + c2 * 8, buf + 16384 + q * 16);
      }
    };
    __syncthreads();
    stage(0, smem);
    for (int kt = 0; kt < nkt; ++kt) {
      __syncthreads();
      char* cur = smem + (kt & 1) * 32768;
      if (kt + 1 < nkt) stage(kt + 1, smem + ((kt + 1) & 1) * 32768);
      bf16x8 pb[2][2];
#pragma unroll
      for (int m = 0; m < 2; ++m) {
        f32x4 s[4];
#pragma unroll
        for (int sf = 0; sf < 4; ++sf) {
          s[sf] = f32x4{0.f, 0.f, 0.f, 0.f};
#pragma unroll
          for (int ks = 0; ks < 2; ++ks) {
            bf16x8 a = *(const bf16x8*)(cur + swz256(sf * 16 + fr, m * 8 + ks * 4 + fq));
            s[sf] = mfma16(a, qf[m][ks], s[sf]);
          }
        }
        float tm = -1e30f;
#pragma unroll
        for (int sf = 0; sf < 4; ++sf)
#pragma unroll
          for (int j = 0; j < 4; ++j) tm = fmaxf(tm, s[sf][j]);
        tm = xor_max(tm, 16); tm = xor_max(tm, 32);
        const float mn = fmaxf(mrun[m], tm), sc = ex2(mrun[m] - mn);
        mrun[m] = mn;
        float ps = 0.f;
#pragma unroll
        for (int sf = 0; sf < 4; ++sf)
#pragma unroll
          for (int j = 0; j < 4; ++j) { s[sf][j] = ex2(s[sf][j] - mn); ps += s[sf][j]; }
        lsum[m] = lsum[m] * sc + ps;
#pragma unroll
        for (int v = 0; v < 8; ++v) O[m][v] *= sc;
#pragma unroll
        for (int k2 = 0; k2 < 2; ++k2) {
          union { bf16x8 v; unsigned u[4]; } t;
          t.u[0] = pk2(s[2 * k2][0], s[2 * k2][1]); t.u[1] = pk2(s[2 * k2][2], s[2 * k2][3]);
          t.u[2] = pk2(s[2 * k2 + 1][0], s[2 * k2 + 1][1]); t.u[3] = pk2(s[2 * k2 + 1][2], s[2 * k2 + 1][3]);
          pb[m][k2] = t.v;
        }
      }
#pragma unroll
      for (int v = 0; v < 8; ++v) {
        const int dv = v * 16 + fr;
        union { bf16x8 v; uint2 u[2]; } a0, a1;
        a0.u[0] = *(const uint2*)(cur + 16384 + swz128(dv, (fq >> 1)) + (fq & 1) * 8);
        a0.u[1] = *(const uint2*)(cur + 16384 + swz128(dv, 2 + (fq >> 1)) + (fq & 1) * 8);
        a1.u[0] = *(const uint2*)(cur + 16384 + swz128(dv, 4 + (fq >> 1)) + (fq & 1) * 8);
        a1.u[1] = *(const uint2*)(cur + 16384 + swz128(dv, 6 + (fq >> 1)) + (fq & 1) * 8);
        O[0][v] = mfma16(a0.v, pb[0][0], O[0][v]);
        O[1][v] = mfma16(a0.v, pb[1][0], O[1][v]);
        O[0][v] = mfma16(a1.v, pb[0][1], O[0][v]);
        O[1][v] = mfma16(a1.v, pb[1][1], O[1][v]);
        if (v & 1) __builtin_amdgcn_sched_barrier(0);
      }
    }
    float l0 = xor_sum(xor_sum(lsum[0], 16), 32), l1 = xor_sum(xor_sum(lsum[1], 16), 32);
    const float i0 = 1.f / l0, i1 = lam / l1;
    float ssq = 0.f;
#pragma unroll
    for (int v = 0; v < 8; ++v)
#pragma unroll
      for (int j = 0; j < 4; ++j) { float o = O[0][v][j] * i0 - O[1][v][j] * i1; O[0][v][j] = o; ssq += o * o; }
    ssq = xor_sum(xor_sum(ssq, 16), 32);
    const float rs = rsqrtf(ssq * (1.f / 128.f) + 1e-6f) * (1.f - lam_init);
    u16* op = MIX + (size_t)(qrow0 + w * 16 + fr) * D + h * 128;
#pragma unroll
    for (int v = 0; v < 8; ++v) {
      int dv = v * 16 + fq * 4;
      float4 sw = *(const float4*)(subw + dv);
      uint2 o = {pk2(O[0][v][0] * rs * sw.x, O[0][v][1] * rs * sw.y), pk2(O[0][v][2] * rs * sw.z, O[0][v][3] * rs * sw.w)};
      *(uint2*)(op + dv) = o;
    }
  }
}

__device__ __forceinline__ void chunk_rows(int b, int cc_seq, int& row0, int& pos0) {
  if (cc_seq < 4) { row0 = ML + b * 256 + cc_seq * 64; pos0 = cc_seq * 64; }
  else { row0 = b * 4096 + (cc_seq - 4) * 64; pos0 = CTX + (cc_seq - 4) * 64; }
}
__device__ __forceinline__ int scan2tok(int c, int dir) {
  if (!dir) return c;
  return c < 4 ? 3 - c : 4 + 63 - (c - 4);
}

__device__ void hg_u_item(const P& p, int e, int item, char* smem) {
  const int tid = get_tid(), lane = tid & 63, wid = tid >> 6, wr = wid >> 1, wc = wid & 1, fr = lane & 15, fq = lane >> 4;
  const u16* PROJ = (const u16*)(p.ws + OFF_PROJ);
  const u16* IT = (const u16*)(p.ws + OFF_VT);
  float* U = (float*)(p.ws + OFF_U);
  float* DEC = (float*)(p.ws + OFF_DEC);
  const float* LB = (const float*)(p.ws + OFF_LB);
  const int c = item % NCH, seq = item / NCH, dir = seq & 1, h = (seq >> 1) & 3, b = seq >> 3;
  int row0, pos0;
  chunk_rows(b, scan2tok(c, dir), row0, pos0);
  float* tot = (float*)(smem + 16384);
  const int d = tid & 127, half = tid >> 7;
  const float lb = LB[(e * 2 + dir) * 512 + h * 128 + d];
  const u16* zp = PROJ + (size_t)row0 * 3072 + 1536 + dir * 512 + h * 128 + d;
  __syncthreads();
  float sum = 0.f;
#pragma unroll 8
  for (int i = 0; i < 32; ++i) {
    int tau = half * 32 + i, t = dir ? 63 - tau : tau;
    float f = lb + (1.f - lb) * sigm(bf2f(zp[(size_t)t * 3072]));
    sum += __logf(fmaxf(f, 1e-20f));
  }
  tot[half * 128 + d] = sum;
  __syncthreads();
  float rel = half ? 0.f : tot[128 + d];
#pragma unroll 8
  for (int i = 31; i >= 0; --i) {
    int tau = half * 32 + i, t = dir ? 63 - tau : tau;
    float f = lb + (1.f - lb) * sigm(bf2f(zp[(size_t)t * 3072]));
    float lf = __logf(fmaxf(f, 1e-20f));
    *(u16*)(smem + swz128(d, t >> 3) + (t & 7) * 2) = f2bf((1.f - f) * __expf(rel));
    rel += lf;
  }
  if (!half) DEC[(size_t)(seq * NCH + c) * 128 + d] = __expf(rel);
  __syncthreads();
  f32x4 acc[4][4];
#pragma unroll
  for (int m = 0; m < 4; ++m)
#pragma unroll
    for (int n = 0; n < 4; ++n) acc[m][n] = f32x4{0.f, 0.f, 0.f, 0.f};
  const u16* vb = IT + (size_t)((b * 4 + h) * 128) * TK + pos0;
#pragma unroll
  for (int ks = 0; ks < 2; ++ks) {
    bf16x8 a[4], bb[4];
#pragma unroll
    for (int m = 0; m < 4; ++m) a[m] = *(const bf16x8*)(vb + (size_t)(wr * 64 + m * 16 + fr) * TK + ks * 32 + fq * 8);
#pragma unroll
    for (int n = 0; n < 4; ++n) bb[n] = *(const bf16x8*)(smem + swz128(wc * 64 + n * 16 + fr, ks * 4 + fq));
#pragma unroll
    for (int m = 0; m < 4; ++m)
#pragma unroll
      for (int n = 0; n < 4; ++n) acc[m][n] = mfma16(a[m], bb[n], acc[m][n]);
  }
  float* up = U + (size_t)(seq * NCH + c) * 16384;
#pragma unroll
  for (int m = 0; m < 4; ++m)
#pragma unroll
    for (int n = 0; n < 4; ++n)
#pragma unroll
      for (int j = 0; j < 4; ++j) up[(wr * 64 + m * 16 + fq * 4 + j) * 128 + wc * 64 + n * 16 + fr] = acc[m][n][j];
}

__device__ void pool_item(const P& p, int item) {
  const int tid = get_tid();
  const u16* PROJ = (const u16*)(p.ws + OFF_PROJ);
  u16* PO = (u16*)(p.ws + OFF_POOLED);
  const int ch = tid * 2, g = ch >> 7, w = 2 << g;
  for (int i = 0; i < 32; ++i) {
    const int row = item * 32 + i;
    int base, n, pos;
    if (row < ML) { base = row & ~4095; n = 4096; pos = row & 4095; }
    else { base = ML + ((row - ML) & ~255); n = 256; pos = (row - ML) & 255; }
    const int lo = max(pos - w / 2, 0), hi = min(pos + w - w / 2, n);
    float s0 = 0.f, s1 = 0.f;
    for (int r = lo; r < hi; ++r) {
      unsigned v = *(const unsigned*)(PROJ + (size_t)(base + r) * 3072 + 2560 + ch);
      s0 += bf2f((u16)(v & 0xffff)); s1 += bf2f((u16)(v >> 16));
    }
    unsigned v = *(const unsigned*)(PROJ + (size_t)row * 3072 + 2560 + ch);
    const float ic = 1.f / (float)(hi - lo);
    *(unsigned*)(PO + (size_t)row * 512 + ch) = pk2(s0 * ic - bf2f((u16)(v & 0xffff)), s1 * ic - bf2f((u16)(v >> 16)));
  }
}

__device__ void hg_scan_item(const P& p, int item) {
  float* U = (float*)(p.ws + OFF_U);
  const float* DEC = (const float*)(p.ws + OFF_DEC);
  const int ei = item * 256 + get_tid(), seq = ei >> 14, vd = ei & 16383, d = vd & 127;
  float* up = U + (size_t)seq * NCH * 16384 + vd;
  const float* dp = DEC + (size_t)seq * NCH * 128 + d;
  float s = 0.f;
  for (int c = 0; c < NCH; c += 4) {
    float u0 = up[(size_t)c * 16384], u1 = up[(size_t)(c + 1) * 16384], u2 = up[(size_t)(c + 2) * 16384], u3 = up[(size_t)(c + 3) * 16384];
    float d0 = dp[c * 128], d1 = dp[(c + 1) * 128], d2 = dp[(c + 2) * 128], d3 = dp[(c + 3) * 128];
    up[(size_t)c * 16384] = s; s = d0 * s + u0;
    up[(size_t)(c + 1) * 16384] = s; s = d1 * s + u1;
    up[(size_t)(c + 2) * 16384] = s; s = d2 * s + u2;
    up[(size_t)(c + 3) * 16384] = s; s = d3 * s + u3;
  }
}

__device__ void hg_o_item(const P& p, int e, int item, char* smem) {
  const int tid = get_tid(), lane = tid & 63, w = tid >> 6, fr = lane & 15, fq = lane >> 4;
  const u16* PROJ = (const u16*)(p.ws + OFF_PROJ);
  const u16* IT = (const u16*)(p.ws + OFF_VT);
  const float* S = (const float*)(p.ws + OFF_U);
  const float* LB = (const float*)(p.ws + OFF_LB);
  u16* MIX = (u16*)(p.ws + OFF_MIX);
  const int tc = item % NCH, bh = item / NCH, h = bh & 3, b = bh >> 2;
  int row0, pos0;
  chunk_rows(b, tc, row0, pos0);
  char* qh = smem;
  char* kh = smem + 16384;
  char* vt = smem + 32768;
  float* eref = (float*)(smem + 49152);
  __syncthreads();
  {
    const u16* vb = IT + (size_t)((b * 4 + h) * 128) * TK + pos0;
#pragma unroll
    for (int i = 0; i < 4; ++i) {
      int q = tid + i * 256, dv = q >> 3, c2 = (q & 7) ^ ((dv >> 1) & 7);
      glds16(vb + (size_t)dv * TK + c2 * 8, vt + q * 16);
    }
  }
  f32x4 O[8];
#pragma unroll
  for (int v = 0; v < 8; ++v) O[v] = f32x4{0.f, 0.f, 0.f, 0.f};
  const int d = tid & 127, half = tid >> 7;
  for (int dir = 0; dir < 2; ++dir) {
    const int c = dir ? (tc < 4 ? 3 - tc : 4 + 63 - (tc - 4)) : tc;
    const int seq = (b * 4 + h) * 2 + dir;
    const float lb = LB[(e * 2 + dir) * 512 + h * 128 + d];
    const u16* zp = PROJ + (size_t)row0 * 3072 + 1536 + dir * 512 + h * 128 + d;
    const u16* qp = PROJ + (size_t)row0 * 3072 + h * 128 + d;
    if (dir) __syncthreads();
    float rel = 0.f;
    if (!half) {
#pragma unroll 8
      for (int tau = 31; tau >= 0; --tau) {
        int t = dir ? 63 - tau : tau;
        float f = lb + (1.f - lb) * sigm(bf2f(zp[(size_t)t * 3072]));
        float lf = __logf(fmaxf(f, 1e-20f));
        float q = bf2f(qp[(size_t)t * 3072]);
        int off = swz256(t, d >> 3) + (d & 7) * 2;
        *(u16*)(qh + off) = f2bf(q * __expf(rel));
        *(u16*)(kh + off) = f2bf((1.f - f) * __expf(-rel));
        rel -= lf;
      }
      eref[d] = __expf(-rel);
    } else {
#pragma unroll 8
      for (int tau = 32; tau < 64; ++tau) {
        int t = dir ? 63 - tau : tau;
        float f = lb + (1.f - lb) * sigm(bf2f(zp[(size_t)t * 3072]));
        float lf = __logf(fmaxf(f, 1e-20f));
        float q = bf2f(qp[(size_t)t * 3072]);
        rel += lf;
        int off = swz256(t, d >> 3) + (d & 7) * 2;
        *(u16*)(qh + off) = f2bf(q * __expf(rel));
        *(u16*)(kh + off) = f2bf((1.f - f) * __expf(-rel));
      }
    }
    __syncthreads();
    bf16x8 qf[4];
#pragma unroll
    for (int ks = 0; ks < 4; ++ks) qf[ks] = *(const bf16x8*)(qh + swz256(w * 16 + fr, ks * 4 + fq));
    f32x4 s[4];
#pragma unroll
    for (int sf = 0; sf < 4; ++sf) {
      s[sf] = f32x4{0.f, 0.f, 0.f, 0.f};
#pragma unroll
      for (int ks = 0; ks < 4; ++ks) {
        bf16x8 a = *(const bf16x8*)(kh + swz256(sf * 16 + fr, ks * 4 + fq));
        s[sf] = mfma16(a, qf[ks], s[sf]);
      }
    }
    const int tq = w * 16 + fr;
#pragma unroll
    for (int sf = 0; sf < 4; ++sf)
#pragma unroll
      for (int j = 0; j < 4; ++j) {
        int ss = sf * 16 + fq * 4 + j;
        bool keep = dir ? (ss >= tq) : (ss <= tq);
        s[sf][j] = keep ? s[sf][j] : 0.f;
      }
    bf16x8 pb[2];
#pragma unroll
    for (int k2 = 0; k2 < 2; ++k2) {
      union { bf16x8 v; unsigned u[4]; } t;
      t.u[0] = pk2(s[2 * k2][0], s[2 * k2][1]); t.u[1] = pk2(s[2 * k2][2], s[2 * k2][3]);
      t.u[2] = pk2(s[2 * k2 + 1][0], s[2 * k2 + 1][1]); t.u[3] = pk2(s[2 * k2 + 1][2], s[2 * k2 + 1][3]);
      pb[k2] = t.v;
    }
#pragma unroll
    for (int v = 0; v < 8; ++v)
#pragma unroll
      for (int k2 = 0; k2 < 2; ++k2) {
        const int dv = v * 16 + fr;
        union { bf16x8 v; uint2 u[2]; } a;
        a.u[0] = *(const uint2*)(vt + swz128(dv, k2 * 4 + (fq >> 1)) + (fq & 1) * 8);
        a.u[1] = *(const uint2*)(vt + swz128(dv, k2 * 4 + 2 + (fq >> 1)) + (fq & 1) * 8);
        O[v] = mfma16(a.v, pb[k2], O[v]);
      }
    const float* sp = S + (size_t)(seq * NCH + c) * 16384;
#pragma unroll
    for (int ks = 0; ks < 4; ++ks) {
      union { bf16x8 v; u16 h[8]; unsigned u[4]; } qq, qs;
      qq.v = qf[ks];
      const float* er = eref + ks * 32 + fq * 8;
#pragma unroll
      for (int i = 0; i < 4; ++i) qs.u[i] = pk2(bf2f(qq.h[2 * i]) * er[2 * i], bf2f(qq.h[2 * i + 1]) * er[2 * i + 1]);
#pragma unroll
      for (int v = 0; v < 8; ++v) {
        const float* g = sp + (v * 16 + fr) * 128 + ks * 32 + fq * 8;
        float4 x0 = *(const float4*)g, x1 = *(const float4*)(g + 4);
        union { bf16x8 v; unsigned u[4]; } a;
        a.u[0] = pk2(x0.x, x0.y); a.u[1] = pk2(x0.z, x0.w); a.u[2] = pk2(x1.x, x1.y); a.u[3] = pk2(x1.z, x1.w);
        O[v] = mfma16(a.v, qs.v, O[v]);
      }
    }
  }
  float ssq = 0.f;
#pragma unroll
  for (int v = 0; v < 8; ++v)
#pragma unroll
    for (int j = 0; j < 4; ++j) ssq += O[v][j] * O[v][j];
  ssq = xor_sum(xor_sum(ssq, 16), 32);
  const float rs = rsqrtf(ssq * (1.f / 128.f) + 1e-6f);
  const int row = row0 + w * 16 + fr;
  const float* nw = p.hg_norm_w + e * 128;
#pragma unroll
  for (int v = 0; v < 8; ++v) {
    int dv = v * 16 + fq * 4;
    uint2 gv = *(const uint2*)(PROJ + (size_t)row * 3072 + 1024 + h * 128 + dv);
    float4 n4 = *(const float4*)(nw + dv);
    float g0 = bf2f((u16)(gv.x & 0xffff)), g1 = bf2f((u16)(gv.x >> 16)), g2 = bf2f((u16)(gv.y & 0xffff)), g3 = bf2f((u16)(gv.y >> 16));
    uint2 o = {pk2(O[v][0] * rs * n4.x * silu(g0), O[v][1] * rs * n4.y * silu(g1)),
               pk2(O[v][2] * rs * n4.z * silu(g2), O[v][3] * rs * n4.w * silu(g3))};
    *(uint2*)(MIX + (size_t)row * D + h * 128 + dv) = o;
  }
}

#define XB_TMO      128
#define XB_XCNT(j)  (256  + 64 * (j))
#define XB_XSUB(j)  (1280 + 64 * (j))
#define XB_XGEN(j)  (2304 + 64 * (j))
#define XB_TOP      3328
#define XB_TOPGEN   3392
#define XCD_BAR_WORDS 3456
#define XB_SPIN_CAP (1u << 18)
__device__ __forceinline__ unsigned xb_ld(unsigned* p) { return __hip_atomic_load(p, __ATOMIC_RELAXED, __HIP_MEMORY_SCOPE_AGENT); }
__device__ __forceinline__ unsigned xb_add(unsigned* p, unsigned v) { return __hip_atomic_fetch_add(p, v, __ATOMIC_RELAXED, __HIP_MEMORY_SCOPE_AGENT); }
__device__ __forceinline__ unsigned xb_xcc_id() { return (unsigned)__builtin_amdgcn_s_getreg((3 << 11) | 20) & 0xFu; }
#define XB_SPIN(cond, bar) do { unsigned _sp = 0; while (cond) { __builtin_amdgcn_s_sleep(1); \
    if ((++_sp & 255u) == 0u) { if (xb_ld(&(bar)[XB_TMO])) break; if (_sp > XB_SPIN_CAP) { atomicAdd(&(bar)[XB_TMO], 1u); break; } } } } while (0)
struct GB { unsigned* bar; unsigned x, nloc, nx; };
__device__ __forceinline__ void gb_complete(unsigned* bar, unsigned x, unsigned& nloc, unsigned& nx) {
  const unsigned G = gridDim.x;
  unsigned sum, cnt, mine, sp = 0u;
  for (;;) {
    sum = 0u; cnt = 0u; mine = 0u;
#pragma unroll
    for (unsigned j = 0; j < 16; ++j) { const unsigned c = xb_ld(&bar[XB_XCNT(j)]); sum += c; cnt += (c > 0u) ? 1u : 0u; mine = (j == x) ? c : mine; }
    if (sum == G) break;
    __builtin_amdgcn_s_sleep(1);
    if ((++sp & 255u) == 0u) { if (xb_ld(&bar[XB_TMO])) break; if (sp > XB_SPIN_CAP) { atomicAdd(&bar[XB_TMO], 1u); break; } }
  }
  nloc = mine > 0u ? mine : 1u; nx = cnt > 0u ? cnt : 1u;
}
__device__ __forceinline__ void gbar(GB& b) {
  asm volatile("s_waitcnt vmcnt(0)" ::: "memory");
  __syncthreads();
  if (threadIdx.x == 0) {
    unsigned* bar = b.bar;
    __builtin_amdgcn_s_waitcnt(0);
    if (b.nloc == 0u) gb_complete(bar, b.x, b.nloc, b.nx);
    const unsigned nloc = b.nloc, nx = b.nx;
    const unsigned old = xb_add(&bar[XB_XSUB(b.x)], 1u);
    const unsigned gen = old / nloc;
    if (old + 1u == (gen + 1u) * nloc) {
      __builtin_amdgcn_fence(__ATOMIC_RELEASE, "agent");
      asm volatile("s_waitcnt vmcnt(0)" ::: "memory");
      const unsigned og = xb_add(&bar[XB_TOP], 1u);
      const unsigned tg = og / nx;
      if (og + 1u == (tg + 1u) * nx) xb_add(&bar[XB_TOPGEN], 1u);
      else XB_SPIN(xb_ld(&bar[XB_TOPGEN]) == tg, bar);
      __builtin_amdgcn_fence(__ATOMIC_ACQUIRE, "agent");
      xb_add(&bar[XB_XGEN(b.x)], 1u);
      asm volatile("s_waitcnt vmcnt(0)" ::: "memory");
    } else {
      XB_SPIN(xb_ld(&bar[XB_XGEN(b.x)]) == gen, bar);
      __builtin_amdgcn_fence(__ATOMIC_ACQUIRE, "agent");
      asm volatile("s_waitcnt vmcnt(0)" ::: "memory");
    }
  }
  __syncthreads();
}

constexpr int PH_PER_EVEN = 12, PH_PER_ODD = 10;
constexpr int N_PHASES = 2 + 2 * PH_PER_EVEN + 2 * PH_PER_ODD;

__device__ __forceinline__ void run_phase(const P& pin, int ph, char* smem) {
  P p = pin;
  asm volatile("" : "+s"(p.ws));
  asm volatile("" : "+s"(p.out));
  u16* H = (u16*)(p.ws + OFF_H);
  u16* HID = (u16*)(p.ws + OFF_HID);
  float* Y = (float*)(p.ws + OFF_Y);
  u16* PROJ = (u16*)(p.ws + OFF_PROJ);
  u16* VT = (u16*)(p.ws + OFF_VT);
  u16* MIX = (u16*)(p.ws + OFF_MIX);
  if (ph == 0) { phase_prep(p, smem); return; }
  if (ph == 1) { phase_rows(p, 0, 0, 0, MT, false); return; }
  int q = ph - 2, l;
  if (q < PH_PER_EVEN) l = 0;
  else if (q < PH_PER_EVEN + PH_PER_ODD) { l = 1; q -= PH_PER_EVEN; }
  else if (q < 2 * PH_PER_EVEN + PH_PER_ODD) { l = 2; q -= PH_PER_EVEN + PH_PER_ODD; }
  else { l = 3; q -= 2 * PH_PER_EVEN + PH_PER_ODD; }
  const bool even = !(l & 1), last = (l == 3);
  int step = q;
  if (!even && q >= 5) step = q + 2;
  const int Mpost = last ? ML : MT;
  const u16* WFI = (const u16*)(p.ws + OFF_WFI);
  const u16* WFO = (const u16*)(p.ws + OFF_WFO);
  switch (step) {
    case 0: gemm_phase(H, D, WFI + (size_t)(l * 2 + 0) * 5632 * 1024, MT, 5632, 1024, smem, EpiSwiglu{HID}); break;
    case 1: gemm_phase(HID, FH, WFO + (size_t)(l * 2 + 0) * 1024 * 2816, MT, 1024, 2816, smem, EpiF32{Y}); break;
    case 2: phase_rows(p, 1, l, 0, MT, false); break;
    case 3:
      if (even) gemm_phase(H, D, (const u16*)(p.ws + OFF_WMI) + (size_t)l * 3072 * 1024, MT, 3072, 1024, smem, EpiProjEven{PROJ, VT});
      else gemm_phase(H, D, (const u16*)(p.ws + OFF_WMI) + (size_t)l * 3072 * 1024, MT, 3072, 1024, smem,
                      EpiProjOdd{PROJ, VT, (const float*)(p.ws + OFF_ROPE)});
      break;
    case 4:
      if (even) {
        for (int it = blockIdx.x; it < 32 * NCH + MT / 32; it += gridDim.x) {
          if (it < 32 * NCH) hg_u_item(p, l >> 1, it, smem);
          else pool_item(p, it - 32 * NCH);
        }
      } else phase_attn(p, l, smem);
      break;
    case 5: {
      for (int it = blockIdx.x; it < 2048 + 4 * (MT / 128); it += gridDim.x) {
        if (it < 2048) hg_scan_item(p, it);
        else {
          int t = it - 2048, g = t / (MT / 128), mt = t % (MT / 128);
          gemm_tile((const u16*)(p.ws + OFF_POOLED) + g * 128, 512,
                    (const u16*)(p.ws + OFF_WPL) + (size_t)((l >> 1) * 4 + g) * 128 * 128, 128, 128, mt * 128, 0, smem,
                    EpiPool{MIX, p.pool_scale + (l >> 1) * 512, g});
        }
      }
    } break;
    case 6:
      for (int it = blockIdx.x; it < 16 * NCH; it += gridDim.x) hg_o_item(p, l >> 1, it, smem);
      break;
    case 7: gemm_phase(MIX, D, (const u16*)(p.ws + OFF_WMO) + (size_t)l * 1024 * 1024, Mpost, 1024, 1024, smem, EpiF32{Y}); break;
    case 8: phase_rows(p, 1, l, 1, Mpost, false); break;
    case 9: gemm_phase(H, D, WFI + (size_t)(l * 2 + 1) * 5632 * 1024, Mpost, 5632, 1024, smem, EpiSwiglu{HID}); break;
    case 10: gemm_phase(HID, FH, WFO + (size_t)(l * 2 + 1) * 1024 * 2816, Mpost, 1024, 2816, smem, EpiF32{Y}); break;
    case 11: phase_rows(p, 1, l, 2, Mpost, last); break;
  }
}

__global__ void __launch_bounds__(256, 2) mega(P p, int ph_lo, int ph_hi) {
  __shared__ __attribute__((aligned(16))) char smem[65536];
  GB gb;
  gb.bar = (unsigned*)(p.ws + OFF_BAR); gb.x = xb_xcc_id(); gb.nloc = 0u; gb.nx = 0u;
  if (threadIdx.x == 0) (void)xb_add(&gb.bar[XB_XCNT(gb.x)], 1u);
  for (int ph = ph_lo; ph < ph_hi; ++ph) {
    run_phase(p, ph, smem);
#ifdef DOUBLE_GEMM
    {
      int q = ph - 2, l = 0;
      if (ph >= 2) {
        if (q < 12) l = 0; else if (q < 22) { l = 1; q -= 12; } else if (q < 34) { l = 2; q -= 22; } else { l = 3; q -= 34; }
        int step = q; if ((l & 1) && q >= 5) step = q + 2;
        if (step == 0 || step == 1 || step == 3 || step == 7 || step == 9 || step == 10) run_phase(p, ph, smem);
      }
    }
#endif
#ifdef DOUBLE_ATT
    if (ph == 2 + 12 + 4 || ph == 2 + 34 + 4) run_phase(p, ph, smem);
#endif
    if (ph + 1 < ph_hi) {
      if (ph == ph_lo) cg::this_grid().sync();
      else gbar(gb);
    }
  }
}

extern "C" void kernel_launch(void* const* d_in, const int* in_sizes, int n_in, void* d_out, int out_size, void* d_ws,
                              size_t ws_size, hipStream_t stream) {
  static int grid_blocks = 0;
  if (!grid_blocks) {
    int dev = 0, cus = 0, per_cu = 0;
    hipGetDevice(&dev);
    hipDeviceGetAttribute(&cus, hipDeviceAttributeMultiprocessorCount, dev);
    hipOccupancyMaxActiveBlocksPerMultiprocessor(&per_cu, mega, 256, 0);
    if (per_cu > 2) per_cu = 2;
    grid_blocks = cus * per_cu;
  }
  if (ws_size < OFF_END2) { fprintf(stderr, "workspace too small: %zu < %zu\n", ws_size, (size_t)OFF_END); return; }
  P p{};
  const float** f = (const float**)&p;
  for (int i = 0; i < 20; ++i) f[i] = (const float*)d_in[i];
  p.out = (float*)d_out;
  p.ws = (char*)d_ws;
#if MULTI_LAUNCH
  for (int ph = 0; ph < N_PHASES; ++ph) hipLaunchKernelGGL(mega, dim3(grid_blocks), dim3(256), 0, stream, p, ph, ph + 1);
#else
  hipMemsetAsync((char*)d_ws + OFF_BAR, 0, XCD_BAR_WORDS * 4, stream);
  int lo = 0, hi = N_PHASES;
  void* args[] = {&p, &lo, &hi};
  hipError_t e = hipLaunchCooperativeKernel((void*)mega, dim3(grid_blocks), dim3(256), args, 0, stream);
  if (e != hipSuccess) fprintf(stderr, "cooperative launch failed: %s (grid %d)\n", hipGetErrorString(e), grid_blocks);
#endif
}
```

```cpp
#include <hip/hip_runtime.h>
#include <hip/hip_cooperative_groups.h>
#include <cstdio>
namespace cg = cooperative_groups;

typedef __attribute__((ext_vector_type(8))) short bf16x8;
typedef __attribute__((ext_vector_type(4))) float f32x4;
typedef unsigned short u16;

#ifndef MULTI_LAUNCH
#define MULTI_LAUNCH 0
#endif

constexpr int D = 1024, NB = 4, SEQ = 4096, CTX = 256, FH = 2816;
constexpr int ML = NB * SEQ, MC = NB * CTX, MT = ML + MC;
constexpr int TK = CTX + SEQ;
constexpr int NCH = TK / 64;
constexpr float ALPHA = 1.6817928305074290f;
constexpr float LOG2E = 1.4426950408889634f;

constexpr size_t al256(size_t x) { return (x + 255) & ~(size_t)255; }
constexpr size_t OFF_WFI = 0;
constexpr size_t OFF_WFO = OFF_WFI + al256((size_t)4 * 2 * 5632 * 1024 * 2);
constexpr size_t OFF_WMI = OFF_WFO + al256((size_t)4 * 2 * 1024 * 2816 * 2);
constexpr size_t OFF_WMO = OFF_WMI + al256((size_t)4 * 3072 * 1024 * 2);
constexpr size_t OFF_WPL = OFF_WMO + al256((size_t)4 * 1024 * 1024 * 2);
constexpr size_t OFF_MODS = OFF_WPL + al256((size_t)2 * 4 * 128 * 128 * 2);
constexpr size_t OFF_LB = OFF_MODS + al256((size_t)4 * 5 * 9216 * 4);
constexpr size_t OFF_LAM = OFF_LB + al256((size_t)2 * 2 * 512 * 4);
constexpr size_t OFF_ROPE = OFF_LAM + 256;
constexpr size_t OFF_DEC = OFF_ROPE + al256((size_t)64 * 16 * 2 * 4);
constexpr size_t OFF_X = OFF_DEC + al256((size_t)32 * NCH * 128 * 4);
constexpr size_t OFF_H = OFF_X + al256((size_t)MT * 1024 * 4);
constexpr size_t OFF_PROJ = OFF_H + al256((size_t)MT * 1024 * 2);
constexpr size_t OFF_VT = OFF_PROJ + al256((size_t)MT * 3072 * 2);
constexpr size_t OFF_MIX = OFF_VT + al256((size_t)NB * 8 * 128 * TK * 2);
constexpr size_t OFF_POOLED = OFF_MIX + al256((size_t)MT * 1024 * 2);
constexpr size_t OFF_HID = OFF_POOLED + al256((size_t)MT * 512 * 2);
constexpr size_t OFF_Y = OFF_HID + al256((size_t)MT * FH * 2);
constexpr size_t OFF_END = OFF_Y + al256((size_t)MT * 1024 * 4);
constexpr size_t OFF_BAR = OFF_END;
constexpr size_t OFF_END2 = OFF_BAR + al256((size_t)3456 * 4);
constexpr size_t OFF_U = OFF_HID;
static_assert((size_t)32 * NCH * 16384 * 4 <= OFF_END - OFF_HID, "U alias too big");

struct P {
  const float *x, *c, *ctx, *c_ctx, *w_ada, *b_ada, *ln_g, *ln_b, *w_ffn_in, *w_ffn_out, *w_in_even, *w_out_even,
      *hg_lb, *hg_norm_w, *pool_w, *pool_scale, *w_in_odd, *w_out_odd, *da_lambda, *da_sub_w;
  float* out;
  char* ws;
};

__device__ __forceinline__ u16 f2bf(float f) {
  unsigned u = __float_as_uint(f);
  u += 0x7fffu + ((u >> 16) & 1u);
  return (u16)(u >> 16);
}
__device__ __forceinline__ float bf2f(u16 h) { return __uint_as_float(((unsigned)h) << 16); }
__device__ __forceinline__ unsigned pk2(float a, float b) { return (unsigned)f2bf(a) | ((unsigned)f2bf(b) << 16); }
__device__ __forceinline__ float sigm(float z) { return 1.f / (1.f + __expf(-z)); }
__device__ __forceinline__ float silu(float z) { return z / (1.f + __expf(-z)); }
__device__ __forceinline__ float ex2(float x) { return __builtin_amdgcn_exp2f(x); }
__device__ __forceinline__ void glds16(const void* g, void* l) {
  __builtin_amdgcn_global_load_lds((const unsigned*)g, (unsigned*)l, 16, 0, 0);
}
__device__ __forceinline__ int get_tid() { int t = threadIdx.x; asm volatile("" : "+v"(t)); return t; }
__device__ __forceinline__ int swz128(int row, int ch) { return row * 128 + ((ch ^ ((row >> 1) & 7)) << 4); }
__device__ __forceinline__ int swz256(int row, int ch) { return row * 256 + ((ch ^ (row & 15)) << 4); }
__device__ __forceinline__ f32x4 mfma16(bf16x8 a, bf16x8 b, f32x4 c) {
  return __builtin_amdgcn_mfma_f32_16x16x32_bf16(a, b, c, 0, 0, 0);
}
__device__ __forceinline__ float xor_sum(float v, int m) { return v + __shfl_xor(v, m, 64); }
__device__ __forceinline__ float xor_max(float v, int m) { return fmaxf(v, __shfl_xor(v, m, 64)); }
__device__ __forceinline__ void row_bpos(int row, int& b, int& pos) {
  if (row < ML) { b = row >> 12; pos = CTX + (row & 4095); }
  else { int r = row - ML; b = r >> 8; pos = r & 255; }
}
__device__ __forceinline__ int mod_row(int row) { return row < ML ? (row >> 12) : 4; }

constexpr int BM = 128, BN = 128, BK = 64;

template <class Epi>
__device__ __forceinline__ void gemm_tile(const u16* __restrict__ A, int lda, const u16* __restrict__ Bt, int ldb, int K,
                                          int m0, int n0, char* smem, const Epi& epi) {
  const int tid = get_tid(), lane = tid & 63, wid = tid >> 6, wr = wid >> 1, wc = wid & 1, fr = lane & 15, fq = lane >> 4;
  f32x4 acc[4][4];
#pragma unroll
  for (int m = 0; m < 4; ++m)
#pragma unroll
    for (int n = 0; n < 4; ++n) acc[m][n] = f32x4{0.f, 0.f, 0.f, 0.f};
  const int nk = K / BK;
  const u16* ga[4];
  const u16* gb[4];
#pragma unroll
  for (int i = 0; i < 4; ++i) {
    int q = tid + i * 256, row = q >> 3, ch = (q & 7) ^ ((row >> 1) & 7);
    ga[i] = A + (size_t)(m0 + row) * lda + ch * 8;
    gb[i] = Bt + (size_t)(n0 + row) * ldb + ch * 8;
  }
  __syncthreads();
#pragma unroll
  for (int i = 0; i < 4; ++i) {
    glds16(ga[i], smem + (tid + i * 256) * 16);
    glds16(gb[i], smem + 16384 + (tid + i * 256) * 16);
  }
  for (int kt = 0; kt < nk; ++kt) {
    __syncthreads();
    char* cur = smem + (kt & 1) * 32768;
    if (kt + 1 < nk) {
      char* nxt = smem + ((kt + 1) & 1) * 32768;
#pragma unroll
      for (int i = 0; i < 4; ++i) {
        glds16(ga[i] + (kt + 1) * BK, nxt + (tid + i * 256) * 16);
        glds16(gb[i] + (kt + 1) * BK, nxt + 16384 + (tid + i * 256) * 16);
      }
    }
#pragma unroll
    for (int ks = 0; ks < 2; ++ks) {
      bf16x8 a[4], b[4];
#pragma unroll
      for (int m = 0; m < 4; ++m) a[m] = *(const bf16x8*)(cur + swz128(wr * 64 + m * 16 + fr, ks * 4 + fq));
#pragma unroll
      for (int n = 0; n < 4; ++n) b[n] = *(const bf16x8*)(cur + 16384 + swz128(wc * 64 + n * 16 + fr, ks * 4 + fq));
#pragma unroll
      for (int m = 0; m < 4; ++m)
#pragma unroll
        for (int n = 0; n < 4; ++n) acc[m][n] = mfma16(b[n], a[m], acc[m][n]);
    }
  }
  epi(acc, m0 + wr * 64, n0 + wc * 64, fr, fq);
}

template <class Epi>
__device__ __forceinline__ void gemm_phase(const u16* A, int lda, const u16* Bt, int M, int N, int K, char* smem,
                                           const Epi& epi) {
  const int nM = M / BM, nN = N / BN, ntile = nM * nN;
  constexpr int WGM = 16;
  for (int t = blockIdx.x; t < ntile; t += gridDim.x) {
    int nig = WGM * nN, gid = t / nig, fm = gid * WGM, gsz = min(nM - fm, WGM);
    int pm = fm + (t % nig) % gsz, pn = (t % nig) / gsz;
    gemm_tile(A, lda, Bt, K, K, pm * BM, pn * BN, smem, epi);
  }
}

struct EpiSwiglu {
  u16* hid;
  __device__ __forceinline__ void operator()(f32x4 (&acc)[4][4], int rb, int cb, int fr, int fq) const {
#pragma unroll
    for (int m = 0; m < 4; ++m)
#pragma unroll
      for (int n = 0; n < 4; n += 2) {
        int row = rb + m * 16 + fr, hc = (cb >> 1) + (n >> 1) * 16 + fq * 4;
        uint2 v = {pk2(silu(acc[m][n][0]) * acc[m][n + 1][0], silu(acc[m][n][1]) * acc[m][n + 1][1]),
                   pk2(silu(acc[m][n][2]) * acc[m][n + 1][2], silu(acc[m][n][3]) * acc[m][n + 1][3])};
        *(uint2*)(hid + (size_t)row * FH + hc) = v;
      }
  }
};
struct EpiF32 {
  u16* y;
  __device__ __forceinline__ void operator()(f32x4 (&acc)[4][4], int rb, int cb, int fr, int fq) const {
#pragma unroll
    for (int m = 0; m < 4; ++m)
#pragma unroll
      for (int n = 0; n < 4; ++n)
        *(uint2*)(y + (size_t)(rb + m * 16 + fr) * D + cb + n * 16 + fq * 4) =
            uint2{pk2(acc[m][n][0], acc[m][n][1]), pk2(acc[m][n][2], acc[m][n][3])};
  }
};
struct EpiPool {
  u16* mix; const float* scale; int g;
  __device__ __forceinline__ void operator()(f32x4 (&acc)[4][4], int rb, int cb, int fr, int fq) const {
#pragma unroll
    for (int n = 0; n < 4; ++n) {
      int col = g * 128 + cb + n * 16 + fq * 4;
      float4 sc = *(const float4*)(scale + col);
#pragma unroll
      for (int m = 0; m < 4; ++m) {
        uint2 v = {pk2(acc[m][n][0] * sc.x, acc[m][n][1] * sc.y), pk2(acc[m][n][2] * sc.z, acc[m][n][3] * sc.w)};
        *(uint2*)(mix + (size_t)(rb + m * 16 + fr) * D + 512 + col) = v;
      }
    }
  }
};
__device__ __forceinline__ void store_vt(u16* vt, int nh, f32x4 (&acc)[4][4], int rb, int fcol0, int fr, int fq) {
#pragma unroll
  for (int m = 0; m < 4; ++m) {
    int row = rb + m * 16 + fr, b, pos;
    row_bpos(row, b, pos);
#pragma unroll
    for (int n = 0; n < 4; ++n) {
      int fc = fcol0 + n * 16 + fq * 4, h = fc >> 7, f = fc & 127;
      u16* o = vt + ((size_t)((b * nh + h) * 128 + f)) * TK + pos;
#pragma unroll
      for (int j = 0; j < 4; ++j) o[(size_t)j * TK] = f2bf(acc[m][n][j]);
    }
  }
}
struct EpiProjEven {
  u16* proj; u16* vt;
  __device__ __forceinline__ void operator()(f32x4 (&acc)[4][4], int rb, int cb, int fr, int fq) const {
    if (cb >= 512 && cb < 1024) { store_vt(vt, 4, acc, rb, cb - 512, fr, fq); return; }
    const float sc = (cb < 512) ? 0.08838834764831845f : 1.f;
#pragma unroll
    for (int m = 0; m < 4; ++m)
#pragma unroll
      for (int n = 0; n < 4; ++n) {
        uint2 v = {pk2(acc[m][n][0] * sc, acc[m][n][1] * sc), pk2(acc[m][n][2] * sc, acc[m][n][3] * sc)};
        *(uint2*)(proj + (size_t)(rb + m * 16 + fr) * 3072 + cb + n * 16 + fq * 4) = v;
      }
  }
};
struct EpiProjOdd {
  u16* proj; u16* vt; const float* rope;
  __device__ __forceinline__ void operator()(f32x4 (&acc)[4][4], int rb, int cb, int fr, int fq) const {
    if (cb >= 2048) { store_vt(vt, 8, acc, rb, cb - 2048, fr, fq); return; }
    const float sc = (cb < 1024) ? 0.125f * LOG2E : 1.f;
#pragma unroll
    for (int m = 0; m < 4; ++m) {
      int row = rb + m * 16 + fr;
      f32x4 v0 = acc[m][0], v1 = acc[m][1], v2 = acc[m][2], v3 = acc[m][3];
      if (row < ML) {
        int t = row & 4095, pr = t >> 6, pc = t & 63;
        const float* rr = rope + (pr * 16 + fq * 4) * 2;
        const float* rc = rope + (pc * 16 + fq * 4) * 2;
        float4 r0 = *(const float4*)rr, r1 = *(const float4*)(rr + 4), c0 = *(const float4*)rc, c1 = *(const float4*)(rc + 4);
        float cs[4] = {r0.x, r0.z, r1.x, r1.z}, sn[4] = {r0.y, r0.w, r1.y, r1.w};
        float cs2[4] = {c0.x, c0.z, c1.x, c1.z}, sn2[4] = {c0.y, c0.w, c1.y, c1.w};
#pragma unroll
        for (int j = 0; j < 4; ++j) {
          float a0 = v0[j] * cs[j] - v1[j] * sn[j], a1 = v1[j] * cs[j] + v0[j] * sn[j];
          float a2 = v2[j] * cs2[j] - v3[j] * sn2[j], a3 = v3[j] * cs2[j] + v2[j] * sn2[j];
          v0[j] = a0; v1[j] = a1; v2[j] = a2; v3[j] = a3;
        }
      }
      u16* o = proj + (size_t)row * 3072 + cb + fq * 4;
      *(uint2*)(o) = uint2{pk2(v0[0] * sc, v0[1] * sc), pk2(v0[2] * sc, v0[3] * sc)};
      *(uint2*)(o + 16) = uint2{pk2(v1[0] * sc, v1[1] * sc), pk2(v1[2] * sc, v1[3] * sc)};
      *(uint2*)(o + 32) = uint2{pk2(v2[0] * sc, v2[1] * sc), pk2(v2[2] * sc, v2[3] * sc)};
      *(uint2*)(o + 48) = uint2{pk2(v3[0] * sc, v3[1] * sc), pk2(v3[2] * sc, v3[3] * sc)};
    }
  }
};

__device__ __forceinline__ void convert_tile(const float* __restrict__ src, int K, int N, u16* __restrict__ dst, int tile,
                                             bool swiglu, char* smem) {
  float* t = (float*)smem;
  const int tid = get_tid();
  const int nN = N / 64, nt = tile % nN, kt = tile / nN, k0 = kt * 64, n0 = nt * 64;
  __syncthreads();
#pragma unroll
  for (int i = 0; i < 4; ++i) {
    int k = (tid >> 4) + 16 * i, n4 = (tid & 15) * 4;
    float4 v = *(const float4*)(src + (size_t)(k0 + k) * N + n0 + n4);
    t[k * 65 + n4] = v.x; t[k * 65 + n4 + 1] = v.y; t[k * 65 + n4 + 2] = v.z; t[k * 65 + n4 + 3] = v.w;
  }
  __syncthreads();
#pragma unroll
  for (int i = 0; i < 2; ++i) {
    int q = tid + i * 256, n = q >> 3, kc = (q & 7) * 8;
    int c = n0 + n, nr = c;
    if (swiglu) nr = (c < FH) ? (32 * (c >> 4) + (c & 15)) : (32 * ((c - FH) >> 4) + 16 + ((c - FH) & 15));
    uint4 o = {pk2(t[kc * 65 + n], t[(kc + 1) * 65 + n]), pk2(t[(kc + 2) * 65 + n], t[(kc + 3) * 65 + n]),
               pk2(t[(kc + 4) * 65 + n], t[(kc + 5) * 65 + n]), pk2(t[(kc + 6) * 65 + n], t[(kc + 7) * 65 + n])};
    *(uint4*)(dst + (size_t)nr * K + k0 + kc) = o;
  }
}

__device__ void phase_prep(const P& p, char* smem) {
  const int tid = get_tid();
  constexpr int N_ADA = 576, N_TR = 4 * 5248 + 32;
  for (int item = blockIdx.x; item < N_ADA + N_TR + 1; item += gridDim.x) {
    if (item < N_ADA) {
      float* act = (float*)smem;
      float* red = (float*)(smem + 20480);
      const int l = item / 144, cb = (item % 144) * 64;
      __syncthreads();
      for (int i = tid; i < 5120; i += 256) {
        int r = i >> 10, k = i & 1023;
        float v = r < 4 ? p.c[r * 1024 + k] : p.c_ctx[k];
        act[i] = silu(v);
      }
      __syncthreads();
      const int tx = tid & 63, kg = tid >> 6;
      float a0 = 0, a1 = 0, a2 = 0, a3 = 0, a4 = 0;
      const float* w = p.w_ada + ((size_t)l * 1024 + kg * 256) * 9216 + cb + tx;
#pragma unroll 8
      for (int k = 0; k < 256; ++k) {
        float wv = w[(size_t)k * 9216];
        int kk = kg * 256 + k;
        a0 += act[kk] * wv; a1 += act[1024 + kk] * wv; a2 += act[2048 + kk] * wv; a3 += act[3072 + kk] * wv;
        a4 += act[4096 + kk] * wv;
      }
      red[(kg * 5 + 0) * 64 + tx] = a0; red[(kg * 5 + 1) * 64 + tx] = a1; red[(kg * 5 + 2) * 64 + tx] = a2;
      red[(kg * 5 + 3) * 64 + tx] = a3; red[(kg * 5 + 4) * 64 + tx] = a4;
      __syncthreads();
      for (int i = tid; i < 320; i += 256) {
        int r = i >> 6, x = i & 63;
        float s = red[(0 * 5 + r) * 64 + x] + red[(1 * 5 + r) * 64 + x] + red[(2 * 5 + r) * 64 + x] + red[(3 * 5 + r) * 64 + x];
        ((float*)(p.ws + OFF_MODS))[(size_t)(l * 5 + r) * 9216 + cb + x] = s + p.b_ada[l * 9216 + cb + x];
      }
    } else if (item < N_ADA + N_TR) {
      int idx = item - N_ADA;
      if (idx < 4 * 5248) {
        int l = idx / 5248, r = idx % 5248;
        if (r < 2816) {
          int f = r / 1408, tile = r % 1408;
          convert_tile(p.w_ffn_in + (size_t)(l * 2 + f) * 1024 * 5632, 1024, 5632,
                       (u16*)(p.ws + OFF_WFI) + (size_t)(l * 2 + f) * 5632 * 1024, tile, true, smem);
        } else if (r < 4224) {
          int f = (r - 2816) / 704, tile = (r - 2816) % 704;
          convert_tile(p.w_ffn_out + (size_t)(l * 2 + f) * 2816 * 1024, 2816, 1024,
                       (u16*)(p.ws + OFF_WFO) + (size_t)(l * 2 + f) * 1024 * 2816, tile, false, smem);
        } else if (r < 4992) {
          const float* src = (l & 1) ? p.w_in_odd + (size_t)(l >> 1) * 1024 * 3072 : p.w_in_even + (size_t)(l >> 1) * 1024 * 3072;
          convert_tile(src, 1024, 3072, (u16*)(p.ws + OFF_WMI) + (size_t)l * 3072 * 1024, r - 4224, false, smem);
        } else {
          const float* src = (l & 1) ? p.w_out_odd + (size_t)(l >> 1) * 1024 * 1024 : p.w_out_even + (size_t)(l >> 1) * 1024 * 1024;
          convert_tile(src, 1024, 1024, (u16*)(p.ws + OFF_WMO) + (size_t)l * 1024 * 1024, r - 4992, false, smem);
        }
      } else {
        int i2 = idx - 4 * 5248, eg = i2 >> 2, tile = i2 & 3;
        convert_tile(p.pool_w + (size_t)eg * 128 * 128, 128, 128, (u16*)(p.ws + OFF_WPL) + (size_t)eg * 128 * 128, tile, false, smem);
      }
    } else {
      float* LB = (float*)(p.ws + OFF_LB);
      for (int i = tid; i < 1024; i += 256) {
        float a0 = p.hg_lb[i], a1 = p.hg_lb[1024 + i];
        float mx = fmaxf(a0, a1), e0 = __expf(a0 - mx), e1 = __expf(a1 - mx);
        LB[i] = 0.f;
        LB[1024 + i] = e1 / (e0 + e1);
      }
      if (tid < 2) {
        const float* lv = p.da_lambda + tid * 256;
        float s0 = 0, s1 = 0;
        for (int i = 0; i < 64; ++i) { s0 += lv[i] * lv[64 + i]; s1 += lv[128 + i] * lv[192 + i]; }
        float li = 0.8f - 0.6f * expf(-0.3f * (float)(2 * tid + 1));
        ((float*)(p.ws + OFF_LAM))[tid] = expf(s0) - expf(s1) + li;
      }
      float* rope = (float*)(p.ws + OFF_ROPE);
      for (int i = tid; i < 1024; i += 256) {
        int pos = i >> 4, fi = i & 15;
        float inv = exp2f(-(float)fi * (13.287712379549449f / 16.f));
        float ang = (float)pos * inv;
        float k = rintf(ang * 0.15915494309189535f);
        float r = fmaf(-k, 6.28125f, ang);
        r = fmaf(-k, 1.9353071795864769e-3f, r);
        rope[i * 2] = cosf(r);
        rope[i * 2 + 1] = sinf(r);
      }
    }
  }
}

__device__ void phase_rows(const P& p, int mode, int l, int sub, int M, bool final_out) {
  const int tid = get_tid(), lane = tid & 63, wid = tid >> 6;
  float* X = (float*)(p.ws + OFF_X);
  const u16* Y = (const u16*)(p.ws + OFF_Y);
  u16* H = (u16*)(p.ws + OFF_H);
  const float* MODS = (const float*)(p.ws + OFF_MODS);
  int nl, si;
  if (mode == 0) { nl = 0; si = 0; }
  else if (sub == 0) { nl = l; si = 3; }
  else if (sub == 1) { nl = l; si = 6; }
  else { nl = l + 1; si = 0; }
  const float gs = (sub == 1) ? 1.f : 0.5f;
  const float* lg = p.ln_g + (size_t)(l * 3 + sub) * D;
  const float* lbp = p.ln_b + (size_t)(l * 3 + sub) * D;
  for (int row0 = (blockIdx.x * 4 + wid) * 2; row0 < M; row0 += gridDim.x * 8) {
    const int mr = mod_row(row0);
    float v[2][16];
    if (mode == 0) {
#pragma unroll
      for (int r = 0; r < 2; ++r) {
        const int row = row0 + r;
        const float* src = row < ML ? p.x + (size_t)row * D : p.ctx + (size_t)(row - ML) * D;
#pragma unroll
        for (int i = 0; i < 4; ++i) {
          float4 t = *(const float4*)(src + i * 256 + lane * 4);
          v[r][i * 4] = t.x; v[r][i * 4 + 1] = t.y; v[r][i * 4 + 2] = t.z; v[r][i * 4 + 3] = t.w;
        }
      }
    } else {
      const float* gate = MODS + (size_t)(l * 5 + mr) * 9216 + (2 + 3 * sub) * 1024;
      float4 xv[2][4]; uint2 yv[2][4]; float4 gv[4];
#pragma unroll
      for (int r = 0; r < 2; ++r)
#pragma unroll
        for (int i = 0; i < 4; ++i) {
          int c = i * 256 + lane * 4;
          xv[r][i] = *(const float4*)(X + (size_t)(row0 + r) * D + c);
          yv[r][i] = *(const uint2*)(Y + (size_t)(row0 + r) * D + c);
        }
#pragma unroll
      for (int i = 0; i < 4; ++i) gv[i] = *(const float4*)(gate + i * 256 + lane * 4);
      float s[2] = {0.f, 0.f};
#pragma unroll
      for (int r = 0; r < 2; ++r)
#pragma unroll
        for (int i = 0; i < 4; ++i) {
          float y0 = bf2f((u16)(yv[r][i].x & 0xffff)), y1 = bf2f((u16)(yv[r][i].x >> 16));
          float y2 = bf2f((u16)(yv[r][i].y & 0xffff)), y3 = bf2f((u16)(yv[r][i].y >> 16));
          v[r][i * 4] = ALPHA * xv[r][i].x + gs * gv[i].x * y0; v[r][i * 4 + 1] = ALPHA * xv[r][i].y + gs * gv[i].y * y1;
          v[r][i * 4 + 2] = ALPHA * xv[r][i].z + gs * gv[i].z * y2; v[r][i * 4 + 3] = ALPHA * xv[r][i].w + gs * gv[i].w * y3;
          s[r] += v[r][i * 4] + v[r][i * 4 + 1] + v[r][i * 4 + 2] + v[r][i * 4 + 3];
        }
#pragma unroll
      for (int o = 1; o < 64; o <<= 1) { s[0] = xor_sum(s[0], o); s[1] = xor_sum(s[1], o); }
      float q[2] = {0.f, 0.f};
#pragma unroll
      for (int r = 0; r < 2; ++r) {
        const float mu = s[r] * (1.f / 1024.f);
#pragma unroll
        for (int i = 0; i < 16; ++i) { v[r][i] -= mu; q[r] += v[r][i] * v[r][i]; }
      }
#pragma unroll
      for (int o = 1; o < 64; o <<= 1) { q[0] = xor_sum(q[0], o); q[1] = xor_sum(q[1], o); }
#pragma unroll
      for (int i = 0; i < 4; ++i) {
        int c = i * 256 + lane * 4;
        float4 g4 = *(const float4*)(lg + c), b4 = *(const float4*)(lbp + c);
#pragma unroll
        for (int r = 0; r < 2; ++r) {
          const float rstd = rsqrtf(q[r] * (1.f / 1024.f) + 1e-5f);
          v[r][i * 4] = v[r][i * 4] * rstd * g4.x + b4.x; v[r][i * 4 + 1] = v[r][i * 4 + 1] * rstd * g4.y + b4.y;
          v[r][i * 4 + 2] = v[r][i * 4 + 2] * rstd * g4.z + b4.z; v[r][i * 4 + 3] = v[r][i * 4 + 3] * rstd * g4.w + b4.w;
        }
      }
    }
    if (final_out) {
#pragma unroll
      for (int r = 0; r < 2; ++r)
#pragma unroll
        for (int i = 0; i < 4; ++i)
          *(float4*)(p.out + (size_t)(row0 + r) * D + i * 256 + lane * 4) =
              float4{v[r][i * 4], v[r][i * 4 + 1], v[r][i * 4 + 2], v[r][i * 4 + 3]};
      continue;
    }
    const float* sh = MODS + (size_t)(nl * 5 + mr) * 9216 + si * 1024;
#pragma unroll
    for (int i = 0; i < 4; ++i) {
      int c = i * 256 + lane * 4;
      float4 s4 = *(const float4*)(sh + c), c4 = *(const float4*)(sh + 1024 + c);
#pragma unroll
      for (int r = 0; r < 2; ++r) {
        *(float4*)(X + (size_t)(row0 + r) * D + c) = float4{v[r][i * 4], v[r][i * 4 + 1], v[r][i * 4 + 2], v[r][i * 4 + 3]};
        uint2 hv = {pk2(v[r][i * 4] * (1.f + c4.x) + s4.x, v[r][i * 4 + 1] * (1.f + c4.y) + s4.y),
                    pk2(v[r][i * 4 + 2] * (1.f + c4.z) + s4.z, v[r][i * 4 + 3] * (1.f + c4.w) + s4.w)};
        *(uint2*)(H + (size_t)(row0 + r) * D + c) = hv;
      }
    }
  }
}

__device__ void phase_attn(const P& p, int l, char* smem) {
  const int tid = get_tid(), lane = tid & 63, w = tid >> 6, fr = lane & 15, fq = lane >> 4;
  const u16* PROJ = (const u16*)(p.ws + OFF_PROJ);
  const u16* VT = (const u16*)(p.ws + OFF_VT);
  u16* MIX = (u16*)(p.ws + OFF_MIX);
  const float lam = ((const float*)(p.ws + OFF_LAM))[l >> 1];
  const float lam_init = 0.8f - 0.6f * expf(-0.3f * (float)l);
  const float* subw = p.da_sub_w + (l >> 1) * 128;
  const int n_items = (l == 3) ? 2048 : 2176;
  for (int item = blockIdx.x; item < n_items; item += gridDim.x) {
    int b, h, qrow0, nkt;
    if (item < 2048) { b = item >> 9; h = (item >> 6) & 7; qrow0 = b * 4096 + (item & 63) * 64; nkt = 68; }
    else { int it = item - 2048; b = it >> 5; h = (it >> 2) & 7; qrow0 = ML + b * 256 + (it & 3) * 64; nkt = 4; }
    bf16x8 qf[2][2];
    {
      const u16* qp = PROJ + (size_t)(qrow0 + w * 16 + fr) * 3072 + h * 128 + fq * 8;
#pragma unroll
      for (int m = 0; m < 2; ++m)
#pragma unroll
        for (int ks = 0; ks < 2; ++ks) qf[m][ks] = *(const bf16x8*)(qp + m * 64 + ks * 32);
    }
    f32x4 O[2][8];
#pragma unroll
    for (int m = 0; m < 2; ++m)
#pragma unroll
      for (int v = 0; v < 8; ++v) O[m][v] = f32x4{0.f, 0.f, 0.f, 0.f};
    float mrun[2] = {-1e30f, -1e30f}, lsum[2] = {0.f, 0.f};
    const u16* vbase = VT + (size_t)((b * 8 + h) * 128) * TK;
    auto stage = [&](int kt, char* buf) {
      const int krow0 = kt < 4 ? ML + b * 256 + kt * 64 : b * 4096 + (kt - 4) * 64;
#pragma unroll
      for (int i = 0; i < 4; ++i) {
        int q = tid + i * 256;
        int key = q >> 4, ch = (q & 15) ^ (key & 15);
        glds16(PROJ + (size_t)(krow0 + key) * 3072 + 1024 + h * 128 + ch * 8, buf + q * 16);
        int dv = q >> 3, c2 = (q & 7) ^ ((dv >> 1) & 7);
        glds16(vbase + (size_t)dv * TK + kt * 64 + c2 * 8, buf + 16384 + q * 16);
      }
    };
    __syncthreads();
    stage(0, smem);
    for (int kt = 0; kt < nkt; ++kt) {
      __syncthreads();
      char* cur = smem + (kt & 1) * 32768;
      if (kt + 1 < nkt) stage(kt + 1, smem + ((kt + 1) & 1) * 32768);
      bf16x8 pb[2][2];
#pragma unroll
      for (int m = 0; m < 2; ++m) {
        f32x4 s[4];
#pragma unroll
        for (int sf = 0; sf < 4; ++sf) {
          s[sf] = f32x4{0.f, 0.f, 0.f, 0.f};
#pragma unroll
          for (int ks = 0; ks < 2; ++ks) {
            bf16x8 a = *(const bf16x8*)(cur + swz256(sf * 16 + fr, m * 8 + ks * 4 + fq));
            s[sf] = mfma16(a, qf[m][ks], s[sf]);
          }
        }
        float tm = -1e30f;
#pragma unroll
        for (int sf = 0; sf < 4; ++sf)
#pragma unroll
          for (int j = 0; j < 4; ++j) tm = fmaxf(tm, s[sf][j]);
        tm = xor_max(tm, 16); tm = xor_max(tm, 32);
        const float mn = fmaxf(mrun[m], tm), sc = ex2(mrun[m] - mn);
        mrun[m] = mn;
        float ps = 0.f;
#pragma unroll
        for (int sf = 0; sf < 4; ++sf)
#pragma unroll
          for (int j = 0; j < 4; ++j) { s[sf][j] = ex2(s[sf][j] - mn); ps += s[sf][j]; }
        lsum[m] = lsum[m] * sc + ps;
#pragma unroll
        for (int v = 0; v < 8; ++v) O[m][v] *= sc;
#pragma unroll
        for (int k2 = 0; k2 < 2; ++k2) {
          union { bf16x8 v; unsigned u[4]; } t;
          t.u[0] = pk2(s[2 * k2][0], s[2 * k2][1]); t.u[1] = pk2(s[2 * k2][2], s[2 * k2][3]);
          t.u[2] = pk2(s[2 * k2 + 1][0], s[2 * k2 + 1][1]); t.u[3] = pk2(s[2 * k2 + 1][2], s[2 * k2 + 1][3]);
          pb[m][k2] = t.v;
        }
      }
#pragma unroll
      for (int v = 0; v < 8; ++v) {
        const int dv = v * 16 + fr;
        union { bf16x8 v; uint2 u[2]; } a0, a1;
        a0.u[0] = *(const uint2*)(cur + 16384 + swz128(dv, (fq >> 1)) + (fq & 1) * 8);
        a0.u[1] = *(const uint2*)(cur + 16384 + swz128(dv, 2 + (fq >> 1)) + (fq & 1) * 8);
        a1.u[0] = *(const uint2*)(cur + 16384 + swz128(dv, 4 + (fq >> 1)) + (fq & 1) * 8);
        a1.u[1] = *(const uint2*)(cur + 16384 + swz128(dv, 6 + (fq >> 1)) + (fq & 1) * 8);
        O[0][v] = mfma16(a0.v, pb[0][0], O[0][v]);
        O[1][v] = mfma16(a0.v, pb[1][0], O[1][v]);
        O[0][v] = mfma16(a1.v, pb[0][1], O[0][v]);
        O[1][v] = mfma16(a1.v, pb[1][1], O[1][v]);
        if (v & 1) __builtin_amdgcn_sched_barrier(0);
      }
    }
    float l0 = xor_sum(xor_sum(lsum[0], 16), 32), l1 = xor_sum(xor_sum(lsum[1], 16), 32);
    const float i0 = 1.f / l0, i1 = lam / l1;
    float ssq = 0.f;
#pragma unroll
    for (int v = 0; v < 8; ++v)
#pragma unroll
      for (int j = 0; j < 4; ++j) { float o = O[0][v][j] * i0 - O[1][v][j] * i1; O[0][v][j] = o; ssq += o * o; }
    ssq = xor_sum(xor_sum(ssq, 16), 32);
    const float rs = rsqrtf(ssq * (1.f / 128.f) + 1e-6f) * (1.f - lam_init);
    u16* op = MIX + (size_t)(qrow0 + w * 16 + fr) * D + h * 128;
#pragma unroll
    for (int v = 0; v < 8; ++v) {
      int dv = v * 16 + fq * 4;
      float4 sw = *(const float4*)(subw + dv);
      uint2 o = {pk2(O[0][v][0] * rs * sw.x, O[0][v][1] * rs * sw.y), pk2(O[0][v][2] * rs * sw.z, O[0][v][3] * rs * sw.w)};
      *(uint2*)(op + dv) = o;
    }
  }
}

__device__ __forceinline__ void chunk_rows(int b, int cc_seq, int& row0, int& pos0) {
  if (cc_seq < 4) { row0 = ML + b * 256 + cc_seq * 64; pos0 = cc_seq * 64; }
  else { row0 = b * 4096 + (cc_seq - 4) * 64; pos0 = CTX + (cc_seq - 4) * 64; }
}
__device__ __forceinline__ int scan2tok(int c, int dir) {
  if (!dir) return c;
  return c < 4 ? 3 - c : 4 + 63 - (c - 4);
}

__device__ void hg_u_item(const P& p, int e, int item, char* smem) {
  const int tid = get_tid(), lane = tid & 63, wid = tid >> 6, wr = wid >> 1, wc = wid & 1, fr = lane & 15, fq = lane >> 4;
  const u16* PROJ = (const u16*)(p.ws + OFF_PROJ);
  const u16* IT = (const u16*)(p.ws + OFF_VT);
  float* U = (float*)(p.ws + OFF_U);
  float* DEC = (float*)(p.ws + OFF_DEC);
  const float* LB = (const float*)(p.ws + OFF_LB);
  const int c = item % NCH, seq = item / NCH, dir = seq & 1, h = (seq >> 1) & 3, b = seq >> 3;
  int row0, pos0;
  chunk_rows(b, scan2tok(c, dir), row0, pos0);
  float* tot = (float*)(smem + 16384);
  const int d = tid & 127, half = tid >> 7;
  const float lb = LB[(e * 2 + dir) * 512 + h * 128 + d];
  const u16* zp = PROJ + (size_t)row0 * 3072 + 1536 + dir * 512 + h * 128 + d;
  __syncthreads();
  float sum = 0.f;
#pragma unroll 8
  for (int i = 0; i < 32; ++i) {
    int tau = half * 32 + i, t = dir ? 63 - tau : tau;
    float f = lb + (1.f - lb) * sigm(bf2f(zp[(size_t)t * 3072]));
    sum += __logf(fmaxf(f, 1e-20f));
  }
  tot[half * 128 + d] = sum;
  __syncthreads();
  float rel = half ? 0.f : tot[128 + d];
#pragma unroll 8
  for (int i = 31; i >= 0; --i) {
    int tau = half * 32 + i, t = dir ? 63 - tau : tau;
    float f = lb + (1.f - lb) * sigm(bf2f(zp[(size_t)t * 3072]));
    float lf = __logf(fmaxf(f, 1e-20f));
    *(u16*)(smem + swz128(d, t >> 3) + (t & 7) * 2) = f2bf((1.f - f) * __expf(rel));
    rel += lf;
  }
  if (!half) DEC[(size_t)(seq * NCH + c) * 128 + d] = __expf(rel);
  __syncthreads();
  f32x4 acc[4][4];
#pragma unroll
  for (int m = 0; m < 4; ++m)
#pragma unroll
    for (int n = 0; n < 4; ++n) acc[m][n] = f32x4{0.f, 0.f, 0.f, 0.f};
  const u16* vb = IT + (size_t)((b * 4 + h) * 128) * TK + pos0;
#pragma unroll
  for (int ks = 0; ks < 2; ++ks) {
    bf16x8 a[4], bb[4];
#pragma unroll
    for (int m = 0; m < 4; ++m) a[m] = *(const bf16x8*)(vb + (size_t)(wr * 64 + m * 16 + fr) * TK + ks * 32 + fq * 8);
#pragma unroll
    for (int n = 0; n < 4; ++n) bb[n] = *(const bf16x8*)(smem + swz128(wc * 64 + n * 16 + fr, ks * 4 + fq));
#pragma unroll
    for (int m = 0; m < 4; ++m)
#pragma unroll
      for (int n = 0; n < 4; ++n) acc[m][n] = mfma16(a[m], bb[n], acc[m][n]);
  }
  float* up = U + (size_t)(seq * NCH + c) * 16384;
#pragma unroll
  for (int m = 0; m < 4; ++m)
#pragma unroll
    for (int n = 0; n < 4; ++n)
#pragma unroll
      for (int j = 0; j < 4; ++j) up[(wr * 64 + m * 16 + fq * 4 + j) * 128 + wc * 64 + n * 16 + fr] = acc[m][n][j];
}

__device__ void pool_item(const P& p, int item) {
  const int tid = get_tid();
  const u16* PROJ = (const u16*)(p.ws + OFF_PROJ);
  u16* PO = (u16*)(p.ws + OFF_POOLED);
  const int ch = tid * 2, g = ch >> 7, w = 2 << g;
  for (int i = 0; i < 32; ++i) {
    const int row = item * 32 + i;
    int base, n, pos;
    if (row < ML) { base = row & ~4095; n = 4096; pos = row & 4095; }
    else { base = ML + ((row - ML) & ~255); n = 256; pos = (row - ML) & 255; }
    const int lo = max(pos - w / 2, 0), hi = min(pos + w - w / 2, n);
    float s0 = 0.f, s1 = 0.f;
    for (int r = lo; r < hi; ++r) {
      unsigned v = *(const unsigned*)(PROJ + (size_t)(base + r) * 3072 + 2560 + ch);
      s0 += bf2f((u16)(v & 0xffff)); s1 += bf2f((u16)(v >> 16));
    }
    unsigned v = *(const unsigned*)(PROJ + (size_t)row * 3072 + 2560 + ch);
    const float ic = 1.f / (float)(hi - lo);
    *(unsigned*)(PO + (size_t)row * 512 + ch) = pk2(s0 * ic - bf2f((u16)(v & 0xffff)), s1 * ic - bf2f((u16)(v >> 16)));
  }
}

__device__ void hg_scan_item(const P& p, int item) {
  float* U = (float*)(p.ws + OFF_U);
  const float* DEC = (const float*)(p.ws + OFF_DEC);
  const int ei = item * 256 + get_tid(), seq = ei >> 14, vd = ei & 16383, d = vd & 127;
  float* up = U + (size_t)seq * NCH * 16384 + vd;
  const float* dp = DEC + (size_t)seq * NCH * 128 + d;
  float s = 0.f;
  for (int c0 = 0; c0 < NCH; c0 += 17) {
    float u[17], dd[17];
#pragma unroll
    for (int i = 0; i < 17; ++i) { u[i] = up[(size_t)(c0 + i) * 16384]; dd[i] = dp[(c0 + i) * 128]; }
#pragma unroll
    for (int i = 0; i < 17; ++i) { up[(size_t)(c0 + i) * 16384] = s; s = dd[i] * s + u[i]; }
  }
}

__device__ void hg_o_item(const P& p, int e, int item, char* smem) {
  const int tid = get_tid(), lane = tid & 63, w = tid >> 6, fr = lane & 15, fq = lane >> 4;
  const u16* PROJ = (const u16*)(p.ws + OFF_PROJ);
  const u16* IT = (const u16*)(p.ws + OFF_VT);
  const float* S = (const float*)(p.ws + OFF_U);
  const float* LB = (const float*)(p.ws + OFF_LB);
  u16* MIX = (u16*)(p.ws + OFF_MIX);
  const int tc = item % NCH, bh = item / NCH, h = bh & 3, b = bh >> 2;
  int row0, pos0;
  chunk_rows(b, tc, row0, pos0);
  char* qh = smem;
  char* kh = smem + 16384;
  char* vt = smem + 32768;
  float* eref = (float*)(smem + 49152);
  __syncthreads();
  {
    const u16* vb = IT + (size_t)((b * 4 + h) * 128) * TK + pos0;
#pragma unroll
    for (int i = 0; i < 4; ++i) {
      int q = tid + i * 256, dv = q >> 3, c2 = (q & 7) ^ ((dv >> 1) & 7);
      glds16(vb + (size_t)dv * TK + c2 * 8, vt + q * 16);
    }
  }
  f32x4 O[8];
#pragma unroll
  for (int v = 0; v < 8; ++v) O[v] = f32x4{0.f, 0.f, 0.f, 0.f};
  const int d = tid & 127, half = tid >> 7;
  for (int dir = 0; dir < 2; ++dir) {
    const int c = dir ? (tc < 4 ? 3 - tc : 4 + 63 - (tc - 4)) : tc;
    const int seq = (b * 4 + h) * 2 + dir;
    const float lb = LB[(e * 2 + dir) * 512 + h * 128 + d];
    const u16* zp = PROJ + (size_t)row0 * 3072 + 1536 + dir * 512 + h * 128 + d;
    const u16* qp = PROJ + (size_t)row0 * 3072 + h * 128 + d;
    if (dir) __syncthreads();
    float rel = 0.f;
    if (!half) {
#pragma unroll 8
      for (int tau = 31; tau >= 0; --tau) {
        int t = dir ? 63 - tau : tau;
        float f = lb + (1.f - lb) * sigm(bf2f(zp[(size_t)t * 3072]));
        float lf = __logf(fmaxf(f, 1e-20f));
        float q = bf2f(qp[(size_t)t * 3072]);
        int off = swz256(t, d >> 3) + (d & 7) * 2;
        *(u16*)(qh + off) = f2bf(q * __expf(rel));
        *(u16*)(kh + off) = f2bf((1.f - f) * __expf(-rel));
        rel -= lf;
      }
      eref[d] = __expf(-rel);
    } else {
#pragma unroll 8
      for (int tau = 32; tau < 64; ++tau) {
        int t = dir ? 63 - tau : tau;
        float f = lb + (1.f - lb) * sigm(bf2f(zp[(size_t)t * 3072]));
        float lf = __logf(fmaxf(f, 1e-20f));
        float q = bf2f(qp[(size_t)t * 3072]);
        rel += lf;
        int off = swz256(t, d >> 3) + (d & 7) * 2;
        *(u16*)(qh + off) = f2bf(q * __expf(rel));
        *(u16*)(kh + off) = f2bf((1.f - f) * __expf(-rel));
      }
    }
    __syncthreads();
    bf16x8 qf[4];
#pragma unroll
    for (int ks = 0; ks < 4; ++ks) qf[ks] = *(const bf16x8*)(qh + swz256(w * 16 + fr, ks * 4 + fq));
    f32x4 s[4];
#pragma unroll
    for (int sf = 0; sf < 4; ++sf) {
      s[sf] = f32x4{0.f, 0.f, 0.f, 0.f};
#pragma unroll
      for (int ks = 0; ks < 4; ++ks) {
        bf16x8 a = *(const bf16x8*)(kh + swz256(sf * 16 + fr, ks * 4 + fq));
        s[sf] = mfma16(a, qf[ks], s[sf]);
      }
    }
    const int tq = w * 16 + fr;
#pragma unroll
    for (int sf = 0; sf < 4; ++sf)
#pragma unroll
      for (int j = 0; j < 4; ++j) {
        int ss = sf * 16 + fq * 4 + j;
        bool keep = dir ? (ss >= tq) : (ss <= tq);
        s[sf][j] = keep ? s[sf][j] : 0.f;
      }
    bf16x8 pb[2];
#pragma unroll
    for (int k2 = 0; k2 < 2; ++k2) {
      union { bf16x8 v; unsigned u[4]; } t;
      t.u[0] = pk2(s[2 * k2][0], s[2 * k2][1]); t.u[1] = pk2(s[2 * k2][2], s[2 * k2][3]);
      t.u[2] = pk2(s[2 * k2 + 1][0], s[2 * k2 + 1][1]); t.u[3] = pk2(s[2 * k2 + 1][2], s[2 * k2 + 1][3]);
      pb[k2] = t.v;
    }
#pragma unroll
    for (int v = 0; v < 8; ++v)
#pragma unroll
      for (int k2 = 0; k2 < 2; ++k2) {
        const int dv = v * 16 + fr;
        union { bf16x8 v; uint2 u[2]; } a;
        a.u[0] = *(const uint2*)(vt + swz128(dv, k2 * 4 + (fq >> 1)) + (fq & 1) * 8);
        a.u[1] = *(const uint2*)(vt + swz128(dv, k2 * 4 + 2 + (fq >> 1)) + (fq & 1) * 8);
        O[v] = mfma16(a.v, pb[k2], O[v]);
      }
    const float* sp = S + (size_t)(seq * NCH + c) * 16384;
#pragma unroll
    for (int ks = 0; ks < 4; ++ks) {
      union { bf16x8 v; u16 h[8]; unsigned u[4]; } qq, qs;
      qq.v = qf[ks];
      const float* er = eref + ks * 32 + fq * 8;
#pragma unroll
      for (int i = 0; i < 4; ++i) qs.u[i] = pk2(bf2f(qq.h[2 * i]) * er[2 * i], bf2f(qq.h[2 * i + 1]) * er[2 * i + 1]);
#pragma unroll
      for (int v = 0; v < 8; ++v) {
        const float* g = sp + (v * 16 + fr) * 128 + ks * 32 + fq * 8;
        float4 x0 = *(const float4*)g, x1 = *(const float4*)(g + 4);
        union { bf16x8 v; unsigned u[4]; } a;
        a.u[0] = pk2(x0.x, x0.y); a.u[1] = pk2(x0.z, x0.w); a.u[2] = pk2(x1.x, x1.y); a.u[3] = pk2(x1.z, x1.w);
        O[v] = mfma16(a.v, qs.v, O[v]);
      }
    }
  }
  float ssq = 0.f;
#pragma unroll
  for (int v = 0; v < 8; ++v)
#pragma unroll
    for (int j = 0; j < 4; ++j) ssq += O[v][j] * O[v][j];
  ssq = xor_sum(xor_sum(ssq, 16), 32);
  const float rs = rsqrtf(ssq * (1.f / 128.f) + 1e-6f);
  const int row = row0 + w * 16 + fr;
  const float* nw = p.hg_norm_w + e * 128;
#pragma unroll
  for (int v = 0; v < 8; ++v) {
    int dv = v * 16 + fq * 4;
    uint2 gv = *(const uint2*)(PROJ + (size_t)row * 3072 + 1024 + h * 128 + dv);
    float4 n4 = *(const float4*)(nw + dv);
    float g0 = bf2f((u16)(gv.x & 0xffff)), g1 = bf2f((u16)(gv.x >> 16)), g2 = bf2f((u16)(gv.y & 0xffff)), g3 = bf2f((u16)(gv.y >> 16));
    uint2 o = {pk2(O[v][0] * rs * n4.x * silu(g0), O[v][1] * rs * n4.y * silu(g1)),
               pk2(O[v][2] * rs * n4.z * silu(g2), O[v][3] * rs * n4.w * silu(g3))};
    *(uint2*)(MIX + (size_t)row * D + h * 128 + dv) = o;
  }
}

#define XB_TMO      128
#define XB_XCNT(j)  (256  + 64 * (j))
#define XB_XSUB(j)  (1280 + 64 * (j))
#define XB_XGEN(j)  (2304 + 64 * (j))
#define XB_TOP      3328
#define XB_TOPGEN   3392
#define XCD_BAR_WORDS 3456
#define XB_SPIN_CAP (1u << 18)
__device__ __forceinline__ unsigned xb_ld(unsigned* p) { return __hip_atomic_load(p, __ATOMIC_RELAXED, __HIP_MEMORY_SCOPE_AGENT); }
__device__ __forceinline__ unsigned xb_add(unsigned* p, unsigned v) { return __hip_atomic_fetch_add(p, v, __ATOMIC_RELAXED, __HIP_MEMORY_SCOPE_AGENT); }
__device__ __forceinline__ unsigned xb_xcc_id() { return (unsigned)__builtin_amdgcn_s_getreg((3 << 11) | 20) & 0xFu; }
#define XB_SPIN(cond, bar) do { unsigned _sp = 0; while (cond) { __builtin_amdgcn_s_sleep(1); \
    if ((++_sp & 255u) == 0u) { if (xb_ld(&(bar)[XB_TMO])) break; if (_sp > XB_SPIN_CAP) { atomicAdd(&(bar)[XB_TMO], 1u); break; } } } } while (0)
struct GB { unsigned* bar; unsigned x, nloc, nx; };
__device__ __forceinline__ void gb_complete(unsigned* bar, unsigned x, unsigned& nloc, unsigned& nx) {
  const unsigned G = gridDim.x;
  unsigned sum, cnt, mine, sp = 0u;
  for (;;) {
    sum = 0u; cnt = 0u; mine = 0u;
#pragma unroll
    for (unsigned j = 0; j < 16; ++j) { const unsigned c = xb_ld(&bar[XB_XCNT(j)]); sum += c; cnt += (c > 0u) ? 1u : 0u; mine = (j == x) ? c : mine; }
    if (sum == G) break;
    __builtin_amdgcn_s_sleep(1);
    if ((++sp & 255u) == 0u) { if (xb_ld(&bar[XB_TMO])) break; if (sp > XB_SPIN_CAP) { atomicAdd(&bar[XB_TMO], 1u); break; } }
  }
  nloc = mine > 0u ? mine : 1u; nx = cnt > 0u ? cnt : 1u;
}
__device__ __forceinline__ void gbar(GB& b) {
  asm volatile("s_waitcnt vmcnt(0)" ::: "memory");
  __syncthreads();
  if (threadIdx.x == 0) {
    unsigned* bar = b.bar;
    __builtin_amdgcn_s_waitcnt(0);
    if (b.nloc == 0u) gb_complete(bar, b.x, b.nloc, b.nx);
    const unsigned nloc = b.nloc, nx = b.nx;
    const unsigned old = xb_add(&bar[XB_XSUB(b.x)], 1u);
    const unsigned gen = old / nloc;
    if (old + 1u == (gen + 1u) * nloc) {
      __builtin_amdgcn_fence(__ATOMIC_RELEASE, "agent");
      asm volatile("s_waitcnt vmcnt(0)" ::: "memory");
      const unsigned og = xb_add(&bar[XB_TOP], 1u);
      const unsigned tg = og / nx;
      if (og + 1u == (tg + 1u) * nx) xb_add(&bar[XB_TOPGEN], 1u);
      else XB_SPIN(xb_ld(&bar[XB_TOPGEN]) == tg, bar);
      __builtin_amdgcn_fence(__ATOMIC_ACQUIRE, "agent");
      xb_add(&bar[XB_XGEN(b.x)], 1u);
      asm volatile("s_waitcnt vmcnt(0)" ::: "memory");
    } else {
      XB_SPIN(xb_ld(&bar[XB_XGEN(b.x)]) == gen, bar);
      __builtin_amdgcn_fence(__ATOMIC_ACQUIRE, "agent");
      asm volatile("s_waitcnt vmcnt(0)" ::: "memory");
    }
  }
  __syncthreads();
}

constexpr int PH_PER_EVEN = 12, PH_PER_ODD = 10;
constexpr int N_PHASES = 2 + 2 * PH_PER_EVEN + 2 * PH_PER_ODD;

__device__ __forceinline__ void run_phase(const P& pin, int ph, char* smem) {
  P p = pin;
  asm volatile("" : "+s"(p.ws));
  asm volatile("" : "+s"(p.out));
  u16* H = (u16*)(p.ws + OFF_H);
  u16* HID = (u16*)(p.ws + OFF_HID);
  u16* Y = (u16*)(p.ws + OFF_Y);
  u16* PROJ = (u16*)(p.ws + OFF_PROJ);
  u16* VT = (u16*)(p.ws + OFF_VT);
  u16* MIX = (u16*)(p.ws + OFF_MIX);
  if (ph == 0) { phase_prep(p, smem); return; }
  if (ph == 1) { phase_rows(p, 0, 0, 0, MT, false); return; }
  int q = ph - 2, l;
  if (q < PH_PER_EVEN) l = 0;
  else if (q < PH_PER_EVEN + PH_PER_ODD) { l = 1; q -= PH_PER_EVEN; }
  else if (q < 2 * PH_PER_EVEN + PH_PER_ODD) { l = 2; q -= PH_PER_EVEN + PH_PER_ODD; }
  else { l = 3; q -= 2 * PH_PER_EVEN + PH_PER_ODD; }
  const bool even = !(l & 1), last = (l == 3);
  int step = q;
  if (!even && q >= 5) step = q + 2;
  const int Mpost = last ? ML : MT;
  const u16* WFI = (const u16*)(p.ws + OFF_WFI);
  const u16* WFO = (const u16*)(p.ws + OFF_WFO);
  switch (step) {
    case 0: gemm_phase(H, D, WFI + (size_t)(l * 2 + 0) * 5632 * 1024, MT, 5632, 1024, smem, EpiSwiglu{HID}); break;
    case 1: gemm_phase(HID, FH, WFO + (size_t)(l * 2 + 0) * 1024 * 2816, MT, 1024, 2816, smem, EpiF32{Y}); break;
    case 2: phase_rows(p, 1, l, 0, MT, false); break;
    case 3:
      if (even) gemm_phase(H, D, (const u16*)(p.ws + OFF_WMI) + (size_t)l * 3072 * 1024, MT, 3072, 1024, smem, EpiProjEven{PROJ, VT});
      else gemm_phase(H, D, (const u16*)(p.ws + OFF_WMI) + (size_t)l * 3072 * 1024, MT, 3072, 1024, smem,
                      EpiProjOdd{PROJ, VT, (const float*)(p.ws + OFF_ROPE)});
      break;
    case 4:
      if (even) {
        for (int it = blockIdx.x; it < 32 * NCH + MT / 32; it += gridDim.x) {
          if (it < 32 * NCH) hg_u_item(p, l >> 1, it, smem);
          else pool_item(p, it - 32 * NCH);
        }
      } else phase_attn(p, l, smem);
      break;
    case 5: {
      for (int it = blockIdx.x; it < 2048 + 4 * (MT / 128); it += gridDim.x) {
        if (it < 2048) hg_scan_item(p, it);
        else {
          int t = it - 2048, g = t / (MT / 128), mt = t % (MT / 128);
          gemm_tile((const u16*)(p.ws + OFF_POOLED) + g * 128, 512,
                    (const u16*)(p.ws + OFF_WPL) + (size_t)((l >> 1) * 4 + g) * 128 * 128, 128, 128, mt * 128, 0, smem,
                    EpiPool{MIX, p.pool_scale + (l >> 1) * 512, g});
        }
      }
    } break;
    case 6:
      for (int it = blockIdx.x; it < 16 * NCH; it += gridDim.x) hg_o_item(p, l >> 1, it, smem);
      break;
    case 7: gemm_phase(MIX, D, (const u16*)(p.ws + OFF_WMO) + (size_t)l * 1024 * 1024, Mpost, 1024, 1024, smem, EpiF32{Y}); break;
    case 8: phase_rows(p, 1, l, 1, Mpost, false); break;
    case 9: gemm_phase(H, D, WFI + (size_t)(l * 2 + 1) * 5632 * 1024, Mpost, 5632, 1024, smem, EpiSwiglu{HID}); break;
    case 10: gemm_phase(HID, FH, WFO + (size_t)(l * 2 + 1) * 1024 * 2816, Mpost, 1024, 2816, smem, EpiF32{Y}); break;
    case 11: phase_rows(p, 1, l, 2, Mpost, last); break;
  }
}

__global__ void __launch_bounds__(256, 2) mega(P p, int ph_lo, int ph_hi) {
  __shared__ __attribute__((aligned(16))) char smem[65536];
  GB gb;
  gb.bar = (unsigned*)(p.ws + OFF_BAR); gb.x = xb_xcc_id(); gb.nloc = 0u; gb.nx = 0u;
  if (threadIdx.x == 0) (void)xb_add(&gb.bar[XB_XCNT(gb.x)], 1u);
  for (int ph = ph_lo; ph < ph_hi; ++ph) {
    run_phase(p, ph, smem);
#ifdef DOUBLE_GEMM
    {
      int q = ph - 2, l = 0;
      if (ph >= 2) {
        if (q < 12) l = 0; else if (q < 22) { l = 1; q -= 12; } else if (q < 34) { l = 2; q -= 22; } else { l = 3; q -= 34; }
        int step = q; if ((l & 1) && q >= 5) step = q + 2;
        if (step == 0 || step == 1 || step == 3 || step == 7 || step == 9 || step == 10) run_phase(p, ph, smem);
      }
    }
#endif
#ifdef DOUBLE_ATT
    if (ph == 2 + 12 + 4 || ph == 2 + 34 + 4) run_phase(p, ph, smem);
#endif
    if (ph + 1 < ph_hi) {
      if (ph == ph_lo) cg::this_grid().sync();
      else gbar(gb);
    }
  }
}

extern "C" void kernel_launch(void* const* d_in, const int* in_sizes, int n_in, void* d_out, int out_size, void* d_ws,
                              size_t ws_size, hipStream_t stream) {
  static int grid_blocks = 0;
  if (!grid_blocks) {
    int dev = 0, cus = 0, per_cu = 0;
    hipGetDevice(&dev);
    hipDeviceGetAttribute(&cus, hipDeviceAttributeMultiprocessorCount, dev);
    hipOccupancyMaxActiveBlocksPerMultiprocessor(&per_cu, mega, 256, 0);
    if (per_cu > 2) per_cu = 2;
    grid_blocks = cus * per_cu;
  }
  if (ws_size < OFF_END2) { fprintf(stderr, "workspace too small: %zu < %zu\n", ws_size, (size_t)OFF_END); return; }
  P p{};
  const float** f = (const float**)&p;
  for (int i = 0; i < 20; ++i) f[i] = (const float*)d_in[i];
  p.out = (float*)d_out;
  p.ws = (char*)d_ws;
#if MULTI_LAUNCH
  for (int ph = 0; ph < N_PHASES; ++ph) hipLaunchKernelGGL(mega, dim3(grid_blocks), dim3(256), 0, stream, p, ph, ph + 1);
#else
  hipMemsetAsync((char*)d_ws + OFF_BAR, 0, XCD_BAR_WORDS * 4, stream);
  int lo = 0, hi = N_PHASES;
  void* args[] = {&p, &lo, &hi};
  hipError_t e = hipLaunchCooperativeKernel((void*)mega, dim3(grid_blocks), dim3(256), args, 0, stream);
  if (e != hipSuccess) fprintf(stderr, "cooperative launch failed: %s (grid %d)\n", hipGetErrorString(e), grid_blocks);
#endif
}
```

```cpp
#include <hip/hip_runtime.h>
#include <hip/hip_cooperative_groups.h>
#include <cstdio>
namespace cg = cooperative_groups;

typedef __attribute__((ext_vector_type(8))) short bf16x8;
typedef __attribute__((ext_vector_type(4))) float f32x4;
typedef unsigned short u16;

#ifndef MULTI_LAUNCH
#define MULTI_LAUNCH 0
#endif

constexpr int D = 1024, NB = 4, SEQ = 4096, CTX = 256, FH = 2816;
constexpr int ML = NB * SEQ, MC = NB * CTX, MT = ML + MC;
constexpr int TK = CTX + SEQ;
constexpr int NCH = TK / 64;
constexpr float ALPHA = 1.6817928305074290f;
constexpr float LOG2E = 1.4426950408889634f;

constexpr size_t al256(size_t x) { return (x + 255) & ~(size_t)255; }
constexpr size_t OFF_WFI = 0;
constexpr size_t OFF_WFO = OFF_WFI + al256((size_t)4 * 2 * 5632 * 1024 * 2);
constexpr size_t OFF_WMI = OFF_WFO + al256((size_t)4 * 2 * 1024 * 2816 * 2);
constexpr size_t OFF_WMO = OFF_WMI + al256((size_t)4 * 3072 * 1024 * 2);
constexpr size_t OFF_WPL = OFF_WMO + al256((size_t)4 * 1024 * 1024 * 2);
constexpr size_t OFF_MODS = OFF_WPL + al256((size_t)2 * 4 * 128 * 128 * 2);
constexpr size_t OFF_LB = OFF_MODS + al256((size_t)4 * 5 * 9216 * 4);
constexpr size_t OFF_LAM = OFF_LB + al256((size_t)2 * 2 * 512 * 4);
constexpr size_t OFF_ROPE = OFF_LAM + 256;
constexpr size_t OFF_DEC = OFF_ROPE + al256((size_t)64 * 16 * 2 * 4);
constexpr size_t OFF_X = OFF_DEC + al256((size_t)32 * NCH * 128 * 4);
constexpr size_t OFF_H = OFF_X + al256((size_t)MT * 1024 * 4);
constexpr size_t OFF_PROJ = OFF_H + al256((size_t)MT * 1024 * 2);
constexpr size_t OFF_VT = OFF_PROJ + al256((size_t)MT * 3072 * 2);
constexpr size_t OFF_MIX = OFF_VT + al256((size_t)NB * 8 * 128 * TK * 2);
constexpr size_t OFF_POOLED = OFF_MIX + al256((size_t)MT * 1024 * 2);
constexpr size_t OFF_HID = OFF_POOLED + al256((size_t)MT * 512 * 2);
constexpr size_t OFF_Y = OFF_HID + al256((size_t)MT * FH * 2);
constexpr size_t OFF_END = OFF_Y + al256((size_t)MT * 1024 * 4);
constexpr size_t OFF_BAR = OFF_END;
constexpr size_t OFF_END2 = OFF_BAR + al256((size_t)3456 * 4);
constexpr size_t OFF_U = OFF_HID;
static_assert((size_t)32 * NCH * 16384 * 4 <= OFF_END - OFF_HID, "U alias too big");

struct P {
  const float *x, *c, *ctx, *c_ctx, *w_ada, *b_ada, *ln_g, *ln_b, *w_ffn_in, *w_ffn_out, *w_in_even, *w_out_even,
      *hg_lb, *hg_norm_w, *pool_w, *pool_scale, *w_in_odd, *w_out_odd, *da_lambda, *da_sub_w;
  float* out;
  char* ws;
};

typedef __attribute__((ext_vector_type(2))) __bf16 bf16v2;
typedef __attribute__((ext_vector_type(2))) float f32v2;
__device__ __forceinline__ unsigned pk2(float a, float b) {
  f32v2 v = {a, b};
  bf16v2 r = __builtin_convertvector(v, bf16v2);
  return *(unsigned*)&r;
}
__device__ __forceinline__ u16 f2bf(float f) { return (u16)(pk2(f, 0.f) & 0xffffu); }
__device__ __forceinline__ float bf2f(u16 h) { return __uint_as_float(((unsigned)h) << 16); }
__device__ __forceinline__ float sigm(float z) { return 1.f / (1.f + __expf(-z)); }
__device__ __forceinline__ float silu(float z) { return z / (1.f + __expf(-z)); }
__device__ __forceinline__ float ex2(float x) { return __builtin_amdgcn_exp2f(x); }
__device__ __forceinline__ void glds16(const void* g, void* l) {
  __builtin_amdgcn_global_load_lds((const unsigned*)g, (unsigned*)l, 16, 0, 0);
}
__device__ __forceinline__ int get_tid() { int t = threadIdx.x; asm volatile("" : "+v"(t)); return t; }
__device__ __forceinline__ int swz128(int row, int ch) { return row * 128 + ((ch ^ ((row >> 1) & 7)) << 4); }
__device__ __forceinline__ int swz256(int row, int ch) { return row * 256 + ((ch ^ (row & 15)) << 4); }
__device__ __forceinline__ f32x4 mfma16(bf16x8 a, bf16x8 b, f32x4 c) {
  return __builtin_amdgcn_mfma_f32_16x16x32_bf16(a, b, c, 0, 0, 0);
}
__device__ __forceinline__ float xor_sum(float v, int m) { return v + __shfl_xor(v, m, 64); }
__device__ __forceinline__ float xor_max(float v, int m) { return fmaxf(v, __shfl_xor(v, m, 64)); }
__device__ __forceinline__ void row_bpos(int row, int& b, int& pos) {
  if (row < ML) { b = row >> 12; pos = CTX + (row & 4095); }
  else { int r = row - ML; b = r >> 8; pos = r & 255; }
}
__device__ __forceinline__ int mod_row(int row) { return row < ML ? (row >> 12) : 4; }

constexpr int BM = 128, BN = 128, BK = 64;

template <class Epi>
__device__ __forceinline__ void gemm_tile(const u16* __restrict__ A, int lda, const u16* __restrict__ Bt, int ldb, int K,
                                          int m0, int n0, char* smem, const Epi& epi) {
  const int tid = get_tid(), lane = tid & 63, wid = tid >> 6, wr = wid >> 1, wc = wid & 1, fr = lane & 15, fq = lane >> 4;
  f32x4 acc[4][4];
#pragma unroll
  for (int m = 0; m < 4; ++m)
#pragma unroll
    for (int n = 0; n < 4; ++n) acc[m][n] = f32x4{0.f, 0.f, 0.f, 0.f};
  const int nk = K / BK;
  const u16* ga[4];
  const u16* gb[4];
#pragma unroll
  for (int i = 0; i < 4; ++i) {
    int q = tid + i * 256, row = q >> 3, ch = (q & 7) ^ ((row >> 1) & 7);
    ga[i] = A + (size_t)(m0 + row) * lda + ch * 8;
    gb[i] = Bt + (size_t)(n0 + row) * ldb + ch * 8;
  }
  __syncthreads();
#pragma unroll
  for (int i = 0; i < 4; ++i) {
    glds16(ga[i], smem + (tid + i * 256) * 16);
    glds16(gb[i], smem + 16384 + (tid + i * 256) * 16);
  }
  for (int kt = 0; kt < nk; ++kt) {
    __syncthreads();
    char* cur = smem + (kt & 1) * 32768;
    if (kt + 1 < nk) {
      char* nxt = smem + ((kt + 1) & 1) * 32768;
#pragma unroll
      for (int i = 0; i < 4; ++i) {
        glds16(ga[i] + (kt + 1) * BK, nxt + (tid + i * 256) * 16);
        glds16(gb[i] + (kt + 1) * BK, nxt + 16384 + (tid + i * 256) * 16);
      }
    }
#pragma unroll
    for (int ks = 0; ks < 2; ++ks) {
      bf16x8 a[4], b[4];
#pragma unroll
      for (int m = 0; m < 4; ++m) a[m] = *(const bf16x8*)(cur + swz128(wr * 64 + m * 16 + fr, ks * 4 + fq));
#pragma unroll
      for (int n = 0; n < 4; ++n) b[n] = *(const bf16x8*)(cur + 16384 + swz128(wc * 64 + n * 16 + fr, ks * 4 + fq));
#pragma unroll
      for (int m = 0; m < 4; ++m)
#pragma unroll
        for (int n = 0; n < 4; ++n) acc[m][n] = mfma16(b[n], a[m], acc[m][n]);
    }
  }
  epi(acc, m0 + wr * 64, n0 + wc * 64, fr, fq);
}

template <class Epi>
__device__ __forceinline__ void gemm_phase(const u16* A, int lda, const u16* Bt, int M, int N, int K, char* smem,
                                           const Epi& epi) {
  const int nM = M / BM, nN = N / BN, ntile = nM * nN;
  constexpr int WGM = 16;
  for (int t = blockIdx.x; t < ntile; t += gridDim.x) {
    int nig = WGM * nN, gid = t / nig, fm = gid * WGM, gsz = min(nM - fm, WGM);
    int pm = fm + (t % nig) % gsz, pn = (t % nig) / gsz;
    gemm_tile(A, lda, Bt, K, K, pm * BM, pn * BN, smem, epi);
  }
}

struct EpiSwiglu {
  u16* hid;
  __device__ __forceinline__ void operator()(f32x4 (&acc)[4][4], int rb, int cb, int fr, int fq) const {
#pragma unroll
    for (int m = 0; m < 4; ++m)
#pragma unroll
      for (int n = 0; n < 4; n += 2) {
        int row = rb + m * 16 + fr, hc = (cb >> 1) + (n >> 1) * 16 + fq * 4;
        uint2 v = {pk2(silu(acc[m][n][0]) * acc[m][n + 1][0], silu(acc[m][n][1]) * acc[m][n + 1][1]),
                   pk2(silu(acc[m][n][2]) * acc[m][n + 1][2], silu(acc[m][n][3]) * acc[m][n + 1][3])};
        *(uint2*)(hid + (size_t)row * FH + hc) = v;
      }
  }
};
struct EpiF32 {
  u16* y;
  __device__ __forceinline__ void operator()(f32x4 (&acc)[4][4], int rb, int cb, int fr, int fq) const {
#pragma unroll
    for (int m = 0; m < 4; ++m)
#pragma unroll
      for (int n = 0; n < 4; ++n)
        *(uint2*)(y + (size_t)(rb + m * 16 + fr) * D + cb + n * 16 + fq * 4) =
            uint2{pk2(acc[m][n][0], acc[m][n][1]), pk2(acc[m][n][2], acc[m][n][3])};
  }
};
struct EpiPool {
  u16* mix; const float* scale; int g;
  __device__ __forceinline__ void operator()(f32x4 (&acc)[4][4], int rb, int cb, int fr, int fq) const {
#pragma unroll
    for (int n = 0; n < 4; ++n) {
      int col = g * 128 + cb + n * 16 + fq * 4;
      float4 sc = *(const float4*)(scale + col);
#pragma unroll
      for (int m = 0; m < 4; ++m) {
        uint2 v = {pk2(acc[m][n][0] * sc.x, acc[m][n][1] * sc.y), pk2(acc[m][n][2] * sc.z, acc[m][n][3] * sc.w)};
        *(uint2*)(mix + (size_t)(rb + m * 16 + fr) * D + 512 + col) = v;
      }
    }
  }
};
__device__ __forceinline__ void store_vt(u16* vt, int nh, f32x4 (&acc)[4][4], int rb, int fcol0, int fr, int fq) {
#pragma unroll
  for (int m = 0; m < 4; ++m) {
    int row = rb + m * 16 + fr, b, pos;
    row_bpos(row, b, pos);
#pragma unroll
    for (int n = 0; n < 4; ++n) {
      int fc = fcol0 + n * 16 + fq * 4, h = fc >> 7, f = fc & 127;
      u16* o = vt + ((size_t)((b * nh + h) * 128 + f)) * TK + pos;
#pragma unroll
      for (int j = 0; j < 4; ++j) o[(size_t)j * TK] = f2bf(acc[m][n][j]);
    }
  }
}
struct EpiProjEven {
  u16* proj; u16* vt;
  __device__ __forceinline__ void operator()(f32x4 (&acc)[4][4], int rb, int cb, int fr, int fq) const {
    if (cb >= 512 && cb < 1024) { store_vt(vt, 4, acc, rb, cb - 512, fr, fq); return; }
    const float sc = (cb < 512) ? 0.08838834764831845f : 1.f;
#pragma unroll
    for (int m = 0; m < 4; ++m)
#pragma unroll
      for (int n = 0; n < 4; ++n) {
        uint2 v = {pk2(acc[m][n][0] * sc, acc[m][n][1] * sc), pk2(acc[m][n][2] * sc, acc[m][n][3] * sc)};
        *(uint2*)(proj + (size_t)(rb + m * 16 + fr) * 3072 + cb + n * 16 + fq * 4) = v;
      }
  }
};
struct EpiProjOdd {
  u16* proj; u16* vt; const float* rope;
  __device__ __forceinline__ void operator()(f32x4 (&acc)[4][4], int rb, int cb, int fr, int fq) const {
    if (cb >= 2048) { store_vt(vt, 8, acc, rb, cb - 2048, fr, fq); return; }
    const float sc = (cb < 1024) ? 0.125f * LOG2E : 1.f;
#pragma unroll
    for (int m = 0; m < 4; ++m) {
      int row = rb + m * 16 + fr;
      f32x4 v0 = acc[m][0], v1 = acc[m][1], v2 = acc[m][2], v3 = acc[m][3];
      if (row < ML) {
        int t = row & 4095, pr = t >> 6, pc = t & 63;
        const float* rr = rope + (pr * 16 + fq * 4) * 2;
        const float* rc = rope + (pc * 16 + fq * 4) * 2;
        float4 r0 = *(const float4*)rr, r1 = *(const float4*)(rr + 4), c0 = *(const float4*)rc, c1 = *(const float4*)(rc + 4);
        float cs[4] = {r0.x, r0.z, r1.x, r1.z}, sn[4] = {r0.y, r0.w, r1.y, r1.w};
        float cs2[4] = {c0.x, c0.z, c1.x, c1.z}, sn2[4] = {c0.y, c0.w, c1.y, c1.w};
#pragma unroll
        for (int j = 0; j < 4; ++j) {
          float a0 = v0[j] * cs[j] - v1[j] * sn[j], a1 = v1[j] * cs[j] + v0[j] * sn[j];
          float a2 = v2[j] * cs2[j] - v3[j] * sn2[j], a3 = v3[j] * cs2[j] + v2[j] * sn2[j];
          v0[j] = a0; v1[j] = a1; v2[j] = a2; v3[j] = a3;
        }
      }
      u16* o = proj + (size_t)row * 3072 + cb + fq * 4;
      *(uint2*)(o) = uint2{pk2(v0[0] * sc, v0[1] * sc), pk2(v0[2] * sc, v0[3] * sc)};
      *(uint2*)(o + 16) = uint2{pk2(v1[0] * sc, v1[1] * sc), pk2(v1[2] * sc, v1[3] * sc)};
      *(uint2*)(o + 32) = uint2{pk2(v2[0] * sc, v2[1] * sc), pk2(v2[2] * sc, v2[3] * sc)};
      *(uint2*)(o + 48) = uint2{pk2(v3[0] * sc, v3[1] * sc), pk2(v3[2] * sc, v3[3] * sc)};
    }
  }
};

__device__ __forceinline__ void convert_tile(const float* __restrict__ src, int K, int N, u16* __restrict__ dst, int tile,
                                             bool swiglu, char* smem) {
  float* t = (float*)smem;
  const int tid = get_tid();
  const int nN = N / 64, nt = tile % nN, kt = tile / nN, k0 = kt * 64, n0 = nt * 64;
  __syncthreads();
#pragma unroll
  for (int i = 0; i < 4; ++i) {
    int k = (tid >> 4) + 16 * i, n4 = (tid & 15) * 4;
    float4 v = *(const float4*)(src + (size_t)(k0 + k) * N + n0 + n4);
    t[k * 65 + n4] = v.x; t[k * 65 + n4 + 1] = v.y; t[k * 65 + n4 + 2] = v.z; t[k * 65 + n4 + 3] = v.w;
  }
  __syncthreads();
#pragma unroll
  for (int i = 0; i < 2; ++i) {
    int q = tid + i * 256, n = q >> 3, kc = (q & 7) * 8;
    int c = n0 + n, nr = c;
    if (swiglu) nr = (c < FH) ? (32 * (c >> 4) + (c & 15)) : (32 * ((c - FH) >> 4) + 16 + ((c - FH) & 15));
    uint4 o = {pk2(t[kc * 65 + n], t[(kc + 1) * 65 + n]), pk2(t[(kc + 2) * 65 + n], t[(kc + 3) * 65 + n]),
               pk2(t[(kc + 4) * 65 + n], t[(kc + 5) * 65 + n]), pk2(t[(kc + 6) * 65 + n], t[(kc + 7) * 65 + n])};
    *(uint4*)(dst + (size_t)nr * K + k0 + kc) = o;
  }
}

__device__ void phase_prep(const P& p, char* smem) {
  const int tid = get_tid();
  constexpr int N_ADA = 1152, N_TR = 4 * 5248 + 32;
  for (int item = blockIdx.x; item < N_ADA + N_TR + 1; item += gridDim.x) {
    if (item < N_ADA) {
      float* act = (float*)smem;
      float* red = (float*)(smem + 20480);
      const int l = item / 288, cb = (item % 288) * 32;
      __syncthreads();
      for (int i = tid; i < 5120; i += 256) {
        int r = i >> 10, k = i & 1023;
        float v = r < 4 ? p.c[r * 1024 + k] : p.c_ctx[k];
        act[i] = silu(v);
      }
      __syncthreads();
      const int tx = tid & 31, kg = tid >> 5;
      float a0 = 0, a1 = 0, a2 = 0, a3 = 0, a4 = 0;
      const float* w = p.w_ada + ((size_t)l * 1024 + kg * 128) * 9216 + cb + tx;
      for (int k0 = 0; k0 < 128; k0 += 16) {
        float wv[16];
#pragma unroll
        for (int k = 0; k < 16; ++k) wv[k] = w[(size_t)(k0 + k) * 9216];
#pragma unroll
        for (int k = 0; k < 16; ++k) {
          int kk = kg * 128 + k0 + k;
          a0 += act[kk] * wv[k]; a1 += act[1024 + kk] * wv[k]; a2 += act[2048 + kk] * wv[k]; a3 += act[3072 + kk] * wv[k];
          a4 += act[4096 + kk] * wv[k];
        }
      }
      red[(kg * 5 + 0) * 32 + tx] = a0; red[(kg * 5 + 1) * 32 + tx] = a1; red[(kg * 5 + 2) * 32 + tx] = a2;
      red[(kg * 5 + 3) * 32 + tx] = a3; red[(kg * 5 + 4) * 32 + tx] = a4;
      __syncthreads();
      if (tid < 160) {
        int r = tid >> 5, x = tid & 31;
        float sacc = 0.f;
#pragma unroll
        for (int g8 = 0; g8 < 8; ++g8) sacc += red[(g8 * 5 + r) * 32 + x];
        ((float*)(p.ws + OFF_MODS))[(size_t)(l * 5 + r) * 9216 + cb + x] = sacc + p.b_ada[l * 9216 + cb + x];
      }
    } else if (item < N_ADA + N_TR) {
      int idx = item - N_ADA;
      if (idx < 4 * 5248) {
        int l = idx / 5248, r = idx % 5248;
        if (r < 2816) {
          int f = r / 1408, tile = r % 1408;
          convert_tile(p.w_ffn_in + (size_t)(l * 2 + f) * 1024 * 5632, 1024, 5632,
                       (u16*)(p.ws + OFF_WFI) + (size_t)(l * 2 + f) * 5632 * 1024, tile, true, smem);
        } else if (r < 4224) {
          int f = (r - 2816) / 704, tile = (r - 2816) % 704;
          convert_tile(p.w_ffn_out + (size_t)(l * 2 + f) * 2816 * 1024, 2816, 1024,
                       (u16*)(p.ws + OFF_WFO) + (size_t)(l * 2 + f) * 1024 * 2816, tile, false, smem);
        } else if (r < 4992) {
          const float* src = (l & 1) ? p.w_in_odd + (size_t)(l >> 1) * 1024 * 3072 : p.w_in_even + (size_t)(l >> 1) * 1024 * 3072;
          convert_tile(src, 1024, 3072, (u16*)(p.ws + OFF_WMI) + (size_t)l * 3072 * 1024, r - 4224, false, smem);
        } else {
          const float* src = (l & 1) ? p.w_out_odd + (size_t)(l >> 1) * 1024 * 1024 : p.w_out_even + (size_t)(l >> 1) * 1024 * 1024;
          convert_tile(src, 1024, 1024, (u16*)(p.ws + OFF_WMO) + (size_t)l * 1024 * 1024, r - 4992, false, smem);
        }
      } else {
        int i2 = idx - 4 * 5248, eg = i2 >> 2, tile = i2 & 3;
        convert_tile(p.pool_w + (size_t)eg * 128 * 128, 128, 128, (u16*)(p.ws + OFF_WPL) + (size_t)eg * 128 * 128, tile, false, smem);
      }
    } else {
      float* LB = (float*)(p.ws + OFF_LB);
      for (int i = tid; i < 1024; i += 256) {
        float a0 = p.hg_lb[i], a1 = p.hg_lb[1024 + i];
        float mx = fmaxf(a0, a1), e0 = __expf(a0 - mx), e1 = __expf(a1 - mx);
        LB[i] = 0.f;
        LB[1024 + i] = e1 / (e0 + e1);
      }
      if (tid < 2) {
        const float* lv = p.da_lambda + tid * 256;
        float s0 = 0, s1 = 0;
        for (int i = 0; i < 64; ++i) { s0 += lv[i] * lv[64 + i]; s1 += lv[128 + i] * lv[192 + i]; }
        float li = 0.8f - 0.6f * expf(-0.3f * (float)(2 * tid + 1));
        ((float*)(p.ws + OFF_LAM))[tid] = expf(s0) - expf(s1) + li;
      }
      float* rope = (float*)(p.ws + OFF_ROPE);
      for (int i = tid; i < 1024; i += 256) {
        int pos = i >> 4, fi = i & 15;
        float inv = exp2f(-(float)fi * (13.287712379549449f / 16.f));
        float ang = (float)pos * inv;
        float k = rintf(ang * 0.15915494309189535f);
        float r = fmaf(-k, 6.28125f, ang);
        r = fmaf(-k, 1.9353071795864769e-3f, r);
        rope[i * 2] = cosf(r);
        rope[i * 2 + 1] = sinf(r);
      }
    }
  }
}

__device__ void phase_rows(const P& p, int mode, int l, int sub, int M, bool final_out) {
  const int tid = get_tid(), lane = tid & 63, wid = tid >> 6;
  float* X = (float*)(p.ws + OFF_X);
  const u16* Y = (const u16*)(p.ws + OFF_Y);
  u16* H = (u16*)(p.ws + OFF_H);
  const float* MODS = (const float*)(p.ws + OFF_MODS);
  int nl, si;
  if (mode == 0) { nl = 0; si = 0; }
  else if (sub == 0) { nl = l; si = 3; }
  else if (sub == 1) { nl = l; si = 6; }
  else { nl = l + 1; si = 0; }
  const float gs = (sub == 1) ? 1.f : 0.5f;
  const float* lg = p.ln_g + (size_t)(l * 3 + sub) * D;
  const float* lbp = p.ln_b + (size_t)(l * 3 + sub) * D;
  for (int row0 = (blockIdx.x * 4 + wid) * 2; row0 < M; row0 += gridDim.x * 8) {
    const int mr = mod_row(row0);
    float v[2][16];
    if (mode == 0) {
#pragma unroll
      for (int r = 0; r < 2; ++r) {
        const int row = row0 + r;
        const float* src = row < ML ? p.x + (size_t)row * D : p.ctx + (size_t)(row - ML) * D;
#pragma unroll
        for (int i = 0; i < 4; ++i) {
          float4 t = *(const float4*)(src + i * 256 + lane * 4);
          v[r][i * 4] = t.x; v[r][i * 4 + 1] = t.y; v[r][i * 4 + 2] = t.z; v[r][i * 4 + 3] = t.w;
        }
      }
    } else {
      const float* gate = MODS + (size_t)(l * 5 + mr) * 9216 + (2 + 3 * sub) * 1024;
      float4 xv[2][4]; uint2 yv[2][4]; float4 gv[4];
#pragma unroll
      for (int r = 0; r < 2; ++r)
#pragma unroll
        for (int i = 0; i < 4; ++i) {
          int c = i * 256 + lane * 4;
          xv[r][i] = *(const float4*)(X + (size_t)(row0 + r) * D + c);
          yv[r][i] = *(const uint2*)(Y + (size_t)(row0 + r) * D + c);
        }
#pragma unroll
      for (int i = 0; i < 4; ++i) gv[i] = *(const float4*)(gate + i * 256 + lane * 4);
      float s[2] = {0.f, 0.f};
#pragma unroll
      for (int r = 0; r < 2; ++r)
#pragma unroll
        for (int i = 0; i < 4; ++i) {
          float y0 = bf2f((u16)(yv[r][i].x & 0xffff)), y1 = bf2f((u16)(yv[r][i].x >> 16));
          float y2 = bf2f((u16)(yv[r][i].y & 0xffff)), y3 = bf2f((u16)(yv[r][i].y >> 16));
          v[r][i * 4] = ALPHA * xv[r][i].x + gs * gv[i].x * y0; v[r][i * 4 + 1] = ALPHA * xv[r][i].y + gs * gv[i].y * y1;
          v[r][i * 4 + 2] = ALPHA * xv[r][i].z + gs * gv[i].z * y2; v[r][i * 4 + 3] = ALPHA * xv[r][i].w + gs * gv[i].w * y3;
          s[r] += v[r][i * 4] + v[r][i * 4 + 1] + v[r][i * 4 + 2] + v[r][i * 4 + 3];
        }
#pragma unroll
      for (int o = 1; o < 64; o <<= 1) { s[0] = xor_sum(s[0], o); s[1] = xor_sum(s[1], o); }
      float q[2] = {0.f, 0.f};
#pragma unroll
      for (int r = 0; r < 2; ++r) {
        const float mu = s[r] * (1.f / 1024.f);
#pragma unroll
        for (int i = 0; i < 16; ++i) { v[r][i] -= mu; q[r] += v[r][i] * v[r][i]; }
      }
#pragma unroll
      for (int o = 1; o < 64; o <<= 1) { q[0] = xor_sum(q[0], o); q[1] = xor_sum(q[1], o); }
#pragma unroll
      for (int i = 0; i < 4; ++i) {
        int c = i * 256 + lane * 4;
        float4 g4 = *(const float4*)(lg + c), b4 = *(const float4*)(lbp + c);
#pragma unroll
        for (int r = 0; r < 2; ++r) {
          const float rstd = rsqrtf(q[r] * (1.f / 1024.f) + 1e-5f);
          v[r][i * 4] = v[r][i * 4] * rstd * g4.x + b4.x; v[r][i * 4 + 1] = v[r][i * 4 + 1] * rstd * g4.y + b4.y;
          v[r][i * 4 + 2] = v[r][i * 4 + 2] * rstd * g4.z + b4.z; v[r][i * 4 + 3] = v[r][i * 4 + 3] * rstd * g4.w + b4.w;
        }
      }
    }
    if (final_out) {
#pragma unroll
      for (int r = 0; r < 2; ++r)
#pragma unroll
        for (int i = 0; i < 4; ++i)
          *(float4*)(p.out + (size_t)(row0 + r) * D + i * 256 + lane * 4) =
              float4{v[r][i * 4], v[r][i * 4 + 1], v[r][i * 4 + 2], v[r][i * 4 + 3]};
      continue;
    }
    const float* sh = MODS + (size_t)(nl * 5 + mr) * 9216 + si * 1024;
#pragma unroll
    for (int i = 0; i < 4; ++i) {
      int c = i * 256 + lane * 4;
      float4 s4 = *(const float4*)(sh + c), c4 = *(const float4*)(sh + 1024 + c);
#pragma unroll
      for (int r = 0; r < 2; ++r) {
        *(float4*)(X + (size_t)(row0 + r) * D + c) = float4{v[r][i * 4], v[r][i * 4 + 1], v[r][i * 4 + 2], v[r][i * 4 + 3]};
        uint2 hv = {pk2(v[r][i * 4] * (1.f + c4.x) + s4.x, v[r][i * 4 + 1] * (1.f + c4.y) + s4.y),
                    pk2(v[r][i * 4 + 2] * (1.f + c4.z) + s4.z, v[r][i * 4 + 3] * (1.f + c4.w) + s4.w)};
        *(uint2*)(H + (size_t)(row0 + r) * D + c) = hv;
      }
    }
  }
}

__device__ void phase_attn(const P& p, int l, char* smem) {
  const int tid = get_tid(), lane = tid & 63, w = tid >> 6, fr = lane & 15, fq = lane >> 4;
  const u16* PROJ = (const u16*)(p.ws + OFF_PROJ);
  const u16* VT = (const u16*)(p.ws + OFF_VT);
  u16* MIX = (u16*)(p.ws + OFF_MIX);
  const float lam = ((const float*)(p.ws + OFF_LAM))[l >> 1];
  const float lam_init = 0.8f - 0.6f * expf(-0.3f * (float)l);
  const float* subw = p.da_sub_w + (l >> 1) * 128;
  const int n_items = (l == 3) ? 2048 : 2176;
  for (int item = blockIdx.x; item < n_items; item += gridDim.x) {
    int b, h, qrow0, nkt;
    if (item < 2048) { b = item >> 9; h = (item >> 6) & 7; qrow0 = b * 4096 + (item & 63) * 64; nkt = 68; }
    else { int it = item - 2048; b = it >> 5; h = (it >> 2) & 7; qrow0 = ML + b * 256 + (it & 3) * 64; nkt = 4; }
    bf16x8 qf[2][2];
    {
      const u16* qp = PROJ + (size_t)(qrow0 + w * 16 + fr) * 3072 + h * 128 + fq * 8;
#pragma unroll
      for (int m = 0; m < 2; ++m)
#pragma unroll
        for (int ks = 0; ks < 2; ++ks) qf[m][ks] = *(const bf16x8*)(qp + m * 64 + ks * 32);
    }
    f32x4 O[2][8];
#pragma unroll
    for (int m = 0; m < 2; ++m)
#pragma unroll
      for (int v = 0; v < 8; ++v) O[m][v] = f32x4{0.f, 0.f, 0.f, 0.f};
    float mrun[2] = {-1e30f, -1e30f}, lsum[2] = {0.f, 0.f};
    const u16* vbase = VT + (size_t)((b * 8 + h) * 128) * TK;
    auto stage = [&](int kt, char* buf) {
      const int krow0 = kt < 4 ? ML + b * 256 + kt * 64 : b * 4096 + (kt - 4) * 64;
#pragma unroll
      for (int i = 0; i < 4; ++i) {
        int q = tid + i * 256;
        int key = q >> 4, ch = (q & 15) ^ (key & 15);
        glds16(PROJ + (size_t)(krow0 + key) * 3072 + 1024 + h * 128 + ch * 8, buf + q * 16);
        int dv = q >> 3, c2 = (q & 7) ^ ((dv >> 1) & 7);
        glds16(vbase + (size_t)dv * TK + kt * 64 + c2 * 8, buf + 16384 + q * 16);
      }
    };
    __syncthreads();
    stage(0, smem);
    for (int kt = 0; kt < nkt; ++kt) {
      __syncthreads();
      char* cur = smem + (kt & 1) * 32768;
      if (kt + 1 < nkt) stage(kt + 1, smem + ((kt + 1) & 1) * 32768);
      bf16x8 pb[2][2];
#pragma unroll
      for (int m = 0; m < 2; ++m) {
        f32x4 s[4];
#pragma unroll
        for (int sf = 0; sf < 4; ++sf) {
          s[sf] = f32x4{0.f, 0.f, 0.f, 0.f};
#pragma unroll
          for (int ks = 0; ks < 2; ++ks) {
            bf16x8 a = *(const bf16x8*)(cur + swz256(sf * 16 + fr, m * 8 + ks * 4 + fq));
            s[sf] = mfma16(a, qf[m][ks], s[sf]);
          }
        }
        float tm = -1e30f;
#pragma unroll
        for (int sf = 0; sf < 4; ++sf)
#pragma unroll
          for (int j = 0; j < 4; ++j) tm = fmaxf(tm, s[sf][j]);
        tm = xor_max(tm, 16); tm = xor_max(tm, 32);
        if (__any(tm - mrun[m] > 6.f)) {
          const float mn = fmaxf(mrun[m], tm), sc = ex2(mrun[m] - mn);
          mrun[m] = mn;
          lsum[m] *= sc;
#pragma unroll
          for (int v = 0; v < 8; ++v) O[m][v] *= sc;
        }
        const float mn = mrun[m];
        float ps = 0.f;
#pragma unroll
        for (int sf = 0; sf < 4; ++sf)
#pragma unroll
          for (int j = 0; j < 4; ++j) { s[sf][j] = ex2(s[sf][j] - mn); ps += s[sf][j]; }
        lsum[m] += ps;
#pragma unroll
        for (int k2 = 0; k2 < 2; ++k2) {
          union { bf16x8 v; unsigned u[4]; } t;
          t.u[0] = pk2(s[2 * k2][0], s[2 * k2][1]); t.u[1] = pk2(s[2 * k2][2], s[2 * k2][3]);
          t.u[2] = pk2(s[2 * k2 + 1][0], s[2 * k2 + 1][1]); t.u[3] = pk2(s[2 * k2 + 1][2], s[2 * k2 + 1][3]);
          pb[m][k2] = t.v;
        }
      }
#pragma unroll
      for (int v = 0; v < 8; ++v) {
        const int dv = v * 16 + fr;
        union { bf16x8 v; uint2 u[2]; } a0, a1;
        a0.u[0] = *(const uint2*)(cur + 16384 + swz128(dv, (fq >> 1)) + (fq & 1) * 8);
        a0.u[1] = *(const uint2*)(cur + 16384 + swz128(dv, 2 + (fq >> 1)) + (fq & 1) * 8);
        a1.u[0] = *(const uint2*)(cur + 16384 + swz128(dv, 4 + (fq >> 1)) + (fq & 1) * 8);
        a1.u[1] = *(const uint2*)(cur + 16384 + swz128(dv, 6 + (fq >> 1)) + (fq & 1) * 8);
        O[0][v] = mfma16(a0.v, pb[0][0], O[0][v]);
        O[1][v] = mfma16(a0.v, pb[1][0], O[1][v]);
        O[0][v] = mfma16(a1.v, pb[0][1], O[0][v]);
        O[1][v] = mfma16(a1.v, pb[1][1], O[1][v]);
        if (v & 1) __builtin_amdgcn_sched_barrier(0);
      }
    }
    float l0 = xor_sum(xor_sum(lsum[0], 16), 32), l1 = xor_sum(xor_sum(lsum[1], 16), 32);
    const float i0 = 1.f / l0, i1 = lam / l1;
    float ssq = 0.f;
#pragma unroll
    for (int v = 0; v < 8; ++v)
#pragma unroll
      for (int j = 0; j < 4; ++j) { float o = O[0][v][j] * i0 - O[1][v][j] * i1; O[0][v][j] = o; ssq += o * o; }
    ssq = xor_sum(xor_sum(ssq, 16), 32);
    const float rs = rsqrtf(ssq * (1.f / 128.f) + 1e-6f) * (1.f - lam_init);
    u16* op = MIX + (size_t)(qrow0 + w * 16 + fr) * D + h * 128;
#pragma unroll
    for (int v = 0; v < 8; ++v) {
      int dv = v * 16 + fq * 4;
      float4 sw = *(const float4*)(subw + dv);
      uint2 o = {pk2(O[0][v][0] * rs * sw.x, O[0][v][1] * rs * sw.y), pk2(O[0][v][2] * rs * sw.z, O[0][v][3] * rs * sw.w)};
      *(uint2*)(op + dv) = o;
    }
  }
}

__device__ __forceinline__ void chunk_rows(int b, int cc_seq, int& row0, int& pos0) {
  if (cc_seq < 4) { row0 = ML + b * 256 + cc_seq * 64; pos0 = cc_seq * 64; }
  else { row0 = b * 4096 + (cc_seq - 4) * 64; pos0 = CTX + (cc_seq - 4) * 64; }
}
__device__ __forceinline__ int scan2tok(int c, int dir) {
  if (!dir) return c;
  return c < 4 ? 3 - c : 4 + 63 - (c - 4);
}

__device__ void hg_u_item(const P& p, int e, int item, char* smem) {
  const int tid = get_tid(), lane = tid & 63, wid = tid >> 6, wr = wid >> 1, wc = wid & 1, fr = lane & 15, fq = lane >> 4;
  const u16* PROJ = (const u16*)(p.ws + OFF_PROJ);
  const u16* IT = (const u16*)(p.ws + OFF_VT);
  float* U = (float*)(p.ws + OFF_U);
  float* DEC = (float*)(p.ws + OFF_DEC);
  const float* LB = (const float*)(p.ws + OFF_LB);
  const int c = item % NCH, seq = item / NCH, dir = seq & 1, h = (seq >> 1) & 3, b = seq >> 3;
  int row0, pos0;
  chunk_rows(b, scan2tok(c, dir), row0, pos0);
  float* tot = (float*)(smem + 16384);
  const int d = tid & 127, half = tid >> 7;
  const float lb = LB[(e * 2 + dir) * 512 + h * 128 + d];
  const u16* zp = PROJ + (size_t)row0 * 3072 + 1536 + dir * 512 + h * 128 + d;
  __syncthreads();
  float sum = 0.f;
#pragma unroll 8
  for (int i = 0; i < 32; ++i) {
    int tau = half * 32 + i, t = dir ? 63 - tau : tau;
    float f = lb + (1.f - lb) * sigm(bf2f(zp[(size_t)t * 3072]));
    sum += __logf(fmaxf(f, 1e-20f));
  }
  tot[half * 128 + d] = sum;
  __syncthreads();
  float rel = half ? 0.f : tot[128 + d];
#pragma unroll 8
  for (int i = 31; i >= 0; --i) {
    int tau = half * 32 + i, t = dir ? 63 - tau : tau;
    float f = lb + (1.f - lb) * sigm(bf2f(zp[(size_t)t * 3072]));
    float lf = __logf(fmaxf(f, 1e-20f));
    *(u16*)(smem + swz128(d, t >> 3) + (t & 7) * 2) = f2bf((1.f - f) * __expf(rel));
    rel += lf;
  }
  if (!half) DEC[(size_t)(seq * NCH + c) * 128 + d] = __expf(rel);
  __syncthreads();
  f32x4 acc[4][4];
#pragma unroll
  for (int m = 0; m < 4; ++m)
#pragma unroll
    for (int n = 0; n < 4; ++n) acc[m][n] = f32x4{0.f, 0.f, 0.f, 0.f};
  const u16* vb = IT + (size_t)((b * 4 + h) * 128) * TK + pos0;
#pragma unroll
  for (int ks = 0; ks < 2; ++ks) {
    bf16x8 a[4], bb[4];
#pragma unroll
    for (int m = 0; m < 4; ++m) a[m] = *(const bf16x8*)(vb + (size_t)(wr * 64 + m * 16 + fr) * TK + ks * 32 + fq * 8);
#pragma unroll
    for (int n = 0; n < 4; ++n) bb[n] = *(const bf16x8*)(smem + swz128(wc * 64 + n * 16 + fr, ks * 4 + fq));
#pragma unroll
    for (int m = 0; m < 4; ++m)
#pragma unroll
      for (int n = 0; n < 4; ++n) acc[m][n] = mfma16(a[m], bb[n], acc[m][n]);
  }
  float* up = U + (size_t)(seq * NCH + c) * 16384;
#pragma unroll
  for (int m = 0; m < 4; ++m)
#pragma unroll
    for (int n = 0; n < 4; ++n)
#pragma unroll
      for (int j = 0; j < 4; ++j) up[(wr * 64 + m * 16 + fq * 4 + j) * 128 + wc * 64 + n * 16 + fr] = acc[m][n][j];
}

__device__ void pool_item(const P& p, int item) {
  const int tid = get_tid();
  const u16* PROJ = (const u16*)(p.ws + OFF_PROJ);
  u16* PO = (u16*)(p.ws + OFF_POOLED);
  const int ch = tid * 2, g = ch >> 7, hw = 1 << g;
  const int row0 = item * 32;
  int base, n, pos0;
  if (row0 < ML) { base = row0 & ~4095; n = 4096; pos0 = row0 & 4095; }
  else { base = ML + ((row0 - ML) & ~255); n = 256; pos0 = (row0 - ML) & 255; }
  const u16* up = PROJ + (size_t)base * 3072 + 2560 + ch;
  float s0 = 0.f, s1 = 0.f;
  {
    const int lo = max(pos0 - hw, 0), hi = min(pos0 + hw, n);
    for (int r = lo; r < hi; ++r) {
      unsigned v = *(const unsigned*)(up + (size_t)r * 3072);
      s0 += __uint_as_float(v << 16); s1 += __uint_as_float(v & 0xffff0000u);
    }
  }
  for (int i0 = 0; i0 < 32; i0 += 16) {
    unsigned ce[16], en[16], le[16];
#pragma unroll
    for (int i = 0; i < 16; ++i) {
      const int pos = pos0 + i0 + i;
      ce[i] = *(const unsigned*)(up + (size_t)pos * 3072);
      en[i] = (pos + hw < n) ? *(const unsigned*)(up + (size_t)(pos + hw) * 3072) : 0u;
      le[i] = (pos - hw >= 0) ? *(const unsigned*)(up + (size_t)(pos - hw) * 3072) : 0u;
    }
#pragma unroll
    for (int i = 0; i < 16; ++i) {
      const int pos = pos0 + i0 + i;
      const int lo = max(pos - hw, 0), hi = min(pos + hw, n);
      const float ic = 1.f / (float)(hi - lo);
      *(unsigned*)(PO + (size_t)(base + pos) * 512 + ch) =
          pk2(s0 * ic - __uint_as_float(ce[i] << 16), s1 * ic - __uint_as_float(ce[i] & 0xffff0000u));
      s0 += __uint_as_float(en[i] << 16) - __uint_as_float(le[i] << 16);
      s1 += __uint_as_float(en[i] & 0xffff0000u) - __uint_as_float(le[i] & 0xffff0000u);
    }
  }
}

__device__ void hg_scan_item(const P& p, int item) {
  float* U = (float*)(p.ws + OFF_U);
  const float* DEC = (const float*)(p.ws + OFF_DEC);
  const int ei = item * 256 + get_tid(), seq = ei >> 14, vd = ei & 16383, d = vd & 127;
  float* up = U + (size_t)seq * NCH * 16384 + vd;
  const float* dp = DEC + (size_t)seq * NCH * 128 + d;
  float s = 0.f;
  for (int c0 = 0; c0 < NCH; c0 += 17) {
    float u[17], dd[17];
#pragma unroll
    for (int i = 0; i < 17; ++i) { u[i] = up[(size_t)(c0 + i) * 16384]; dd[i] = dp[(c0 + i) * 128]; }
#pragma unroll
    for (int i = 0; i < 17; ++i) { up[(size_t)(c0 + i) * 16384] = s; s = dd[i] * s + u[i]; }
  }
}

__device__ void hg_o_item(const P& p, int e, int item, char* smem) {
  const int tid = get_tid(), lane = tid & 63, w = tid >> 6, fr = lane & 15, fq = lane >> 4;
  const u16* PROJ = (const u16*)(p.ws + OFF_PROJ);
  const u16* IT = (const u16*)(p.ws + OFF_VT);
  const float* S = (const float*)(p.ws + OFF_U);
  const float* LB = (const float*)(p.ws + OFF_LB);
  u16* MIX = (u16*)(p.ws + OFF_MIX);
  const int tc = item % NCH, bh = item / NCH, h = bh & 3, b = bh >> 2;
  int row0, pos0;
  chunk_rows(b, tc, row0, pos0);
  char* qh = smem;
  char* kh = smem + 16384;
  char* vt = smem + 32768;
  float* eref = (float*)(smem + 49152);
  __syncthreads();
  {
    const u16* vb = IT + (size_t)((b * 4 + h) * 128) * TK + pos0;
#pragma unroll
    for (int i = 0; i < 4; ++i) {
      int q = tid + i * 256, dv = q >> 3, c2 = (q & 7) ^ ((dv >> 1) & 7);
      glds16(vb + (size_t)dv * TK + c2 * 8, vt + q * 16);
    }
  }
  f32x4 O[8];
#pragma unroll
  for (int v = 0; v < 8; ++v) O[v] = f32x4{0.f, 0.f, 0.f, 0.f};
  const int d = tid & 127, half = tid >> 7;
  for (int dir = 0; dir < 2; ++dir) {
    const int c = dir ? (tc < 4 ? 3 - tc : 4 + 63 - (tc - 4)) : tc;
    const int seq = (b * 4 + h) * 2 + dir;
    const float lb = LB[(e * 2 + dir) * 512 + h * 128 + d];
    const u16* zp = PROJ + (size_t)row0 * 3072 + 1536 + dir * 512 + h * 128 + d;
    const u16* qp = PROJ + (size_t)row0 * 3072 + h * 128 + d;
    if (dir) __syncthreads();
    float rel = 0.f;
    if (!half) {
#pragma unroll 8
      for (int tau = 31; tau >= 0; --tau) {
        int t = dir ? 63 - tau : tau;
        float f = lb + (1.f - lb) * sigm(bf2f(zp[(size_t)t * 3072]));
        float lf = __logf(fmaxf(f, 1e-20f));
        float q = bf2f(qp[(size_t)t * 3072]);
        int off = swz256(t, d >> 3) + (d & 7) * 2;
        *(u16*)(qh + off) = f2bf(q * __expf(rel));
        *(u16*)(kh + off) = f2bf((1.f - f) * __expf(-rel));
        rel -= lf;
      }
      eref[d] = __expf(-rel);
    } else {
#pragma unroll 8
      for (int tau = 32; tau < 64; ++tau) {
        int t = dir ? 63 - tau : tau;
        float f = lb + (1.f - lb) * sigm(bf2f(zp[(size_t)t * 3072]));
        float lf = __logf(fmaxf(f, 1e-20f));
        float q = bf2f(qp[(size_t)t * 3072]);
        rel += lf;
        int off = swz256(t, d >> 3) + (d & 7) * 2;
        *(u16*)(qh + off) = f2bf(q * __expf(rel));
        *(u16*)(kh + off) = f2bf((1.f - f) * __expf(-rel));
      }
    }
    __syncthreads();
    bf16x8 qf[4];
#pragma unroll
    for (int ks = 0; ks < 4; ++ks) qf[ks] = *(const bf16x8*)(qh + swz256(w * 16 + fr, ks * 4 + fq));
    f32x4 s[4];
#pragma unroll
    for (int sf = 0; sf < 4; ++sf) {
      s[sf] = f32x4{0.f, 0.f, 0.f, 0.f};
#pragma unroll
      for (int ks = 0; ks < 4; ++ks) {
        bf16x8 a = *(const bf16x8*)(kh + swz256(sf * 16 + fr, ks * 4 + fq));
        s[sf] = mfma16(a, qf[ks], s[sf]);
      }
    }
    const int tq = w * 16 + fr;
#pragma unroll
    for (int sf = 0; sf < 4; ++sf)
#pragma unroll
      for (int j = 0; j < 4; ++j) {
        int ss = sf * 16 + fq * 4 + j;
        bool keep = dir ? (ss >= tq) : (ss <= tq);
        s[sf][j] = keep ? s[sf][j] : 0.f;
      }
    bf16x8 pb[2];
#pragma unroll
    for (int k2 = 0; k2 < 2; ++k2) {
      union { bf16x8 v; unsigned u[4]; } t;
      t.u[0] = pk2(s[2 * k2][0], s[2 * k2][1]); t.u[1] = pk2(s[2 * k2][2], s[2 * k2][3]);
      t.u[2] = pk2(s[2 * k2 + 1][0], s[2 * k2 + 1][1]); t.u[3] = pk2(s[2 * k2 + 1][2], s[2 * k2 + 1][3]);
      pb[k2] = t.v;
    }
#pragma unroll
    for (int v = 0; v < 8; ++v)
#pragma unroll
      for (int k2 = 0; k2 < 2; ++k2) {
        const int dv = v * 16 + fr;
        union { bf16x8 v; uint2 u[2]; } a;
        a.u[0] = *(const uint2*)(vt + swz128(dv, k2 * 4 + (fq >> 1)) + (fq & 1) * 8);
        a.u[1] = *(const uint2*)(vt + swz128(dv, k2 * 4 + 2 + (fq >> 1)) + (fq & 1) * 8);
        O[v] = mfma16(a.v, pb[k2], O[v]);
      }
    const float* sp = S + (size_t)(seq * NCH + c) * 16384;
#pragma unroll
    for (int ks = 0; ks < 4; ++ks) {
      union { bf16x8 v; u16 h[8]; unsigned u[4]; } qq, qs;
      qq.v = qf[ks];
      const float* er = eref + ks * 32 + fq * 8;
#pragma unroll
      for (int i = 0; i < 4; ++i) qs.u[i] = pk2(bf2f(qq.h[2 * i]) * er[2 * i], bf2f(qq.h[2 * i + 1]) * er[2 * i + 1]);
#pragma unroll
      for (int v = 0; v < 8; ++v) {
        const float* g = sp + (v * 16 + fr) * 128 + ks * 32 + fq * 8;
        float4 x0 = *(const float4*)g, x1 = *(const float4*)(g + 4);
        union { bf16x8 v; unsigned u[4]; } a;
        a.u[0] = pk2(x0.x, x0.y); a.u[1] = pk2(x0.z, x0.w); a.u[2] = pk2(x1.x, x1.y); a.u[3] = pk2(x1.z, x1.w);
        O[v] = mfma16(a.v, qs.v, O[v]);
      }
    }
  }
  float ssq = 0.f;
#pragma unroll
  for (int v = 0; v < 8; ++v)
#pragma unroll
    for (int j = 0; j < 4; ++j) ssq += O[v][j] * O[v][j];
  ssq = xor_sum(xor_sum(ssq, 16), 32);
  const float rs = rsqrtf(ssq * (1.f / 128.f) + 1e-6f);
  const int row = row0 + w * 16 + fr;
  const float* nw = p.hg_norm_w + e * 128;
#pragma unroll
  for (int v = 0; v < 8; ++v) {
    int dv = v * 16 + fq * 4;
    uint2 gv = *(const uint2*)(PROJ + (size_t)row * 3072 + 1024 + h * 128 + dv);
    float4 n4 = *(const float4*)(nw + dv);
    float g0 = bf2f((u16)(gv.x & 0xffff)), g1 = bf2f((u16)(gv.x >> 16)), g2 = bf2f((u16)(gv.y & 0xffff)), g3 = bf2f((u16)(gv.y >> 16));
    uint2 o = {pk2(O[v][0] * rs * n4.x * silu(g0), O[v][1] * rs * n4.y * silu(g1)),
               pk2(O[v][2] * rs * n4.z * silu(g2), O[v][3] * rs * n4.w * silu(g3))};
    *(uint2*)(MIX + (size_t)row * D + h * 128 + dv) = o;
  }
}

#define XB_TMO      128
#define XB_XCNT(j)  (256  + 64 * (j))
#define XB_XSUB(j)  (1280 + 64 * (j))
#define XB_XGEN(j)  (2304 + 64 * (j))
#define XB_TOP      3328
#define XB_TOPGEN   3392
#define XCD_BAR_WORDS 3456
#define XB_SPIN_CAP (1u << 18)
__device__ __forceinline__ unsigned xb_ld(unsigned* p) { return __hip_atomic_load(p, __ATOMIC_RELAXED, __HIP_MEMORY_SCOPE_AGENT); }
__device__ __forceinline__ unsigned xb_add(unsigned* p, unsigned v) { return __hip_atomic_fetch_add(p, v, __ATOMIC_RELAXED, __HIP_MEMORY_SCOPE_AGENT); }
__device__ __forceinline__ unsigned xb_xcc_id() { return (unsigned)__builtin_amdgcn_s_getreg((3 << 11) | 20) & 0xFu; }
#define XB_SPIN(cond, bar) do { unsigned _sp = 0; while (cond) { __builtin_amdgcn_s_sleep(1); \
    if ((++_sp & 255u) == 0u) { if (xb_ld(&(bar)[XB_TMO])) break; if (_sp > XB_SPIN_CAP) { atomicAdd(&(bar)[XB_TMO], 1u); break; } } } } while (0)
struct GB { unsigned* bar; unsigned x, nloc, nx; };
__device__ __forceinline__ void gb_complete(unsigned* bar, unsigned x, unsigned& nloc, unsigned& nx) {
  const unsigned G = gridDim.x;
  unsigned sum, cnt, mine, sp = 0u;
  for (;;) {
    sum = 0u; cnt = 0u; mine = 0u;
#pragma unroll
    for (unsigned j = 0; j < 16; ++j) { const unsigned c = xb_ld(&bar[XB_XCNT(j)]); sum += c; cnt += (c > 0u) ? 1u : 0u; mine = (j == x) ? c : mine; }
    if (sum == G) break;
    __builtin_amdgcn_s_sleep(1);
    if ((++sp & 255u) == 0u) { if (xb_ld(&bar[XB_TMO])) break; if (sp > XB_SPIN_CAP) { atomicAdd(&bar[XB_TMO], 1u); break; } }
  }
  nloc = mine > 0u ? mine : 1u; nx = cnt > 0u ? cnt : 1u;
}
__device__ __forceinline__ void gbar(GB& b) {
  asm volatile("s_waitcnt vmcnt(0)" ::: "memory");
  __syncthreads();
  if (threadIdx.x == 0) {
    unsigned* bar = b.bar;
    __builtin_amdgcn_s_waitcnt(0);
    if (b.nloc == 0u) gb_complete(bar, b.x, b.nloc, b.nx);
    const unsigned nloc = b.nloc, nx = b.nx;
    const unsigned old = xb_add(&bar[XB_XSUB(b.x)], 1u);
    const unsigned gen = old / nloc;
    if (old + 1u == (gen + 1u) * nloc) {
      __builtin_amdgcn_fence(__ATOMIC_RELEASE, "agent");
      asm volatile("s_waitcnt vmcnt(0)" ::: "memory");
      const unsigned og = xb_add(&bar[XB_TOP], 1u);
      const unsigned tg = og / nx;
      if (og + 1u == (tg + 1u) * nx) xb_add(&bar[XB_TOPGEN], 1u);
      else XB_SPIN(xb_ld(&bar[XB_TOPGEN]) == tg, bar);
      __builtin_amdgcn_fence(__ATOMIC_ACQUIRE, "agent");
      xb_add(&bar[XB_XGEN(b.x)], 1u);
      asm volatile("s_waitcnt vmcnt(0)" ::: "memory");
    } else {
      XB_SPIN(xb_ld(&bar[XB_XGEN(b.x)]) == gen, bar);
      __builtin_amdgcn_fence(__ATOMIC_ACQUIRE, "agent");
      asm volatile("s_waitcnt vmcnt(0)" ::: "memory");
    }
  }
  __syncthreads();
}

constexpr int PH_PER_EVEN = 12, PH_PER_ODD = 10;
constexpr int N_PHASES = 2 + 2 * PH_PER_EVEN + 2 * PH_PER_ODD;

__device__ __forceinline__ void run_phase(const P& pin, int ph, char* smem) {
  P p = pin;
  asm volatile("" : "+s"(p.ws));
  asm volatile("" : "+s"(p.out));
  u16* H = (u16*)(p.ws + OFF_H);
  u16* HID = (u16*)(p.ws + OFF_HID);
  u16* Y = (u16*)(p.ws + OFF_Y);
  u16* PROJ = (u16*)(p.ws + OFF_PROJ);
  u16* VT = (u16*)(p.ws + OFF_VT);
  u16* MIX = (u16*)(p.ws + OFF_MIX);
  if (ph == 0) { phase_prep(p, smem); return; }
  if (ph == 1) { phase_rows(p, 0, 0, 0, MT, false); return; }
  int q = ph - 2, l;
  if (q < PH_PER_EVEN) l = 0;
  else if (q < PH_PER_EVEN + PH_PER_ODD) { l = 1; q -= PH_PER_EVEN; }
  else if (q < 2 * PH_PER_EVEN + PH_PER_ODD) { l = 2; q -= PH_PER_EVEN + PH_PER_ODD; }
  else { l = 3; q -= 2 * PH_PER_EVEN + PH_PER_ODD; }
  const bool even = !(l & 1), last = (l == 3);
  int step = q;
  if (!even && q >= 5) step = q + 2;
  const int Mpost = last ? ML : MT;
  const u16* WFI = (const u16*)(p.ws + OFF_WFI);
  const u16* WFO = (const u16*)(p.ws + OFF_WFO);
  switch (step) {
    case 0: gemm_phase(H, D, WFI + (size_t)(l * 2 + 0) * 5632 * 1024, MT, 5632, 1024, smem, EpiSwiglu{HID}); break;
    case 1: gemm_phase(HID, FH, WFO + (size_t)(l * 2 + 0) * 1024 * 2816, MT, 1024, 2816, smem, EpiF32{Y}); break;
    case 2: phase_rows(p, 1, l, 0, MT, false); break;
    case 3:
      if (even) gemm_phase(H, D, (const u16*)(p.ws + OFF_WMI) + (size_t)l * 3072 * 1024, MT, 3072, 1024, smem, EpiProjEven{PROJ, VT});
      else gemm_phase(H, D, (const u16*)(p.ws + OFF_WMI) + (size_t)l * 3072 * 1024, MT, 3072, 1024, smem,
                      EpiProjOdd{PROJ, VT, (const float*)(p.ws + OFF_ROPE)});
      break;
    case 4:
      if (even) {
        for (int it = blockIdx.x; it < 32 * NCH + MT / 32; it += gridDim.x) {
          if (it < 32 * NCH) hg_u_item(p, l >> 1, it, smem);
          else pool_item(p, it - 32 * NCH);
        }
      } else phase_attn(p, l, smem);
      break;
    case 5: {
      for (int it = blockIdx.x; it < 2048 + 4 * (MT / 128); it += gridDim.x) {
        if (it < 2048) hg_scan_item(p, it);
        else {
          int t = it - 2048, g = t / (MT / 128), mt = t % (MT / 128);
          gemm_tile((const u16*)(p.ws + OFF_POOLED) + g * 128, 512,
                    (const u16*)(p.ws + OFF_WPL) + (size_t)((l >> 1) * 4 + g) * 128 * 128, 128, 128, mt * 128, 0, smem,
                    EpiPool{MIX, p.pool_scale + (l >> 1) * 512, g});
        }
      }
    } break;
    case 6:
      for (int it = blockIdx.x; it < 16 * NCH; it += gridDim.x) hg_o_item(p, l >> 1, it, smem);
      break;
    case 7: gemm_phase(MIX, D, (const u16*)(p.ws + OFF_WMO) + (size_t)l * 1024 * 1024, Mpost, 1024, 1024, smem, EpiF32{Y}); break;
    case 8: phase_rows(p, 1, l, 1, Mpost, false); break;
    case 9: gemm_phase(H, D, WFI + (size_t)(l * 2 + 1) * 5632 * 1024, Mpost, 5632, 1024, smem, EpiSwiglu{HID}); break;
    case 10: gemm_phase(HID, FH, WFO + (size_t)(l * 2 + 1) * 1024 * 2816, Mpost, 1024, 2816, smem, EpiF32{Y}); break;
    case 11: phase_rows(p, 1, l, 2, Mpost, last); break;
  }
}

__global__ void __launch_bounds__(256, 2) mega(P p, int ph_lo, int ph_hi) {
  __shared__ __attribute__((aligned(16))) char smem[65536];
  GB gb;
  gb.bar = (unsigned*)(p.ws + OFF_BAR); gb.x = xb_xcc_id(); gb.nloc = 0u; gb.nx = 0u;
  if (threadIdx.x == 0) (void)xb_add(&gb.bar[XB_XCNT(gb.x)], 1u);
  for (int ph = ph_lo; ph < ph_hi; ++ph) {
    run_phase(p, ph, smem);
#ifdef DOUBLE_GEMM
    {
      int q = ph - 2, l = 0;
      if (ph >= 2) {
        if (q < 12) l = 0; else if (q < 22) { l = 1; q -= 12; } else if (q < 34) { l = 2; q -= 22; } else { l = 3; q -= 34; }
        int step = q; if ((l & 1) && q >= 5) step = q + 2;
        if (step == 0 || step == 1 || step == 3 || step == 7 || step == 9 || step == 10) run_phase(p, ph, smem);
      }
    }
#endif
#ifdef DOUBLE_ATT
    if (ph == 2 + 12 + 4 || ph == 2 + 34 + 4) run_phase(p, ph, smem);
#endif
    if (ph + 1 < ph_hi) {
      if (ph == ph_lo) cg::this_grid().sync();
      else gbar(gb);
    }
  }
}

extern "C" void kernel_launch(void* const* d_in, const int* in_sizes, int n_in, void* d_out, int out_size, void* d_ws,
                              size_t ws_size, hipStream_t stream) {
  static int grid_blocks = 0;
  if (!grid_blocks) {
    int dev = 0, cus = 0, per_cu = 0;
    hipGetDevice(&dev);
    hipDeviceGetAttribute(&cus, hipDeviceAttributeMultiprocessorCount, dev);
    hipOccupancyMaxActiveBlocksPerMultiprocessor(&per_cu, mega, 256, 0);
    if (per_cu > 2) per_cu = 2;
    grid_blocks = cus * per_cu;
  }
  if (ws_size < OFF_END2) { fprintf(stderr, "workspace too small: %zu < %zu\n", ws_size, (size_t)OFF_END); return; }
  P p{};
  const float** f = (const float**)&p;
  for (int i = 0; i < 20; ++i) f[i] = (const float*)d_in[i];
  p.out = (float*)d_out;
  p.ws = (char*)d_ws;
#if MULTI_LAUNCH
  for (int ph = 0; ph < N_PHASES; ++ph) hipLaunchKernelGGL(mega, dim3(grid_blocks), dim3(256), 0, stream, p, ph, ph + 1);
#else
  hipMemsetAsync((char*)d_ws + OFF_BAR, 0, XCD_BAR_WORDS * 4, stream);
  int lo = 0, hi = N_PHASES;
  void* args[] = {&p, &lo, &hi};
  hipError_t e = hipLaunchCooperativeKernel((void*)mega, dim3(grid_blocks), dim3(256), args, 0, stream);
  if (e != hipSuccess) fprintf(stderr, "cooperative launch failed: %s (grid %d)\n", hipGetErrorString(e), grid_blocks);
#endif
}
```

```cpp
#include <hip/hip_runtime.h>
#include <hip/hip_cooperative_groups.h>
#include <cstdio>
namespace cg = cooperative_groups;

typedef __attribute__((ext_vector_type(8))) short bf16x8;
typedef __attribute__((ext_vector_type(4))) float f32x4;
typedef unsigned short u16;

#ifndef MULTI_LAUNCH
#define MULTI_LAUNCH 0
#endif

constexpr int D = 1024, NB = 4, SEQ = 4096, CTX = 256, FH = 2816;
constexpr int ML = NB * SEQ, MC = NB * CTX, MT = ML + MC;
constexpr int TK = CTX + SEQ;
constexpr int NCH = TK / 64;
constexpr float ALPHA = 1.6817928305074290f;
constexpr float LOG2E = 1.4426950408889634f;

constexpr size_t al256(size_t x) { return (x + 255) & ~(size_t)255; }
constexpr size_t OFF_WFI = 0;
constexpr size_t OFF_WFO = OFF_WFI + al256((size_t)4 * 2 * 5632 * 1024 * 2);
constexpr size_t OFF_WMI = OFF_WFO + al256((size_t)4 * 2 * 1024 * 2816 * 2);
constexpr size_t OFF_WMO = OFF_WMI + al256((size_t)4 * 3072 * 1024 * 2);
constexpr size_t OFF_WPL = OFF_WMO + al256((size_t)4 * 1024 * 1024 * 2);
constexpr size_t OFF_MODS = OFF_WPL + al256((size_t)2 * 4 * 128 * 128 * 2);
constexpr size_t OFF_LB = OFF_MODS + al256((size_t)4 * 5 * 9216 * 4);
constexpr size_t OFF_LAM = OFF_LB + al256((size_t)2 * 2 * 512 * 4);
constexpr size_t OFF_ROPE = OFF_LAM + 256;
constexpr size_t OFF_DEC = OFF_ROPE + al256((size_t)64 * 16 * 2 * 4);
constexpr size_t OFF_X = OFF_DEC + al256((size_t)32 * NCH * 128 * 4);
constexpr size_t OFF_H = OFF_X + al256((size_t)MT * 1024 * 4);
constexpr size_t OFF_PROJ = OFF_H + al256((size_t)MT * 1024 * 2);
constexpr size_t OFF_VT = OFF_PROJ + al256((size_t)MT * 3072 * 2);
constexpr size_t OFF_MIX = OFF_VT + al256((size_t)NB * 8 * 128 * TK * 2);
constexpr size_t OFF_POOLED = OFF_MIX + al256((size_t)MT * 1024 * 2);
constexpr size_t OFF_HID = OFF_POOLED + al256((size_t)MT * 512 * 2);
constexpr size_t OFF_Y = OFF_HID + al256((size_t)MT * FH * 2);
constexpr size_t OFF_END = OFF_Y + al256((size_t)MT * 1024 * 4);
constexpr size_t OFF_YC = OFF_END;
constexpr size_t OFF_BAR = OFF_YC + al256((size_t)4 * MC * 1024 * 2);
constexpr size_t OFF_END2 = OFF_BAR + al256((size_t)3456 * 4);
constexpr size_t OFF_U = OFF_HID;
static_assert((size_t)32 * NCH * 16384 * 4 <= OFF_END - OFF_HID, "U alias too big");

struct P {
  const float *x, *c, *ctx, *c_ctx, *w_ada, *b_ada, *ln_g, *ln_b, *w_ffn_in, *w_ffn_out, *w_in_even, *w_out_even,
      *hg_lb, *hg_norm_w, *pool_w, *pool_scale, *w_in_odd, *w_out_odd, *da_lambda, *da_sub_w;
  float* out;
  char* ws;
};

typedef __attribute__((ext_vector_type(2))) __bf16 bf16v2;
typedef __attribute__((ext_vector_type(2))) float f32v2;
__device__ __forceinline__ unsigned pk2(float a, float b) {
  f32v2 v = {a, b};
  bf16v2 r = __builtin_convertvector(v, bf16v2);
  return *(unsigned*)&r;
}
__device__ __forceinline__ u16 f2bf(float f) { return (u16)(pk2(f, 0.f) & 0xffffu); }
__device__ __forceinline__ float bf2f(u16 h) { return __uint_as_float(((unsigned)h) << 16); }
__device__ __forceinline__ float sigm(float z) { return 1.f / (1.f + __expf(-z)); }
__device__ __forceinline__ float silu(float z) { return z / (1.f + __expf(-z)); }
__device__ __forceinline__ float ex2(float x) { return __builtin_amdgcn_exp2f(x); }
__device__ __forceinline__ void glds16(const void* g, void* l) {
  __builtin_amdgcn_global_load_lds((const unsigned*)g, (unsigned*)l, 16, 0, 0);
}
__device__ __forceinline__ int get_tid() { int t = threadIdx.x; asm volatile("" : "+v"(t)); return t; }
__device__ __forceinline__ int swz128(int row, int ch) { return row * 128 + ((ch ^ ((row >> 1) & 7)) << 4); }
__device__ __forceinline__ int swz256(int row, int ch) { return row * 256 + ((ch ^ (row & 15)) << 4); }
__device__ __forceinline__ f32x4 mfma16(bf16x8 a, bf16x8 b, f32x4 c) {
  return __builtin_amdgcn_mfma_f32_16x16x32_bf16(a, b, c, 0, 0, 0);
}
__device__ __forceinline__ float xor_sum(float v, int m) { return v + __shfl_xor(v, m, 64); }
__device__ __forceinline__ float xor_max(float v, int m) { return fmaxf(v, __shfl_xor(v, m, 64)); }
__device__ __forceinline__ void row_bpos(int row, int& b, int& pos) {
  if (row < ML) { b = row >> 12; pos = CTX + (row & 4095); }
  else { int r = row - ML; b = r >> 8; pos = r & 255; }
}
__device__ __forceinline__ int mod_row(int row) { return row < ML ? (row >> 12) : 4; }

constexpr int BM = 128, BN = 128, BK = 64;

template <class Epi>
__device__ __forceinline__ void gemm_tile(const u16* __restrict__ A, int lda, const u16* __restrict__ Bt, int ldb, int K,
                                          int m0, int n0, char* smem, const Epi& epi) {
  const int tid = get_tid(), lane = tid & 63, wid = tid >> 6, wr = wid >> 1, wc = wid & 1, fr = lane & 15, fq = lane >> 4;
  f32x4 acc[4][4];
#pragma unroll
  for (int m = 0; m < 4; ++m)
#pragma unroll
    for (int n = 0; n < 4; ++n) acc[m][n] = f32x4{0.f, 0.f, 0.f, 0.f};
  const int nk = K / BK;
  const u16* ga[4];
  const u16* gb[4];
#pragma unroll
  for (int i = 0; i < 4; ++i) {
    int q = tid + i * 256, row = q >> 3, ch = (q & 7) ^ ((row >> 1) & 7);
    ga[i] = A + (size_t)(m0 + row) * lda + ch * 8;
    gb[i] = Bt + (size_t)(n0 + row) * ldb + ch * 8;
  }
  __syncthreads();
#pragma unroll
  for (int i = 0; i < 4; ++i) {
    glds16(ga[i], smem + (tid + i * 256) * 16);
    glds16(gb[i], smem + 16384 + (tid + i * 256) * 16);
  }
  for (int kt = 0; kt < nk; ++kt) {
    __syncthreads();
    char* cur = smem + (kt & 1) * 32768;
    if (kt + 1 < nk) {
      char* nxt = smem + ((kt + 1) & 1) * 32768;
#pragma unroll
      for (int i = 0; i < 4; ++i) {
        glds16(ga[i] + (kt + 1) * BK, nxt + (tid + i * 256) * 16);
        glds16(gb[i] + (kt + 1) * BK, nxt + 16384 + (tid + i * 256) * 16);
      }
    }
#pragma unroll
    for (int ks = 0; ks < 2; ++ks) {
      bf16x8 a[4], b[4];
#pragma unroll
      for (int m = 0; m < 4; ++m) a[m] = *(const bf16x8*)(cur + swz128(wr * 64 + m * 16 + fr, ks * 4 + fq));
#pragma unroll
      for (int n = 0; n < 4; ++n) b[n] = *(const bf16x8*)(cur + 16384 + swz128(wc * 64 + n * 16 + fr, ks * 4 + fq));
#pragma unroll
      for (int m = 0; m < 4; ++m)
#pragma unroll
        for (int n = 0; n < 4; ++n) acc[m][n] = mfma16(b[n], a[m], acc[m][n]);
    }
  }
  epi(acc, m0 + wr * 64, n0 + wc * 64, fr, fq);
}

__device__ __forceinline__ bool xcd_tile(int it, int nM, int nN, int& pm, int& pn) {
  const int xcd = blockIdx.x & 7, slot = blockIdx.x >> 3, nslot = gridDim.x >> 3;
  const int mlo = (nM * xcd) >> 3, mhi = (nM * (xcd + 1)) >> 3, mcnt = mhi - mlo;
  const int j = slot + it * nslot;
  if (j >= mcnt * nN) return false;
  const int per_ng = mcnt * 8;
  const int ng = j / per_ng, r = j - ng * per_ng;
  const int nrem = min(8, nN - ng * 8);
  pm = mlo + r / nrem; pn = ng * 8 + r % nrem;
  return true;
}
template <class Epi>
__device__ __forceinline__ void gemm_phase(const u16* A, int lda, const u16* Bt, int M, int N, int K, char* smem,
                                           const Epi& epi) {
  const int nM = M / BM, nN = N / BN;
  for (int it = 0;; ++it) {
    int pm, pn;
    if (!xcd_tile(it, nM, nN, pm, pn)) break;
    gemm_tile(A, lda, Bt, K, K, pm * BM, pn * BN, smem, epi);
  }
}

struct EpiSwiglu {
  u16* hid;
  __device__ __forceinline__ void operator()(f32x4 (&acc)[4][4], int rb, int cb, int fr, int fq) const {
#pragma unroll
    for (int m = 0; m < 4; ++m)
#pragma unroll
      for (int n = 0; n < 4; n += 2) {
        int row = rb + m * 16 + fr, hc = (cb >> 1) + (n >> 1) * 16 + fq * 4;
        uint2 v = {pk2(silu(acc[m][n][0]) * acc[m][n + 1][0], silu(acc[m][n][1]) * acc[m][n + 1][1]),
                   pk2(silu(acc[m][n][2]) * acc[m][n + 1][2], silu(acc[m][n][3]) * acc[m][n + 1][3])};
        *(uint2*)(hid + (size_t)row * FH + hc) = v;
      }
  }
};
struct EpiF32 {
  u16* y;
  __device__ __forceinline__ void operator()(f32x4 (&acc)[4][4], int rb, int cb, int fr, int fq) const {
#pragma unroll
    for (int m = 0; m < 4; ++m)
#pragma unroll
      for (int n = 0; n < 4; ++n)
        *(uint2*)(y + (size_t)(rb + m * 16 + fr) * D + cb + n * 16 + fq * 4) =
            uint2{pk2(acc[m][n][0], acc[m][n][1]), pk2(acc[m][n][2], acc[m][n][3])};
  }
};
struct EpiPool {
  u16* mix; const float* scale; int g;
  __device__ __forceinline__ void operator()(f32x4 (&acc)[4][4], int rb, int cb, int fr, int fq) const {
#pragma unroll
    for (int n = 0; n < 4; ++n) {
      int col = g * 128 + cb + n * 16 + fq * 4;
      float4 sc = *(const float4*)(scale + col);
#pragma unroll
      for (int m = 0; m < 4; ++m) {
        uint2 v = {pk2(acc[m][n][0] * sc.x, acc[m][n][1] * sc.y), pk2(acc[m][n][2] * sc.z, acc[m][n][3] * sc.w)};
        *(uint2*)(mix + (size_t)(rb + m * 16 + fr) * D + 512 + col) = v;
      }
    }
  }
};
__device__ __forceinline__ void store_vt(u16* vt, int nh, f32x4 (&acc)[4][4], int rb, int fcol0, int fr, int fq) {
#pragma unroll
  for (int m = 0; m < 4; ++m) {
    int row = rb + m * 16 + fr, b, pos;
    row_bpos(row, b, pos);
#pragma unroll
    for (int n = 0; n < 4; ++n) {
      int fc = fcol0 + n * 16 + fq * 4, h = fc >> 7, f = fc & 127;
      u16* o = vt + ((size_t)((b * nh + h) * 128 + f)) * TK + pos;
#pragma unroll
      for (int j = 0; j < 4; ++j) o[(size_t)j * TK] = f2bf(acc[m][n][j]);
    }
  }
}
struct EpiProjEven {
  u16* proj; u16* vt;
  __device__ __forceinline__ void operator()(f32x4 (&acc)[4][4], int rb, int cb, int fr, int fq) const {
    if (cb >= 512 && cb < 1024) { store_vt(vt, 4, acc, rb, cb - 512, fr, fq); return; }
    const float sc = (cb < 512) ? 0.08838834764831845f : 1.f;
#pragma unroll
    for (int m = 0; m < 4; ++m)
#pragma unroll
      for (int n = 0; n < 4; ++n) {
        uint2 v = {pk2(acc[m][n][0] * sc, acc[m][n][1] * sc), pk2(acc[m][n][2] * sc, acc[m][n][3] * sc)};
        *(uint2*)(proj + (size_t)(rb + m * 16 + fr) * 3072 + cb + n * 16 + fq * 4) = v;
      }
  }
};
struct EpiProjOdd {
  u16* proj; u16* vt; const float* rope;
  __device__ __forceinline__ void operator()(f32x4 (&acc)[4][4], int rb, int cb, int fr, int fq) const {
    if (cb >= 2048) { store_vt(vt, 8, acc, rb, cb - 2048, fr, fq); return; }
    const float sc = (cb < 1024) ? 0.125f * LOG2E : 1.f;
#pragma unroll
    for (int m = 0; m < 4; ++m) {
      int row = rb + m * 16 + fr;
      f32x4 v0 = acc[m][0], v1 = acc[m][1], v2 = acc[m][2], v3 = acc[m][3];
      if (row < ML) {
        int t = row & 4095, pr = t >> 6, pc = t & 63;
        const float* rr = rope + (pr * 16 + fq * 4) * 2;
        const float* rc = rope + (pc * 16 + fq * 4) * 2;
        float4 r0 = *(const float4*)rr, r1 = *(const float4*)(rr + 4), c0 = *(const float4*)rc, c1 = *(const float4*)(rc + 4);
        float cs[4] = {r0.x, r0.z, r1.x, r1.z}, sn[4] = {r0.y, r0.w, r1.y, r1.w};
        float cs2[4] = {c0.x, c0.z, c1.x, c1.z}, sn2[4] = {c0.y, c0.w, c1.y, c1.w};
#pragma unroll
        for (int j = 0; j < 4; ++j) {
          float a0 = v0[j] * cs[j] - v1[j] * sn[j], a1 = v1[j] * cs[j] + v0[j] * sn[j];
          float a2 = v2[j] * cs2[j] - v3[j] * sn2[j], a3 = v3[j] * cs2[j] + v2[j] * sn2[j];
          v0[j] = a0; v1[j] = a1; v2[j] = a2; v3[j] = a3;
        }
      }
      u16* o = proj + (size_t)row * 3072 + cb + fq * 4;
      *(uint2*)(o) = uint2{pk2(v0[0] * sc, v0[1] * sc), pk2(v0[2] * sc, v0[3] * sc)};
      *(uint2*)(o + 16) = uint2{pk2(v1[0] * sc, v1[1] * sc), pk2(v1[2] * sc, v1[3] * sc)};
      *(uint2*)(o + 32) = uint2{pk2(v2[0] * sc, v2[1] * sc), pk2(v2[2] * sc, v2[3] * sc)};
      *(uint2*)(o + 48) = uint2{pk2(v3[0] * sc, v3[1] * sc), pk2(v3[2] * sc, v3[3] * sc)};
    }
  }
};

__device__ __forceinline__ void convert_tile(const float* __restrict__ src, int K, int N, u16* __restrict__ dst, int tile,
                                             bool swiglu, char* smem) {
  float* t = (float*)smem;
  const int tid = get_tid();
  const int nN = N / 64, nt = tile % nN, kt = tile / nN, k0 = kt * 64, n0 = nt * 64;
  __syncthreads();
#pragma unroll
  for (int i = 0; i < 4; ++i) {
    int k = (tid >> 4) + 16 * i, n4 = (tid & 15) * 4;
    float4 v = *(const float4*)(src + (size_t)(k0 + k) * N + n0 + n4);
    t[k * 65 + n4] = v.x; t[k * 65 + n4 + 1] = v.y; t[k * 65 + n4 + 2] = v.z; t[k * 65 + n4 + 3] = v.w;
  }
  __syncthreads();
#pragma unroll
  for (int i = 0; i < 2; ++i) {
    int q = tid + i * 256, n = q >> 3, kc = (q & 7) * 8;
    int c = n0 + n, nr = c;
    if (swiglu) nr = (c < FH) ? (32 * (c >> 4) + (c & 15)) : (32 * ((c - FH) >> 4) + 16 + ((c - FH) & 15));
    uint4 o = {pk2(t[kc * 65 + n], t[(kc + 1) * 65 + n]), pk2(t[(kc + 2) * 65 + n], t[(kc + 3) * 65 + n]),
               pk2(t[(kc + 4) * 65 + n], t[(kc + 5) * 65 + n]), pk2(t[(kc + 6) * 65 + n], t[(kc + 7) * 65 + n])};
    *(uint4*)(dst + (size_t)nr * K + k0 + kc) = o;
  }
}

__device__ void phase_prep(const P& p, char* smem) {
  const int tid = get_tid();
  constexpr int N_ADA = 1152, N_TR = 4 * 5248 + 32;
  for (int item = blockIdx.x; item < N_ADA + N_TR + 1; item += gridDim.x) {
    if (item < N_ADA) {
      float* act = (float*)smem;
      float* red = (float*)(smem + 20480);
      const int l = item / 288, cb = (item % 288) * 32;
      __syncthreads();
      for (int i = tid; i < 5120; i += 256) {
        int r = i >> 10, k = i & 1023;
        float v = r < 4 ? p.c[r * 1024 + k] : p.c_ctx[k];
        act[i] = silu(v);
      }
      __syncthreads();
      const int tx = tid & 31, kg = tid >> 5;
      float a0 = 0, a1 = 0, a2 = 0, a3 = 0, a4 = 0;
      const float* w = p.w_ada + ((size_t)l * 1024 + kg * 128) * 9216 + cb + tx;
      for (int k0 = 0; k0 < 128; k0 += 16) {
        float wv[16];
#pragma unroll
        for (int k = 0; k < 16; ++k) wv[k] = w[(size_t)(k0 + k) * 9216];
#pragma unroll
        for (int k = 0; k < 16; ++k) {
          int kk = kg * 128 + k0 + k;
          a0 += act[kk] * wv[k]; a1 += act[1024 + kk] * wv[k]; a2 += act[2048 + kk] * wv[k]; a3 += act[3072 + kk] * wv[k];
          a4 += act[4096 + kk] * wv[k];
        }
      }
      red[(kg * 5 + 0) * 32 + tx] = a0; red[(kg * 5 + 1) * 32 + tx] = a1; red[(kg * 5 + 2) * 32 + tx] = a2;
      red[(kg * 5 + 3) * 32 + tx] = a3; red[(kg * 5 + 4) * 32 + tx] = a4;
      __syncthreads();
      if (tid < 160) {
        int r = tid >> 5, x = tid & 31;
        float sacc = 0.f;
#pragma unroll
        for (int g8 = 0; g8 < 8; ++g8) sacc += red[(g8 * 5 + r) * 32 + x];
        ((float*)(p.ws + OFF_MODS))[(size_t)(l * 5 + r) * 9216 + cb + x] = sacc + p.b_ada[l * 9216 + cb + x];
      }
    } else if (item < N_ADA + N_TR) {
      int idx = item - N_ADA;
      if (idx < 4 * 5248) {
        int l = idx / 5248, r = idx % 5248;
        if (r < 2816) {
          int f = r / 1408, tile = r % 1408;
          convert_tile(p.w_ffn_in + (size_t)(l * 2 + f) * 1024 * 5632, 1024, 5632,
                       (u16*)(p.ws + OFF_WFI) + (size_t)(l * 2 + f) * 5632 * 1024, tile, true, smem);
        } else if (r < 4224) {
          int f = (r - 2816) / 704, tile = (r - 2816) % 704;
          convert_tile(p.w_ffn_out + (size_t)(l * 2 + f) * 2816 * 1024, 2816, 1024,
                       (u16*)(p.ws + OFF_WFO) + (size_t)(l * 2 + f) * 1024 * 2816, tile, false, smem);
        } else if (r < 4992) {
          const float* src = (l & 1) ? p.w_in_odd + (size_t)(l >> 1) * 1024 * 3072 : p.w_in_even + (size_t)(l >> 1) * 1024 * 3072;
          convert_tile(src, 1024, 3072, (u16*)(p.ws + OFF_WMI) + (size_t)l * 3072 * 1024, r - 4224, false, smem);
        } else {
          const float* src = (l & 1) ? p.w_out_odd + (size_t)(l >> 1) * 1024 * 1024 : p.w_out_even + (size_t)(l >> 1) * 1024 * 1024;
          convert_tile(src, 1024, 1024, (u16*)(p.ws + OFF_WMO) + (size_t)l * 1024 * 1024, r - 4992, false, smem);
        }
      } else {
        int i2 = idx - 4 * 5248, eg = i2 >> 2, tile = i2 & 3;
        convert_tile(p.pool_w + (size_t)eg * 128 * 128, 128, 128, (u16*)(p.ws + OFF_WPL) + (size_t)eg * 128 * 128, tile, false, smem);
      }
    } else {
      float* LB = (float*)(p.ws + OFF_LB);
      for (int i = tid; i < 1024; i += 256) {
        float a0 = p.hg_lb[i], a1 = p.hg_lb[1024 + i];
        float mx = fmaxf(a0, a1), e0 = __expf(a0 - mx), e1 = __expf(a1 - mx);
        LB[i] = 0.f;
        LB[1024 + i] = e1 / (e0 + e1);
      }
      if (tid < 2) {
        const float* lv = p.da_lambda + tid * 256;
        float s0 = 0, s1 = 0;
        for (int i = 0; i < 64; ++i) { s0 += lv[i] * lv[64 + i]; s1 += lv[128 + i] * lv[192 + i]; }
        float li = 0.8f - 0.6f * expf(-0.3f * (float)(2 * tid + 1));
        ((float*)(p.ws + OFF_LAM))[tid] = expf(s0) - expf(s1) + li;
      }
      float* rope = (float*)(p.ws + OFF_ROPE);
      for (int i = tid; i < 1024; i += 256) {
        int pos = i >> 4, fi = i & 15;
        float inv = exp2f(-(float)fi * (13.287712379549449f / 16.f));
        float ang = (float)pos * inv;
        float k = rintf(ang * 0.15915494309189535f);
        float r = fmaf(-k, 6.28125f, ang);
        r = fmaf(-k, 1.9353071795864769e-3f, r);
        rope[i * 2] = cosf(r);
        rope[i * 2 + 1] = sinf(r);
      }
    }
  }
}

__device__ void phase_rows(const P& p, int mode, int l, int sub, int M, bool final_out) {
  const int tid = get_tid(), lane = tid & 63, wid = tid >> 6;
  float* X = (float*)(p.ws + OFF_X);
  const u16* Y = (const u16*)(p.ws + OFF_Y);
  u16* H = (u16*)(p.ws + OFF_H);
  const float* MODS = (const float*)(p.ws + OFF_MODS);
  int nl, si;
  if (mode == 0) { nl = 0; si = 0; }
  else if (sub == 0) { nl = l; si = 3; }
  else if (sub == 1) { nl = l; si = 6; }
  else { nl = l + 1; si = 0; }
  const float gs = (sub == 1) ? 1.f : 0.5f;
  const float* lg = p.ln_g + (size_t)(l * 3 + sub) * D;
  const float* lbp = p.ln_b + (size_t)(l * 3 + sub) * D;
  for (int row0 = (blockIdx.x * 4 + wid) * 2; row0 < M; row0 += gridDim.x * 8) {
    const int mr = mod_row(row0);
    const bool ksplit = (mode == 1) && (sub != 1) && (row0 >= ML);
    float v[2][16];
    if (mode == 0) {
#pragma unroll
      for (int r = 0; r < 2; ++r) {
        const int row = row0 + r;
        const float* src = row < ML ? p.x + (size_t)row * D : p.ctx + (size_t)(row - ML) * D;
#pragma unroll
        for (int i = 0; i < 4; ++i) {
          float4 t = *(const float4*)(src + i * 256 + lane * 4);
          v[r][i * 4] = t.x; v[r][i * 4 + 1] = t.y; v[r][i * 4 + 2] = t.z; v[r][i * 4 + 3] = t.w;
        }
      }
    } else {
      const float* gate = MODS + (size_t)(l * 5 + mr) * 9216 + (2 + 3 * sub) * 1024;
      float4 xv[2][4]; uint2 yv[2][4]; float4 gv[4];
#pragma unroll
      for (int r = 0; r < 2; ++r)
#pragma unroll
        for (int i = 0; i < 4; ++i) {
          int c = i * 256 + lane * 4;
          xv[r][i] = *(const float4*)(X + (size_t)(row0 + r) * D + c);
          if (!ksplit) yv[r][i] = *(const uint2*)(Y + (size_t)(row0 + r) * D + c);
        }
      float ysum[2][16];
      if (ksplit) {
        const u16* YC = (const u16*)(p.ws + OFF_YC);
#pragma unroll
        for (int r = 0; r < 2; ++r)
#pragma unroll
          for (int i = 0; i < 4; ++i) {
            int c = i * 256 + lane * 4;
            uint2 t0 = *(const uint2*)(YC + ((size_t)0 * MC + row0 + r - ML) * D + c), t1 = *(const uint2*)(YC + ((size_t)1 * MC + row0 + r - ML) * D + c);
            uint2 t2 = *(const uint2*)(YC + ((size_t)2 * MC + row0 + r - ML) * D + c), t3 = *(const uint2*)(YC + ((size_t)3 * MC + row0 + r - ML) * D + c);
            ysum[r][i * 4] = __uint_as_float(t0.x << 16) + __uint_as_float(t1.x << 16) + __uint_as_float(t2.x << 16) + __uint_as_float(t3.x << 16);
            ysum[r][i * 4 + 1] = __uint_as_float(t0.x & 0xffff0000u) + __uint_as_float(t1.x & 0xffff0000u) + __uint_as_float(t2.x & 0xffff0000u) + __uint_as_float(t3.x & 0xffff0000u);
            ysum[r][i * 4 + 2] = __uint_as_float(t0.y << 16) + __uint_as_float(t1.y << 16) + __uint_as_float(t2.y << 16) + __uint_as_float(t3.y << 16);
            ysum[r][i * 4 + 3] = __uint_as_float(t0.y & 0xffff0000u) + __uint_as_float(t1.y & 0xffff0000u) + __uint_as_float(t2.y & 0xffff0000u) + __uint_as_float(t3.y & 0xffff0000u);
          }
      }
#pragma unroll
      for (int i = 0; i < 4; ++i) gv[i] = *(const float4*)(gate + i * 256 + lane * 4);
      float s[2] = {0.f, 0.f};
#pragma unroll
      for (int r = 0; r < 2; ++r)
#pragma unroll
        for (int i = 0; i < 4; ++i) {
          float y0, y1, y2, y3;
          if (ksplit) { y0 = ysum[r][i * 4]; y1 = ysum[r][i * 4 + 1]; y2 = ysum[r][i * 4 + 2]; y3 = ysum[r][i * 4 + 3]; }
          else {
            y0 = bf2f((u16)(yv[r][i].x & 0xffff)); y1 = bf2f((u16)(yv[r][i].x >> 16));
            y2 = bf2f((u16)(yv[r][i].y & 0xffff)); y3 = bf2f((u16)(yv[r][i].y >> 16));
          }
          v[r][i * 4] = ALPHA * xv[r][i].x + gs * gv[i].x * y0; v[r][i * 4 + 1] = ALPHA * xv[r][i].y + gs * gv[i].y * y1;
          v[r][i * 4 + 2] = ALPHA * xv[r][i].z + gs * gv[i].z * y2; v[r][i * 4 + 3] = ALPHA * xv[r][i].w + gs * gv[i].w * y3;
          s[r] += v[r][i * 4] + v[r][i * 4 + 1] + v[r][i * 4 + 2] + v[r][i * 4 + 3];
        }
#pragma unroll
      for (int o = 1; o < 64; o <<= 1) { s[0] = xor_sum(s[0], o); s[1] = xor_sum(s[1], o); }
      float q[2] = {0.f, 0.f};
#pragma unroll
      for (int r = 0; r < 2; ++r) {
        const float mu = s[r] * (1.f / 1024.f);
#pragma unroll
        for (int i = 0; i < 16; ++i) { v[r][i] -= mu; q[r] += v[r][i] * v[r][i]; }
      }
#pragma unroll
      for (int o = 1; o < 64; o <<= 1) { q[0] = xor_sum(q[0], o); q[1] = xor_sum(q[1], o); }
#pragma unroll
      for (int i = 0; i < 4; ++i) {
        int c = i * 256 + lane * 4;
        float4 g4 = *(const float4*)(lg + c), b4 = *(const float4*)(lbp + c);
#pragma unroll
        for (int r = 0; r < 2; ++r) {
          const float rstd = rsqrtf(q[r] * (1.f / 1024.f) + 1e-5f);
          v[r][i * 4] = v[r][i * 4] * rstd * g4.x + b4.x; v[r][i * 4 + 1] = v[r][i * 4 + 1] * rstd * g4.y + b4.y;
          v[r][i * 4 + 2] = v[r][i * 4 + 2] * rstd * g4.z + b4.z; v[r][i * 4 + 3] = v[r][i * 4 + 3] * rstd * g4.w + b4.w;
        }
      }
    }
    if (final_out) {
#pragma unroll
      for (int r = 0; r < 2; ++r)
#pragma unroll
        for (int i = 0; i < 4; ++i)
          *(float4*)(p.out + (size_t)(row0 + r) * D + i * 256 + lane * 4) =
              float4{v[r][i * 4], v[r][i * 4 + 1], v[r][i * 4 + 2], v[r][i * 4 + 3]};
      continue;
    }
    const float* sh = MODS + (size_t)(nl * 5 + mr) * 9216 + si * 1024;
#pragma unroll
    for (int i = 0; i < 4; ++i) {
      int c = i * 256 + lane * 4;
      float4 s4 = *(const float4*)(sh + c), c4 = *(const float4*)(sh + 1024 + c);
#pragma unroll
      for (int r = 0; r < 2; ++r) {
        *(float4*)(X + (size_t)(row0 + r) * D + c) = float4{v[r][i * 4], v[r][i * 4 + 1], v[r][i * 4 + 2], v[r][i * 4 + 3]};
        uint2 hv = {pk2(v[r][i * 4] * (1.f + c4.x) + s4.x, v[r][i * 4 + 1] * (1.f + c4.y) + s4.y),
                    pk2(v[r][i * 4 + 2] * (1.f + c4.z) + s4.z, v[r][i * 4 + 3] * (1.f + c4.w) + s4.w)};
        *(uint2*)(H + (size_t)(row0 + r) * D + c) = hv;
      }
    }
  }
}

__device__ void phase_attn(const P& p, int l, char* smem) {
  const int tid = get_tid(), lane = tid & 63, w = tid >> 6, fr = lane & 15, fq = lane >> 4;
  const u16* PROJ = (const u16*)(p.ws + OFF_PROJ);
  const u16* VT = (const u16*)(p.ws + OFF_VT);
  u16* MIX = (u16*)(p.ws + OFF_MIX);
  const float lam = ((const float*)(p.ws + OFF_LAM))[l >> 1];
  const float lam_init = 0.8f - 0.6f * expf(-0.3f * (float)l);
  const float* subw = p.da_sub_w + (l >> 1) * 128;
  const int xcd = blockIdx.x & 7, slot = blockIdx.x >> 3, nslot = gridDim.x >> 3;
  const int n_virt = (l == 3) ? 256 : 272;
  for (int idx = slot; idx < n_virt; idx += nslot) {
    int b, h, qrow0, nkt;
    if (idx < 256) {
      const int bh = (idx >> 6) * 8 + xcd;
      b = bh >> 3; h = bh & 7; qrow0 = b * 4096 + (idx & 63) * 64; nkt = 68;
    } else {
      const int cs = idx - 256, bh = (cs >> 2) * 8 + xcd;
      b = bh >> 3; h = bh & 7; qrow0 = ML + b * 256 + (cs & 3) * 64; nkt = 4;
    }
    bf16x8 qf[2][2];
    {
      const u16* qp = PROJ + (size_t)(qrow0 + w * 16 + fr) * 3072 + h * 128 + fq * 8;
#pragma unroll
      for (int m = 0; m < 2; ++m)
#pragma unroll
        for (int ks = 0; ks < 2; ++ks) qf[m][ks] = *(const bf16x8*)(qp + m * 64 + ks * 32);
    }
    f32x4 O[2][8];
#pragma unroll
    for (int m = 0; m < 2; ++m)
#pragma unroll
      for (int v = 0; v < 8; ++v) O[m][v] = f32x4{0.f, 0.f, 0.f, 0.f};
    float mrun[2] = {-1e30f, -1e30f}, lsum[2] = {0.f, 0.f};
    const u16* vbase = VT + (size_t)((b * 8 + h) * 128) * TK;
    auto stage = [&](int kt, char* buf) {
      const int krow0 = kt < 4 ? ML + b * 256 + kt * 64 : b * 4096 + (kt - 4) * 64;
#pragma unroll
      for (int i = 0; i < 4; ++i) {
        int q = tid + i * 256;
        int key = q >> 4, ch = (q & 15) ^ (key & 15);
        glds16(PROJ + (size_t)(krow0 + key) * 3072 + 1024 + h * 128 + ch * 8, buf + q * 16);
        int dv = q >> 3, c2 = (q & 7) ^ ((dv >> 1) & 7);
        glds16(vbase + (size_t)dv * TK + kt * 64 + c2 * 8, buf + 16384 + q * 16);
      }
    };
    __syncthreads();
    stage(0, smem);
    for (int kt = 0; kt < nkt; ++kt) {
      __syncthreads();
      char* cur = smem + (kt & 1) * 32768;
      if (kt + 1 < nkt) stage(kt + 1, smem + ((kt + 1) & 1) * 32768);
      bf16x8 pb[2][2];
      f32x4 s[2][4];
#pragma unroll
      for (int sf = 0; sf < 4; ++sf) {
        s[0][sf] = f32x4{0.f, 0.f, 0.f, 0.f};
        s[1][sf] = f32x4{0.f, 0.f, 0.f, 0.f};
#pragma unroll
        for (int m = 0; m < 2; ++m)
#pragma unroll
          for (int ks = 0; ks < 2; ++ks) {
            bf16x8 a = *(const bf16x8*)(cur + swz256(sf * 16 + fr, m * 8 + ks * 4 + fq));
            s[m][sf] = mfma16(a, qf[m][ks], s[m][sf]);
          }
      }
      float tm0 = -1e30f, tm1 = -1e30f;
#pragma unroll
      for (int sf = 0; sf < 4; ++sf)
#pragma unroll
        for (int j = 0; j < 4; ++j) { tm0 = fmaxf(tm0, s[0][sf][j]); tm1 = fmaxf(tm1, s[1][sf][j]); }
      if (__any(fmaxf(tm0 - mrun[0], tm1 - mrun[1]) > 6.f)) {
        tm0 = xor_max(tm0, 16); tm1 = xor_max(tm1, 16);
        tm0 = xor_max(tm0, 32); tm1 = xor_max(tm1, 32);
        const float mn0 = fmaxf(mrun[0], tm0), sc0 = ex2(mrun[0] - mn0);
        const float mn1 = fmaxf(mrun[1], tm1), sc1 = ex2(mrun[1] - mn1);
        mrun[0] = mn0; mrun[1] = mn1;
        lsum[0] *= sc0; lsum[1] *= sc1;
#pragma unroll
        for (int v = 0; v < 8; ++v) { O[0][v] *= sc0; O[1][v] *= sc1; }
      }
#pragma unroll
      for (int m = 0; m < 2; ++m) {
        const float mn = mrun[m];
        float ps = 0.f;
#pragma unroll
        for (int sf = 0; sf < 4; ++sf)
#pragma unroll
          for (int j = 0; j < 4; ++j) { s[m][sf][j] = ex2(s[m][sf][j] - mn); ps += s[m][sf][j]; }
        lsum[m] += ps;
#pragma unroll
        for (int k2 = 0; k2 < 2; ++k2) {
          union { bf16x8 v; unsigned u[4]; } t;
          t.u[0] = pk2(s[m][2 * k2][0], s[m][2 * k2][1]); t.u[1] = pk2(s[m][2 * k2][2], s[m][2 * k2][3]);
          t.u[2] = pk2(s[m][2 * k2 + 1][0], s[m][2 * k2 + 1][1]); t.u[3] = pk2(s[m][2 * k2 + 1][2], s[m][2 * k2 + 1][3]);
          pb[m][k2] = t.v;
        }
      }
#pragma unroll
      for (int v = 0; v < 8; ++v) {
        const int dv = v * 16 + fr;
        union { bf16x8 v; uint2 u[2]; } a0, a1;
        a0.u[0] = *(const uint2*)(cur + 16384 + swz128(dv, (fq >> 1)) + (fq & 1) * 8);
        a0.u[1] = *(const uint2*)(cur + 16384 + swz128(dv, 2 + (fq >> 1)) + (fq & 1) * 8);
        a1.u[0] = *(const uint2*)(cur + 16384 + swz128(dv, 4 + (fq >> 1)) + (fq & 1) * 8);
        a1.u[1] = *(const uint2*)(cur + 16384 + swz128(dv, 6 + (fq >> 1)) + (fq & 1) * 8);
        O[0][v] = mfma16(a0.v, pb[0][0], O[0][v]);
        O[1][v] = mfma16(a0.v, pb[1][0], O[1][v]);
        O[0][v] = mfma16(a1.v, pb[0][1], O[0][v]);
        O[1][v] = mfma16(a1.v, pb[1][1], O[1][v]);
        if (v & 1) __builtin_amdgcn_sched_barrier(0);
      }
    }
    float l0 = xor_sum(xor_sum(lsum[0], 16), 32), l1 = xor_sum(xor_sum(lsum[1], 16), 32);
    const float i0 = 1.f / l0, i1 = lam / l1;
    float ssq = 0.f;
#pragma unroll
    for (int v = 0; v < 8; ++v)
#pragma unroll
      for (int j = 0; j < 4; ++j) { float o = O[0][v][j] * i0 - O[1][v][j] * i1; O[0][v][j] = o; ssq += o * o; }
    ssq = xor_sum(xor_sum(ssq, 16), 32);
    const float rs = rsqrtf(ssq * (1.f / 128.f) + 1e-6f) * (1.f - lam_init);
    u16* op = MIX + (size_t)(qrow0 + w * 16 + fr) * D + h * 128;
#pragma unroll
    for (int v = 0; v < 8; ++v) {
      int dv = v * 16 + fq * 4;
      float4 sw = *(const float4*)(subw + dv);
      uint2 o = {pk2(O[0][v][0] * rs * sw.x, O[0][v][1] * rs * sw.y), pk2(O[0][v][2] * rs * sw.z, O[0][v][3] * rs * sw.w)};
      *(uint2*)(op + dv) = o;
    }
  }
}

__device__ __forceinline__ void chunk_rows(int b, int cc_seq, int& row0, int& pos0) {
  if (cc_seq < 4) { row0 = ML + b * 256 + cc_seq * 64; pos0 = cc_seq * 64; }
  else { row0 = b * 4096 + (cc_seq - 4) * 64; pos0 = CTX + (cc_seq - 4) * 64; }
}
__device__ __forceinline__ int scan2tok(int c, int dir) {
  if (!dir) return c;
  return c < 4 ? 3 - c : 4 + 63 - (c - 4);
}

__device__ void hg_u_item(const P& p, int e, int item, char* smem) {
  const int tid = get_tid(), lane = tid & 63, wid = tid >> 6, wr = wid >> 1, wc = wid & 1, fr = lane & 15, fq = lane >> 4;
  const u16* PROJ = (const u16*)(p.ws + OFF_PROJ);
  const u16* IT = (const u16*)(p.ws + OFF_VT);
  float* U = (float*)(p.ws + OFF_U);
  float* DEC = (float*)(p.ws + OFF_DEC);
  const float* LB = (const float*)(p.ws + OFF_LB);
  const int c = item % NCH, seq = item / NCH, dir = seq & 1, h = (seq >> 1) & 3, b = seq >> 3;
  int row0, pos0;
  chunk_rows(b, scan2tok(c, dir), row0, pos0);
  float* tot = (float*)(smem + 16384);
  const int d = tid & 127, half = tid >> 7;
  const float lb = LB[(e * 2 + dir) * 512 + h * 128 + d];
  const u16* zp = PROJ + (size_t)row0 * 3072 + 1536 + dir * 512 + h * 128 + d;
  __syncthreads();
  float sum = 0.f;
#pragma unroll 8
  for (int i = 0; i < 32; ++i) {
    int tau = half * 32 + i, t = dir ? 63 - tau : tau;
    float f = lb + (1.f - lb) * sigm(bf2f(zp[(size_t)t * 3072]));
    sum += __logf(fmaxf(f, 1e-20f));
  }
  tot[half * 128 + d] = sum;
  __syncthreads();
  float rel = half ? 0.f : tot[128 + d];
#pragma unroll 8
  for (int i = 31; i >= 0; --i) {
    int tau = half * 32 + i, t = dir ? 63 - tau : tau;
    float f = lb + (1.f - lb) * sigm(bf2f(zp[(size_t)t * 3072]));
    float lf = __logf(fmaxf(f, 1e-20f));
    *(u16*)(smem + swz128(d, t >> 3) + (t & 7) * 2) = f2bf((1.f - f) * __expf(rel));
    rel += lf;
  }
  if (!half) DEC[(size_t)(seq * NCH + c) * 128 + d] = __expf(rel);
  __syncthreads();
  f32x4 acc[4][4];
#pragma unroll
  for (int m = 0; m < 4; ++m)
#pragma unroll
    for (int n = 0; n < 4; ++n) acc[m][n] = f32x4{0.f, 0.f, 0.f, 0.f};
  const u16* vb = IT + (size_t)((b * 4 + h) * 128) * TK + pos0;
#pragma unroll
  for (int ks = 0; ks < 2; ++ks) {
    bf16x8 a[4], bb[4];
#pragma unroll
    for (int m = 0; m < 4; ++m) a[m] = *(const bf16x8*)(vb + (size_t)(wr * 64 + m * 16 + fr) * TK + ks * 32 + fq * 8);
#pragma unroll
    for (int n = 0; n < 4; ++n) bb[n] = *(const bf16x8*)(smem + swz128(wc * 64 + n * 16 + fr, ks * 4 + fq));
#pragma unroll
    for (int m = 0; m < 4; ++m)
#pragma unroll
      for (int n = 0; n < 4; ++n) acc[m][n] = mfma16(a[m], bb[n], acc[m][n]);
  }
  float* up = U + (size_t)(seq * NCH + c) * 16384;
#pragma unroll
  for (int m = 0; m < 4; ++m)
#pragma unroll
    for (int n = 0; n < 4; ++n)
#pragma unroll
      for (int j = 0; j < 4; ++j) up[(wr * 64 + m * 16 + fq * 4 + j) * 128 + wc * 64 + n * 16 + fr] = acc[m][n][j];
}

__device__ void pool_item(const P& p, int item) {
  const int tid = get_tid();
  const u16* PROJ = (const u16*)(p.ws + OFF_PROJ);
  u16* PO = (u16*)(p.ws + OFF_POOLED);
  const int ch = tid * 2, g = ch >> 7, hw = 1 << g;
  const int row0 = item * 32;
  int base, n, pos0;
  if (row0 < ML) { base = row0 & ~4095; n = 4096; pos0 = row0 & 4095; }
  else { base = ML + ((row0 - ML) & ~255); n = 256; pos0 = (row0 - ML) & 255; }
  const u16* up = PROJ + (size_t)base * 3072 + 2560 + ch;
  float s0 = 0.f, s1 = 0.f;
  {
    const int lo = max(pos0 - hw, 0), hi = min(pos0 + hw, n);
    for (int r = lo; r < hi; ++r) {
      unsigned v = *(const unsigned*)(up + (size_t)r * 3072);
      s0 += __uint_as_float(v << 16); s1 += __uint_as_float(v & 0xffff0000u);
    }
  }
  for (int i0 = 0; i0 < 32; i0 += 16) {
    unsigned ce[16], en[16], le[16];
#pragma unroll
    for (int i = 0; i < 16; ++i) {
      const int pos = pos0 + i0 + i;
      ce[i] = *(const unsigned*)(up + (size_t)pos * 3072);
      en[i] = (pos + hw < n) ? *(const unsigned*)(up + (size_t)(pos + hw) * 3072) : 0u;
      le[i] = (pos - hw >= 0) ? *(const unsigned*)(up + (size_t)(pos - hw) * 3072) : 0u;
    }
#pragma unroll
    for (int i = 0; i < 16; ++i) {
      const int pos = pos0 + i0 + i;
      const int lo = max(pos - hw, 0), hi = min(pos + hw, n);
      const float ic = 1.f / (float)(hi - lo);
      *(unsigned*)(PO + (size_t)(base + pos) * 512 + ch) =
          pk2(s0 * ic - __uint_as_float(ce[i] << 16), s1 * ic - __uint_as_float(ce[i] & 0xffff0000u));
      s0 += __uint_as_float(en[i] << 16) - __uint_as_float(le[i] << 16);
      s1 += __uint_as_float(en[i] & 0xffff0000u) - __uint_as_float(le[i] & 0xffff0000u);
    }
  }
}

__device__ void hg_scan_item(const P& p, int item) {
  float* U = (float*)(p.ws + OFF_U);
  const float* DEC = (const float*)(p.ws + OFF_DEC);
  const int ei = item * 256 + get_tid(), seq = ei >> 14, vd = ei & 16383, d = vd & 127;
  float* up = U + (size_t)seq * NCH * 16384 + vd;
  const float* dp = DEC + (size_t)seq * NCH * 128 + d;
  float s = 0.f;
  for (int c0 = 0; c0 < NCH; c0 += 17) {
    float u[17], dd[17];
#pragma unroll
    for (int i = 0; i < 17; ++i) { u[i] = up[(size_t)(c0 + i) * 16384]; dd[i] = dp[(c0 + i) * 128]; }
#pragma unroll
    for (int i = 0; i < 17; ++i) { up[(size_t)(c0 + i) * 16384] = s; s = dd[i] * s + u[i]; }
  }
}

__device__ void hg_o_item(const P& p, int e, int item, char* smem) {
  const int tid = get_tid(), lane = tid & 63, w = tid >> 6, fr = lane & 15, fq = lane >> 4;
  const u16* PROJ = (const u16*)(p.ws + OFF_PROJ);
  const u16* IT = (const u16*)(p.ws + OFF_VT);
  const float* S = (const float*)(p.ws + OFF_U);
  const float* LB = (const float*)(p.ws + OFF_LB);
  u16* MIX = (u16*)(p.ws + OFF_MIX);
  const int tc = item % NCH, bh = item / NCH, h = bh & 3, b = bh >> 2;
  int row0, pos0;
  chunk_rows(b, tc, row0, pos0);
  char* qh = smem;
  char* kh = smem + 16384;
  char* vt = smem + 32768;
  float* eref = (float*)(smem + 49152);
  __syncthreads();
  {
    const u16* vb = IT + (size_t)((b * 4 + h) * 128) * TK + pos0;
#pragma unroll
    for (int i = 0; i < 4; ++i) {
      int q = tid + i * 256, dv = q >> 3, c2 = (q & 7) ^ ((dv >> 1) & 7);
      glds16(vb + (size_t)dv * TK + c2 * 8, vt + q * 16);
    }
  }
  f32x4 O[8];
#pragma unroll
  for (int v = 0; v < 8; ++v) O[v] = f32x4{0.f, 0.f, 0.f, 0.f};
  const int d = tid & 127, half = tid >> 7;
  for (int dir = 0; dir < 2; ++dir) {
    const int c = dir ? (tc < 4 ? 3 - tc : 4 + 63 - (tc - 4)) : tc;
    const int seq = (b * 4 + h) * 2 + dir;
    const float lb = LB[(e * 2 + dir) * 512 + h * 128 + d];
    const u16* zp = PROJ + (size_t)row0 * 3072 + 1536 + dir * 512 + h * 128 + d;
    const u16* qp = PROJ + (size_t)row0 * 3072 + h * 128 + d;
    if (dir) __syncthreads();
    float rel = 0.f;
    if (!half) {
#pragma unroll 8
      for (int tau = 31; tau >= 0; --tau) {
        int t = dir ? 63 - tau : tau;
        float f = lb + (1.f - lb) * sigm(bf2f(zp[(size_t)t * 3072]));
        float lf = __logf(fmaxf(f, 1e-20f));
        float q = bf2f(qp[(size_t)t * 3072]);
        int off = swz256(t, d >> 3) + (d & 7) * 2;
        *(u16*)(qh + off) = f2bf(q * __expf(rel));
        *(u16*)(kh + off) = f2bf((1.f - f) * __expf(-rel));
        rel -= lf;
      }
      eref[d] = __expf(-rel);
    } else {
#pragma unroll 8
      for (int tau = 32; tau < 64; ++tau) {
        int t = dir ? 63 - tau : tau;
        float f = lb + (1.f - lb) * sigm(bf2f(zp[(size_t)t * 3072]));
        float lf = __logf(fmaxf(f, 1e-20f));
        float q = bf2f(qp[(size_t)t * 3072]);
        rel += lf;
        int off = swz256(t, d >> 3) + (d & 7) * 2;
        *(u16*)(qh + off) = f2bf(q * __expf(rel));
        *(u16*)(kh + off) = f2bf((1.f - f) * __expf(-rel));
      }
    }
    __syncthreads();
    bf16x8 qf[4];
#pragma unroll
    for (int ks = 0; ks < 4; ++ks) qf[ks] = *(const bf16x8*)(qh + swz256(w * 16 + fr, ks * 4 + fq));
    f32x4 s[4];
#pragma unroll
    for (int sf = 0; sf < 4; ++sf) {
      s[sf] = f32x4{0.f, 0.f, 0.f, 0.f};
#pragma unroll
      for (int ks = 0; ks < 4; ++ks) {
        bf16x8 a = *(const bf16x8*)(kh + swz256(sf * 16 + fr, ks * 4 + fq));
        s[sf] = mfma16(a, qf[ks], s[sf]);
      }
    }
    const int tq = w * 16 + fr;
#pragma unroll
    for (int sf = 0; sf < 4; ++sf)
#pragma unroll
      for (int j = 0; j < 4; ++j) {
        int ss = sf * 16 + fq * 4 + j;
        bool keep = dir ? (ss >= tq) : (ss <= tq);
        s[sf][j] = keep ? s[sf][j] : 0.f;
      }
    bf16x8 pb[2];
#pragma unroll
    for (int k2 = 0; k2 < 2; ++k2) {
      union { bf16x8 v; unsigned u[4]; } t;
      t.u[0] = pk2(s[2 * k2][0], s[2 * k2][1]); t.u[1] = pk2(s[2 * k2][2], s[2 * k2][3]);
      t.u[2] = pk2(s[2 * k2 + 1][0], s[2 * k2 + 1][1]); t.u[3] = pk2(s[2 * k2 + 1][2], s[2 * k2 + 1][3]);
      pb[k2] = t.v;
    }
#pragma unroll
    for (int v = 0; v < 8; ++v)
#pragma unroll
      for (int k2 = 0; k2 < 2; ++k2) {
        const int dv = v * 16 + fr;
        union { bf16x8 v; uint2 u[2]; } a;
        a.u[0] = *(const uint2*)(vt + swz128(dv, k2 * 4 + (fq >> 1)) + (fq & 1) * 8);
        a.u[1] = *(const uint2*)(vt + swz128(dv, k2 * 4 + 2 + (fq >> 1)) + (fq & 1) * 8);
        O[v] = mfma16(a.v, pb[k2], O[v]);
      }
    const float* sp = S + (size_t)(seq * NCH + c) * 16384;
#pragma unroll
    for (int ks = 0; ks < 4; ++ks) {
      union { bf16x8 v; u16 h[8]; unsigned u[4]; } qq, qs;
      qq.v = qf[ks];
      const float* er = eref + ks * 32 + fq * 8;
#pragma unroll
      for (int i = 0; i < 4; ++i) qs.u[i] = pk2(bf2f(qq.h[2 * i]) * er[2 * i], bf2f(qq.h[2 * i + 1]) * er[2 * i + 1]);
#pragma unroll
      for (int v = 0; v < 8; ++v) {
        const float* g = sp + (v * 16 + fr) * 128 + ks * 32 + fq * 8;
        float4 x0 = *(const float4*)g, x1 = *(const float4*)(g + 4);
        union { bf16x8 v; unsigned u[4]; } a;
        a.u[0] = pk2(x0.x, x0.y); a.u[1] = pk2(x0.z, x0.w); a.u[2] = pk2(x1.x, x1.y); a.u[3] = pk2(x1.z, x1.w);
        O[v] = mfma16(a.v, qs.v, O[v]);
      }
    }
  }
  float ssq = 0.f;
#pragma unroll
  for (int v = 0; v < 8; ++v)
#pragma unroll
    for (int j = 0; j < 4; ++j) ssq += O[v][j] * O[v][j];
  ssq = xor_sum(xor_sum(ssq, 16), 32);
  const float rs = rsqrtf(ssq * (1.f / 128.f) + 1e-6f);
  const int row = row0 + w * 16 + fr;
  const float* nw = p.hg_norm_w + e * 128;
#pragma unroll
  for (int v = 0; v < 8; ++v) {
    int dv = v * 16 + fq * 4;
    uint2 gv = *(const uint2*)(PROJ + (size_t)row * 3072 + 1024 + h * 128 + dv);
    float4 n4 = *(const float4*)(nw + dv);
    float g0 = bf2f((u16)(gv.x & 0xffff)), g1 = bf2f((u16)(gv.x >> 16)), g2 = bf2f((u16)(gv.y & 0xffff)), g3 = bf2f((u16)(gv.y >> 16));
    uint2 o = {pk2(O[v][0] * rs * n4.x * silu(g0), O[v][1] * rs * n4.y * silu(g1)),
               pk2(O[v][2] * rs * n4.z * silu(g2), O[v][3] * rs * n4.w * silu(g3))};
    *(uint2*)(MIX + (size_t)row * D + h * 128 + dv) = o;
  }
}

#define XB_TMO      128
#define XB_XCNT(j)  (256  + 64 * (j))
#define XB_XSUB(j)  (1280 + 64 * (j))
#define XB_XGEN(j)  (2304 + 64 * (j))
#define XB_TOP      3328
#define XB_TOPGEN   3392
#define XCD_BAR_WORDS 3456
#define XB_SPIN_CAP (1u << 18)
__device__ __forceinline__ unsigned xb_ld(unsigned* p) { return __hip_atomic_load(p, __ATOMIC_RELAXED, __HIP_MEMORY_SCOPE_AGENT); }
__device__ __forceinline__ unsigned xb_add(unsigned* p, unsigned v) { return __hip_atomic_fetch_add(p, v, __ATOMIC_RELAXED, __HIP_MEMORY_SCOPE_AGENT); }
__device__ __forceinline__ unsigned xb_xcc_id() { return (unsigned)__builtin_amdgcn_s_getreg((3 << 11) | 20) & 0xFu; }
#define XB_SPIN(cond, bar) do { unsigned _sp = 0; while (cond) { __builtin_amdgcn_s_sleep(1); \
    if ((++_sp & 255u) == 0u) { if (xb_ld(&(bar)[XB_TMO])) break; if (_sp > XB_SPIN_CAP) { atomicAdd(&(bar)[XB_TMO], 1u); break; } } } } while (0)
struct GB { unsigned* bar; unsigned x, nloc, nx; };
__device__ __forceinline__ void gb_complete(unsigned* bar, unsigned x, unsigned& nloc, unsigned& nx) {
  const unsigned G = gridDim.x;
  unsigned sum, cnt, mine, sp = 0u;
  for (;;) {
    sum = 0u; cnt = 0u; mine = 0u;
#pragma unroll
    for (unsigned j = 0; j < 16; ++j) { const unsigned c = xb_ld(&bar[XB_XCNT(j)]); sum += c; cnt += (c > 0u) ? 1u : 0u; mine = (j == x) ? c : mine; }
    if (sum == G) break;
    __builtin_amdgcn_s_sleep(1);
    if ((++sp & 255u) == 0u) { if (xb_ld(&bar[XB_TMO])) break; if (sp > XB_SPIN_CAP) { atomicAdd(&bar[XB_TMO], 1u); break; } }
  }
  nloc = mine > 0u ? mine : 1u; nx = cnt > 0u ? cnt : 1u;
}
__device__ __forceinline__ void gbar(GB& b) {
  asm volatile("s_waitcnt vmcnt(0)" ::: "memory");
  __syncthreads();
  if (threadIdx.x == 0) {
    unsigned* bar = b.bar;
    __builtin_amdgcn_s_waitcnt(0);
    if (b.nloc == 0u) gb_complete(bar, b.x, b.nloc, b.nx);
    const unsigned nloc = b.nloc, nx = b.nx;
    const unsigned old = xb_add(&bar[XB_XSUB(b.x)], 1u);
    const unsigned gen = old / nloc;
    if (old + 1u == (gen + 1u) * nloc) {
      __builtin_amdgcn_fence(__ATOMIC_RELEASE, "agent");
      asm volatile("s_waitcnt vmcnt(0)" ::: "memory");
      const unsigned og = xb_add(&bar[XB_TOP], 1u);
      const unsigned tg = og / nx;
      if (og + 1u == (tg + 1u) * nx) xb_add(&bar[XB_TOPGEN], 1u);
      else XB_SPIN(xb_ld(&bar[XB_TOPGEN]) == tg, bar);
      __builtin_amdgcn_fence(__ATOMIC_ACQUIRE, "agent");
      xb_add(&bar[XB_XGEN(b.x)], 1u);
      asm volatile("s_waitcnt vmcnt(0)" ::: "memory");
    } else {
      XB_SPIN(xb_ld(&bar[XB_XGEN(b.x)]) == gen, bar);
      __builtin_amdgcn_fence(__ATOMIC_ACQUIRE, "agent");
      asm volatile("s_waitcnt vmcnt(0)" ::: "memory");
    }
  }
  __syncthreads();
}

__device__ __forceinline__ void ffn_out_phase(const P& p, const u16* HID, const u16* Wt, int M, char* smem) {
  u16* Y = (u16*)(p.ws + OFF_Y);
  u16* YC = (u16*)(p.ws + OFF_YC);
  for (int it = 0;; ++it) {
    int pm, pn;
    if (!xcd_tile(it, ML / 128, 8, pm, pn)) break;
    gemm_tile(HID, FH, Wt, FH, FH, pm * 128, pn * 128, smem, EpiF32{Y});
  }
  if (M > ML) {
    for (int u = blockIdx.x; u < 256; u += gridDim.x) {
      {
      const int ks = u & 3, ct = u >> 2, pm = ct >> 3, pn = ct & 7;
      gemm_tile(HID + ks * 704, FH, Wt + ks * 704, FH, 704, ML + pm * 128, pn * 128, smem,
                EpiF32{YC + ((size_t)ks * MC - ML) * D});
      }
    }
  }
}

constexpr int PH_PER_EVEN = 12, PH_PER_ODD = 10;
constexpr int N_PHASES = 2 + 2 * PH_PER_EVEN + 2 * PH_PER_ODD;

__device__ __forceinline__ void run_phase(const P& pin, int ph, char* smem) {
  P p = pin;
  asm volatile("" : "+s"(p.ws));
  asm volatile("" : "+s"(p.out));
  u16* H = (u16*)(p.ws + OFF_H);
  u16* HID = (u16*)(p.ws + OFF_HID);
  u16* Y = (u16*)(p.ws + OFF_Y);
  u16* PROJ = (u16*)(p.ws + OFF_PROJ);
  u16* VT = (u16*)(p.ws + OFF_VT);
  u16* MIX = (u16*)(p.ws + OFF_MIX);
  if (ph == 0) { phase_prep(p, smem); return; }
  if (ph == 1) { phase_rows(p, 0, 0, 0, MT, false); return; }
  int q = ph - 2, l;
  if (q < PH_PER_EVEN) l = 0;
  else if (q < PH_PER_EVEN + PH_PER_ODD) { l = 1; q -= PH_PER_EVEN; }
  else if (q < 2 * PH_PER_EVEN + PH_PER_ODD) { l = 2; q -= PH_PER_EVEN + PH_PER_ODD; }
  else { l = 3; q -= 2 * PH_PER_EVEN + PH_PER_ODD; }
  const bool even = !(l & 1), last = (l == 3);
  int step = q;
  if (!even && q >= 5) step = q + 2;
  const int Mpost = last ? ML : MT;
  const u16* WFI = (const u16*)(p.ws + OFF_WFI);
  const u16* WFO = (const u16*)(p.ws + OFF_WFO);
  switch (step) {
    case 0: gemm_phase(H, D, WFI + (size_t)(l * 2 + 0) * 5632 * 1024, MT, 5632, 1024, smem, EpiSwiglu{HID}); break;
    case 1: ffn_out_phase(p, HID, WFO + (size_t)(l * 2 + 0) * 1024 * 2816, MT, smem); break;
    case 2: phase_rows(p, 1, l, 0, MT, false); break;
    case 3:
      if (even) gemm_phase(H, D, (const u16*)(p.ws + OFF_WMI) + (size_t)l * 3072 * 1024, MT, 3072, 1024, smem, EpiProjEven{PROJ, VT});
      else gemm_phase(H, D, (const u16*)(p.ws + OFF_WMI) + (size_t)l * 3072 * 1024, MT, 3072, 1024, smem,
                      EpiProjOdd{PROJ, VT, (const float*)(p.ws + OFF_ROPE)});
      break;
    case 4:
      if (even) {
        for (int it = blockIdx.x; it < 32 * NCH + MT / 32; it += gridDim.x) {
          if (it < 32 * NCH) hg_u_item(p, l >> 1, it, smem);
          else pool_item(p, it - 32 * NCH);
        }
      } else phase_attn(p, l, smem);
      break;
    case 5: {
      for (int it = blockIdx.x; it < 2048 + 4 * (MT / 128); it += gridDim.x) {
        if (it < 2048) hg_scan_item(p, it);
        else {
          int t = it - 2048, g = t / (MT / 128), mt = t % (MT / 128);
          gemm_tile((const u16*)(p.ws + OFF_POOLED) + g * 128, 512,
                    (const u16*)(p.ws + OFF_WPL) + (size_t)((l >> 1) * 4 + g) * 128 * 128, 128, 128, mt * 128, 0, smem,
                    EpiPool{MIX, p.pool_scale + (l >> 1) * 512, g});
        }
      }
    } break;
    case 6:
      for (int it = blockIdx.x; it < 16 * NCH; it += gridDim.x) hg_o_item(p, l >> 1, it, smem);
      break;
    case 7: gemm_phase(MIX, D, (const u16*)(p.ws + OFF_WMO) + (size_t)l * 1024 * 1024, Mpost, 1024, 1024, smem, EpiF32{Y}); break;
    case 8: phase_rows(p, 1, l, 1, Mpost, false); break;
    case 9: gemm_phase(H, D, WFI + (size_t)(l * 2 + 1) * 5632 * 1024, Mpost, 5632, 1024, smem, EpiSwiglu{HID}); break;
    case 10: ffn_out_phase(p, HID, WFO + (size_t)(l * 2 + 1) * 1024 * 2816, Mpost, smem); break;
    case 11: phase_rows(p, 1, l, 2, Mpost, last); break;
  }
}

__global__ void __launch_bounds__(256, 2) mega(P p, int ph_lo, int ph_hi) {
  __shared__ __attribute__((aligned(16))) char smem[65536];
  GB gb;
  gb.bar = (unsigned*)(p.ws + OFF_BAR); gb.x = xb_xcc_id(); gb.nloc = 0u; gb.nx = 0u;
  if (threadIdx.x == 0) (void)xb_add(&gb.bar[XB_XCNT(gb.x)], 1u);
  for (int ph = ph_lo; ph < ph_hi; ++ph) {
    run_phase(p, ph, smem);
#ifdef DOUBLE_GEMM
    {
      int q = ph - 2, l = 0;
      if (ph >= 2) {
        if (q < 12) l = 0; else if (q < 22) { l = 1; q -= 12; } else if (q < 34) { l = 2; q -= 22; } else { l = 3; q -= 34; }
        int step = q; if ((l & 1) && q >= 5) step = q + 2;
        if (step == 0 || step == 1 || step == 3 || step == 7 || step == 9 || step == 10) run_phase(p, ph, smem);
      }
    }
#endif
#ifdef DOUBLE_ATT
    if (ph == 2 + 12 + 4 || ph == 2 + 34 + 4) run_phase(p, ph, smem);
#endif
    if (ph + 1 < ph_hi) {
      if (ph == ph_lo) cg::this_grid().sync();
      else gbar(gb);
    }
  }
}

extern "C" void kernel_launch(void* const* d_in, const int* in_sizes, int n_in, void* d_out, int out_size, void* d_ws,
                              size_t ws_size, hipStream_t stream) {
  static int grid_blocks = 0;
  if (!grid_blocks) {
    int dev = 0, cus = 0, per_cu = 0;
    hipGetDevice(&dev);
    hipDeviceGetAttribute(&cus, hipDeviceAttributeMultiprocessorCount, dev);
    hipOccupancyMaxActiveBlocksPerMultiprocessor(&per_cu, mega, 256, 0);
    if (per_cu > 2) per_cu = 2;
    grid_blocks = cus * per_cu;
  }
  if (ws_size < OFF_END2) { fprintf(stderr, "workspace too small: %zu < %zu\n", ws_size, (size_t)OFF_END); return; }
  P p{};
  const float** f = (const float**)&p;
  for (int i = 0; i < 20; ++i) f[i] = (const float*)d_in[i];
  p.out = (float*)d_out;
  p.ws = (char*)d_ws;
#if MULTI_LAUNCH
  for (int ph = 0; ph < N_PHASES; ++ph) hipLaunchKernelGGL(mega, dim3(grid_blocks), dim3(256), 0, stream, p, ph, ph + 1);
#else
  hipMemsetAsync((char*)d_ws + OFF_BAR, 0, XCD_BAR_WORDS * 4, stream);
  int lo = 0, hi = N_PHASES;
  void* args[] = {&p, &lo, &hi};
  hipError_t e = hipLaunchCooperativeKernel((void*)mega, dim3(grid_blocks), dim3(256), args, 0, stream);
  if (e != hipSuccess) fprintf(stderr, "cooperative launch failed: %s (grid %d)\n", hipGetErrorString(e), grid_blocks);
#endif
}
```

```cpp
#include <hip/hip_runtime.h>
#include <hip/hip_cooperative_groups.h>
#include <cstdio>
namespace cg = cooperative_groups;

typedef __attribute__((ext_vector_type(8))) short bf16x8;
typedef __attribute__((ext_vector_type(4))) float f32x4;
typedef unsigned short u16;

#ifndef MULTI_LAUNCH
#define MULTI_LAUNCH 0
#endif

constexpr int D = 1024, NB = 4, SEQ = 4096, CTX = 256, FH = 2816;
constexpr int ML = NB * SEQ, MC = NB * CTX, MT = ML + MC;
constexpr int TK = CTX + SEQ;
constexpr int NCH = TK / 64;
constexpr float ALPHA = 1.6817928305074290f;
constexpr float LOG2E = 1.4426950408889634f;

constexpr size_t al256(size_t x) { return (x + 255) & ~(size_t)255; }
constexpr size_t OFF_WFI = 0;
constexpr size_t OFF_WFO = OFF_WFI + al256((size_t)4 * 2 * 5632 * 1024 * 2);
constexpr size_t OFF_WMI = OFF_WFO + al256((size_t)4 * 2 * 1024 * 2816 * 2);
constexpr size_t OFF_WMO = OFF_WMI + al256((size_t)4 * 3072 * 1024 * 2);
constexpr size_t OFF_WPL = OFF_WMO + al256((size_t)4 * 1024 * 1024 * 2);
constexpr size_t OFF_MODS = OFF_WPL + al256((size_t)2 * 4 * 128 * 128 * 2);
constexpr size_t OFF_LB = OFF_MODS + al256((size_t)4 * 5 * 9216 * 4);
constexpr size_t OFF_LAM = OFF_LB + al256((size_t)2 * 2 * 512 * 4);
constexpr size_t OFF_ROPE = OFF_LAM + 256;
constexpr size_t OFF_DEC = OFF_ROPE + al256((size_t)64 * 16 * 2 * 4);
constexpr size_t OFF_X = OFF_DEC + al256((size_t)32 * NCH * 128 * 4);
constexpr size_t OFF_H = OFF_X + al256((size_t)MT * 1024 * 4);
constexpr size_t OFF_PROJ = OFF_H + al256((size_t)MT * 1024 * 2);
constexpr size_t OFF_VT = OFF_PROJ + al256((size_t)MT * 3072 * 2);
constexpr size_t OFF_MIX = OFF_VT + al256((size_t)NB * 8 * 128 * TK * 2);
constexpr size_t OFF_POOLED = OFF_MIX + al256((size_t)MT * 1024 * 2);
constexpr size_t OFF_HID = OFF_POOLED + al256((size_t)MT * 512 * 2);
constexpr size_t OFF_Y = OFF_HID + al256((size_t)MT * FH * 2);
constexpr size_t OFF_END = OFF_Y + al256((size_t)MT * 1024 * 4);
constexpr size_t OFF_YC = OFF_END;
constexpr size_t OFF_BAR = OFF_YC + al256((size_t)4 * MC * 1024 * 2);
constexpr size_t OFF_END2 = OFF_BAR + al256((size_t)3456 * 4);
constexpr size_t OFF_U = OFF_HID;
static_assert((size_t)32 * NCH * 16384 * 4 <= OFF_END - OFF_HID, "U alias too big");

struct P {
  const float *x, *c, *ctx, *c_ctx, *w_ada, *b_ada, *ln_g, *ln_b, *w_ffn_in, *w_ffn_out, *w_in_even, *w_out_even,
      *hg_lb, *hg_norm_w, *pool_w, *pool_scale, *w_in_odd, *w_out_odd, *da_lambda, *da_sub_w;
  float* out;
  char* ws;
};

typedef __attribute__((ext_vector_type(2))) __bf16 bf16v2;
typedef __attribute__((ext_vector_type(2))) float f32v2;
__device__ __forceinline__ unsigned pk2(float a, float b) {
  f32v2 v = {a, b};
  bf16v2 r = __builtin_convertvector(v, bf16v2);
  return *(unsigned*)&r;
}
__device__ __forceinline__ u16 f2bf(float f) { return (u16)(pk2(f, 0.f) & 0xffffu); }
__device__ __forceinline__ float bf2f(u16 h) { return __uint_as_float(((unsigned)h) << 16); }
__device__ __forceinline__ float sigm(float z) { return 1.f / (1.f + __expf(-z)); }
__device__ __forceinline__ float silu(float z) { return z / (1.f + __expf(-z)); }
__device__ __forceinline__ float ex2(float x) { return __builtin_amdgcn_exp2f(x); }
__device__ __forceinline__ void glds16(const void* g, void* l) {
  __builtin_amdgcn_global_load_lds((const unsigned*)g, (unsigned*)l, 16, 0, 0);
}
__device__ __forceinline__ int get_tid() { int t = threadIdx.x; asm volatile("" : "+v"(t)); return t; }
__device__ __forceinline__ int swz128(int row, int ch) { return row * 128 + ((ch ^ ((row >> 1) & 7)) << 4); }
__device__ __forceinline__ int swz256(int row, int ch) { return row * 256 + ((ch ^ (row & 15)) << 4); }
__device__ __forceinline__ f32x4 mfma16(bf16x8 a, bf16x8 b, f32x4 c) {
  return __builtin_amdgcn_mfma_f32_16x16x32_bf16(a, b, c, 0, 0, 0);
}
__device__ __forceinline__ float xor_sum(float v, int m) { return v + __shfl_xor(v, m, 64); }
__device__ __forceinline__ float xor_max(float v, int m) { return fmaxf(v, __shfl_xor(v, m, 64)); }
__device__ __forceinline__ void row_bpos(int row, int& b, int& pos) {
  if (row < ML) { b = row >> 12; pos = CTX + (row & 4095); }
  else { int r = row - ML; b = r >> 8; pos = r & 255; }
}
__device__ __forceinline__ int mod_row(int row) { return row < ML ? (row >> 12) : 4; }

constexpr int BM = 128, BN = 128, BK = 64;

template <class Epi>
__device__ __forceinline__ void gemm_tile(const u16* __restrict__ A, int lda, const u16* __restrict__ Bt, int ldb, int K,
                                          int m0, int n0, char* smem, const Epi& epi) {
  const int tid = get_tid(), lane = tid & 63, wid = tid >> 6, wr = wid >> 1, wc = wid & 1, fr = lane & 15, fq = lane >> 4;
  f32x4 acc[4][4];
#pragma unroll
  for (int m = 0; m < 4; ++m)
#pragma unroll
    for (int n = 0; n < 4; ++n) acc[m][n] = f32x4{0.f, 0.f, 0.f, 0.f};
  const int nk = K / BK;
  const u16* ga[4];
  const u16* gb[4];
#pragma unroll
  for (int i = 0; i < 4; ++i) {
    int q = tid + i * 256, row = q >> 3, ch = (q & 7) ^ ((row >> 1) & 7);
    ga[i] = A + (size_t)(m0 + row) * lda + ch * 8;
    gb[i] = Bt + (size_t)(n0 + row) * ldb + ch * 8;
  }
  __syncthreads();
#pragma unroll
  for (int i = 0; i < 4; ++i) {
    glds16(ga[i], smem + (tid + i * 256) * 16);
    glds16(gb[i], smem + 16384 + (tid + i * 256) * 16);
  }
  for (int kt = 0; kt < nk; ++kt) {
    __syncthreads();
    char* cur = smem + (kt & 1) * 32768;
    bf16x8 a[2][4], b[2][4];
#pragma unroll
    for (int ks = 0; ks < 2; ++ks) {
#pragma unroll
      for (int n = 0; n < 4; ++n) b[ks][n] = *(const bf16x8*)(cur + 16384 + swz128(wc * 64 + n * 16 + fr, ks * 4 + fq));
#pragma unroll
      for (int m = 0; m < 4; ++m) a[ks][m] = *(const bf16x8*)(cur + swz128(wr * 64 + m * 16 + fr, ks * 4 + fq));
    }
    __builtin_amdgcn_sched_barrier(0);
    if (kt + 1 < nk) {
      char* nxt = smem + ((kt + 1) & 1) * 32768;
#pragma unroll
      for (int i = 0; i < 4; ++i) {
        glds16(ga[i] + (kt + 1) * BK, nxt + (tid + i * 256) * 16);
        glds16(gb[i] + (kt + 1) * BK, nxt + 16384 + (tid + i * 256) * 16);
      }
    }
    __builtin_amdgcn_sched_barrier(0);
#pragma unroll
    for (int ks = 0; ks < 2; ++ks)
#pragma unroll
      for (int m = 0; m < 4; ++m)
#pragma unroll
        for (int n = 0; n < 4; ++n) acc[m][n] = mfma16(b[ks][n], a[ks][m], acc[m][n]);
  }
  epi(acc, m0 + wr * 64, n0 + wc * 64, fr, fq);
}

__device__ __forceinline__ bool xcd_tile(int it, int nM, int nN, int& pm, int& pn) {
  const int xcd = blockIdx.x & 7, slot = blockIdx.x >> 3, nslot = gridDim.x >> 3;
  const int mlo = (nM * xcd) >> 3, mhi = (nM * (xcd + 1)) >> 3, mcnt = mhi - mlo;
  const int j = slot + it * nslot;
  if (j >= mcnt * nN) return false;
  const int per_ng = mcnt * 8;
  const int ng = j / per_ng, r = j - ng * per_ng;
  const int nrem = min(8, nN - ng * 8);
  pm = mlo + r / nrem; pn = ng * 8 + r % nrem;
  return true;
}
template <class Epi>
__device__ __forceinline__ void gemm_phase(const u16* A, int lda, const u16* Bt, int M, int N, int K, char* smem,
                                           const Epi& epi) {
  const int nM = M / BM, nN = N / BN;
  for (int it = 0;; ++it) {
    int pm, pn;
    if (!xcd_tile(it, nM, nN, pm, pn)) break;
    gemm_tile(A, lda, Bt, K, K, pm * BM, pn * BN, smem, epi);
  }
}

struct EpiSwiglu {
  u16* hid;
  __device__ __forceinline__ void operator()(f32x4 (&acc)[4][4], int rb, int cb, int fr, int fq) const {
#pragma unroll
    for (int m = 0; m < 4; ++m)
#pragma unroll
      for (int n = 0; n < 4; n += 2) {
        int row = rb + m * 16 + fr, hc = (cb >> 1) + (n >> 1) * 16 + fq * 4;
        uint2 v = {pk2(silu(acc[m][n][0]) * acc[m][n + 1][0], silu(acc[m][n][1]) * acc[m][n + 1][1]),
                   pk2(silu(acc[m][n][2]) * acc[m][n + 1][2], silu(acc[m][n][3]) * acc[m][n + 1][3])};
        *(uint2*)(hid + (size_t)row * FH + hc) = v;
      }
  }
};
struct EpiF32 {
  u16* y;
  __device__ __forceinline__ void operator()(f32x4 (&acc)[4][4], int rb, int cb, int fr, int fq) const {
#pragma unroll
    for (int m = 0; m < 4; ++m)
#pragma unroll
      for (int n = 0; n < 4; ++n)
        *(uint2*)(y + (size_t)(rb + m * 16 + fr) * D + cb + n * 16 + fq * 4) =
            uint2{pk2(acc[m][n][0], acc[m][n][1]), pk2(acc[m][n][2], acc[m][n][3])};
  }
};
struct EpiPool {
  u16* mix; const float* scale; int g;
  __device__ __forceinline__ void operator()(f32x4 (&acc)[4][4], int rb, int cb, int fr, int fq) const {
#pragma unroll
    for (int n = 0; n < 4; ++n) {
      int col = g * 128 + cb + n * 16 + fq * 4;
      float4 sc = *(const float4*)(scale + col);
#pragma unroll
      for (int m = 0; m < 4; ++m) {
        uint2 v = {pk2(acc[m][n][0] * sc.x, acc[m][n][1] * sc.y), pk2(acc[m][n][2] * sc.z, acc[m][n][3] * sc.w)};
        *(uint2*)(mix + (size_t)(rb + m * 16 + fr) * D + 512 + col) = v;
      }
    }
  }
};
__device__ __forceinline__ void store_vt(u16* vt, int nh, f32x4 (&acc)[4][4], int rb, int fcol0, int fr, int fq) {
#pragma unroll
  for (int m = 0; m < 4; ++m) {
    int row = rb + m * 16 + fr, b, pos;
    row_bpos(row, b, pos);
#pragma unroll
    for (int n = 0; n < 4; ++n) {
      int fc = fcol0 + n * 16 + fq * 4, h = fc >> 7, f = fc & 127;
      u16* o = vt + ((size_t)((b * nh + h) * 128 + f)) * TK + pos;
#pragma unroll
      for (int j = 0; j < 4; ++j) o[(size_t)j * TK] = f2bf(acc[m][n][j]);
    }
  }
}
struct EpiProjEven {
  u16* proj; u16* vt;
  __device__ __forceinline__ void operator()(f32x4 (&acc)[4][4], int rb, int cb, int fr, int fq) const {
    if (cb >= 512 && cb < 1024) { store_vt(vt, 4, acc, rb, cb - 512, fr, fq); return; }
    const float sc = (cb < 512) ? 0.08838834764831845f : 1.f;
#pragma unroll
    for (int m = 0; m < 4; ++m)
#pragma unroll
      for (int n = 0; n < 4; ++n) {
        uint2 v = {pk2(acc[m][n][0] * sc, acc[m][n][1] * sc), pk2(acc[m][n][2] * sc, acc[m][n][3] * sc)};
        *(uint2*)(proj + (size_t)(rb + m * 16 + fr) * 3072 + cb + n * 16 + fq * 4) = v;
      }
  }
};
struct EpiProjOdd {
  u16* proj; u16* vt; const float* rope;
  __device__ __forceinline__ void operator()(f32x4 (&acc)[4][4], int rb, int cb, int fr, int fq) const {
    if (cb >= 2048) { store_vt(vt, 8, acc, rb, cb - 2048, fr, fq); return; }
    const float sc = (cb < 1024) ? 0.125f * LOG2E : 1.f;
#pragma unroll
    for (int m = 0; m < 4; ++m) {
      int row = rb + m * 16 + fr;
      f32x4 v0 = acc[m][0], v1 = acc[m][1], v2 = acc[m][2], v3 = acc[m][3];
      if (row < ML) {
        int t = row & 4095, pr = t >> 6, pc = t & 63;
        const float* rr = rope + (pr * 16 + fq * 4) * 2;
        const float* rc = rope + (pc * 16 + fq * 4) * 2;
        float4 r0 = *(const float4*)rr, r1 = *(const float4*)(rr + 4), c0 = *(const float4*)rc, c1 = *(const float4*)(rc + 4);
        float cs[4] = {r0.x, r0.z, r1.x, r1.z}, sn[4] = {r0.y, r0.w, r1.y, r1.w};
        float cs2[4] = {c0.x, c0.z, c1.x, c1.z}, sn2[4] = {c0.y, c0.w, c1.y, c1.w};
#pragma unroll
        for (int j = 0; j < 4; ++j) {
          float a0 = v0[j] * cs[j] - v1[j] * sn[j], a1 = v1[j] * cs[j] + v0[j] * sn[j];
          float a2 = v2[j] * cs2[j] - v3[j] * sn2[j], a3 = v3[j] * cs2[j] + v2[j] * sn2[j];
          v0[j] = a0; v1[j] = a1; v2[j] = a2; v3[j] = a3;
        }
      }
      u16* o = proj + (size_t)row * 3072 + cb + fq * 4;
      *(uint2*)(o) = uint2{pk2(v0[0] * sc, v0[1] * sc), pk2(v0[2] * sc, v0[3] * sc)};
      *(uint2*)(o + 16) = uint2{pk2(v1[0] * sc, v1[1] * sc), pk2(v1[2] * sc, v1[3] * sc)};
      *(uint2*)(o + 32) = uint2{pk2(v2[0] * sc, v2[1] * sc), pk2(v2[2] * sc, v2[3] * sc)};
      *(uint2*)(o + 48) = uint2{pk2(v3[0] * sc, v3[1] * sc), pk2(v3[2] * sc, v3[3] * sc)};
    }
  }
};

__device__ __forceinline__ void convert_tile(const float* __restrict__ src, int K, int N, u16* __restrict__ dst, int tile,
                                             bool swiglu, char* smem) {
  float* t = (float*)smem;
  const int tid = get_tid();
  const int nN = N / 64, nt = tile % nN, kt = tile / nN, k0 = kt * 64, n0 = nt * 64;
  __syncthreads();
#pragma unroll
  for (int i = 0; i < 4; ++i) {
    int k = (tid >> 4) + 16 * i, n4 = (tid & 15) * 4;
    float4 v = *(const float4*)(src + (size_t)(k0 + k) * N + n0 + n4);
    t[k * 65 + n4] = v.x; t[k * 65 + n4 + 1] = v.y; t[k * 65 + n4 + 2] = v.z; t[k * 65 + n4 + 3] = v.w;
  }
  __syncthreads();
#pragma unroll
  for (int i = 0; i < 2; ++i) {
    int q = tid + i * 256, n = q >> 3, kc = (q & 7) * 8;
    int c = n0 + n, nr = c;
    if (swiglu) nr = (c < FH) ? (32 * (c >> 4) + (c & 15)) : (32 * ((c - FH) >> 4) + 16 + ((c - FH) & 15));
    uint4 o = {pk2(t[kc * 65 + n], t[(kc + 1) * 65 + n]), pk2(t[(kc + 2) * 65 + n], t[(kc + 3) * 65 + n]),
               pk2(t[(kc + 4) * 65 + n], t[(kc + 5) * 65 + n]), pk2(t[(kc + 6) * 65 + n], t[(kc + 7) * 65 + n])};
    *(uint4*)(dst + (size_t)nr * K + k0 + kc) = o;
  }
}

__device__ void phase_prep(const P& p, char* smem) {
  const int tid = get_tid();
  constexpr int N_ADA = 1152, N_TR = 4 * 5248 + 32;
  for (int item = blockIdx.x; item < N_ADA + N_TR + 1; item += gridDim.x) {
    if (item < N_ADA) {
      float* act = (float*)smem;
      float* red = (float*)(smem + 20480);
      const int l = item / 288, cb = (item % 288) * 32;
      __syncthreads();
      for (int i = tid; i < 5120; i += 256) {
        int r = i >> 10, k = i & 1023;
        float v = r < 4 ? p.c[r * 1024 + k] : p.c_ctx[k];
        act[i] = silu(v);
      }
      __syncthreads();
      const int tx = tid & 31, kg = tid >> 5;
      float a0 = 0, a1 = 0, a2 = 0, a3 = 0, a4 = 0;
      const float* w = p.w_ada + ((size_t)l * 1024 + kg * 128) * 9216 + cb + tx;
      for (int k0 = 0; k0 < 128; k0 += 16) {
        float wv[16];
#pragma unroll
        for (int k = 0; k < 16; ++k) wv[k] = w[(size_t)(k0 + k) * 9216];
#pragma unroll
        for (int k = 0; k < 16; ++k) {
          int kk = kg * 128 + k0 + k;
          a0 += act[kk] * wv[k]; a1 += act[1024 + kk] * wv[k]; a2 += act[2048 + kk] * wv[k]; a3 += act[3072 + kk] * wv[k];
          a4 += act[4096 + kk] * wv[k];
        }
      }
      red[(kg * 5 + 0) * 32 + tx] = a0; red[(kg * 5 + 1) * 32 + tx] = a1; red[(kg * 5 + 2) * 32 + tx] = a2;
      red[(kg * 5 + 3) * 32 + tx] = a3; red[(kg * 5 + 4) * 32 + tx] = a4;
      __syncthreads();
      if (tid < 160) {
        int r = tid >> 5, x = tid & 31;
        float sacc = 0.f;
#pragma unroll
        for (int g8 = 0; g8 < 8; ++g8) sacc += red[(g8 * 5 + r) * 32 + x];
        ((float*)(p.ws + OFF_MODS))[(size_t)(l * 5 + r) * 9216 + cb + x] = sacc + p.b_ada[l * 9216 + cb + x];
      }
    } else if (item < N_ADA + N_TR) {
      int idx = item - N_ADA;
      if (idx < 4 * 5248) {
        int l = idx / 5248, r = idx % 5248;
        if (r < 2816) {
          int f = r / 1408, tile = r % 1408;
          convert_tile(p.w_ffn_in + (size_t)(l * 2 + f) * 1024 * 5632, 1024, 5632,
                       (u16*)(p.ws + OFF_WFI) + (size_t)(l * 2 + f) * 5632 * 1024, tile, true, smem);
        } else if (r < 4224) {
          int f = (r - 2816) / 704, tile = (r - 2816) % 704;
          convert_tile(p.w_ffn_out + (size_t)(l * 2 + f) * 2816 * 1024, 2816, 1024,
                       (u16*)(p.ws + OFF_WFO) + (size_t)(l * 2 + f) * 1024 * 2816, tile, false, smem);
        } else if (r < 4992) {
          const float* src = (l & 1) ? p.w_in_odd + (size_t)(l >> 1) * 1024 * 3072 : p.w_in_even + (size_t)(l >> 1) * 1024 * 3072;
          convert_tile(src, 1024, 3072, (u16*)(p.ws + OFF_WMI) + (size_t)l * 3072 * 1024, r - 4224, false, smem);
        } else {
          const float* src = (l & 1) ? p.w_out_odd + (size_t)(l >> 1) * 1024 * 1024 : p.w_out_even + (size_t)(l >> 1) * 1024 * 1024;
          convert_tile(src, 1024, 1024, (u16*)(p.ws + OFF_WMO) + (size_t)l * 1024 * 1024, r - 4992, false, smem);
        }
      } else {
        int i2 = idx - 4 * 5248, eg = i2 >> 2, tile = i2 & 3;
        convert_tile(p.pool_w + (size_t)eg * 128 * 128, 128, 128, (u16*)(p.ws + OFF_WPL) + (size_t)eg * 128 * 128, tile, false, smem);
      }
    } else {
      float* LB = (float*)(p.ws + OFF_LB);
      for (int i = tid; i < 1024; i += 256) {
        float a0 = p.hg_lb[i], a1 = p.hg_lb[1024 + i];
        float mx = fmaxf(a0, a1), e0 = __expf(a0 - mx), e1 = __expf(a1 - mx);
        LB[i] = 0.f;
        LB[1024 + i] = e1 / (e0 + e1);
      }
      if (tid < 2) {
        const float* lv = p.da_lambda + tid * 256;
        float s0 = 0, s1 = 0;
        for (int i = 0; i < 64; ++i) { s0 += lv[i] * lv[64 + i]; s1 += lv[128 + i] * lv[192 + i]; }
        float li = 0.8f - 0.6f * expf(-0.3f * (float)(2 * tid + 1));
        ((float*)(p.ws + OFF_LAM))[tid] = expf(s0) - expf(s1) + li;
      }
      float* rope = (float*)(p.ws + OFF_ROPE);
      for (int i = tid; i < 1024; i += 256) {
        int pos = i >> 4, fi = i & 15;
        float inv = exp2f(-(float)fi * (13.287712379549449f / 16.f));
        float ang = (float)pos * inv;
        float k = rintf(ang * 0.15915494309189535f);
        float r = fmaf(-k, 6.28125f, ang);
        r = fmaf(-k, 1.9353071795864769e-3f, r);
        rope[i * 2] = cosf(r);
        rope[i * 2 + 1] = sinf(r);
      }
    }
  }
}

__device__ void phase_rows(const P& p, int mode, int l, int sub, int M, bool final_out) {
  const int tid = get_tid(), lane = tid & 63, wid = tid >> 6;
  float* X = (float*)(p.ws + OFF_X);
  const u16* Y = (const u16*)(p.ws + OFF_Y);
  u16* H = (u16*)(p.ws + OFF_H);
  const float* MODS = (const float*)(p.ws + OFF_MODS);
  int nl, si;
  if (mode == 0) { nl = 0; si = 0; }
  else if (sub == 0) { nl = l; si = 3; }
  else if (sub == 1) { nl = l; si = 6; }
  else { nl = l + 1; si = 0; }
  const float gs = (sub == 1) ? 1.f : 0.5f;
  const float* lg = p.ln_g + (size_t)(l * 3 + sub) * D;
  const float* lbp = p.ln_b + (size_t)(l * 3 + sub) * D;
  for (int row0 = (blockIdx.x * 4 + wid) * 2; row0 < M; row0 += gridDim.x * 8) {
    const int mr = mod_row(row0);
    const bool ksplit = (mode == 1) && (sub != 1) && (row0 >= ML);
    float v[2][16];
    if (mode == 0) {
#pragma unroll
      for (int r = 0; r < 2; ++r) {
        const int row = row0 + r;
        const float* src = row < ML ? p.x + (size_t)row * D : p.ctx + (size_t)(row - ML) * D;
#pragma unroll
        for (int i = 0; i < 4; ++i) {
          float4 t = *(const float4*)(src + i * 256 + lane * 4);
          v[r][i * 4] = t.x; v[r][i * 4 + 1] = t.y; v[r][i * 4 + 2] = t.z; v[r][i * 4 + 3] = t.w;
        }
      }
    } else {
      const float* gate = MODS + (size_t)(l * 5 + mr) * 9216 + (2 + 3 * sub) * 1024;
      float4 xv[2][4]; uint2 yv[2][4]; float4 gv[4];
#pragma unroll
      for (int r = 0; r < 2; ++r)
#pragma unroll
        for (int i = 0; i < 4; ++i) {
          int c = i * 256 + lane * 4;
          xv[r][i] = *(const float4*)(X + (size_t)(row0 + r) * D + c);
          if (!ksplit) yv[r][i] = *(const uint2*)(Y + (size_t)(row0 + r) * D + c);
        }
      float ysum[2][16];
      if (ksplit) {
        const u16* YC = (const u16*)(p.ws + OFF_YC);
#pragma unroll
        for (int r = 0; r < 2; ++r)
#pragma unroll
          for (int i = 0; i < 4; ++i) {
            int c = i * 256 + lane * 4;
            uint2 t0 = *(const uint2*)(YC + ((size_t)0 * MC + row0 + r - ML) * D + c), t1 = *(const uint2*)(YC + ((size_t)1 * MC + row0 + r - ML) * D + c);
            uint2 t2 = *(const uint2*)(YC + ((size_t)2 * MC + row0 + r - ML) * D + c), t3 = *(const uint2*)(YC + ((size_t)3 * MC + row0 + r - ML) * D + c);
            ysum[r][i * 4] = __uint_as_float(t0.x << 16) + __uint_as_float(t1.x << 16) + __uint_as_float(t2.x << 16) + __uint_as_float(t3.x << 16);
            ysum[r][i * 4 + 1] = __uint_as_float(t0.x & 0xffff0000u) + __uint_as_float(t1.x & 0xffff0000u) + __uint_as_float(t2.x & 0xffff0000u) + __uint_as_float(t3.x & 0xffff0000u);
            ysum[r][i * 4 + 2] = __uint_as_float(t0.y << 16) + __uint_as_float(t1.y << 16) + __uint_as_float(t2.y << 16) + __uint_as_float(t3.y << 16);
            ysum[r][i * 4 + 3] = __uint_as_float(t0.y & 0xffff0000u) + __uint_as_float(t1.y & 0xffff0000u) + __uint_as_float(t2.y & 0xffff0000u) + __uint_as_float(t3.y & 0xffff0000u);
          }
      }
#pragma unroll
      for (int i = 0; i < 4; ++i) gv[i] = *(const float4*)(gate + i * 256 + lane * 4);
      float s[2] = {0.f, 0.f};
#pragma unroll
      for (int r = 0; r < 2; ++r)
#pragma unroll
        for (int i = 0; i < 4; ++i) {
          float y0, y1, y2, y3;
          if (ksplit) { y0 = ysum[r][i * 4]; y1 = ysum[r][i * 4 + 1]; y2 = ysum[r][i * 4 + 2]; y3 = ysum[r][i * 4 + 3]; }
          else {
            y0 = bf2f((u16)(yv[r][i].x & 0xffff)); y1 = bf2f((u16)(yv[r][i].x >> 16));
            y2 = bf2f((u16)(yv[r][i].y & 0xffff)); y3 = bf2f((u16)(yv[r][i].y >> 16));
          }
          v[r][i * 4] = ALPHA * xv[r][i].x + gs * gv[i].x * y0; v[r][i * 4 + 1] = ALPHA * xv[r][i].y + gs * gv[i].y * y1;
          v[r][i * 4 + 2] = ALPHA * xv[r][i].z + gs * gv[i].z * y2; v[r][i * 4 + 3] = ALPHA * xv[r][i].w + gs * gv[i].w * y3;
          s[r] += v[r][i * 4] + v[r][i * 4 + 1] + v[r][i * 4 + 2] + v[r][i * 4 + 3];
        }
#pragma unroll
      for (int o = 1; o < 64; o <<= 1) { s[0] = xor_sum(s[0], o); s[1] = xor_sum(s[1], o); }
      float q[2] = {0.f, 0.f};
#pragma unroll
      for (int r = 0; r < 2; ++r) {
        const float mu = s[r] * (1.f / 1024.f);
#pragma unroll
        for (int i = 0; i < 16; ++i) { v[r][i] -= mu; q[r] += v[r][i] * v[r][i]; }
      }
#pragma unroll
      for (int o = 1; o < 64; o <<= 1) { q[0] = xor_sum(q[0], o); q[1] = xor_sum(q[1], o); }
#pragma unroll
      for (int i = 0; i < 4; ++i) {
        int c = i * 256 + lane * 4;
        float4 g4 = *(const float4*)(lg + c), b4 = *(const float4*)(lbp + c);
#pragma unroll
        for (int r = 0; r < 2; ++r) {
          const float rstd = rsqrtf(q[r] * (1.f / 1024.f) + 1e-5f);
          v[r][i * 4] = v[r][i * 4] * rstd * g4.x + b4.x; v[r][i * 4 + 1] = v[r][i * 4 + 1] * rstd * g4.y + b4.y;
          v[r][i * 4 + 2] = v[r][i * 4 + 2] * rstd * g4.z + b4.z; v[r][i * 4 + 3] = v[r][i * 4 + 3] * rstd * g4.w + b4.w;
        }
      }
    }
    if (final_out) {
#pragma unroll
      for (int r = 0; r < 2; ++r)
#pragma unroll
        for (int i = 0; i < 4; ++i)
          *(float4*)(p.out + (size_t)(row0 + r) * D + i * 256 + lane * 4) =
              float4{v[r][i * 4], v[r][i * 4 + 1], v[r][i * 4 + 2], v[r][i * 4 + 3]};
      continue;
    }
    const float* sh = MODS + (size_t)(nl * 5 + mr) * 9216 + si * 1024;
#pragma unroll
    for (int i = 0; i < 4; ++i) {
      int c = i * 256 + lane * 4;
      float4 s4 = *(const float4*)(sh + c), c4 = *(const float4*)(sh + 1024 + c);
#pragma unroll
      for (int r = 0; r < 2; ++r) {
        *(float4*)(X + (size_t)(row0 + r) * D + c) = float4{v[r][i * 4], v[r][i * 4 + 1], v[r][i * 4 + 2], v[r][i * 4 + 3]};
        uint2 hv = {pk2(v[r][i * 4] * (1.f + c4.x) + s4.x, v[r][i * 4 + 1] * (1.f + c4.y) + s4.y),
                    pk2(v[r][i * 4 + 2] * (1.f + c4.z) + s4.z, v[r][i * 4 + 3] * (1.f + c4.w) + s4.w)};
        *(uint2*)(H + (size_t)(row0 + r) * D + c) = hv;
      }
    }
  }
}

__device__ void phase_attn(const P& p, int l, char* smem) {
  const int tid = get_tid(), lane = tid & 63, w = tid >> 6, fr = lane & 15, fq = lane >> 4;
  const u16* PROJ = (const u16*)(p.ws + OFF_PROJ);
  const u16* VT = (const u16*)(p.ws + OFF_VT);
  u16* MIX = (u16*)(p.ws + OFF_MIX);
  const float lam = ((const float*)(p.ws + OFF_LAM))[l >> 1];
  const float lam_init = 0.8f - 0.6f * expf(-0.3f * (float)l);
  const float* subw = p.da_sub_w + (l >> 1) * 128;
  const int xcd = blockIdx.x & 7, slot = blockIdx.x >> 3, nslot = gridDim.x >> 3;
  const int n_virt = (l == 3) ? 256 : 272;
  for (int idx = slot; idx < n_virt; idx += nslot) {
    int b, h, qrow0, nkt;
    if (idx < 256) {
      const int bh = (idx >> 6) * 8 + xcd;
      b = bh >> 3; h = bh & 7; qrow0 = b * 4096 + (idx & 63) * 64; nkt = 68;
    } else {
      const int cs = idx - 256, bh = (cs >> 2) * 8 + xcd;
      b = bh >> 3; h = bh & 7; qrow0 = ML + b * 256 + (cs & 3) * 64; nkt = 4;
    }
    bf16x8 qf[2][2];
    {
      const u16* qp = PROJ + (size_t)(qrow0 + w * 16 + fr) * 3072 + h * 128 + fq * 8;
#pragma unroll
      for (int m = 0; m < 2; ++m)
#pragma unroll
        for (int ks = 0; ks < 2; ++ks) qf[m][ks] = *(const bf16x8*)(qp + m * 64 + ks * 32);
    }
    f32x4 O[2][8];
#pragma unroll
    for (int m = 0; m < 2; ++m)
#pragma unroll
      for (int v = 0; v < 8; ++v) O[m][v] = f32x4{0.f, 0.f, 0.f, 0.f};
    float mrun[2] = {-1e30f, -1e30f}, lsum[2] = {0.f, 0.f};
    const u16* vbase = VT + (size_t)((b * 8 + h) * 128) * TK;
    auto stage = [&](int kt, char* buf) {
      const int krow0 = kt < 4 ? ML + b * 256 + kt * 64 : b * 4096 + (kt - 4) * 64;
#pragma unroll
      for (int i = 0; i < 4; ++i) {
        int q = tid + i * 256;
        int key = q >> 4, ch = (q & 15) ^ (key & 15);
        glds16(PROJ + (size_t)(krow0 + key) * 3072 + 1024 + h * 128 + ch * 8, buf + q * 16);
        int dv = q >> 3, c2 = (q & 7) ^ ((dv >> 1) & 7);
        glds16(vbase + (size_t)dv * TK + kt * 64 + c2 * 8, buf + 16384 + q * 16);
      }
    };
    __syncthreads();
    stage(0, smem);
    for (int kt = 0; kt < nkt; ++kt) {
      __syncthreads();
      char* cur = smem + (kt & 1) * 32768;
      if (kt + 1 < nkt) stage(kt + 1, smem + ((kt + 1) & 1) * 32768);
      bf16x8 pb[2][2];
      f32x4 s[2][4];
#pragma unroll
      for (int sf = 0; sf < 4; ++sf) {
        s[0][sf] = f32x4{0.f, 0.f, 0.f, 0.f};
        s[1][sf] = f32x4{0.f, 0.f, 0.f, 0.f};
#pragma unroll
        for (int m = 0; m < 2; ++m)
#pragma unroll
          for (int ks = 0; ks < 2; ++ks) {
            bf16x8 a = *(const bf16x8*)(cur + swz256(sf * 16 + fr, m * 8 + ks * 4 + fq));
            s[m][sf] = mfma16(a, qf[m][ks], s[m][sf]);
          }
      }
      float tm0 = -1e30f, tm1 = -1e30f;
#pragma unroll
      for (int sf = 0; sf < 4; ++sf)
#pragma unroll
        for (int j = 0; j < 4; ++j) { tm0 = fmaxf(tm0, s[0][sf][j]); tm1 = fmaxf(tm1, s[1][sf][j]); }
      if (__any(fmaxf(tm0 - mrun[0], tm1 - mrun[1]) > 6.f)) {
        tm0 = xor_max(tm0, 16); tm1 = xor_max(tm1, 16);
        tm0 = xor_max(tm0, 32); tm1 = xor_max(tm1, 32);
        const float mn0 = fmaxf(mrun[0], tm0), sc0 = ex2(mrun[0] - mn0);
        const float mn1 = fmaxf(mrun[1], tm1), sc1 = ex2(mrun[1] - mn1);
        mrun[0] = mn0; mrun[1] = mn1;
        lsum[0] *= sc0; lsum[1] *= sc1;
#pragma unroll
        for (int v = 0; v < 8; ++v) { O[0][v] *= sc0; O[1][v] *= sc1; }
      }
#pragma unroll
      for (int m = 0; m < 2; ++m) {
        const float mn = mrun[m];
        float ps = 0.f;
#pragma unroll
        for (int sf = 0; sf < 4; ++sf)
#pragma unroll
          for (int j = 0; j < 4; ++j) { s[m][sf][j] = ex2(s[m][sf][j] - mn); ps += s[m][sf][j]; }
        lsum[m] += ps;
#pragma unroll
        for (int k2 = 0; k2 < 2; ++k2) {
          union { bf16x8 v; unsigned u[4]; } t;
          t.u[0] = pk2(s[m][2 * k2][0], s[m][2 * k2][1]); t.u[1] = pk2(s[m][2 * k2][2], s[m][2 * k2][3]);
          t.u[2] = pk2(s[m][2 * k2 + 1][0], s[m][2 * k2 + 1][1]); t.u[3] = pk2(s[m][2 * k2 + 1][2], s[m][2 * k2 + 1][3]);
          pb[m][k2] = t.v;
        }
      }
#pragma unroll
      for (int v = 0; v < 8; ++v) {
        const int dv = v * 16 + fr;
        union { bf16x8 v; uint2 u[2]; } a0, a1;
        a0.u[0] = *(const uint2*)(cur + 16384 + swz128(dv, (fq >> 1)) + (fq & 1) * 8);
        a0.u[1] = *(const uint2*)(cur + 16384 + swz128(dv, 2 + (fq >> 1)) + (fq & 1) * 8);
        a1.u[0] = *(const uint2*)(cur + 16384 + swz128(dv, 4 + (fq >> 1)) + (fq & 1) * 8);
        a1.u[1] = *(const uint2*)(cur + 16384 + swz128(dv, 6 + (fq >> 1)) + (fq & 1) * 8);
        O[0][v] = mfma16(a0.v, pb[0][0], O[0][v]);
        O[1][v] = mfma16(a0.v, pb[1][0], O[1][v]);
        O[0][v] = mfma16(a1.v, pb[0][1], O[0][v]);
        O[1][v] = mfma16(a1.v, pb[1][1], O[1][v]);
        if (v & 1) __builtin_amdgcn_sched_barrier(0);
      }
    }
    float l0 = xor_sum(xor_sum(lsum[0], 16), 32), l1 = xor_sum(xor_sum(lsum[1], 16), 32);
    const float i0 = 1.f / l0, i1 = lam / l1;
    float ssq = 0.f;
#pragma unroll
    for (int v = 0; v < 8; ++v)
#pragma unroll
      for (int j = 0; j < 4; ++j) { float o = O[0][v][j] * i0 - O[1][v][j] * i1; O[0][v][j] = o; ssq += o * o; }
    ssq = xor_sum(xor_sum(ssq, 16), 32);
    const float rs = rsqrtf(ssq * (1.f / 128.f) + 1e-6f) * (1.f - lam_init);
    u16* op = MIX + (size_t)(qrow0 + w * 16 + fr) * D + h * 128;
#pragma unroll
    for (int v = 0; v < 8; ++v) {
      int dv = v * 16 + fq * 4;
      float4 sw = *(const float4*)(subw + dv);
      uint2 o = {pk2(O[0][v][0] * rs * sw.x, O[0][v][1] * rs * sw.y), pk2(O[0][v][2] * rs * sw.z, O[0][v][3] * rs * sw.w)};
      *(uint2*)(op + dv) = o;
    }
  }
}

__device__ __forceinline__ void chunk_rows(int b, int cc_seq, int& row0, int& pos0) {
  if (cc_seq < 4) { row0 = ML + b * 256 + cc_seq * 64; pos0 = cc_seq * 64; }
  else { row0 = b * 4096 + (cc_seq - 4) * 64; pos0 = CTX + (cc_seq - 4) * 64; }
}
__device__ __forceinline__ int scan2tok(int c, int dir) {
  if (!dir) return c;
  return c < 4 ? 3 - c : 4 + 63 - (c - 4);
}

__device__ void hg_u_item(const P& p, int e, int item, char* smem) {
  const int tid = get_tid(), lane = tid & 63, wid = tid >> 6, wr = wid >> 1, wc = wid & 1, fr = lane & 15, fq = lane >> 4;
  const u16* PROJ = (const u16*)(p.ws + OFF_PROJ);
  const u16* IT = (const u16*)(p.ws + OFF_VT);
  float* U = (float*)(p.ws + OFF_U);
  float* DEC = (float*)(p.ws + OFF_DEC);
  const float* LB = (const float*)(p.ws + OFF_LB);
  const int c = item % NCH, seq = item / NCH, dir = seq & 1, h = (seq >> 1) & 3, b = seq >> 3;
  int row0, pos0;
  chunk_rows(b, scan2tok(c, dir), row0, pos0);
  float* tot = (float*)(smem + 16384);
  const int d = tid & 127, half = tid >> 7;
  const float lb = LB[(e * 2 + dir) * 512 + h * 128 + d];
  const u16* zp = PROJ + (size_t)row0 * 3072 + 1536 + dir * 512 + h * 128 + d;
  __syncthreads();
  float sum = 0.f;
#pragma unroll 8
  for (int i = 0; i < 32; ++i) {
    int tau = half * 32 + i, t = dir ? 63 - tau : tau;
    float f = lb + (1.f - lb) * sigm(bf2f(zp[(size_t)t * 3072]));
    sum += __logf(fmaxf(f, 1e-20f));
  }
  tot[half * 128 + d] = sum;
  __syncthreads();
  float rel = half ? 0.f : tot[128 + d];
#pragma unroll 8
  for (int i = 31; i >= 0; --i) {
    int tau = half * 32 + i, t = dir ? 63 - tau : tau;
    float f = lb + (1.f - lb) * sigm(bf2f(zp[(size_t)t * 3072]));
    float lf = __logf(fmaxf(f, 1e-20f));
    *(u16*)(smem + swz128(d, t >> 3) + (t & 7) * 2) = f2bf((1.f - f) * __expf(rel));
    rel += lf;
  }
  if (!half) DEC[(size_t)(seq * NCH + c) * 128 + d] = __expf(rel);
  __syncthreads();
  f32x4 acc[4][4];
#pragma unroll
  for (int m = 0; m < 4; ++m)
#pragma unroll
    for (int n = 0; n < 4; ++n) acc[m][n] = f32x4{0.f, 0.f, 0.f, 0.f};
  const u16* vb = IT + (size_t)((b * 4 + h) * 128) * TK + pos0;
#pragma unroll
  for (int ks = 0; ks < 2; ++ks) {
    bf16x8 a[4], bb[4];
#pragma unroll
    for (int m = 0; m < 4; ++m) a[m] = *(const bf16x8*)(vb + (size_t)(wr * 64 + m * 16 + fr) * TK + ks * 32 + fq * 8);
#pragma unroll
    for (int n = 0; n < 4; ++n) bb[n] = *(const bf16x8*)(smem + swz128(wc * 64 + n * 16 + fr, ks * 4 + fq));
#pragma unroll
    for (int m = 0; m < 4; ++m)
#pragma unroll
      for (int n = 0; n < 4; ++n) acc[m][n] = mfma16(a[m], bb[n], acc[m][n]);
  }
  float* up = U + (size_t)(seq * NCH + c) * 16384;
#pragma unroll
  for (int m = 0; m < 4; ++m)
#pragma unroll
    for (int n = 0; n < 4; ++n)
#pragma unroll
      for (int j = 0; j < 4; ++j) up[(wr * 64 + m * 16 + fq * 4 + j) * 128 + wc * 64 + n * 16 + fr] = acc[m][n][j];
}

__device__ void pool_item(const P& p, int item) {
  const int tid = get_tid();
  const u16* PROJ = (const u16*)(p.ws + OFF_PROJ);
  u16* PO = (u16*)(p.ws + OFF_POOLED);
  const int ch = tid * 2, g = ch >> 7, hw = 1 << g;
  const int row0 = item * 32;
  int base, n, pos0;
  if (row0 < ML) { base = row0 & ~4095; n = 4096; pos0 = row0 & 4095; }
  else { base = ML + ((row0 - ML) & ~255); n = 256; pos0 = (row0 - ML) & 255; }
  const u16* up = PROJ + (size_t)base * 3072 + 2560 + ch;
  float s0 = 0.f, s1 = 0.f;
  {
    const int lo = max(pos0 - hw, 0), hi = min(pos0 + hw, n);
    for (int r = lo; r < hi; ++r) {
      unsigned v = *(const unsigned*)(up + (size_t)r * 3072);
      s0 += __uint_as_float(v << 16); s1 += __uint_as_float(v & 0xffff0000u);
    }
  }
  for (int i0 = 0; i0 < 32; i0 += 16) {
    unsigned ce[16], en[16], le[16];
#pragma unroll
    for (int i = 0; i < 16; ++i) {
      const int pos = pos0 + i0 + i;
      ce[i] = *(const unsigned*)(up + (size_t)pos * 3072);
      en[i] = (pos + hw < n) ? *(const unsigned*)(up + (size_t)(pos + hw) * 3072) : 0u;
      le[i] = (pos - hw >= 0) ? *(const unsigned*)(up + (size_t)(pos - hw) * 3072) : 0u;
    }
#pragma unroll
    for (int i = 0; i < 16; ++i) {
      const int pos = pos0 + i0 + i;
      const int lo = max(pos - hw, 0), hi = min(pos + hw, n);
      const float ic = 1.f / (float)(hi - lo);
      *(unsigned*)(PO + (size_t)(base + pos) * 512 + ch) =
          pk2(s0 * ic - __uint_as_float(ce[i] << 16), s1 * ic - __uint_as_float(ce[i] & 0xffff0000u));
      s0 += __uint_as_float(en[i] << 16) - __uint_as_float(le[i] << 16);
      s1 += __uint_as_float(en[i] & 0xffff0000u) - __uint_as_float(le[i] & 0xffff0000u);
    }
  }
}

__device__ void hg_scan_item(const P& p, int item) {
  float* U = (float*)(p.ws + OFF_U);
  const float* DEC = (const float*)(p.ws + OFF_DEC);
  const int ei = item * 256 + get_tid(), seq = ei >> 14, vd = ei & 16383, d = vd & 127;
  float* up = U + (size_t)seq * NCH * 16384 + vd;
  const float* dp = DEC + (size_t)seq * NCH * 128 + d;
  float s = 0.f;
  for (int c0 = 0; c0 < NCH; c0 += 17) {
    float u[17], dd[17];
#pragma unroll
    for (int i = 0; i < 17; ++i) { u[i] = up[(size_t)(c0 + i) * 16384]; dd[i] = dp[(c0 + i) * 128]; }
#pragma unroll
    for (int i = 0; i < 17; ++i) { up[(size_t)(c0 + i) * 16384] = s; s = dd[i] * s + u[i]; }
  }
}

__device__ void hg_o_item(const P& p, int e, int item, char* smem) {
  const int tid = get_tid(), lane = tid & 63, w = tid >> 6, fr = lane & 15, fq = lane >> 4;
  const u16* PROJ = (const u16*)(p.ws + OFF_PROJ);
  const u16* IT = (const u16*)(p.ws + OFF_VT);
  const float* S = (const float*)(p.ws + OFF_U);
  const float* LB = (const float*)(p.ws + OFF_LB);
  u16* MIX = (u16*)(p.ws + OFF_MIX);
  const int tc = item % NCH, bh = item / NCH, h = bh & 3, b = bh >> 2;
  int row0, pos0;
  chunk_rows(b, tc, row0, pos0);
  char* qh = smem;
  char* kh = smem + 16384;
  char* vt = smem + 32768;
  float* eref = (float*)(smem + 49152);
  __syncthreads();
  {
    const u16* vb = IT + (size_t)((b * 4 + h) * 128) * TK + pos0;
#pragma unroll
    for (int i = 0; i < 4; ++i) {
      int q = tid + i * 256, dv = q >> 3, c2 = (q & 7) ^ ((dv >> 1) & 7);
      glds16(vb + (size_t)dv * TK + c2 * 8, vt + q * 16);
    }
  }
  f32x4 O[8];
#pragma unroll
  for (int v = 0; v < 8; ++v) O[v] = f32x4{0.f, 0.f, 0.f, 0.f};
  const int d = tid & 127, half = tid >> 7;
  for (int dir = 0; dir < 2; ++dir) {
    const int c = dir ? (tc < 4 ? 3 - tc : 4 + 63 - (tc - 4)) : tc;
    const int seq = (b * 4 + h) * 2 + dir;
    const float lb = LB[(e * 2 + dir) * 512 + h * 128 + d];
    const u16* zp = PROJ + (size_t)row0 * 3072 + 1536 + dir * 512 + h * 128 + d;
    const u16* qp = PROJ + (size_t)row0 * 3072 + h * 128 + d;
    if (dir) __syncthreads();
    float rel = 0.f;
    if (!half) {
#pragma unroll 8
      for (int tau = 31; tau >= 0; --tau) {
        int t = dir ? 63 - tau : tau;
        float f = lb + (1.f - lb) * sigm(bf2f(zp[(size_t)t * 3072]));
        float lf = __logf(fmaxf(f, 1e-20f));
        float q = bf2f(qp[(size_t)t * 3072]);
        int off = swz256(t, d >> 3) + (d & 7) * 2;
        *(u16*)(qh + off) = f2bf(q * __expf(rel));
        *(u16*)(kh + off) = f2bf((1.f - f) * __expf(-rel));
        rel -= lf;
      }
      eref[d] = __expf(-rel);
    } else {
#pragma unroll 8
      for (int tau = 32; tau < 64; ++tau) {
        int t = dir ? 63 - tau : tau;
        float f = lb + (1.f - lb) * sigm(bf2f(zp[(size_t)t * 3072]));
        float lf = __logf(fmaxf(f, 1e-20f));
        float q = bf2f(qp[(size_t)t * 3072]);
        rel += lf;
        int off = swz256(t, d >> 3) + (d & 7) * 2;
        *(u16*)(qh + off) = f2bf(q * __expf(rel));
        *(u16*)(kh + off) = f2bf((1.f - f) * __expf(-rel));
      }
    }
    __syncthreads();
    bf16x8 qf[4];
#pragma unroll
    for (int ks = 0; ks < 4; ++ks) qf[ks] = *(const bf16x8*)(qh + swz256(w * 16 + fr, ks * 4 + fq));
    f32x4 s[4];
#pragma unroll
    for (int sf = 0; sf < 4; ++sf) {
      s[sf] = f32x4{0.f, 0.f, 0.f, 0.f};
#pragma unroll
      for (int ks = 0; ks < 4; ++ks) {
        bf16x8 a = *(const bf16x8*)(kh + swz256(sf * 16 + fr, ks * 4 + fq));
        s[sf] = mfma16(a, qf[ks], s[sf]);
      }
    }
    const int tq = w * 16 + fr;
#pragma unroll
    for (int sf = 0; sf < 4; ++sf)
#pragma unroll
      for (int j = 0; j < 4; ++j) {
        int ss = sf * 16 + fq * 4 + j;
        bool keep = dir ? (ss >= tq) : (ss <= tq);
        s[sf][j] = keep ? s[sf][j] : 0.f;
      }
    bf16x8 pb[2];
#pragma unroll
    for (int k2 = 0; k2 < 2; ++k2) {
      union { bf16x8 v; unsigned u[4]; } t;
      t.u[0] = pk2(s[2 * k2][0], s[2 * k2][1]); t.u[1] = pk2(s[2 * k2][2], s[2 * k2][3]);
      t.u[2] = pk2(s[2 * k2 + 1][0], s[2 * k2 + 1][1]); t.u[3] = pk2(s[2 * k2 + 1][2], s[2 * k2 + 1][3]);
      pb[k2] = t.v;
    }
#pragma unroll
    for (int v = 0; v < 8; ++v)
#pragma unroll
      for (int k2 = 0; k2 < 2; ++k2) {
        const int dv = v * 16 + fr;
        union { bf16x8 v; uint2 u[2]; } a;
        a.u[0] = *(const uint2*)(vt + swz128(dv, k2 * 4 + (fq >> 1)) + (fq & 1) * 8);
        a.u[1] = *(const uint2*)(vt + swz128(dv, k2 * 4 + 2 + (fq >> 1)) + (fq & 1) * 8);
        O[v] = mfma16(a.v, pb[k2], O[v]);
      }
    const float* sp = S + (size_t)(seq * NCH + c) * 16384;
#pragma unroll
    for (int ks = 0; ks < 4; ++ks) {
      union { bf16x8 v; u16 h[8]; unsigned u[4]; } qq, qs;
      qq.v = qf[ks];
      const float* er = eref + ks * 32 + fq * 8;
#pragma unroll
      for (int i = 0; i < 4; ++i) qs.u[i] = pk2(bf2f(qq.h[2 * i]) * er[2 * i], bf2f(qq.h[2 * i + 1]) * er[2 * i + 1]);
#pragma unroll
      for (int v = 0; v < 8; ++v) {
        const float* g = sp + (v * 16 + fr) * 128 + ks * 32 + fq * 8;
        float4 x0 = *(const float4*)g, x1 = *(const float4*)(g + 4);
        union { bf16x8 v; unsigned u[4]; } a;
        a.u[0] = pk2(x0.x, x0.y); a.u[1] = pk2(x0.z, x0.w); a.u[2] = pk2(x1.x, x1.y); a.u[3] = pk2(x1.z, x1.w);
        O[v] = mfma16(a.v, qs.v, O[v]);
      }
    }
  }
  float ssq = 0.f;
#pragma unroll
  for (int v = 0; v < 8; ++v)
#pragma unroll
    for (int j = 0; j < 4; ++j) ssq += O[v][j] * O[v][j];
  ssq = xor_sum(xor_sum(ssq, 16), 32);
  const float rs = rsqrtf(ssq * (1.f / 128.f) + 1e-6f);
  const int row = row0 + w * 16 + fr;
  const float* nw = p.hg_norm_w + e * 128;
#pragma unroll
  for (int v = 0; v < 8; ++v) {
    int dv = v * 16 + fq * 4;
    uint2 gv = *(const uint2*)(PROJ + (size_t)row * 3072 + 1024 + h * 128 + dv);
    float4 n4 = *(const float4*)(nw + dv);
    float g0 = bf2f((u16)(gv.x & 0xffff)), g1 = bf2f((u16)(gv.x >> 16)), g2 = bf2f((u16)(gv.y & 0xffff)), g3 = bf2f((u16)(gv.y >> 16));
    uint2 o = {pk2(O[v][0] * rs * n4.x * silu(g0), O[v][1] * rs * n4.y * silu(g1)),
               pk2(O[v][2] * rs * n4.z * silu(g2), O[v][3] * rs * n4.w * silu(g3))};
    *(uint2*)(MIX + (size_t)row * D + h * 128 + dv) = o;
  }
}

#define XB_TMO      128
#define XB_XCNT(j)  (256  + 64 * (j))
#define XB_XSUB(j)  (1280 + 64 * (j))
#define XB_XGEN(j)  (2304 + 64 * (j))
#define XB_TOP      3328
#define XB_TOPGEN   3392
#define XCD_BAR_WORDS 3456
#define XB_SPIN_CAP (1u << 18)
__device__ __forceinline__ unsigned xb_ld(unsigned* p) { return __hip_atomic_load(p, __ATOMIC_RELAXED, __HIP_MEMORY_SCOPE_AGENT); }
__device__ __forceinline__ unsigned xb_add(unsigned* p, unsigned v) { return __hip_atomic_fetch_add(p, v, __ATOMIC_RELAXED, __HIP_MEMORY_SCOPE_AGENT); }
__device__ __forceinline__ unsigned xb_xcc_id() { return (unsigned)__builtin_amdgcn_s_getreg((3 << 11) | 20) & 0xFu; }
#define XB_SPIN(cond, bar) do { unsigned _sp = 0; while (cond) { __builtin_amdgcn_s_sleep(1); \
    if ((++_sp & 255u) == 0u) { if (xb_ld(&(bar)[XB_TMO])) break; if (_sp > XB_SPIN_CAP) { atomicAdd(&(bar)[XB_TMO], 1u); break; } } } } while (0)
struct GB { unsigned* bar; unsigned x, nloc, nx; };
__device__ __forceinline__ void gb_complete(unsigned* bar, unsigned x, unsigned& nloc, unsigned& nx) {
  const unsigned G = gridDim.x;
  unsigned sum, cnt, mine, sp = 0u;
  for (;;) {
    sum = 0u; cnt = 0u; mine = 0u;
#pragma unroll
    for (unsigned j = 0; j < 16; ++j) { const unsigned c = xb_ld(&bar[XB_XCNT(j)]); sum += c; cnt += (c > 0u) ? 1u : 0u; mine = (j == x) ? c : mine; }
    if (sum == G) break;
    __builtin_amdgcn_s_sleep(1);
    if ((++sp & 255u) == 0u) { if (xb_ld(&bar[XB_TMO])) break; if (sp > XB_SPIN_CAP) { atomicAdd(&bar[XB_TMO], 1u); break; } }
  }
  nloc = mine > 0u ? mine : 1u; nx = cnt > 0u ? cnt : 1u;
}
__device__ __forceinline__ void gbar(GB& b) {
  asm volatile("s_waitcnt vmcnt(0)" ::: "memory");
  __syncthreads();
  if (threadIdx.x == 0) {
    unsigned* bar = b.bar;
    __builtin_amdgcn_s_waitcnt(0);
    if (b.nloc == 0u) gb_complete(bar, b.x, b.nloc, b.nx);
    const unsigned nloc = b.nloc, nx = b.nx;
    const unsigned old = xb_add(&bar[XB_XSUB(b.x)], 1u);
    const unsigned gen = old / nloc;
    if (old + 1u == (gen + 1u) * nloc) {
      __builtin_amdgcn_fence(__ATOMIC_RELEASE, "agent");
      asm volatile("s_waitcnt vmcnt(0)" ::: "memory");
      const unsigned og = xb_add(&bar[XB_TOP], 1u);
      const unsigned tg = og / nx;
      if (og + 1u == (tg + 1u) * nx) xb_add(&bar[XB_TOPGEN], 1u);
      else XB_SPIN(xb_ld(&bar[XB_TOPGEN]) == tg, bar);
      __builtin_amdgcn_fence(__ATOMIC_ACQUIRE, "agent");
      xb_add(&bar[XB_XGEN(b.x)], 1u);
      asm volatile("s_waitcnt vmcnt(0)" ::: "memory");
    } else {
      XB_SPIN(xb_ld(&bar[XB_XGEN(b.x)]) == gen, bar);
      __builtin_amdgcn_fence(__ATOMIC_ACQUIRE, "agent");
      asm volatile("s_waitcnt vmcnt(0)" ::: "memory");
    }
  }
  __syncthreads();
}

__device__ __forceinline__ void ffn_out_phase(const P& p, const u16* HID, const u16* Wt, int M, char* smem) {
  u16* Y = (u16*)(p.ws + OFF_Y);
  u16* YC = (u16*)(p.ws + OFF_YC);
  for (int it = 0;; ++it) {
    int pm, pn;
    if (!xcd_tile(it, ML / 128, 8, pm, pn)) break;
    gemm_tile(HID, FH, Wt, FH, FH, pm * 128, pn * 128, smem, EpiF32{Y});
  }
  if (M > ML) {
    for (int u = blockIdx.x; u < 256; u += gridDim.x) {
      {
      const int ks = u & 3, ct = u >> 2, pm = ct >> 3, pn = ct & 7;
      gemm_tile(HID + ks * 704, FH, Wt + ks * 704, FH, 704, ML + pm * 128, pn * 128, smem,
                EpiF32{YC + ((size_t)ks * MC - ML) * D});
      }
    }
  }
}

constexpr int PH_PER_EVEN = 12, PH_PER_ODD = 10;
constexpr int N_PHASES = 2 + 2 * PH_PER_EVEN + 2 * PH_PER_ODD;

__device__ __forceinline__ void run_phase(const P& pin, int ph, char* smem) {
  P p = pin;
  asm volatile("" : "+s"(p.ws));
  asm volatile("" : "+s"(p.out));
  u16* H = (u16*)(p.ws + OFF_H);
  u16* HID = (u16*)(p.ws + OFF_HID);
  u16* Y = (u16*)(p.ws + OFF_Y);
  u16* PROJ = (u16*)(p.ws + OFF_PROJ);
  u16* VT = (u16*)(p.ws + OFF_VT);
  u16* MIX = (u16*)(p.ws + OFF_MIX);
  if (ph == 0) { phase_prep(p, smem); return; }
  if (ph == 1) { phase_rows(p, 0, 0, 0, MT, false); return; }
  int q = ph - 2, l;
  if (q < PH_PER_EVEN) l = 0;
  else if (q < PH_PER_EVEN + PH_PER_ODD) { l = 1; q -= PH_PER_EVEN; }
  else if (q < 2 * PH_PER_EVEN + PH_PER_ODD) { l = 2; q -= PH_PER_EVEN + PH_PER_ODD; }
  else { l = 3; q -= 2 * PH_PER_EVEN + PH_PER_ODD; }
  const bool even = !(l & 1), last = (l == 3);
  int step = q;
  if (!even && q >= 5) step = q + 2;
  const int Mpost = last ? ML : MT;
  const u16* WFI = (const u16*)(p.ws + OFF_WFI);
  const u16* WFO = (const u16*)(p.ws + OFF_WFO);
  switch (step) {
    case 0: gemm_phase(H, D, WFI + (size_t)(l * 2 + 0) * 5632 * 1024, MT, 5632, 1024, smem, EpiSwiglu{HID}); break;
    case 1: ffn_out_phase(p, HID, WFO + (size_t)(l * 2 + 0) * 1024 * 2816, MT, smem); break;
    case 2: phase_rows(p, 1, l, 0, MT, false); break;
    case 3:
      if (even) gemm_phase(H, D, (const u16*)(p.ws + OFF_WMI) + (size_t)l * 3072 * 1024, MT, 3072, 1024, smem, EpiProjEven{PROJ, VT});
      else gemm_phase(H, D, (const u16*)(p.ws + OFF_WMI) + (size_t)l * 3072 * 1024, MT, 3072, 1024, smem,
                      EpiProjOdd{PROJ, VT, (const float*)(p.ws + OFF_ROPE)});
      break;
    case 4:
      if (even) {
        for (int it = blockIdx.x; it < 32 * NCH + MT / 32; it += gridDim.x) {
          if (it < 32 * NCH) hg_u_item(p, l >> 1, it, smem);
          else pool_item(p, it - 32 * NCH);
        }
      } else phase_attn(p, l, smem);
      break;
    case 5: {
      for (int it = blockIdx.x; it < 2048 + 4 * (MT / 128); it += gridDim.x) {
        if (it < 2048) hg_scan_item(p, it);
        else {
          int t = it - 2048, g = t / (MT / 128), mt = t % (MT / 128);
          gemm_tile((const u16*)(p.ws + OFF_POOLED) + g * 128, 512,
                    (const u16*)(p.ws + OFF_WPL) + (size_t)((l >> 1) * 4 + g) * 128 * 128, 128, 128, mt * 128, 0, smem,
                    EpiPool{MIX, p.pool_scale + (l >> 1) * 512, g});
        }
      }
    } break;
    case 6:
      for (int it = blockIdx.x; it < 16 * NCH; it += gridDim.x) hg_o_item(p, l >> 1, it, smem);
      break;
    case 7: gemm_phase(MIX, D, (const u16*)(p.ws + OFF_WMO) + (size_t)l * 1024 * 1024, Mpost, 1024, 1024, smem, EpiF32{Y}); break;
    case 8: phase_rows(p, 1, l, 1, Mpost, false); break;
    case 9: gemm_phase(H, D, WFI + (size_t)(l * 2 + 1) * 5632 * 1024, Mpost, 5632, 1024, smem, EpiSwiglu{HID}); break;
    case 10: ffn_out_phase(p, HID, WFO + (size_t)(l * 2 + 1) * 1024 * 2816, Mpost, smem); break;
    case 11: phase_rows(p, 1, l, 2, Mpost, last); break;
  }
}

__global__ void __launch_bounds__(256, 2) mega(P p, int ph_lo, int ph_hi) {
  __shared__ __attribute__((aligned(16))) char smem[65536];
  GB gb;
  gb.bar = (unsigned*)(p.ws + OFF_BAR); gb.x = xb_xcc_id(); gb.nloc = 0u; gb.nx = 0u;
  if (threadIdx.x == 0) (void)xb_add(&gb.bar[XB_XCNT(gb.x)], 1u);
  for (int ph = ph_lo; ph < ph_hi; ++ph) {
    run_phase(p, ph, smem);
#ifdef DOUBLE_GEMM
    {
      int q = ph - 2, l = 0;
      if (ph >= 2) {
        if (q < 12) l = 0; else if (q < 22) { l = 1; q -= 12; } else if (q < 34) { l = 2; q -= 22; } else { l = 3; q -= 34; }
        int step = q; if ((l & 1) && q >= 5) step = q + 2;
        if (step == 0 || step == 1 || step == 3 || step == 7 || step == 9 || step == 10) run_phase(p, ph, smem);
      }
    }
#endif
#ifdef DOUBLE_ATT
    if (ph == 2 + 12 + 4 || ph == 2 + 34 + 4) run_phase(p, ph, smem);
#endif
    if (ph + 1 < ph_hi) {
      if (ph == ph_lo) cg::this_grid().sync();
      else gbar(gb);
    }
  }
}

extern "C" void kernel_launch(void* const* d_in, const int* in_sizes, int n_in, void* d_out, int out_size, void* d_ws,
                              size_t ws_size, hipStream_t stream) {
  static int grid_blocks = 0;
  if (!grid_blocks) {
    int dev = 0, cus = 0, per_cu = 0;
    hipGetDevice(&dev);
    hipDeviceGetAttribute(&cus, hipDeviceAttributeMultiprocessorCount, dev);
    hipOccupancyMaxActiveBlocksPerMultiprocessor(&per_cu, mega, 256, 0);
    if (per_cu > 2) per_cu = 2;
    grid_blocks = cus * per_cu;
  }
  if (ws_size < OFF_END2) { fprintf(stderr, "workspace too small: %zu < %zu\n", ws_size, (size_t)OFF_END); return; }
  P p{};
  const float** f = (const float**)&p;
  for (int i = 0; i < 20; ++i) f[i] = (const float*)d_in[i];
  p.out = (float*)d_out;
  p.ws = (char*)d_ws;
#if MULTI_LAUNCH
  for (int ph = 0; ph < N_PHASES; ++ph) hipLaunchKernelGGL(mega, dim3(grid_blocks), dim3(256), 0, stream, p, ph, ph + 1);
#else
  hipMemsetAsync((char*)d_ws + OFF_BAR, 0, XCD_BAR_WORDS * 4, stream);
  int lo = 0, hi = N_PHASES;
  void* args[] = {&p, &lo, &hi};
  hipError_t e = hipLaunchCooperativeKernel((void*)mega, dim3(grid_blocks), dim3(256), args, 0, stream);
  if (e != hipSuccess) fprintf(stderr, "cooperative launch failed: %s (grid %d)\n", hipGetErrorString(e), grid_blocks);
#endif
}
```

```cpp
#include <hip/hip_runtime.h>
#include <hip/hip_cooperative_groups.h>
#include <cstdio>
namespace cg = cooperative_groups;

typedef __attribute__((ext_vector_type(8))) short bf16x8;
typedef __attribute__((ext_vector_type(4))) float f32x4;
typedef unsigned short u16;

#ifndef MULTI_LAUNCH
#define MULTI_LAUNCH 0
#endif

constexpr int D = 1024, NB = 4, SEQ = 4096, CTX = 256, FH = 2816;
constexpr int ML = NB * SEQ, MC = NB * CTX, MT = ML + MC;
constexpr int TK = CTX + SEQ;
constexpr int NCH = TK / 64;
constexpr float ALPHA = 1.6817928305074290f;
constexpr float LOG2E = 1.4426950408889634f;

constexpr size_t al256(size_t x) { return (x + 255) & ~(size_t)255; }
constexpr size_t OFF_WFI = 0;
constexpr size_t OFF_WFO = OFF_WFI + al256((size_t)4 * 2 * 5632 * 1024 * 2);
constexpr size_t OFF_WMI = OFF_WFO + al256((size_t)4 * 2 * 1024 * 2816 * 2);
constexpr size_t OFF_WMO = OFF_WMI + al256((size_t)4 * 3072 * 1024 * 2);
constexpr size_t OFF_WPL = OFF_WMO + al256((size_t)4 * 1024 * 1024 * 2);
constexpr size_t OFF_MODS = OFF_WPL + al256((size_t)2 * 4 * 128 * 128 * 2);
constexpr size_t OFF_LB = OFF_MODS + al256((size_t)4 * 5 * 9216 * 4);
constexpr size_t OFF_LAM = OFF_LB + al256((size_t)2 * 2 * 512 * 4);
constexpr size_t OFF_ROPE = OFF_LAM + 256;
constexpr size_t OFF_DEC = OFF_ROPE + al256((size_t)64 * 16 * 2 * 4);
constexpr size_t OFF_X = OFF_DEC + al256((size_t)32 * NCH * 128 * 4);
constexpr size_t OFF_H = OFF_X + al256((size_t)MT * 1024 * 4);
constexpr size_t OFF_PROJ = OFF_H + al256((size_t)MT * 1024 * 2);
constexpr size_t OFF_VT = OFF_PROJ + al256((size_t)MT * 3072 * 2);
constexpr size_t OFF_MIX = OFF_VT + al256((size_t)NB * 8 * 128 * TK * 2);
constexpr size_t OFF_POOLED = OFF_MIX + al256((size_t)MT * 1024 * 2);
constexpr size_t OFF_HID = OFF_POOLED + al256((size_t)MT * 512 * 2);
constexpr size_t OFF_Y = OFF_HID + al256((size_t)MT * FH * 2);
constexpr size_t OFF_END = OFF_Y + al256((size_t)MT * 1024 * 4);
constexpr size_t OFF_YC = OFF_END;
constexpr size_t OFF_BAR = OFF_YC + al256((size_t)4 * MC * 1024 * 2);
constexpr size_t OFF_END2 = OFF_BAR + al256((size_t)3456 * 4);
constexpr size_t OFF_U = OFF_HID;
static_assert((size_t)32 * NCH * 16384 * 4 <= OFF_END - OFF_HID, "U alias too big");

struct P {
  const float *x, *c, *ctx, *c_ctx, *w_ada, *b_ada, *ln_g, *ln_b, *w_ffn_in, *w_ffn_out, *w_in_even, *w_out_even,
      *hg_lb, *hg_norm_w, *pool_w, *pool_scale, *w_in_odd, *w_out_odd, *da_lambda, *da_sub_w;
  float* out;
  char* ws;
};

typedef __attribute__((ext_vector_type(2))) __bf16 bf16v2;
typedef __attribute__((ext_vector_type(2))) float f32v2;
__device__ __forceinline__ unsigned pk2(float a, float b) {
  f32v2 v = {a, b};
  bf16v2 r = __builtin_convertvector(v, bf16v2);
  return *(unsigned*)&r;
}
__device__ __forceinline__ u16 f2bf(float f) { return (u16)(pk2(f, 0.f) & 0xffffu); }
__device__ __forceinline__ float bf2f(u16 h) { return __uint_as_float(((unsigned)h) << 16); }
__device__ __forceinline__ float sigm(float z) { return 1.f / (1.f + __expf(-z)); }
__device__ __forceinline__ float silu(float z) { return z / (1.f + __expf(-z)); }
__device__ __forceinline__ float ex2(float x) { return __builtin_amdgcn_exp2f(x); }
__device__ __forceinline__ void glds16(const void* g, void* l) {
  __builtin_amdgcn_global_load_lds((const unsigned*)g, (unsigned*)l, 16, 0, 0);
}
__device__ __forceinline__ int get_tid() { int t = threadIdx.x; asm volatile("" : "+v"(t)); return t; }
__device__ __forceinline__ int swz128(int row, int ch) { return row * 128 + ((ch ^ ((row >> 1) & 7)) << 4); }
__device__ __forceinline__ int swz256(int row, int ch) { return row * 256 + ((ch ^ (row & 15)) << 4); }
__device__ __forceinline__ f32x4 mfma16(bf16x8 a, bf16x8 b, f32x4 c) {
  return __builtin_amdgcn_mfma_f32_16x16x32_bf16(a, b, c, 0, 0, 0);
}
__device__ __forceinline__ float xor_sum(float v, int m) { return v + __shfl_xor(v, m, 64); }
__device__ __forceinline__ float xor_max(float v, int m) { return fmaxf(v, __shfl_xor(v, m, 64)); }
__device__ __forceinline__ void row_bpos(int row, int& b, int& pos) {
  if (row < ML) { b = row >> 12; pos = CTX + (row & 4095); }
  else { int r = row - ML; b = r >> 8; pos = r & 255; }
}
__device__ __forceinline__ int mod_row(int row) { return row < ML ? (row >> 12) : 4; }

constexpr int BM = 128, BN = 128, BK = 64;

template <class Epi>
__device__ __forceinline__ void gemm_tile(const u16* __restrict__ A, int lda, const u16* __restrict__ Bt, int ldb, int K,
                                          int m0, int n0, char* smem, const Epi& epi) {
  const int tid = get_tid(), lane = tid & 63, wid = tid >> 6, wr = wid >> 1, wc = wid & 1, fr = lane & 15, fq = lane >> 4;
  f32x4 acc[4][4];
#pragma unroll
  for (int m = 0; m < 4; ++m)
#pragma unroll
    for (int n = 0; n < 4; ++n) acc[m][n] = f32x4{0.f, 0.f, 0.f, 0.f};
  const int nk = K / BK;
  const u16* ga[4];
  const u16* gb[4];
#pragma unroll
  for (int i = 0; i < 4; ++i) {
    int q = tid + i * 256, row = q >> 3, ch = (q & 7) ^ ((row >> 1) & 7);
    ga[i] = A + (size_t)(m0 + row) * lda + ch * 8;
    gb[i] = Bt + (size_t)(n0 + row) * ldb + ch * 8;
  }
  __syncthreads();
#pragma unroll
  for (int i = 0; i < 4; ++i) {
    glds16(ga[i], smem + (tid + i * 256) * 16);
    glds16(gb[i], smem + 16384 + (tid + i * 256) * 16);
  }
  for (int kt = 0; kt < nk; ++kt) {
    __syncthreads();
    char* cur = smem + (kt & 1) * 32768;
    bf16x8 a[2][4], b[2][4];
#pragma unroll
    for (int ks = 0; ks < 2; ++ks) {
#pragma unroll
      for (int n = 0; n < 4; ++n) b[ks][n] = *(const bf16x8*)(cur + 16384 + swz128(wc * 64 + n * 16 + fr, ks * 4 + fq));
#pragma unroll
      for (int m = 0; m < 4; ++m) a[ks][m] = *(const bf16x8*)(cur + swz128(wr * 64 + m * 16 + fr, ks * 4 + fq));
    }
    __builtin_amdgcn_sched_barrier(0);
    if (kt + 1 < nk) {
      char* nxt = smem + ((kt + 1) & 1) * 32768;
#pragma unroll
      for (int i = 0; i < 4; ++i) {
        glds16(ga[i] + (kt + 1) * BK, nxt + (tid + i * 256) * 16);
        glds16(gb[i] + (kt + 1) * BK, nxt + 16384 + (tid + i * 256) * 16);
      }
    }
    __builtin_amdgcn_sched_barrier(0);
    __builtin_amdgcn_s_setprio(1);
#pragma unroll
    for (int ks = 0; ks < 2; ++ks)
#pragma unroll
      for (int m = 0; m < 4; ++m)
#pragma unroll
        for (int n = 0; n < 4; ++n) acc[m][n] = mfma16(b[ks][n], a[ks][m], acc[m][n]);
    __builtin_amdgcn_s_setprio(0);
  }
  epi(acc, m0 + wr * 64, n0 + wc * 64, fr, fq);
}

__device__ __forceinline__ bool xcd_tile(int it, int nM, int nN, int& pm, int& pn) {
  const int xcd = blockIdx.x & 7, slot = blockIdx.x >> 3, nslot = gridDim.x >> 3;
  const int mlo = (nM * xcd) >> 3, mhi = (nM * (xcd + 1)) >> 3, mcnt = mhi - mlo;
  const int j = slot + it * nslot;
  if (j >= mcnt * nN) return false;
  const int per_ng = mcnt * 8;
  const int ng = j / per_ng, r = j - ng * per_ng;
  const int nrem = min(8, nN - ng * 8);
  pm = mlo + r / nrem; pn = ng * 8 + r % nrem;
  return true;
}
template <class Epi>
__device__ __forceinline__ void gemm_phase(const u16* A, int lda, const u16* Bt, int M, int N, int K, char* smem,
                                           const Epi& epi) {
  const int nM = M / BM, nN = N / BN;
  for (int it = 0;; ++it) {
    int pm, pn;
    if (!xcd_tile(it, nM, nN, pm, pn)) break;
    gemm_tile(A, lda, Bt, K, K, pm * BM, pn * BN, smem, epi);
  }
}

struct EpiSwiglu {
  u16* hid;
  __device__ __forceinline__ void operator()(f32x4 (&acc)[4][4], int rb, int cb, int fr, int fq) const {
#pragma unroll
    for (int m = 0; m < 4; ++m)
#pragma unroll
      for (int n = 0; n < 4; n += 2) {
        int row = rb + m * 16 + fr, hc = (cb >> 1) + (n >> 1) * 16 + fq * 4;
        uint2 v = {pk2(silu(acc[m][n][0]) * acc[m][n + 1][0], silu(acc[m][n][1]) * acc[m][n + 1][1]),
                   pk2(silu(acc[m][n][2]) * acc[m][n + 1][2], silu(acc[m][n][3]) * acc[m][n + 1][3])};
        *(uint2*)(hid + (size_t)row * FH + hc) = v;
      }
  }
};
struct EpiF32 {
  u16* y;
  __device__ __forceinline__ void operator()(f32x4 (&acc)[4][4], int rb, int cb, int fr, int fq) const {
#pragma unroll
    for (int m = 0; m < 4; ++m)
#pragma unroll
      for (int n = 0; n < 4; ++n)
        *(uint2*)(y + (size_t)(rb + m * 16 + fr) * D + cb + n * 16 + fq * 4) =
            uint2{pk2(acc[m][n][0], acc[m][n][1]), pk2(acc[m][n][2], acc[m][n][3])};
  }
};
struct EpiPool {
  u16* mix; const float* scale; int g;
  __device__ __forceinline__ void operator()(f32x4 (&acc)[4][4], int rb, int cb, int fr, int fq) const {
#pragma unroll
    for (int n = 0; n < 4; ++n) {
      int col = g * 128 + cb + n * 16 + fq * 4;
      float4 sc = *(const float4*)(scale + col);
#pragma unroll
      for (int m = 0; m < 4; ++m) {
        uint2 v = {pk2(acc[m][n][0] * sc.x, acc[m][n][1] * sc.y), pk2(acc[m][n][2] * sc.z, acc[m][n][3] * sc.w)};
        *(uint2*)(mix + (size_t)(rb + m * 16 + fr) * D + 512 + col) = v;
      }
    }
  }
};
__device__ __forceinline__ void store_vt(u16* vt, int nh, f32x4 (&acc)[4][4], int rb, int fcol0, int fr, int fq) {
#pragma unroll
  for (int m = 0; m < 4; ++m) {
    int row = rb + m * 16 + fr, b, pos;
    row_bpos(row, b, pos);
#pragma unroll
    for (int n = 0; n < 4; ++n) {
      int fc = fcol0 + n * 16 + fq * 4, h = fc >> 7, f = fc & 127;
      u16* o = vt + ((size_t)((b * nh + h) * 128 + f)) * TK + pos;
#pragma unroll
      for (int j = 0; j < 4; ++j) o[(size_t)j * TK] = f2bf(acc[m][n][j]);
    }
  }
}
struct EpiProjEven {
  u16* proj; u16* vt;
  __device__ __forceinline__ void operator()(f32x4 (&acc)[4][4], int rb, int cb, int fr, int fq) const {
    if (cb >= 512 && cb < 1024) { store_vt(vt, 4, acc, rb, cb - 512, fr, fq); return; }
    const float sc = (cb < 512) ? 0.08838834764831845f : 1.f;
#pragma unroll
    for (int m = 0; m < 4; ++m)
#pragma unroll
      for (int n = 0; n < 4; ++n) {
        uint2 v = {pk2(acc[m][n][0] * sc, acc[m][n][1] * sc), pk2(acc[m][n][2] * sc, acc[m][n][3] * sc)};
        *(uint2*)(proj + (size_t)(rb + m * 16 + fr) * 3072 + cb + n * 16 + fq * 4) = v;
      }
  }
};
struct EpiProjOdd {
  u16* proj; u16* vt; const float* rope;
  __device__ __forceinline__ void operator()(f32x4 (&acc)[4][4], int rb, int cb, int fr, int fq) const {
    if (cb >= 2048) { store_vt(vt, 8, acc, rb, cb - 2048, fr, fq); return; }
    const float sc = (cb < 1024) ? 0.125f * LOG2E : 1.f;
#pragma unroll
    for (int m = 0; m < 4; ++m) {
      int row = rb + m * 16 + fr;
      f32x4 v0 = acc[m][0], v1 = acc[m][1], v2 = acc[m][2], v3 = acc[m][3];
      if (row < ML) {
        int t = row & 4095, pr = t >> 6, pc = t & 63;
        const float* rr = rope + (pr * 16 + fq * 4) * 2;
        const float* rc = rope + (pc * 16 + fq * 4) * 2;
        float4 r0 = *(const float4*)rr, r1 = *(const float4*)(rr + 4), c0 = *(const float4*)rc, c1 = *(const float4*)(rc + 4);
        float cs[4] = {r0.x, r0.z, r1.x, r1.z}, sn[4] = {r0.y, r0.w, r1.y, r1.w};
        float cs2[4] = {c0.x, c0.z, c1.x, c1.z}, sn2[4] = {c0.y, c0.w, c1.y, c1.w};
#pragma unroll
        for (int j = 0; j < 4; ++j) {
          float a0 = v0[j] * cs[j] - v1[j] * sn[j], a1 = v1[j] * cs[j] + v0[j] * sn[j];
          float a2 = v2[j] * cs2[j] - v3[j] * sn2[j], a3 = v3[j] * cs2[j] + v2[j] * sn2[j];
          v0[j] = a0; v1[j] = a1; v2[j] = a2; v3[j] = a3;
        }
      }
      u16* o = proj + (size_t)row * 3072 + cb + fq * 4;
      *(uint2*)(o) = uint2{pk2(v0[0] * sc, v0[1] * sc), pk2(v0[2] * sc, v0[3] * sc)};
      *(uint2*)(o + 16) = uint2{pk2(v1[0] * sc, v1[1] * sc), pk2(v1[2] * sc, v1[3] * sc)};
      *(uint2*)(o + 32) = uint2{pk2(v2[0] * sc, v2[1] * sc), pk2(v2[2] * sc, v2[3] * sc)};
      *(uint2*)(o + 48) = uint2{pk2(v3[0] * sc, v3[1] * sc), pk2(v3[2] * sc, v3[3] * sc)};
    }
  }
};

__device__ __forceinline__ void convert_tile(const float* __restrict__ src, int K, int N, u16* __restrict__ dst, int tile,
                                             bool swiglu, char* smem) {
  float* t = (float*)smem;
  const int tid = get_tid();
  const int nN = N / 64, nt = tile % nN, kt = tile / nN, k0 = kt * 64, n0 = nt * 64;
  __syncthreads();
#pragma unroll
  for (int i = 0; i < 4; ++i) {
    int k = (tid >> 4) + 16 * i, n4 = (tid & 15) * 4;
    float4 v = *(const float4*)(src + (size_t)(k0 + k) * N + n0 + n4);
    t[k * 65 + n4] = v.x; t[k * 65 + n4 + 1] = v.y; t[k * 65 + n4 + 2] = v.z; t[k * 65 + n4 + 3] = v.w;
  }
  __syncthreads();
#pragma unroll
  for (int i = 0; i < 2; ++i) {
    int q = tid + i * 256, n = q >> 3, kc = (q & 7) * 8;
    int c = n0 + n, nr = c;
    if (swiglu) nr = (c < FH) ? (32 * (c >> 4) + (c & 15)) : (32 * ((c - FH) >> 4) + 16 + ((c - FH) & 15));
    uint4 o = {pk2(t[kc * 65 + n], t[(kc + 1) * 65 + n]), pk2(t[(kc + 2) * 65 + n], t[(kc + 3) * 65 + n]),
               pk2(t[(kc + 4) * 65 + n], t[(kc + 5) * 65 + n]), pk2(t[(kc + 6) * 65 + n], t[(kc + 7) * 65 + n])};
    *(uint4*)(dst + (size_t)nr * K + k0 + kc) = o;
  }
}

__device__ void phase_prep(const P& p, char* smem) {
  const int tid = get_tid();
  constexpr int N_ADA = 1152, N_TR = 4 * 5248 + 32;
  for (int item = blockIdx.x; item < N_ADA + N_TR + 1; item += gridDim.x) {
    if (item < N_ADA) {
      float* act = (float*)smem;
      float* red = (float*)(smem + 20480);
      const int l = item / 288, cb = (item % 288) * 32;
      __syncthreads();
      for (int i = tid; i < 5120; i += 256) {
        int r = i >> 10, k = i & 1023;
        float v = r < 4 ? p.c[r * 1024 + k] : p.c_ctx[k];
        act[i] = silu(v);
      }
      __syncthreads();
      const int tx = tid & 31, kg = tid >> 5;
      float a0 = 0, a1 = 0, a2 = 0, a3 = 0, a4 = 0;
      const float* w = p.w_ada + ((size_t)l * 1024 + kg * 128) * 9216 + cb + tx;
      for (int k0 = 0; k0 < 128; k0 += 16) {
        float wv[16];
#pragma unroll
        for (int k = 0; k < 16; ++k) wv[k] = w[(size_t)(k0 + k) * 9216];
#pragma unroll
        for (int k = 0; k < 16; ++k) {
          int kk = kg * 128 + k0 + k;
          a0 += act[kk] * wv[k]; a1 += act[1024 + kk] * wv[k]; a2 += act[2048 + kk] * wv[k]; a3 += act[3072 + kk] * wv[k];
          a4 += act[4096 + kk] * wv[k];
        }
      }
      red[(kg * 5 + 0) * 32 + tx] = a0; red[(kg * 5 + 1) * 32 + tx] = a1; red[(kg * 5 + 2) * 32 + tx] = a2;
      red[(kg * 5 + 3) * 32 + tx] = a3; red[(kg * 5 + 4) * 32 + tx] = a4;
      __syncthreads();
      if (tid < 160) {
        int r = tid >> 5, x = tid & 31;
        float sacc = 0.f;
#pragma unroll
        for (int g8 = 0; g8 < 8; ++g8) sacc += red[(g8 * 5 + r) * 32 + x];
        ((float*)(p.ws + OFF_MODS))[(size_t)(l * 5 + r) * 9216 + cb + x] = sacc + p.b_ada[l * 9216 + cb + x];
      }
    } else if (item < N_ADA + N_TR) {
      int idx = item - N_ADA;
      if (idx < 4 * 5248) {
        int l = idx / 5248, r = idx % 5248;
        if (r < 2816) {
          int f = r / 1408, tile = r % 1408;
          convert_tile(p.w_ffn_in + (size_t)(l * 2 + f) * 1024 * 5632, 1024, 5632,
                       (u16*)(p.ws + OFF_WFI) + (size_t)(l * 2 + f) * 5632 * 1024, tile, true, smem);
        } else if (r < 4224) {
          int f = (r - 2816) / 704, tile = (r - 2816) % 704;
          convert_tile(p.w_ffn_out + (size_t)(l * 2 + f) * 2816 * 1024, 2816, 1024,
                       (u16*)(p.ws + OFF_WFO) + (size_t)(l * 2 + f) * 1024 * 2816, tile, false, smem);
        } else if (r < 4992) {
          const float* src = (l & 1) ? p.w_in_odd + (size_t)(l >> 1) * 1024 * 3072 : p.w_in_even + (size_t)(l >> 1) * 1024 * 3072;
          convert_tile(src, 1024, 3072, (u16*)(p.ws + OFF_WMI) + (size_t)l * 3072 * 1024, r - 4224, false, smem);
        } else {
          const float* src = (l & 1) ? p.w_out_odd + (size_t)(l >> 1) * 1024 * 1024 : p.w_out_even + (size_t)(l >> 1) * 1024 * 1024;
          convert_tile(src, 1024, 1024, (u16*)(p.ws + OFF_WMO) + (size_t)l * 1024 * 1024, r - 4992, false, smem);
        }
      } else {
        int i2 = idx - 4 * 5248, eg = i2 >> 2, tile = i2 & 3;
        convert_tile(p.pool_w + (size_t)eg * 128 * 128, 128, 128, (u16*)(p.ws + OFF_WPL) + (size_t)eg * 128 * 128, tile, false, smem);
      }
    } else {
      float* LB = (float*)(p.ws + OFF_LB);
      for (int i = tid; i < 1024; i += 256) {
        float a0 = p.hg_lb[i], a1 = p.hg_lb[1024 + i];
        float mx = fmaxf(a0, a1), e0 = __expf(a0 - mx), e1 = __expf(a1 - mx);
        LB[i] = 0.f;
        LB[1024 + i] = e1 / (e0 + e1);
      }
      if (tid < 2) {
        const float* lv = p.da_lambda + tid * 256;
        float s0 = 0, s1 = 0;
        for (int i = 0; i < 64; ++i) { s0 += lv[i] * lv[64 + i]; s1 += lv[128 + i] * lv[192 + i]; }
        float li = 0.8f - 0.6f * expf(-0.3f * (float)(2 * tid + 1));
        ((float*)(p.ws + OFF_LAM))[tid] = expf(s0) - expf(s1) + li;
      }
      float* rope = (float*)(p.ws + OFF_ROPE);
      for (int i = tid; i < 1024; i += 256) {
        int pos = i >> 4, fi = i & 15;
        float inv = exp2f(-(float)fi * (13.287712379549449f / 16.f));
        float ang = (float)pos * inv;
        float k = rintf(ang * 0.15915494309189535f);
        float r = fmaf(-k, 6.28125f, ang);
        r = fmaf(-k, 1.9353071795864769e-3f, r);
        rope[i * 2] = cosf(r);
        rope[i * 2 + 1] = sinf(r);
      }
    }
  }
}

__device__ void phase_rows(const P& p, int mode, int l, int sub, int M, bool final_out) {
  const int tid = get_tid(), lane = tid & 63, wid = tid >> 6;
  float* X = (float*)(p.ws + OFF_X);
  const u16* Y = (const u16*)(p.ws + OFF_Y);
  u16* H = (u16*)(p.ws + OFF_H);
  const float* MODS = (const float*)(p.ws + OFF_MODS);
  int nl, si;
  if (mode == 0) { nl = 0; si = 0; }
  else if (sub == 0) { nl = l; si = 3; }
  else if (sub == 1) { nl = l; si = 6; }
  else { nl = l + 1; si = 0; }
  const float gs = (sub == 1) ? 1.f : 0.5f;
  const float* lg = p.ln_g + (size_t)(l * 3 + sub) * D;
  const float* lbp = p.ln_b + (size_t)(l * 3 + sub) * D;
  for (int row0 = (blockIdx.x * 4 + wid) * 2; row0 < M; row0 += gridDim.x * 8) {
    const int mr = mod_row(row0);
    const bool ksplit = (mode == 1) && (sub != 1) && (row0 >= ML);
    float v[2][16];
    if (mode == 0) {
#pragma unroll
      for (int r = 0; r < 2; ++r) {
        const int row = row0 + r;
        const float* src = row < ML ? p.x + (size_t)row * D : p.ctx + (size_t)(row - ML) * D;
#pragma unroll
        for (int i = 0; i < 4; ++i) {
          float4 t = *(const float4*)(src + i * 256 + lane * 4);
          v[r][i * 4] = t.x; v[r][i * 4 + 1] = t.y; v[r][i * 4 + 2] = t.z; v[r][i * 4 + 3] = t.w;
        }
      }
    } else {
      const float* gate = MODS + (size_t)(l * 5 + mr) * 9216 + (2 + 3 * sub) * 1024;
      float4 xv[2][4]; uint2 yv[2][4]; float4 gv[4];
#pragma unroll
      for (int r = 0; r < 2; ++r)
#pragma unroll
        for (int i = 0; i < 4; ++i) {
          int c = i * 256 + lane * 4;
          xv[r][i] = *(const float4*)(X + (size_t)(row0 + r) * D + c);
          if (!ksplit) yv[r][i] = *(const uint2*)(Y + (size_t)(row0 + r) * D + c);
        }
      float ysum[2][16];
      if (ksplit) {
        const u16* YC = (const u16*)(p.ws + OFF_YC);
#pragma unroll
        for (int r = 0; r < 2; ++r)
#pragma unroll
          for (int i = 0; i < 4; ++i) {
            int c = i * 256 + lane * 4;
            uint2 t0 = *(const uint2*)(YC + ((size_t)0 * MC + row0 + r - ML) * D + c), t1 = *(const uint2*)(YC + ((size_t)1 * MC + row0 + r - ML) * D + c);
            uint2 t2 = *(const uint2*)(YC + ((size_t)2 * MC + row0 + r - ML) * D + c), t3 = *(const uint2*)(YC + ((size_t)3 * MC + row0 + r - ML) * D + c);
            ysum[r][i * 4] = __uint_as_float(t0.x << 16) + __uint_as_float(t1.x << 16) + __uint_as_float(t2.x << 16) + __uint_as_float(t3.x << 16);
            ysum[r][i * 4 + 1] = __uint_as_float(t0.x & 0xffff0000u) + __uint_as_float(t1.x & 0xffff0000u) + __uint_as_float(t2.x & 0xffff0000u) + __uint_as_float(t3.x & 0xffff0000u);
            ysum[r][i * 4 + 2] = __uint_as_float(t0.y << 16) + __uint_as_float(t1.y << 16) + __uint_as_float(t2.y << 16) + __uint_as_float(t3.y << 16);
            ysum[r][i * 4 + 3] = __uint_as_float(t0.y & 0xffff0000u) + __uint_as_float(t1.y & 0xffff0000u) + __uint_as_float(t2.y & 0xffff0000u) + __uint_as_float(t3.y & 0xffff0000u);
          }
      }
#pragma unroll
      for (int i = 0; i < 4; ++i) gv[i] = *(const float4*)(gate + i * 256 + lane * 4);
      float s[2] = {0.f, 0.f};
#pragma unroll
      for (int r = 0; r < 2; ++r)
#pragma unroll
        for (int i = 0; i < 4; ++i) {
          float y0, y1, y2, y3;
          if (ksplit) { y0 = ysum[r][i * 4]; y1 = ysum[r][i * 4 + 1]; y2 = ysum[r][i * 4 + 2]; y3 = ysum[r][i * 4 + 3]; }
          else {
            y0 = bf2f((u16)(yv[r][i].x & 0xffff)); y1 = bf2f((u16)(yv[r][i].x >> 16));
            y2 = bf2f((u16)(yv[r][i].y & 0xffff)); y3 = bf2f((u16)(yv[r][i].y >> 16));
          }
          v[r][i * 4] = ALPHA * xv[r][i].x + gs * gv[i].x * y0; v[r][i * 4 + 1] = ALPHA * xv[r][i].y + gs * gv[i].y * y1;
          v[r][i * 4 + 2] = ALPHA * xv[r][i].z + gs * gv[i].z * y2; v[r][i * 4 + 3] = ALPHA * xv[r][i].w + gs * gv[i].w * y3;
          s[r] += v[r][i * 4] + v[r][i * 4 + 1] + v[r][i * 4 + 2] + v[r][i * 4 + 3];
        }
#pragma unroll
      for (int o = 1; o < 64; o <<= 1) { s[0] = xor_sum(s[0], o); s[1] = xor_sum(s[1], o); }
      float q[2] = {0.f, 0.f};
#pragma unroll
      for (int r = 0; r < 2; ++r) {
        const float mu = s[r] * (1.f / 1024.f);
#pragma unroll
        for (int i = 0; i < 16; ++i) { v[r][i] -= mu; q[r] += v[r][i] * v[r][i]; }
      }
#pragma unroll
      for (int o = 1; o < 64; o <<= 1) { q[0] = xor_sum(q[0], o); q[1] = xor_sum(q[1], o); }
#pragma unroll
      for (int i = 0; i < 4; ++i) {
        int c = i * 256 + lane * 4;
        float4 g4 = *(const float4*)(lg + c), b4 = *(const float4*)(lbp + c);
#pragma unroll
        for (int r = 0; r < 2; ++r) {
          const float rstd = rsqrtf(q[r] * (1.f / 1024.f) + 1e-5f);
          v[r][i * 4] = v[r][i * 4] * rstd * g4.x + b4.x; v[r][i * 4 + 1] = v[r][i * 4 + 1] * rstd * g4.y + b4.y;
          v[r][i * 4 + 2] = v[r][i * 4 + 2] * rstd * g4.z + b4.z; v[r][i * 4 + 3] = v[r][i * 4 + 3] * rstd * g4.w + b4.w;
        }
      }
    }
    if (final_out) {
#pragma unroll
      for (int r = 0; r < 2; ++r)
#pragma unroll
        for (int i = 0; i < 4; ++i)
          *(float4*)(p.out + (size_t)(row0 + r) * D + i * 256 + lane * 4) =
              float4{v[r][i * 4], v[r][i * 4 + 1], v[r][i * 4 + 2], v[r][i * 4 + 3]};
      continue;
    }
    const float* sh = MODS + (size_t)(nl * 5 + mr) * 9216 + si * 1024;
#pragma unroll
    for (int i = 0; i < 4; ++i) {
      int c = i * 256 + lane * 4;
      float4 s4 = *(const float4*)(sh + c), c4 = *(const float4*)(sh + 1024 + c);
#pragma unroll
      for (int r = 0; r < 2; ++r) {
        *(float4*)(X + (size_t)(row0 + r) * D + c) = float4{v[r][i * 4], v[r][i * 4 + 1], v[r][i * 4 + 2], v[r][i * 4 + 3]};
        uint2 hv = {pk2(v[r][i * 4] * (1.f + c4.x) + s4.x, v[r][i * 4 + 1] * (1.f + c4.y) + s4.y),
                    pk2(v[r][i * 4 + 2] * (1.f + c4.z) + s4.z, v[r][i * 4 + 3] * (1.f + c4.w) + s4.w)};
        *(uint2*)(H + (size_t)(row0 + r) * D + c) = hv;
      }
    }
  }
}

__device__ void phase_attn(const P& p, int l, char* smem) {
  const int tid = get_tid(), lane = tid & 63, w = tid >> 6, fr = lane & 15, fq = lane >> 4;
  const u16* PROJ = (const u16*)(p.ws + OFF_PROJ);
  const u16* VT = (const u16*)(p.ws + OFF_VT);
  u16* MIX = (u16*)(p.ws + OFF_MIX);
  const float lam = ((const float*)(p.ws + OFF_LAM))[l >> 1];
  const float lam_init = 0.8f - 0.6f * expf(-0.3f * (float)l);
  const float* subw = p.da_sub_w + (l >> 1) * 128;
  const int xcd = blockIdx.x & 7, slot = blockIdx.x >> 3, nslot = gridDim.x >> 3;
  const int n_virt = (l == 3) ? 256 : 272;
  for (int idx = slot; idx < n_virt; idx += nslot) {
    int b, h, qrow0, nkt;
    if (idx < 256) {
      const int bh = (idx >> 6) * 8 + xcd;
      b = bh >> 3; h = bh & 7; qrow0 = b * 4096 + (idx & 63) * 64; nkt = 68;
    } else {
      const int cs = idx - 256, bh = (cs >> 2) * 8 + xcd;
      b = bh >> 3; h = bh & 7; qrow0 = ML + b * 256 + (cs & 3) * 64; nkt = 4;
    }
    bf16x8 qf[2][2];
    {
      const u16* qp = PROJ + (size_t)(qrow0 + w * 16 + fr) * 3072 + h * 128 + fq * 8;
#pragma unroll
      for (int m = 0; m < 2; ++m)
#pragma unroll
        for (int ks = 0; ks < 2; ++ks) qf[m][ks] = *(const bf16x8*)(qp + m * 64 + ks * 32);
    }
    f32x4 O[2][8];
#pragma unroll
    for (int m = 0; m < 2; ++m)
#pragma unroll
      for (int v = 0; v < 8; ++v) O[m][v] = f32x4{0.f, 0.f, 0.f, 0.f};
    float mrun[2] = {-1e30f, -1e30f}, lsum[2] = {0.f, 0.f};
    const u16* vbase = VT + (size_t)((b * 8 + h) * 128) * TK;
    auto stage = [&](int kt, char* buf) {
      const int krow0 = kt < 4 ? ML + b * 256 + kt * 64 : b * 4096 + (kt - 4) * 64;
#pragma unroll
      for (int i = 0; i < 4; ++i) {
        int q = tid + i * 256;
        int key = q >> 4, ch = (q & 15) ^ (key & 15);
        glds16(PROJ + (size_t)(krow0 + key) * 3072 + 1024 + h * 128 + ch * 8, buf + q * 16);
        int dv = q >> 3, c2 = (q & 7) ^ ((dv >> 1) & 7);
        glds16(vbase + (size_t)dv * TK + kt * 64 + c2 * 8, buf + 16384 + q * 16);
      }
    };
    __syncthreads();
    stage(0, smem);
    for (int kt = 0; kt < nkt; ++kt) {
      __syncthreads();
      char* cur = smem + (kt & 1) * 32768;
      if (kt + 1 < nkt) stage(kt + 1, smem + ((kt + 1) & 1) * 32768);
      bf16x8 pb[2][2];
      f32x4 s[2][4];
      {
        bf16x8 kf[4][2][2];
#pragma unroll
        for (int sf = 0; sf < 4; ++sf)
#pragma unroll
          for (int m = 0; m < 2; ++m)
#pragma unroll
            for (int ks = 0; ks < 2; ++ks) kf[sf][m][ks] = *(const bf16x8*)(cur + swz256(sf * 16 + fr, m * 8 + ks * 4 + fq));
        __builtin_amdgcn_sched_barrier(0);
#pragma unroll
        for (int sf = 0; sf < 4; ++sf) {
          s[0][sf] = f32x4{0.f, 0.f, 0.f, 0.f};
          s[1][sf] = f32x4{0.f, 0.f, 0.f, 0.f};
#pragma unroll
          for (int m = 0; m < 2; ++m)
#pragma unroll
            for (int ks = 0; ks < 2; ++ks) s[m][sf] = mfma16(kf[sf][m][ks], qf[m][ks], s[m][sf]);
        }
      }
      float tm0 = -1e30f, tm1 = -1e30f;
#pragma unroll
      for (int sf = 0; sf < 4; ++sf)
#pragma unroll
        for (int j = 0; j < 4; ++j) { tm0 = fmaxf(tm0, s[0][sf][j]); tm1 = fmaxf(tm1, s[1][sf][j]); }
      if (__any(fmaxf(tm0 - mrun[0], tm1 - mrun[1]) > 6.f)) {
        tm0 = xor_max(tm0, 16); tm1 = xor_max(tm1, 16);
        tm0 = xor_max(tm0, 32); tm1 = xor_max(tm1, 32);
        const float mn0 = fmaxf(mrun[0], tm0), sc0 = ex2(mrun[0] - mn0);
        const float mn1 = fmaxf(mrun[1], tm1), sc1 = ex2(mrun[1] - mn1);
        mrun[0] = mn0; mrun[1] = mn1;
        lsum[0] *= sc0; lsum[1] *= sc1;
#pragma unroll
        for (int v = 0; v < 8; ++v) { O[0][v] *= sc0; O[1][v] *= sc1; }
      }
#pragma unroll
      for (int m = 0; m < 2; ++m) {
        const float mn = mrun[m];
        float ps = 0.f;
#pragma unroll
        for (int sf = 0; sf < 4; ++sf)
#pragma unroll
          for (int j = 0; j < 4; ++j) { s[m][sf][j] = ex2(s[m][sf][j] - mn); ps += s[m][sf][j]; }
        lsum[m] += ps;
#pragma unroll
        for (int k2 = 0; k2 < 2; ++k2) {
          union { bf16x8 v; unsigned u[4]; } t;
          t.u[0] = pk2(s[m][2 * k2][0], s[m][2 * k2][1]); t.u[1] = pk2(s[m][2 * k2][2], s[m][2 * k2][3]);
          t.u[2] = pk2(s[m][2 * k2 + 1][0], s[m][2 * k2 + 1][1]); t.u[3] = pk2(s[m][2 * k2 + 1][2], s[m][2 * k2 + 1][3]);
          pb[m][k2] = t.v;
        }
      }
#pragma unroll
      for (int vb = 0; vb < 8; vb += 4) {
        union { bf16x8 v; uint2 u[2]; } a0[4], a1[4];
#pragma unroll
        for (int i = 0; i < 4; ++i) {
          const int dv = (vb + i) * 16 + fr;
          a0[i].u[0] = *(const uint2*)(cur + 16384 + swz128(dv, (fq >> 1)) + (fq & 1) * 8);
          a0[i].u[1] = *(const uint2*)(cur + 16384 + swz128(dv, 2 + (fq >> 1)) + (fq & 1) * 8);
          a1[i].u[0] = *(const uint2*)(cur + 16384 + swz128(dv, 4 + (fq >> 1)) + (fq & 1) * 8);
          a1[i].u[1] = *(const uint2*)(cur + 16384 + swz128(dv, 6 + (fq >> 1)) + (fq & 1) * 8);
        }
        __builtin_amdgcn_sched_barrier(0);
        __builtin_amdgcn_s_setprio(1);
#pragma unroll
        for (int i = 0; i < 4; ++i) {
          O[0][vb + i] = mfma16(a0[i].v, pb[0][0], O[0][vb + i]);
          O[1][vb + i] = mfma16(a0[i].v, pb[1][0], O[1][vb + i]);
          O[0][vb + i] = mfma16(a1[i].v, pb[0][1], O[0][vb + i]);
          O[1][vb + i] = mfma16(a1[i].v, pb[1][1], O[1][vb + i]);
        }
        __builtin_amdgcn_s_setprio(0);
        __builtin_amdgcn_sched_barrier(0);
      }
    }
    float l0 = xor_sum(xor_sum(lsum[0], 16), 32), l1 = xor_sum(xor_sum(lsum[1], 16), 32);
    const float i0 = 1.f / l0, i1 = lam / l1;
    float ssq = 0.f;
#pragma unroll
    for (int v = 0; v < 8; ++v)
#pragma unroll
      for (int j = 0; j < 4; ++j) { float o = O[0][v][j] * i0 - O[1][v][j] * i1; O[0][v][j] = o; ssq += o * o; }
    ssq = xor_sum(xor_sum(ssq, 16), 32);
    const float rs = rsqrtf(ssq * (1.f / 128.f) + 1e-6f) * (1.f - lam_init);
    u16* op = MIX + (size_t)(qrow0 + w * 16 + fr) * D + h * 128;
#pragma unroll
    for (int v = 0; v < 8; ++v) {
      int dv = v * 16 + fq * 4;
      float4 sw = *(const float4*)(subw + dv);
      uint2 o = {pk2(O[0][v][0] * rs * sw.x, O[0][v][1] * rs * sw.y), pk2(O[0][v][2] * rs * sw.z, O[0][v][3] * rs * sw.w)};
      *(uint2*)(op + dv) = o;
    }
  }
}

__device__ __forceinline__ void chunk_rows(int b, int cc_seq, int& row0, int& pos0) {
  if (cc_seq < 4) { row0 = ML + b * 256 + cc_seq * 64; pos0 = cc_seq * 64; }
  else { row0 = b * 4096 + (cc_seq - 4) * 64; pos0 = CTX + (cc_seq - 4) * 64; }
}
__device__ __forceinline__ int scan2tok(int c, int dir) {
  if (!dir) return c;
  return c < 4 ? 3 - c : 4 + 63 - (c - 4);
}

__device__ void hg_u_item(const P& p, int e, int item, char* smem) {
  const int tid = get_tid(), lane = tid & 63, wid = tid >> 6, wr = wid >> 1, wc = wid & 1, fr = lane & 15, fq = lane >> 4;
  const u16* PROJ = (const u16*)(p.ws + OFF_PROJ);
  const u16* IT = (const u16*)(p.ws + OFF_VT);
  float* U = (float*)(p.ws + OFF_U);
  float* DEC = (float*)(p.ws + OFF_DEC);
  const float* LB = (const float*)(p.ws + OFF_LB);
  const int c = item % NCH, seq = item / NCH, dir = seq & 1, h = (seq >> 1) & 3, b = seq >> 3;
  int row0, pos0;
  chunk_rows(b, scan2tok(c, dir), row0, pos0);
  float* tot = (float*)(smem + 16384);
  const int d = tid & 127, half = tid >> 7;
  const float lb = LB[(e * 2 + dir) * 512 + h * 128 + d];
  const u16* zp = PROJ + (size_t)row0 * 3072 + 1536 + dir * 512 + h * 128 + d;
  __syncthreads();
  float sum = 0.f;
#pragma unroll 8
  for (int i = 0; i < 32; ++i) {
    int tau = half * 32 + i, t = dir ? 63 - tau : tau;
    float f = lb + (1.f - lb) * sigm(bf2f(zp[(size_t)t * 3072]));
    sum += __logf(fmaxf(f, 1e-20f));
  }
  tot[half * 128 + d] = sum;
  __syncthreads();
  float rel = half ? 0.f : tot[128 + d];
#pragma unroll 8
  for (int i = 31; i >= 0; --i) {
    int tau = half * 32 + i, t = dir ? 63 - tau : tau;
    float f = lb + (1.f - lb) * sigm(bf2f(zp[(size_t)t * 3072]));
    float lf = __logf(fmaxf(f, 1e-20f));
    *(u16*)(smem + swz128(d, t >> 3) + (t & 7) * 2) = f2bf((1.f - f) * __expf(rel));
    rel += lf;
  }
  if (!half) DEC[(size_t)(seq * NCH + c) * 128 + d] = __expf(rel);
  __syncthreads();
  f32x4 acc[4][4];
#pragma unroll
  for (int m = 0; m < 4; ++m)
#pragma unroll
    for (int n = 0; n < 4; ++n) acc[m][n] = f32x4{0.f, 0.f, 0.f, 0.f};
  const u16* vb = IT + (size_t)((b * 4 + h) * 128) * TK + pos0;
#pragma unroll
  for (int ks = 0; ks < 2; ++ks) {
    bf16x8 a[4], bb[4];
#pragma unroll
    for (int m = 0; m < 4; ++m) a[m] = *(const bf16x8*)(vb + (size_t)(wr * 64 + m * 16 + fr) * TK + ks * 32 + fq * 8);
#pragma unroll
    for (int n = 0; n < 4; ++n) bb[n] = *(const bf16x8*)(smem + swz128(wc * 64 + n * 16 + fr, ks * 4 + fq));
#pragma unroll
    for (int m = 0; m < 4; ++m)
#pragma unroll
      for (int n = 0; n < 4; ++n) acc[m][n] = mfma16(a[m], bb[n], acc[m][n]);
  }
  float* up = U + (size_t)(seq * NCH + c) * 16384;
#pragma unroll
  for (int m = 0; m < 4; ++m)
#pragma unroll
    for (int n = 0; n < 4; ++n)
#pragma unroll
      for (int j = 0; j < 4; ++j) up[(wr * 64 + m * 16 + fq * 4 + j) * 128 + wc * 64 + n * 16 + fr] = acc[m][n][j];
}

__device__ void pool_item(const P& p, int item) {
  const int tid = get_tid();
  const u16* PROJ = (const u16*)(p.ws + OFF_PROJ);
  u16* PO = (u16*)(p.ws + OFF_POOLED);
  const int ch = tid * 2, g = ch >> 7, hw = 1 << g;
  const int row0 = item * 32;
  int base, n, pos0;
  if (row0 < ML) { base = row0 & ~4095; n = 4096; pos0 = row0 & 4095; }
  else { base = ML + ((row0 - ML) & ~255); n = 256; pos0 = (row0 - ML) & 255; }
  const u16* up = PROJ + (size_t)base * 3072 + 2560 + ch;
  float s0 = 0.f, s1 = 0.f;
  {
    const int lo = max(pos0 - hw, 0), hi = min(pos0 + hw, n);
    for (int r = lo; r < hi; ++r) {
      unsigned v = *(const unsigned*)(up + (size_t)r * 3072);
      s0 += __uint_as_float(v << 16); s1 += __uint_as_float(v & 0xffff0000u);
    }
  }
  for (int i0 = 0; i0 < 32; i0 += 16) {
    unsigned ce[16], en[16], le[16];
#pragma unroll
    for (int i = 0; i < 16; ++i) {
      const int pos = pos0 + i0 + i;
      ce[i] = *(const unsigned*)(up + (size_t)pos * 3072);
      en[i] = (pos + hw < n) ? *(const unsigned*)(up + (size_t)(pos + hw) * 3072) : 0u;
      le[i] = (pos - hw >= 0) ? *(const unsigned*)(up + (size_t)(pos - hw) * 3072) : 0u;
    }
#pragma unroll
    for (int i = 0; i < 16; ++i) {
      const int pos = pos0 + i0 + i;
      const int lo = max(pos - hw, 0), hi = min(pos + hw, n);
      const float ic = 1.f / (float)(hi - lo);
      *(unsigned*)(PO + (size_t)(base + pos) * 512 + ch) =
          pk2(s0 * ic - __uint_as_float(ce[i] << 16), s1 * ic - __uint_as_float(ce[i] & 0xffff0000u));
      s0 += __uint_as_float(en[i] << 16) - __uint_as_float(le[i] << 16);
      s1 += __uint_as_float(en[i] & 0xffff0000u) - __uint_as_float(le[i] & 0xffff0000u);
    }
  }
}

__device__ void hg_scan_item(const P& p, int item) {
  float* U = (float*)(p.ws + OFF_U);
  const float* DEC = (const float*)(p.ws + OFF_DEC);
  const int ei = item * 256 + get_tid(), seq = ei >> 14, vd = ei & 16383, d = vd & 127;
  float* up = U + (size_t)seq * NCH * 16384 + vd;
  const float* dp = DEC + (size_t)seq * NCH * 128 + d;
  float s = 0.f;
  for (int c0 = 0; c0 < NCH; c0 += 17) {
    float u[17], dd[17];
#pragma unroll
    for (int i = 0; i < 17; ++i) { u[i] = up[(size_t)(c0 + i) * 16384]; dd[i] = dp[(c0 + i) * 128]; }
#pragma unroll
    for (int i = 0; i < 17; ++i) { up[(size_t)(c0 + i) * 16384] = s; s = dd[i] * s + u[i]; }
  }
}

__device__ void hg_o_item(const P& p, int e, int item, char* smem) {
  const int tid = get_tid(), lane = tid & 63, w = tid >> 6, fr = lane & 15, fq = lane >> 4;
  const u16* PROJ = (const u16*)(p.ws + OFF_PROJ);
  const u16* IT = (const u16*)(p.ws + OFF_VT);
  const float* S = (const float*)(p.ws + OFF_U);
  const float* LB = (const float*)(p.ws + OFF_LB);
  u16* MIX = (u16*)(p.ws + OFF_MIX);
  const int tc = item % NCH, bh = item / NCH, h = bh & 3, b = bh >> 2;
  int row0, pos0;
  chunk_rows(b, tc, row0, pos0);
  char* qh = smem;
  char* kh = smem + 16384;
  char* vt = smem + 32768;
  float* eref = (float*)(smem + 49152);
  __syncthreads();
  {
    const u16* vb = IT + (size_t)((b * 4 + h) * 128) * TK + pos0;
#pragma unroll
    for (int i = 0; i < 4; ++i) {
      int q = tid + i * 256, dv = q >> 3, c2 = (q & 7) ^ ((dv >> 1) & 7);
      glds16(vb + (size_t)dv * TK + c2 * 8, vt + q * 16);
    }
  }
  f32x4 O[8];
#pragma unroll
  for (int v = 0; v < 8; ++v) O[v] = f32x4{0.f, 0.f, 0.f, 0.f};
  const int d = tid & 127, half = tid >> 7;
  for (int dir = 0; dir < 2; ++dir) {
    const int c = dir ? (tc < 4 ? 3 - tc : 4 + 63 - (tc - 4)) : tc;
    const int seq = (b * 4 + h) * 2 + dir;
    const float lb = LB[(e * 2 + dir) * 512 + h * 128 + d];
    const u16* zp = PROJ + (size_t)row0 * 3072 + 1536 + dir * 512 + h * 128 + d;
    const u16* qp = PROJ + (size_t)row0 * 3072 + h * 128 + d;
    if (dir) __syncthreads();
    float rel = 0.f;
    if (!half) {
#pragma unroll 8
      for (int tau = 31; tau >= 0; --tau) {
        int t = dir ? 63 - tau : tau;
        float f = lb + (1.f - lb) * sigm(bf2f(zp[(size_t)t * 3072]));
        float lf = __logf(fmaxf(f, 1e-20f));
        float q = bf2f(qp[(size_t)t * 3072]);
        int off = swz256(t, d >> 3) + (d & 7) * 2;
        *(u16*)(qh + off) = f2bf(q * __expf(rel));
        *(u16*)(kh + off) = f2bf((1.f - f) * __expf(-rel));
        rel -= lf;
      }
      eref[d] = __expf(-rel);
    } else {
#pragma unroll 8
      for (int tau = 32; tau < 64; ++tau) {
        int t = dir ? 63 - tau : tau;
        float f = lb + (1.f - lb) * sigm(bf2f(zp[(size_t)t * 3072]));
        float lf = __logf(fmaxf(f, 1e-20f));
        float q = bf2f(qp[(size_t)t * 3072]);
        rel += lf;
        int off = swz256(t, d >> 3) + (d & 7) * 2;
        *(u16*)(qh + off) = f2bf(q * __expf(rel));
        *(u16*)(kh + off) = f2bf((1.f - f) * __expf(-rel));
      }
    }
    __syncthreads();
    bf16x8 qf[4];
#pragma unroll
    for (int ks = 0; ks < 4; ++ks) qf[ks] = *(const bf16x8*)(qh + swz256(w * 16 + fr, ks * 4 + fq));
    f32x4 s[4];
#pragma unroll
    for (int sf = 0; sf < 4; ++sf) {
      s[sf] = f32x4{0.f, 0.f, 0.f, 0.f};
#pragma unroll
      for (int ks = 0; ks < 4; ++ks) {
        bf16x8 a = *(const bf16x8*)(kh + swz256(sf * 16 + fr, ks * 4 + fq));
        s[sf] = mfma16(a, qf[ks], s[sf]);
      }
    }
    const int tq = w * 16 + fr;
#pragma unroll
    for (int sf = 0; sf < 4; ++sf)
#pragma unroll
      for (int j = 0; j < 4; ++j) {
        int ss = sf * 16 + fq * 4 + j;
        bool keep = dir ? (ss >= tq) : (ss <= tq);
        s[sf][j] = keep ? s[sf][j] : 0.f;
      }
    bf16x8 pb[2];
#pragma unroll
    for (int k2 = 0; k2 < 2; ++k2) {
      union { bf16x8 v; unsigned u[4]; } t;
      t.u[0] = pk2(s[2 * k2][0], s[2 * k2][1]); t.u[1] = pk2(s[2 * k2][2], s[2 * k2][3]);
      t.u[2] = pk2(s[2 * k2 + 1][0], s[2 * k2 + 1][1]); t.u[3] = pk2(s[2 * k2 + 1][2], s[2 * k2 + 1][3]);
      pb[k2] = t.v;
    }
#pragma unroll
    for (int v = 0; v < 8; ++v)
#pragma unroll
      for (int k2 = 0; k2 < 2; ++k2) {
        const int dv = v * 16 + fr;
        union { bf16x8 v; uint2 u[2]; } a;
        a.u[0] = *(const uint2*)(vt + swz128(dv, k2 * 4 + (fq >> 1)) + (fq & 1) * 8);
        a.u[1] = *(const uint2*)(vt + swz128(dv, k2 * 4 + 2 + (fq >> 1)) + (fq & 1) * 8);
        O[v] = mfma16(a.v, pb[k2], O[v]);
      }
    const float* sp = S + (size_t)(seq * NCH + c) * 16384;
#pragma unroll
    for (int ks = 0; ks < 4; ++ks) {
      union { bf16x8 v; u16 h[8]; unsigned u[4]; } qq, qs;
      qq.v = qf[ks];
      const float* er = eref + ks * 32 + fq * 8;
#pragma unroll
      for (int i = 0; i < 4; ++i) qs.u[i] = pk2(bf2f(qq.h[2 * i]) * er[2 * i], bf2f(qq.h[2 * i + 1]) * er[2 * i + 1]);
#pragma unroll
      for (int v = 0; v < 8; ++v) {
        const float* g = sp + (v * 16 + fr) * 128 + ks * 32 + fq * 8;
        float4 x0 = *(const float4*)g, x1 = *(const float4*)(g + 4);
        union { bf16x8 v; unsigned u[4]; } a;
        a.u[0] = pk2(x0.x, x0.y); a.u[1] = pk2(x0.z, x0.w); a.u[2] = pk2(x1.x, x1.y); a.u[3] = pk2(x1.z, x1.w);
        O[v] = mfma16(a.v, qs.v, O[v]);
      }
    }
  }
  float ssq = 0.f;
#pragma unroll
  for (int v = 0; v < 8; ++v)
#pragma unroll
    for (int j = 0; j < 4; ++j) ssq += O[v][j] * O[v][j];
  ssq = xor_sum(xor_sum(ssq, 16), 32);
  const float rs = rsqrtf(ssq * (1.f / 128.f) + 1e-6f);
  const int row = row0 + w * 16 + fr;
  const float* nw = p.hg_norm_w + e * 128;
#pragma unroll
  for (int v = 0; v < 8; ++v) {
    int dv = v * 16 + fq * 4;
    uint2 gv = *(const uint2*)(PROJ + (size_t)row * 3072 + 1024 + h * 128 + dv);
    float4 n4 = *(const float4*)(nw + dv);
    float g0 = bf2f((u16)(gv.x & 0xffff)), g1 = bf2f((u16)(gv.x >> 16)), g2 = bf2f((u16)(gv.y & 0xffff)), g3 = bf2f((u16)(gv.y >> 16));
    uint2 o = {pk2(O[v][0] * rs * n4.x * silu(g0), O[v][1] * rs * n4.y * silu(g1)),
               pk2(O[v][2] * rs * n4.z * silu(g2), O[v][3] * rs * n4.w * silu(g3))};
    *(uint2*)(MIX + (size_t)row * D + h * 128 + dv) = o;
  }
}

#define XB_TMO      128
#define XB_XCNT(j)  (256  + 64 * (j))
#define XB_XSUB(j)  (1280 + 64 * (j))
#define XB_XGEN(j)  (2304 + 64 * (j))
#define XB_TOP      3328
#define XB_TOPGEN   3392
#define XCD_BAR_WORDS 3456
#define XB_SPIN_CAP (1u << 18)
__device__ __forceinline__ unsigned xb_ld(unsigned* p) { return __hip_atomic_load(p, __ATOMIC_RELAXED, __HIP_MEMORY_SCOPE_AGENT); }
__device__ __forceinline__ unsigned xb_add(unsigned* p, unsigned v) { return __hip_atomic_fetch_add(p, v, __ATOMIC_RELAXED, __HIP_MEMORY_SCOPE_AGENT); }
__device__ __forceinline__ unsigned xb_xcc_id() { return (unsigned)__builtin_amdgcn_s_getreg((3 << 11) | 20) & 0xFu; }
#define XB_SPIN(cond, bar) do { unsigned _sp = 0; while (cond) { __builtin_amdgcn_s_sleep(1); \
    if ((++_sp & 255u) == 0u) { if (xb_ld(&(bar)[XB_TMO])) break; if (_sp > XB_SPIN_CAP) { atomicAdd(&(bar)[XB_TMO], 1u); break; } } } } while (0)
struct GB { unsigned* bar; unsigned x, nloc, nx; };
__device__ __forceinline__ void gb_complete(unsigned* bar, unsigned x, unsigned& nloc, unsigned& nx) {
  const unsigned G = gridDim.x;
  unsigned sum, cnt, mine, sp = 0u;
  for (;;) {
    sum = 0u; cnt = 0u; mine = 0u;
#pragma unroll
    for (unsigned j = 0; j < 16; ++j) { const unsigned c = xb_ld(&bar[XB_XCNT(j)]); sum += c; cnt += (c > 0u) ? 1u : 0u; mine = (j == x) ? c : mine; }
    if (sum == G) break;
    __builtin_amdgcn_s_sleep(1);
    if ((++sp & 255u) == 0u) { if (xb_ld(&bar[XB_TMO])) break; if (sp > XB_SPIN_CAP) { atomicAdd(&bar[XB_TMO], 1u); break; } }
  }
  nloc = mine > 0u ? mine : 1u; nx = cnt > 0u ? cnt : 1u;
}
__device__ __forceinline__ void gbar(GB& b) {
  asm volatile("s_waitcnt vmcnt(0)" ::: "memory");
  __syncthreads();
  if (threadIdx.x == 0) {
    unsigned* bar = b.bar;
    __builtin_amdgcn_s_waitcnt(0);
    if (b.nloc == 0u) gb_complete(bar, b.x, b.nloc, b.nx);
    const unsigned nloc = b.nloc, nx = b.nx;
    const unsigned old = xb_add(&bar[XB_XSUB(b.x)], 1u);
    const unsigned gen = old / nloc;
    if (old + 1u == (gen + 1u) * nloc) {
      __builtin_amdgcn_fence(__ATOMIC_RELEASE, "agent");
      asm volatile("s_waitcnt vmcnt(0)" ::: "memory");
      const unsigned og = xb_add(&bar[XB_TOP], 1u);
      const unsigned tg = og / nx;
      if (og + 1u == (tg + 1u) * nx) xb_add(&bar[XB_TOPGEN], 1u);
      else XB_SPIN(xb_ld(&bar[XB_TOPGEN]) == tg, bar);
      __builtin_amdgcn_fence(__ATOMIC_ACQUIRE, "agent");
      xb_add(&bar[XB_XGEN(b.x)], 1u);
      asm volatile("s_waitcnt vmcnt(0)" ::: "memory");
    } else {
      XB_SPIN(xb_ld(&bar[XB_XGEN(b.x)]) == gen, bar);
      __builtin_amdgcn_fence(__ATOMIC_ACQUIRE, "agent");
      asm volatile("s_waitcnt vmcnt(0)" ::: "memory");
    }
  }
  __syncthreads();
}

__device__ __forceinline__ void ffn_out_phase(const P& p, const u16* HID, const u16* Wt, int M, char* smem) {
  u16* Y = (u16*)(p.ws + OFF_Y);
  u16* YC = (u16*)(p.ws + OFF_YC);
  for (int it = 0;; ++it) {
    int pm, pn;
    if (!xcd_tile(it, ML / 128, 8, pm, pn)) break;
    gemm_tile(HID, FH, Wt, FH, FH, pm * 128, pn * 128, smem, EpiF32{Y});
  }
  if (M > ML) {
    for (int u = blockIdx.x; u < 256; u += gridDim.x) {
      {
      const int ks = u & 3, ct = u >> 2, pm = ct >> 3, pn = ct & 7;
      gemm_tile(HID + ks * 704, FH, Wt + ks * 704, FH, 704, ML + pm * 128, pn * 128, smem,
                EpiF32{YC + ((size_t)ks * MC - ML) * D});
      }
    }
  }
}

constexpr int PH_PER_EVEN = 12, PH_PER_ODD = 10;
constexpr int N_PHASES = 2 + 2 * PH_PER_EVEN + 2 * PH_PER_ODD;

__device__ __forceinline__ void run_phase(const P& pin, int ph, char* smem) {
  P p = pin;
  asm volatile("" : "+s"(p.ws));
  asm volatile("" : "+s"(p.out));
  u16* H = (u16*)(p.ws + OFF_H);
  u16* HID = (u16*)(p.ws + OFF_HID);
  u16* Y = (u16*)(p.ws + OFF_Y);
  u16* PROJ = (u16*)(p.ws + OFF_PROJ);
  u16* VT = (u16*)(p.ws + OFF_VT);
  u16* MIX = (u16*)(p.ws + OFF_MIX);
  if (ph == 0) { phase_prep(p, smem); return; }
  if (ph == 1) { phase_rows(p, 0, 0, 0, MT, false); return; }
  int q = ph - 2, l;
  if (q < PH_PER_EVEN) l = 0;
  else if (q < PH_PER_EVEN + PH_PER_ODD) { l = 1; q -= PH_PER_EVEN; }
  else if (q < 2 * PH_PER_EVEN + PH_PER_ODD) { l = 2; q -= PH_PER_EVEN + PH_PER_ODD; }
  else { l = 3; q -= 2 * PH_PER_EVEN + PH_PER_ODD; }
  const bool even = !(l & 1), last = (l == 3);
  int step = q;
  if (!even && q >= 5) step = q + 2;
  const int Mpost = last ? ML : MT;
  const u16* WFI = (const u16*)(p.ws + OFF_WFI);
  const u16* WFO = (const u16*)(p.ws + OFF_WFO);
  switch (step) {
    case 0: gemm_phase(H, D, WFI + (size_t)(l * 2 + 0) * 5632 * 1024, MT, 5632, 1024, smem, EpiSwiglu{HID}); break;
    case 1: ffn_out_phase(p, HID, WFO + (size_t)(l * 2 + 0) * 1024 * 2816, MT, smem); break;
    case 2: phase_rows(p, 1, l, 0, MT, false); break;
    case 3:
      if (even) gemm_phase(H, D, (const u16*)(p.ws + OFF_WMI) + (size_t)l * 3072 * 1024, MT, 3072, 1024, smem, EpiProjEven{PROJ, VT});
      else gemm_phase(H, D, (const u16*)(p.ws + OFF_WMI) + (size_t)l * 3072 * 1024, MT, 3072, 1024, smem,
                      EpiProjOdd{PROJ, VT, (const float*)(p.ws + OFF_ROPE)});
      break;
    case 4:
      if (even) {
        for (int it = blockIdx.x; it < 32 * NCH + MT / 32; it += gridDim.x) {
          if (it < 32 * NCH) hg_u_item(p, l >> 1, it, smem);
          else pool_item(p, it - 32 * NCH);
        }
      } else phase_attn(p, l, smem);
      break;
    case 5: {
      for (int it = blockIdx.x; it < 2048 + 4 * (MT / 128); it += gridDim.x) {
        if (it < 2048) hg_scan_item(p, it);
        else {
          int t = it - 2048, g = t / (MT / 128), mt = t % (MT / 128);
          gemm_tile((const u16*)(p.ws + OFF_POOLED) + g * 128, 512,
                    (const u16*)(p.ws + OFF_WPL) + (size_t)((l >> 1) * 4 + g) * 128 * 128, 128, 128, mt * 128, 0, smem,
                    EpiPool{MIX, p.pool_scale + (l >> 1) * 512, g});
        }
      }
    } break;
    case 6:
      for (int it = blockIdx.x; it < 16 * NCH; it += gridDim.x) hg_o_item(p, l >> 1, it, smem);
      break;
    case 7: gemm_phase(MIX, D, (const u16*)(p.ws + OFF_WMO) + (size_t)l * 1024 * 1024, Mpost, 1024, 1024, smem, EpiF32{Y}); break;
    case 8: phase_rows(p, 1, l, 1, Mpost, false); break;
    case 9: gemm_phase(H, D, WFI + (size_t)(l * 2 + 1) * 5632 * 1024, Mpost, 5632, 1024, smem, EpiSwiglu{HID}); break;
    case 10: ffn_out_phase(p, HID, WFO + (size_t)(l * 2 + 1) * 1024 * 2816, Mpost, smem); break;
    case 11: phase_rows(p, 1, l, 2, Mpost, last); break;
  }
}

__global__ void __launch_bounds__(256, 2) mega(P p, int ph_lo, int ph_hi) {
  __shared__ __attribute__((aligned(16))) char smem[65536];
  GB gb;
  gb.bar = (unsigned*)(p.ws + OFF_BAR); gb.x = xb_xcc_id(); gb.nloc = 0u; gb.nx = 0u;
  if (threadIdx.x == 0) (void)xb_add(&gb.bar[XB_XCNT(gb.x)], 1u);
  for (int ph = ph_lo; ph < ph_hi; ++ph) {
    run_phase(p, ph, smem);
#ifdef DOUBLE_GEMM
    {
      int q = ph - 2, l = 0;
      if (ph >= 2) {
        if (q < 12) l = 0; else if (q < 22) { l = 1; q -= 12; } else if (q < 34) { l = 2; q -= 22; } else { l = 3; q -= 34; }
        int step = q; if ((l & 1) && q >= 5) step = q + 2;
        if (step == 0 || step == 1 || step == 3 || step == 7 || step == 9 || step == 10) run_phase(p, ph, smem);
      }
    }
#endif
#ifdef DOUBLE_ATT
    if (ph == 2 + 12 + 4 || ph == 2 + 34 + 4) run_phase(p, ph, smem);
#endif
    if (ph + 1 < ph_hi) {
      if (ph == ph_lo) cg::this_grid().sync();
      else gbar(gb);
    }
  }
}

extern "C" void kernel_launch(void* const* d_in, const int* in_sizes, int n_in, void* d_out, int out_size, void* d_ws,
                              size_t ws_size, hipStream_t stream) {
  static int grid_blocks = 0;
  if (!grid_blocks) {
    int dev = 0, cus = 0, per_cu = 0;
    hipGetDevice(&dev);
    hipDeviceGetAttribute(&cus, hipDeviceAttributeMultiprocessorCount, dev);
    hipOccupancyMaxActiveBlocksPerMultiprocessor(&per_cu, mega, 256, 0);
    if (per_cu > 2) per_cu = 2;
    grid_blocks = cus * per_cu;
  }
  if (ws_size < OFF_END2) { fprintf(stderr, "workspace too small: %zu < %zu\n", ws_size, (size_t)OFF_END); return; }
  P p{};
  const float** f = (const float**)&p;
  for (int i = 0; i < 20; ++i) f[i] = (const float*)d_in[i];
  p.out = (float*)d_out;
  p.ws = (char*)d_ws;
#if MULTI_LAUNCH
  for (int ph = 0; ph < N_PHASES; ++ph) hipLaunchKernelGGL(mega, dim3(grid_blocks), dim3(256), 0, stream, p, ph, ph + 1);
#else
  hipMemsetAsync((char*)d_ws + OFF_BAR, 0, XCD_BAR_WORDS * 4, stream);
  int lo = 0, hi = N_PHASES;
  void* args[] = {&p, &lo, &hi};
  hipError_t e = hipLaunchCooperativeKernel((void*)mega, dim3(grid_blocks), dim3(256), args, 0, stream);
  if (e != hipSuccess) fprintf(stderr, "cooperative launch failed: %s (grid %d)\n", hipGetErrorString(e), grid_blocks);
#endif
}
```

```cpp
#include <hip/hip_runtime.h>
#include <hip/hip_cooperative_groups.h>
#include <cstdio>
namespace cg = cooperative_groups;

typedef __attribute__((ext_vector_type(8))) short bf16x8;
typedef __attribute__((ext_vector_type(4))) float f32x4;
typedef unsigned short u16;

#ifndef MULTI_LAUNCH
#define MULTI_LAUNCH 0
#endif

constexpr int D = 1024, NB = 4, SEQ = 4096, CTX = 256, FH = 2816;
constexpr int ML = NB * SEQ, MC = NB * CTX, MT = ML + MC;
constexpr int TK = CTX + SEQ;
constexpr int NCH = TK / 64;
constexpr float ALPHA = 1.6817928305074290f;
constexpr float LOG2E = 1.4426950408889634f;

constexpr size_t al256(size_t x) { return (x + 255) & ~(size_t)255; }
constexpr size_t OFF_WFI = 0;
constexpr size_t OFF_WFO = OFF_WFI + al256((size_t)4 * 2 * 5632 * 1024 * 2);
constexpr size_t OFF_WMI = OFF_WFO + al256((size_t)4 * 2 * 1024 * 2816 * 2);
constexpr size_t OFF_WMO = OFF_WMI + al256((size_t)4 * 3072 * 1024 * 2);
constexpr size_t OFF_WPL = OFF_WMO + al256((size_t)4 * 1024 * 1024 * 2);
constexpr size_t OFF_MODS = OFF_WPL + al256((size_t)2 * 4 * 128 * 128 * 2);
constexpr size_t OFF_LB = OFF_MODS + al256((size_t)4 * 5 * 9216 * 4);
constexpr size_t OFF_LAM = OFF_LB + al256((size_t)2 * 2 * 512 * 4);
constexpr size_t OFF_ROPE = OFF_LAM + 256;
constexpr size_t OFF_DEC = OFF_ROPE + al256((size_t)64 * 16 * 2 * 4);
constexpr size_t OFF_X = OFF_DEC + al256((size_t)32 * NCH * 128 * 4);
constexpr size_t OFF_H = OFF_X + al256((size_t)MT * 1024 * 4);
constexpr size_t OFF_PROJ = OFF_H + al256((size_t)MT * 1024 * 2);
constexpr size_t OFF_VT = OFF_PROJ + al256((size_t)MT * 3072 * 2);
constexpr size_t OFF_MIX = OFF_VT + al256((size_t)NB * 8 * 128 * TK * 2);
constexpr size_t OFF_POOLED = OFF_MIX + al256((size_t)MT * 1024 * 2);
constexpr size_t OFF_HID = OFF_POOLED + al256((size_t)MT * 512 * 2);
constexpr size_t OFF_Y = OFF_HID + al256((size_t)MT * FH * 2);
constexpr size_t OFF_END = OFF_Y + al256((size_t)MT * 1024 * 4);
constexpr size_t OFF_YC = OFF_END;
constexpr size_t OFF_BAR = OFF_YC + al256((size_t)4 * MC * 1024 * 2);
constexpr size_t OFF_END2 = OFF_BAR + al256((size_t)3456 * 4);
constexpr size_t OFF_U = OFF_HID;
static_assert((size_t)32 * NCH * 16384 * 4 <= OFF_END - OFF_HID, "U alias too big");

struct P {
  const float *x, *c, *ctx, *c_ctx, *w_ada, *b_ada, *ln_g, *ln_b, *w_ffn_in, *w_ffn_out, *w_in_even, *w_out_even,
      *hg_lb, *hg_norm_w, *pool_w, *pool_scale, *w_in_odd, *w_out_odd, *da_lambda, *da_sub_w;
  float* out;
  char* ws;
};

typedef __attribute__((ext_vector_type(2))) __bf16 bf16v2;
typedef __attribute__((ext_vector_type(2))) float f32v2;
__device__ __forceinline__ unsigned pk2(float a, float b) {
  f32v2 v = {a, b};
  bf16v2 r = __builtin_convertvector(v, bf16v2);
  return *(unsigned*)&r;
}
__device__ __forceinline__ u16 f2bf(float f) { return (u16)(pk2(f, 0.f) & 0xffffu); }
__device__ __forceinline__ float bf2f(u16 h) { return __uint_as_float(((unsigned)h) << 16); }
__device__ __forceinline__ float sigm(float z) { return __builtin_amdgcn_rcpf(1.f + __expf(-z)); }
__device__ __forceinline__ float silu(float z) { return z * __builtin_amdgcn_rcpf(1.f + __expf(-z)); }
__device__ __forceinline__ float ex2(float x) { return __builtin_amdgcn_exp2f(x); }
__device__ __forceinline__ void glds16(const void* g, void* l) {
  __builtin_amdgcn_global_load_lds((const unsigned*)g, (unsigned*)l, 16, 0, 0);
}
__device__ __forceinline__ int get_tid() { int t = threadIdx.x & 255; asm volatile("" : "+v"(t)); return t; }
__device__ __forceinline__ int get_vb() { return __builtin_amdgcn_readfirstlane((int)(threadIdx.x >> 8)); }
__device__ __forceinline__ int swz128(int row, int ch) { return row * 128 + ((ch ^ ((row >> 1) & 7)) << 4); }
__device__ __forceinline__ int swz256(int row, int ch) { return row * 256 + ((ch ^ (row & 15)) << 4); }
__device__ __forceinline__ f32x4 mfma16(bf16x8 a, bf16x8 b, f32x4 c) {
  return __builtin_amdgcn_mfma_f32_16x16x32_bf16(a, b, c, 0, 0, 0);
}
__device__ __forceinline__ float xor_sum(float v, int m) { return v + __shfl_xor(v, m, 64); }
__device__ __forceinline__ float xor_max(float v, int m) { return fmaxf(v, __shfl_xor(v, m, 64)); }
__device__ __forceinline__ int kperm(int pos) { return (pos & ~31) | ((pos & 12) << 1) | ((pos & 16) >> 2) | (pos & 3); }
__device__ __forceinline__ void row_bpos(int row, int& b, int& pos) {
  if (row < ML) { b = row >> 12; pos = CTX + (row & 4095); }
  else { int r = row - ML; b = r >> 8; pos = r & 255; }
}
__device__ __forceinline__ int mod_row(int row) { return row < ML ? (row >> 12) : 4; }

constexpr int BM = 128, BN = 128, BK = 64;

template <class Epi>
__device__ __forceinline__ void gemm_tile(const u16* __restrict__ A, int lda, const u16* __restrict__ Bt, int ldb, int K,
                                          int m0, int n0, char* smem, const Epi& epi) {
  const int tid = get_tid(), lane = tid & 63, wid = tid >> 6, wr = wid >> 1, wc = wid & 1, fr = lane & 15, fq = lane >> 4;
  f32x4 acc[4][4];
#pragma unroll
  for (int m = 0; m < 4; ++m)
#pragma unroll
    for (int n = 0; n < 4; ++n) acc[m][n] = f32x4{0.f, 0.f, 0.f, 0.f};
  const int nk = K / BK;
  const u16* ga[4];
  const u16* gb[4];
#pragma unroll
  for (int i = 0; i < 4; ++i) {
    int q = tid + i * 256, row = q >> 3, ch = (q & 7) ^ ((row >> 1) & 7);
    ga[i] = A + (size_t)(m0 + row) * lda + ch * 8;
    gb[i] = Bt + (size_t)(n0 + row) * ldb + ch * 8;
  }
  __syncthreads();
#pragma unroll
  for (int i = 0; i < 4; ++i) {
    glds16(ga[i], smem + (tid + i * 256) * 16);
    glds16(gb[i], smem + 16384 + (tid + i * 256) * 16);
  }
  for (int kt = 0; kt < nk; ++kt) {
    __syncthreads();
    char* cur = smem + (kt & 1) * 32768;
    bf16x8 a[2][4], b[2][4];
#pragma unroll
    for (int ks = 0; ks < 2; ++ks) {
#pragma unroll
      for (int n = 0; n < 4; ++n) b[ks][n] = *(const bf16x8*)(cur + 16384 + swz128(wc * 64 + n * 16 + fr, ks * 4 + fq));
#pragma unroll
      for (int m = 0; m < 4; ++m) a[ks][m] = *(const bf16x8*)(cur + swz128(wr * 64 + m * 16 + fr, ks * 4 + fq));
    }
    __builtin_amdgcn_sched_barrier(0);
    if (kt + 1 < nk) {
      char* nxt = smem + ((kt + 1) & 1) * 32768;
#pragma unroll
      for (int i = 0; i < 4; ++i) {
        glds16(ga[i] + (kt + 1) * BK, nxt + (tid + i * 256) * 16);
        glds16(gb[i] + (kt + 1) * BK, nxt + 16384 + (tid + i * 256) * 16);
      }
    }
    __builtin_amdgcn_sched_barrier(0);
    __builtin_amdgcn_s_setprio(1);
#pragma unroll
    for (int ks = 0; ks < 2; ++ks)
#pragma unroll
      for (int m = 0; m < 4; ++m)
#pragma unroll
        for (int n = 0; n < 4; ++n) acc[m][n] = mfma16(b[ks][n], a[ks][m], acc[m][n]);
    __builtin_amdgcn_s_setprio(0);
  }
  epi(acc, m0 + wr * 64, n0 + wc * 64, fr, fq);
}

struct BlkSwiglu {
  u16* hid;
  __device__ __forceinline__ void operator()(const f32x4& f0, const f32x4& f1, int row, int cg, int fq) const {
    uint2 v = {pk2(silu(f0[0]) * f1[0], silu(f0[1]) * f1[1]), pk2(silu(f0[2]) * f1[2], silu(f0[3]) * f1[3])};
    *(uint2*)(hid + (size_t)row * FH + (cg >> 1) + fq * 4) = v;
  }
};
struct BlkY {
  u16* y;
  __device__ __forceinline__ void operator()(const f32x4& f0, const f32x4& f1, int row, int cg, int fq) const {
    u16* o = y + (size_t)row * D + cg + fq * 4;
    *(uint2*)o = uint2{pk2(f0[0], f0[1]), pk2(f0[2], f0[3])};
    *(uint2*)(o + 16) = uint2{pk2(f1[0], f1[1]), pk2(f1[2], f1[3])};
  }
};
struct BlkPool {
  u16* mix; const float* scale; int g;
  __device__ __forceinline__ void operator()(const f32x4& f0, const f32x4& f1, int row, int cg, int fq) const {
    const int col = g * 128 + cg + fq * 4;
    float4 s0 = *(const float4*)(scale + col), s1 = *(const float4*)(scale + col + 16);
    u16* o = mix + (size_t)row * D + 512 + col;
    *(uint2*)o = uint2{pk2(f0[0] * s0.x, f0[1] * s0.y), pk2(f0[2] * s0.z, f0[3] * s0.w)};
    *(uint2*)(o + 16) = uint2{pk2(f1[0] * s1.x, f1[1] * s1.y), pk2(f1[2] * s1.z, f1[3] * s1.w)};
  }
};
__device__ __forceinline__ void store_vt_blk(u16* vt, int nh, const f32x4& f0, const f32x4& f1, int row, int fc0, int fq) {
  int b, pos;
  row_bpos(row, b, pos);
  pos = kperm(pos);
  const int fc = fc0 + fq * 4, h = fc >> 7, f = fc & 127;
  u16* o = vt + ((size_t)((b * nh + h) * 128 + f)) * TK + pos;
#pragma unroll
  for (int j = 0; j < 4; ++j) { o[(size_t)j * TK] = f2bf(f0[j]); o[(size_t)(j + 16) * TK] = f2bf(f1[j]); }
}
struct BlkProjEven {
  u16* proj; u16* vt;
  __device__ __forceinline__ void operator()(const f32x4& f0, const f32x4& f1, int row, int cg, int fq) const {
    if (cg >= 512 && cg < 1024) { store_vt_blk(vt, 4, f0, f1, row, cg - 512, fq); return; }
    const float sc = (cg < 512) ? 0.08838834764831845f : 1.f;
    u16* o = proj + (size_t)row * 3072 + cg + fq * 4;
    *(uint2*)o = uint2{pk2(f0[0] * sc, f0[1] * sc), pk2(f0[2] * sc, f0[3] * sc)};
    *(uint2*)(o + 16) = uint2{pk2(f1[0] * sc, f1[1] * sc), pk2(f1[2] * sc, f1[3] * sc)};
  }
};
struct BlkProjOdd {
  u16* proj; u16* vt; const float* rope;
  __device__ __forceinline__ void operator()(const f32x4& f0, const f32x4& f1, int row, int cg, int fq) const {
    if (cg >= 2048) { store_vt_blk(vt, 8, f0, f1, row, cg - 2048, fq); return; }
    const float sc = (cg < 1024) ? 0.125f * LOG2E : 1.f;
    f32x4 v0 = f0, v1 = f1;
    if (row < ML) {
      const int t = row & 4095, pos = ((cg >> 5) & 1) ? (t & 63) : (t >> 6);
      const float* rr = rope + (pos * 16 + fq * 4) * 2;
      float4 r0 = *(const float4*)rr, r1 = *(const float4*)(rr + 4);
      float cs[4] = {r0.x, r0.z, r1.x, r1.z}, sn[4] = {r0.y, r0.w, r1.y, r1.w};
#pragma unroll
      for (int j = 0; j < 4; ++j) {
        float a0 = f0[j] * cs[j] - f1[j] * sn[j], a1 = f1[j] * cs[j] + f0[j] * sn[j];
        v0[j] = a0; v1[j] = a1;
      }
    }
    u16* o = proj + (size_t)row * 3072 + cg + fq * 4;
    *(uint2*)o = uint2{pk2(v0[0] * sc, v0[1] * sc), pk2(v0[2] * sc, v0[3] * sc)};
    *(uint2*)(o + 16) = uint2{pk2(v1[0] * sc, v1[1] * sc), pk2(v1[2] * sc, v1[3] * sc)};
  }
};
template <class Blk> struct Epi4 {
  Blk blk;
  __device__ __forceinline__ void operator()(f32x4 (&acc)[4][4], int rb, int cb, int fr, int fq) const {
#pragma unroll
    for (int m = 0; m < 4; ++m) {
      blk(acc[m][0], acc[m][1], rb + m * 16 + fr, cb, fq);
      blk(acc[m][2], acc[m][3], rb + m * 16 + fr, cb + 32, fq);
    }
  }
};

namespace pg8 {
#define PG8_LAS __attribute__((address_space(3)))
typedef unsigned short bf16_t;
typedef short bf16x8 __attribute__((ext_vector_type(8)));
typedef float f32x4 __attribute__((ext_vector_type(4)));
typedef unsigned u32x4 __attribute__((ext_vector_type(4)));
constexpr int BM = 256, BK = 64, HALF = 128, HTB = HALF * BK * 2  , STAGE_BYTES = 8 * HTB, NXCD = 8, WGM = 8;

__host__ __device__ __forceinline__ int lds_byte(int r, int c) { const int st = (r >> 4) * 2 + (c >> 5), rr = r & 15, cc = c & 31, ob = rr * 64 + cc * 2; return st * 1024 + (ob ^ (((ob >> 9) & 1) << 5)); }
__host__ __device__ __forceinline__ void stage_rc(int b, int& R, int& C) { const int st = b / 1024, sb = b % 1024, swz = sb ^ (((sb >> 9) & 1) << 5); R = (st >> 1) * 16 + swz / 64; C = (st & 1) * 32 + (swz % 64) / 2; }
__host__ __device__ __forceinline__ int perm32(int rho) { const int n = rho >> 4, i = rho & 15; return 8 * (i >> 2) + 4 * n + (i & 3); }

struct Unit { int pm, pn; };
struct Gemm { const bf16_t* A; const bf16_t* Bt; int M, N, K; };

struct StaticOrder {
    int nM, nN, nwg, G, c;
    __host__ __device__ void init(int M, int N, int G_, int c_) { nM = M / BM; nN = N / BM; nwg = nM * nN; G = G_; c = c_; }
    __host__ __device__ bool next(int i, Unit& u) const {
        const long L = (long)i * G + c; if (L >= nwg) return false;
        int wgid = (int)L; { const int q = nwg / NXCD, r = nwg % NXCD, xcd = wgid % NXCD, off = wgid / NXCD; wgid = (xcd < r ? xcd * (q + 1) : r * (q + 1) + (xcd - r) * q) + off; }
        const int nig = WGM * nN, gid = wgid / nig, fm = gid * WGM, gsz = (nM - fm) < WGM ? (nM - fm) : WGM;
        u.pm = fm + ((wgid % nig) % gsz); u.pn = (wgid % nig) / gsz; return true;
    }
    __device__ __forceinline__ void a_ready(const Unit&) const {}
    __device__ __forceinline__ void done(const Unit&) const {}
};

template <class Epi, class Sched, bool STAMP = false>
__device__ __forceinline__ void gemm_phase(PG8_LAS unsigned char* lds, const Gemm g, const Sched& S, const Epi& E, unsigned long long* stamps) {
    int tid = threadIdx.x; asm volatile("" : "+v"(tid));
    const int wid = __builtin_amdgcn_readfirstlane(tid >> 6), lane = tid & 63, wr = wid >> 2, wc = wid & 3, fr = lane & 15, fq = lane >> 4;
    const int K = g.K, nt = K / BK;
    int ts_lo = 0, ts_hi = 0, nts = 0; const unsigned long long rt_entry = STAMP ? (unsigned long long)wall_clock64() : 0ull;
#define PG8_STAMP() do { if (STAMP && wid == 0 && nts < 64) { const unsigned long long _c = (unsigned long long)clock64(); \
        ts_lo = (lane == nts) ? (int)(unsigned)_c : ts_lo; ts_hi = (lane == nts) ? (int)(unsigned)(_c >> 32) : ts_hi; ++nts; } } while (0)
    PG8_STAMP();
    unsigned voffA[2], voffB[2];
#pragma unroll
    for (int i = 0; i < 2; ++i) { int R, C; stage_rc(tid * 16 + i * 8192, R, C); const int Rb = Epi::PERM ? ((R & ~31) + perm32(R & 31)) : R;
        voffA[i] = (unsigned)(R * K + C) * 2u; voffB[i] = (unsigned)(Rb * K + C) * 2u; }
    const size_t kstep = (size_t)(BK * 2);
    const size_t hstep = (size_t)HALF * K * 2;
    const size_t tstep = 2 * hstep;
    const unsigned ldsw = (unsigned)wid * 1024u;
    const int aoff = lds_byte(wr * 64 + fr, fq * 8), boff = lds_byte(wc * 32 + fr, fq * 8);
#define PG8_SA(b, h) (((b) * 2 + (h)) * HTB)
#define PG8_SB(b, h) ((4 + (b) * 2 + (h)) * HTB)
#define PG8_STAGE(bufoff, gbase, voff) do { _Pragma("unroll") for (int _i = 0; _i < 2; ++_i) \
        __builtin_amdgcn_global_load_lds((const unsigned*)((const char*)(gbase) + (voff)[_i]), (PG8_LAS unsigned*)(lds + (bufoff) + ldsw + _i * 8192), 16, 0, 0); } while (0)
#define PG8_LDA(dst, b, h) do { _Pragma("unroll") for (int m = 0; m < 4; ++m) _Pragma("unroll") for (int k = 0; k < 2; ++k) dst[m][k] = *(const PG8_LAS bf16x8*)(lds + PG8_SA(b, h) + aoff + m * 2048 + k * 1024); } while (0)
#define PG8_LDB(dst, b, h) do { _Pragma("unroll") for (int n = 0; n < 2; ++n) _Pragma("unroll") for (int k = 0; k < 2; ++k) dst[n][k] = *(const PG8_LAS bf16x8*)(lds + PG8_SB(b, h) + boff + n * 2048 + k * 1024); } while (0)
#define PG8_MMA(ai, bj, At, Bt) do { __builtin_amdgcn_s_setprio(1); _Pragma("unroll") for (int m = 0; m < 4; ++m) _Pragma("unroll") for (int n = 0; n < 2; ++n) _Pragma("unroll") for (int k = 0; k < 2; ++k) \
        acc[ai][bj][m][n] = __builtin_amdgcn_mfma_f32_16x16x32_bf16(Bt[n][k], At[m][k], acc[ai][bj][m][n], 0, 0, 0); __builtin_amdgcn_s_setprio(0); } while (0)
#define PG8_WAIT_V(n) asm volatile("s_waitcnt vmcnt(" #n ")" ::: "memory")
#define PG8_WAIT_L(n) asm volatile("s_waitcnt lgkmcnt(" #n ")" ::: "memory")
#define PG8_BAR __builtin_amdgcn_s_barrier()
#define PG8_SCHED __builtin_amdgcn_sched_barrier(0)
    Unit cur, nxt; int ui = 0;
    if (!S.next(0, cur)) return;
    f32x4 acc[2][2][4][2];
#pragma unroll
    for (int a = 0; a < 2; ++a)
#pragma unroll
        for (int b = 0; b < 2; ++b)
#pragma unroll
            for (int m = 0; m < 4; ++m)
#pragma unroll
                for (int n = 0; n < 2; ++n) acc[a][b][m][n] = (f32x4){0.f, 0.f, 0.f, 0.f};
    bf16x8 At[4][2], B0[2][2], B1[2][2];
    const char* cA = (const char*)g.A + (size_t)cur.pm * tstep; const char* cB = (const char*)g.Bt + (size_t)cur.pn * tstep;
    S.a_ready(cur);
    PG8_STAGE(PG8_SB(0, 0), cB, voffB); PG8_STAGE(PG8_SA(0, 0), cA, voffA); PG8_STAGE(PG8_SB(0, 1), cB + hstep, voffB); PG8_STAGE(PG8_SA(0, 1), cA + hstep, voffA);
    if (wr == 1) PG8_BAR;
    PG8_WAIT_V(4); PG8_BAR;
    PG8_STAGE(PG8_SB(1, 0), cB + kstep, voffB); PG8_STAGE(PG8_SA(1, 0), cA + kstep, voffA); PG8_STAGE(PG8_SB(1, 1), cB + hstep + kstep, voffB);
    PG8_WAIT_V(6); PG8_BAR;
    PG8_STAMP();
    for (;;) {
        const bool has_next = S.next(ui + 1, nxt);
        const char* nA = has_next ? (const char*)g.A + (size_t)nxt.pm * tstep : cA; const char* nB = has_next ? (const char*)g.Bt + (size_t)nxt.pn * tstep : cB;
        for (int t = 0; t < nt; t += 2) {
            const bool last = (t == nt - 2);
            const char* a1 = cA + (size_t)(t + 1) * kstep;
            const char* a2 = last ? nA : cA + (size_t)(t + 2) * kstep; const char* b2 = last ? nB : cB + (size_t)(t + 2) * kstep;
            const char* a3 = a2 + kstep; const char* b3 = b2 + kstep;
            if (last && has_next) S.a_ready(nxt);
            PG8_LDB(B0, 0, 0); PG8_SCHED; PG8_LDA(At, 0, 0); PG8_STAGE(PG8_SA(1, 1), a1 + hstep, voffA);
            PG8_WAIT_L(8); PG8_BAR; PG8_WAIT_L(0); PG8_MMA(0, 0, At, B0); PG8_BAR; PG8_SCHED;
            PG8_LDB(B1, 0, 1); PG8_STAGE(PG8_SB(0, 0), b2, voffB);
            PG8_BAR; PG8_WAIT_L(0); PG8_MMA(0, 1, At, B1); PG8_BAR;
            PG8_LDA(At, 0, 1); PG8_STAGE(PG8_SA(0, 0), a2, voffA);
            PG8_BAR; PG8_WAIT_L(0); PG8_MMA(1, 0, At, B0); PG8_BAR; PG8_SCHED;
            PG8_STAGE(PG8_SB(0, 1), b2 + hstep, voffB);
            PG8_WAIT_V(6); PG8_BAR; PG8_MMA(1, 1, At, B1); PG8_BAR;
            PG8_LDB(B0, 1, 0); PG8_SCHED; PG8_LDA(At, 1, 0); PG8_STAGE(PG8_SA(0, 1), a2 + hstep, voffA);
            PG8_WAIT_L(8); PG8_BAR; PG8_WAIT_L(0); PG8_MMA(0, 0, At, B0); PG8_BAR; PG8_SCHED;
            PG8_LDB(B1, 1, 1); PG8_STAGE(PG8_SB(1, 0), b3, voffB);
            PG8_BAR; PG8_WAIT_L(0); PG8_MMA(0, 1, At, B1); PG8_BAR;
            PG8_LDA(At, 1, 1); PG8_STAGE(PG8_SA(1, 0), a3, voffA);
            PG8_BAR; PG8_WAIT_L(0); PG8_MMA(1, 0, At, B0); PG8_BAR; PG8_SCHED;
            PG8_STAGE(PG8_SB(1, 1), b3 + hstep, voffB);
            PG8_WAIT_V(6); PG8_BAR; PG8_MMA(1, 1, At, B1); PG8_BAR;
        }
        PG8_STAMP();
        if constexpr (!Epi::AFTER_DRAIN) { E(acc, cur, wr, wc, fr, fq); S.done(cur); }
        PG8_STAMP();
        if (!has_next) break;
#pragma unroll
        for (int a = 0; a < 2; ++a)
#pragma unroll
            for (int b = 0; b < 2; ++b)
#pragma unroll
                for (int m = 0; m < 4; ++m)
#pragma unroll
                    for (int n = 0; n < 2; ++n) acc[a][b][m][n] = (f32x4){0.f, 0.f, 0.f, 0.f};
        cur = nxt; cA = nA; cB = nB; ++ui;
    }
    PG8_WAIT_V(0);
    if (wr == 0) PG8_BAR;
    PG8_BAR;
    if constexpr (Epi::AFTER_DRAIN) { E.fused(acc, cur, wr, wc, fr, fq, lds, wid, lane); S.done(cur); }
    PG8_STAMP();
    if (STAMP && wid == 0) { stamps[lane] = lane < nts ? (((unsigned long long)(unsigned)ts_hi << 32) | (unsigned)ts_lo) : 0ull;
        if (lane == 62) stamps[62] = rt_entry; if (lane == 63) stamps[63] = (unsigned long long)wall_clock64(); }
#undef PG8_STAMP
#undef PG8_SA
#undef PG8_SB
#undef PG8_STAGE
#undef PG8_LDA
#undef PG8_LDB
#undef PG8_MMA
#undef PG8_WAIT_V
#undef PG8_WAIT_L
#undef PG8_BAR
#undef PG8_SCHED
}
}

template <class Blk> struct Epi8 {
  static constexpr bool PERM = false, AFTER_DRAIN = false;
  Blk blk;
  __device__ __forceinline__ void operator()(const f32x4 (&acc)[2][2][4][2], const pg8::Unit& u, int wr, int wc, int fr, int fq) const {
#pragma unroll
    for (int ai = 0; ai < 2; ++ai)
#pragma unroll
      for (int m = 0; m < 4; ++m) {
        const int row = u.pm * 256 + ai * 128 + wr * 64 + m * 16 + fr;
#pragma unroll
        for (int bj = 0; bj < 2; ++bj) blk(acc[ai][bj][m][0], acc[ai][bj][m][1], row, u.pn * 256 + bj * 128 + wc * 32, fq);
      }
  }
};
template <int N, int K, class Blk>
__device__ __forceinline__ void gemm8(const u16* A, const u16* Bt, int M, char* smem, const Blk& blk) {
  pg8::Gemm g{A, Bt, M, N, K};
  pg8::StaticOrder S;
  S.init(M, N, (int)gridDim.x, (int)blockIdx.x);
  pg8::gemm_phase<Epi8<Blk>, pg8::StaticOrder, false>((PG8_LAS unsigned char*)smem, g, S, Epi8<Blk>{blk}, nullptr);
  __syncthreads();
}

__device__ __forceinline__ void convert_tile(const float* __restrict__ src, int K, int N, u16* __restrict__ dst, int tile,
                                             bool swiglu, char* smem) {
  float* t = (float*)smem;
  const int tid = get_tid();
  const int nN = N / 64, nt = tile % nN, kt = tile / nN, k0 = kt * 64, n0 = nt * 64;
  __syncthreads();
#pragma unroll
  for (int i = 0; i < 4; ++i) {
    int k = (tid >> 4) + 16 * i, n4 = (tid & 15) * 4;
    float4 v = *(const float4*)(src + (size_t)(k0 + k) * N + n0 + n4);
    t[k * 65 + n4] = v.x; t[k * 65 + n4 + 1] = v.y; t[k * 65 + n4 + 2] = v.z; t[k * 65 + n4 + 3] = v.w;
  }
  __syncthreads();
#pragma unroll
  for (int i = 0; i < 2; ++i) {
    int q = tid + i * 256, n = q >> 3, kc = (q & 7) * 8;
    int c = n0 + n, nr = c;
    if (swiglu) nr = (c < FH) ? (32 * (c >> 4) + (c & 15)) : (32 * ((c - FH) >> 4) + 16 + ((c - FH) & 15));
    uint4 o = {pk2(t[kc * 65 + n], t[(kc + 1) * 65 + n]), pk2(t[(kc + 2) * 65 + n], t[(kc + 3) * 65 + n]),
               pk2(t[(kc + 4) * 65 + n], t[(kc + 5) * 65 + n]), pk2(t[(kc + 6) * 65 + n], t[(kc + 7) * 65 + n])};
    *(uint4*)(dst + (size_t)nr * K + k0 + kc) = o;
  }
}

__device__ void phase_prep(const P& p, char* smem) {
  const int tid = get_tid();
  constexpr int N_ADA = 1152, N_TR = 4 * 5248 + 32;
  const int vb = get_vb();
  for (int itp = blockIdx.x; itp < (N_ADA + N_TR) / 2 + 1; itp += gridDim.x) {
    const int item = (itp < (N_ADA + N_TR) / 2) ? 2 * itp + vb : (vb == 0 ? N_ADA + N_TR : -1);
    if (item < 0) continue;
    if (item < N_ADA) {
      float* act = (float*)smem;
      float* red = (float*)(smem + 20480);
      const int l = item / 288, cb = (item % 288) * 32;
      __syncthreads();
      for (int i = tid; i < 5120; i += 256) {
        int r = i >> 10, k = i & 1023;
        float v = r < 4 ? p.c[r * 1024 + k] : p.c_ctx[k];
        act[i] = silu(v);
      }
      __syncthreads();
      const int tx = tid & 31, kg = tid >> 5;
      float a0 = 0, a1 = 0, a2 = 0, a3 = 0, a4 = 0;
      const float* w = p.w_ada + ((size_t)l * 1024 + kg * 128) * 9216 + cb + tx;
      for (int k0 = 0; k0 < 128; k0 += 16) {
        float wv[16];
#pragma unroll
        for (int k = 0; k < 16; ++k) wv[k] = w[(size_t)(k0 + k) * 9216];
#pragma unroll
        for (int k = 0; k < 16; ++k) {
          int kk = kg * 128 + k0 + k;
          a0 += act[kk] * wv[k]; a1 += act[1024 + kk] * wv[k]; a2 += act[2048 + kk] * wv[k]; a3 += act[3072 + kk] * wv[k];
          a4 += act[4096 + kk] * wv[k];
        }
      }
      red[(kg * 5 + 0) * 32 + tx] = a0; red[(kg * 5 + 1) * 32 + tx] = a1; red[(kg * 5 + 2) * 32 + tx] = a2;
      red[(kg * 5 + 3) * 32 + tx] = a3; red[(kg * 5 + 4) * 32 + tx] = a4;
      __syncthreads();
      if (tid < 160) {
        int r = tid >> 5, x = tid & 31;
        float sacc = 0.f;
#pragma unroll
        for (int g8 = 0; g8 < 8; ++g8) sacc += red[(g8 * 5 + r) * 32 + x];
        ((float*)(p.ws + OFF_MODS))[(size_t)(l * 5 + r) * 9216 + cb + x] = sacc + p.b_ada[l * 9216 + cb + x];
      }
    } else if (item < N_ADA + N_TR) {
      int idx = item - N_ADA;
      if (idx < 4 * 5248) {
        int l = idx / 5248, r = idx % 5248;
        if (r < 2816) {
          int f = r / 1408, tile = r % 1408;
          convert_tile(p.w_ffn_in + (size_t)(l * 2 + f) * 1024 * 5632, 1024, 5632,
                       (u16*)(p.ws + OFF_WFI) + (size_t)(l * 2 + f) * 5632 * 1024, tile, true, smem);
        } else if (r < 4224) {
          int f = (r - 2816) / 704, tile = (r - 2816) % 704;
          convert_tile(p.w_ffn_out + (size_t)(l * 2 + f) * 2816 * 1024, 2816, 1024,
                       (u16*)(p.ws + OFF_WFO) + (size_t)(l * 2 + f) * 1024 * 2816, tile, false, smem);
        } else if (r < 4992) {
          const float* src = (l & 1) ? p.w_in_odd + (size_t)(l >> 1) * 1024 * 3072 : p.w_in_even + (size_t)(l >> 1) * 1024 * 3072;
          convert_tile(src, 1024, 3072, (u16*)(p.ws + OFF_WMI) + (size_t)l * 3072 * 1024, r - 4224, false, smem);
        } else {
          const float* src = (l & 1) ? p.w_out_odd + (size_t)(l >> 1) * 1024 * 1024 : p.w_out_even + (size_t)(l >> 1) * 1024 * 1024;
          convert_tile(src, 1024, 1024, (u16*)(p.ws + OFF_WMO) + (size_t)l * 1024 * 1024, r - 4992, false, smem);
        }
      } else {
        int i2 = idx - 4 * 5248, eg = i2 >> 2, tile = i2 & 3;
        convert_tile(p.pool_w + (size_t)eg * 128 * 128, 128, 128, (u16*)(p.ws + OFF_WPL) + (size_t)eg * 128 * 128, tile, false, smem);
      }
    } else {
      float* LB = (float*)(p.ws + OFF_LB);
      for (int i = tid; i < 1024; i += 256) {
        float a0 = p.hg_lb[i], a1 = p.hg_lb[1024 + i];
        float mx = fmaxf(a0, a1), e0 = __expf(a0 - mx), e1 = __expf(a1 - mx);
        LB[i] = 0.f;
        LB[1024 + i] = e1 / (e0 + e1);
      }
      if (tid < 2) {
        const float* lv = p.da_lambda + tid * 256;
        float s0 = 0, s1 = 0;
        for (int i = 0; i < 64; ++i) { s0 += lv[i] * lv[64 + i]; s1 += lv[128 + i] * lv[192 + i]; }
        float li = 0.8f - 0.6f * expf(-0.3f * (float)(2 * tid + 1));
        ((float*)(p.ws + OFF_LAM))[tid] = expf(s0) - expf(s1) + li;
      }
      float* rope = (float*)(p.ws + OFF_ROPE);
      for (int i = tid; i < 1024; i += 256) {
        int pos = i >> 4, fi = i & 15;
        float inv = exp2f(-(float)fi * (13.287712379549449f / 16.f));
        float ang = (float)pos * inv;
        float k = rintf(ang * 0.15915494309189535f);
        float r = fmaf(-k, 6.28125f, ang);
        r = fmaf(-k, 1.9353071795864769e-3f, r);
        rope[i * 2] = cosf(r);
        rope[i * 2 + 1] = sinf(r);
      }
    }
  }
}

__device__ void phase_rows(const P& p, int mode, int l, int sub, int M, bool final_out) {
  const int tid = get_tid(), lane = tid & 63, wid = tid >> 6;
  float* X = (float*)(p.ws + OFF_X);
  const u16* Y = (const u16*)(p.ws + OFF_Y);
  u16* H = (u16*)(p.ws + OFF_H);
  const float* MODS = (const float*)(p.ws + OFF_MODS);
  int nl, si;
  if (mode == 0) { nl = 0; si = 0; }
  else if (sub == 0) { nl = l; si = 3; }
  else if (sub == 1) { nl = l; si = 6; }
  else { nl = l + 1; si = 0; }
  const float gs = (sub == 1) ? 1.f : 0.5f;
  const float* lg = p.ln_g + (size_t)(l * 3 + sub) * D;
  const float* lbp = p.ln_b + (size_t)(l * 3 + sub) * D;
  for (int row0 = ((blockIdx.x * 2 + get_vb()) * 4 + wid) * 2; row0 < M; row0 += gridDim.x * 16) {
    const int mr = mod_row(row0);
    const bool ksplit = (mode == 1) && (sub != 1) && (row0 >= ML);
    float v[2][16];
    if (mode == 0) {
#pragma unroll
      for (int r = 0; r < 2; ++r) {
        const int row = row0 + r;
        const float* src = row < ML ? p.x + (size_t)row * D : p.ctx + (size_t)(row - ML) * D;
#pragma unroll
        for (int i = 0; i < 4; ++i) {
          float4 t = *(const float4*)(src + i * 256 + lane * 4);
          v[r][i * 4] = t.x; v[r][i * 4 + 1] = t.y; v[r][i * 4 + 2] = t.z; v[r][i * 4 + 3] = t.w;
        }
      }
    } else {
      const float* gate = MODS + (size_t)(l * 5 + mr) * 9216 + (2 + 3 * sub) * 1024;
      float4 xv[2][4]; uint2 yv[2][4]; float4 gv[4];
#pragma unroll
      for (int r = 0; r < 2; ++r)
#pragma unroll
        for (int i = 0; i < 4; ++i) {
          int c = i * 256 + lane * 4;
          xv[r][i] = *(const float4*)(X + (size_t)(row0 + r) * D + c);
          if (!ksplit) yv[r][i] = *(const uint2*)(Y + (size_t)(row0 + r) * D + c);
        }
      float ysum[2][16];
      if (ksplit) {
        const u16* YC = (const u16*)(p.ws + OFF_YC);
#pragma unroll
        for (int r = 0; r < 2; ++r)
#pragma unroll
          for (int i = 0; i < 4; ++i) {
            int c = i * 256 + lane * 4;
            uint2 t0 = *(const uint2*)(YC + ((size_t)0 * MC + row0 + r - ML) * D + c), t1 = *(const uint2*)(YC + ((size_t)1 * MC + row0 + r - ML) * D + c);
            uint2 t2 = *(const uint2*)(YC + ((size_t)2 * MC + row0 + r - ML) * D + c), t3 = *(const uint2*)(YC + ((size_t)3 * MC + row0 + r - ML) * D + c);
            ysum[r][i * 4] = __uint_as_float(t0.x << 16) + __uint_as_float(t1.x << 16) + __uint_as_float(t2.x << 16) + __uint_as_float(t3.x << 16);
            ysum[r][i * 4 + 1] = __uint_as_float(t0.x & 0xffff0000u) + __uint_as_float(t1.x & 0xffff0000u) + __uint_as_float(t2.x & 0xffff0000u) + __uint_as_float(t3.x & 0xffff0000u);
            ysum[r][i * 4 + 2] = __uint_as_float(t0.y << 16) + __uint_as_float(t1.y << 16) + __uint_as_float(t2.y << 16) + __uint_as_float(t3.y << 16);
            ysum[r][i * 4 + 3] = __uint_as_float(t0.y & 0xffff0000u) + __uint_as_float(t1.y & 0xffff0000u) + __uint_as_float(t2.y & 0xffff0000u) + __uint_as_float(t3.y & 0xffff0000u);
          }
      }
#pragma unroll
      for (int i = 0; i < 4; ++i) gv[i] = *(const float4*)(gate + i * 256 + lane * 4);
      float s[2] = {0.f, 0.f};
#pragma unroll
      for (int r = 0; r < 2; ++r)
#pragma unroll
        for (int i = 0; i < 4; ++i) {
          float y0, y1, y2, y3;
          if (ksplit) { y0 = ysum[r][i * 4]; y1 = ysum[r][i * 4 + 1]; y2 = ysum[r][i * 4 + 2]; y3 = ysum[r][i * 4 + 3]; }
          else {
            y0 = bf2f((u16)(yv[r][i].x & 0xffff)); y1 = bf2f((u16)(yv[r][i].x >> 16));
            y2 = bf2f((u16)(yv[r][i].y & 0xffff)); y3 = bf2f((u16)(yv[r][i].y >> 16));
          }
          v[r][i * 4] = ALPHA * xv[r][i].x + gs * gv[i].x * y0; v[r][i * 4 + 1] = ALPHA * xv[r][i].y + gs * gv[i].y * y1;
          v[r][i * 4 + 2] = ALPHA * xv[r][i].z + gs * gv[i].z * y2; v[r][i * 4 + 3] = ALPHA * xv[r][i].w + gs * gv[i].w * y3;
          s[r] += v[r][i * 4] + v[r][i * 4 + 1] + v[r][i * 4 + 2] + v[r][i * 4 + 3];
        }
#pragma unroll
      for (int o = 1; o < 64; o <<= 1) { s[0] = xor_sum(s[0], o); s[1] = xor_sum(s[1], o); }
      float q[2] = {0.f, 0.f};
#pragma unroll
      for (int r = 0; r < 2; ++r) {
        const float mu = s[r] * (1.f / 1024.f);
#pragma unroll
        for (int i = 0; i < 16; ++i) { v[r][i] -= mu; q[r] += v[r][i] * v[r][i]; }
      }
#pragma unroll
      for (int o = 1; o < 64; o <<= 1) { q[0] = xor_sum(q[0], o); q[1] = xor_sum(q[1], o); }
#pragma unroll
      for (int i = 0; i < 4; ++i) {
        int c = i * 256 + lane * 4;
        float4 g4 = *(const float4*)(lg + c), b4 = *(const float4*)(lbp + c);
#pragma unroll
        for (int r = 0; r < 2; ++r) {
          const float rstd = rsqrtf(q[r] * (1.f / 1024.f) + 1e-5f);
          v[r][i * 4] = v[r][i * 4] * rstd * g4.x + b4.x; v[r][i * 4 + 1] = v[r][i * 4 + 1] * rstd * g4.y + b4.y;
          v[r][i * 4 + 2] = v[r][i * 4 + 2] * rstd * g4.z + b4.z; v[r][i * 4 + 3] = v[r][i * 4 + 3] * rstd * g4.w + b4.w;
        }
      }
    }
    if (final_out) {
#pragma unroll
      for (int r = 0; r < 2; ++r)
#pragma unroll
        for (int i = 0; i < 4; ++i)
          *(float4*)(p.out + (size_t)(row0 + r) * D + i * 256 + lane * 4) =
              float4{v[r][i * 4], v[r][i * 4 + 1], v[r][i * 4 + 2], v[r][i * 4 + 3]};
      continue;
    }
    const float* sh = MODS + (size_t)(nl * 5 + mr) * 9216 + si * 1024;
#pragma unroll
    for (int i = 0; i < 4; ++i) {
      int c = i * 256 + lane * 4;
      float4 s4 = *(const float4*)(sh + c), c4 = *(const float4*)(sh + 1024 + c);
#pragma unroll
      for (int r = 0; r < 2; ++r) {
        *(float4*)(X + (size_t)(row0 + r) * D + c) = float4{v[r][i * 4], v[r][i * 4 + 1], v[r][i * 4 + 2], v[r][i * 4 + 3]};
        uint2 hv = {pk2(v[r][i * 4] * (1.f + c4.x) + s4.x, v[r][i * 4 + 1] * (1.f + c4.y) + s4.y),
                    pk2(v[r][i * 4 + 2] * (1.f + c4.z) + s4.z, v[r][i * 4 + 3] * (1.f + c4.w) + s4.w)};
        *(uint2*)(H + (size_t)(row0 + r) * D + c) = hv;
      }
    }
  }
}

__device__ void phase_attn(const P& p, int l, char* smem) {
  int tid = threadIdx.x; asm volatile("" : "+v"(tid));
  const int lane = tid & 63, w = tid >> 6, fr = lane & 15, fq = lane >> 4;
  const int m = w & 1, pr = w >> 1;
  const u16* PROJ = (const u16*)(p.ws + OFF_PROJ);
  const u16* VT = (const u16*)(p.ws + OFF_VT);
  u16* MIX = (u16*)(p.ws + OFF_MIX);
  const float lam = ((const float*)(p.ws + OFF_LAM))[l >> 1];
  const float lam_init = 0.8f - 0.6f * expf(-0.3f * (float)l);
  const float* subw = p.da_sub_w + (l >> 1) * 128;
  const int xcd = blockIdx.x & 7, slot = blockIdx.x >> 3, nslot = gridDim.x >> 3;
  const int n_virt = (l == 3) ? 128 : 136;
  for (int idx = slot; idx < n_virt; idx += nslot) {
    int b, h, qrow0, nkt;
    if (idx < 128) {
      const int bh = (idx >> 5) * 8 + xcd;
      b = bh >> 3; h = bh & 7; qrow0 = b * 4096 + (idx & 31) * 128; nkt = 68;
    } else {
      const int cs = idx - 128, bh = (cs >> 1) * 8 + xcd;
      b = bh >> 3; h = bh & 7; qrow0 = ML + b * 256 + (cs & 1) * 128; nkt = 4;
    }
    bf16x8 qf[2][2];
#pragma unroll
    for (int qi = 0; qi < 2; ++qi) {
      const u16* qp = PROJ + (size_t)(qrow0 + pr * 32 + qi * 16 + fr) * 3072 + h * 128 + m * 64 + fq * 8;
#pragma unroll
      for (int ks = 0; ks < 2; ++ks) qf[qi][ks] = *(const bf16x8*)(qp + ks * 32);
    }
    f32x4 O[2][8];
#pragma unroll
    for (int qi = 0; qi < 2; ++qi)
#pragma unroll
      for (int v = 0; v < 8; ++v) O[qi][v] = f32x4{0.f, 0.f, 0.f, 0.f};
    float mrun[2] = {-1e30f, -1e30f}, lsum[2] = {0.f, 0.f};
    const u16* vbase = VT + (size_t)((b * 8 + h) * 128) * TK;
    auto stage = [&](int kt2) {
#pragma unroll
      for (int hf = 0; hf < 2; ++hf) {
        const int kt = kt2 * 2 + hf;
        char* buf = smem + (kt2 & 1) * 65536 + hf * 32768;
        const int krow0 = kt < 4 ? ML + b * 256 + kt * 64 : b * 4096 + (kt - 4) * 64;
#pragma unroll
        for (int i = 0; i < 2; ++i) {
          int q = tid + i * 512;
          int key = q >> 4, ch = (q & 15) ^ (key & 15);
          glds16(PROJ + (size_t)(krow0 + key) * 3072 + 1024 + h * 128 + ch * 8, buf + q * 16);
          int dv = q >> 3, c2 = (q & 7) ^ ((dv >> 1) & 7);
          glds16(vbase + (size_t)dv * TK + kt * 64 + c2 * 8, buf + 16384 + q * 16);
        }
      }
    };
    asm volatile("s_waitcnt vmcnt(0)" ::: "memory");
    __syncthreads();
    stage(0);
    for (int kt = 0; kt < nkt; ++kt) {
      if (!(kt & 1)) {
        asm volatile("s_waitcnt vmcnt(0)" ::: "memory");
        asm volatile("s_waitcnt lgkmcnt(0)" ::: "memory");
        __builtin_amdgcn_s_barrier();
        if (kt + 2 < nkt) stage((kt >> 1) + 1);
      }
      const char* cur = smem + ((kt >> 1) & 1) * 65536 + (kt & 1) * 32768;
      bf16x8 pb[2][2];
      f32x4 s[2][4];
      {
        bf16x8 kf[4][2];
#pragma unroll
        for (int sf = 0; sf < 4; ++sf)
#pragma unroll
          for (int ks = 0; ks < 2; ++ks) kf[sf][ks] = *(const bf16x8*)(cur + swz256(sf * 16 + fr, m * 8 + ks * 4 + fq));
        __builtin_amdgcn_sched_barrier(0);
#pragma unroll
        for (int sf = 0; sf < 4; ++sf) {
          s[0][sf] = f32x4{0.f, 0.f, 0.f, 0.f};
          s[1][sf] = f32x4{0.f, 0.f, 0.f, 0.f};
#pragma unroll
          for (int ks = 0; ks < 2; ++ks) {
            s[0][sf] = mfma16(kf[sf][ks], qf[0][ks], s[0][sf]);
            s[1][sf] = mfma16(kf[sf][ks], qf[1][ks], s[1][sf]);
          }
        }
      }
      float tm0 = -1e30f, tm1 = -1e30f;
#pragma unroll
      for (int sf = 0; sf < 4; ++sf)
#pragma unroll
        for (int j = 0; j < 4; ++j) { tm0 = fmaxf(tm0, s[0][sf][j]); tm1 = fmaxf(tm1, s[1][sf][j]); }
      if (__any(fmaxf(tm0 - mrun[0], tm1 - mrun[1]) > 6.f)) {
        tm0 = xor_max(tm0, 16); tm1 = xor_max(tm1, 16);
        tm0 = xor_max(tm0, 32); tm1 = xor_max(tm1, 32);
        const float mn0 = fmaxf(mrun[0], tm0), sc0 = ex2(mrun[0] - mn0);
        const float mn1 = fmaxf(mrun[1], tm1), sc1 = ex2(mrun[1] - mn1);
        mrun[0] = mn0; mrun[1] = mn1;
        lsum[0] *= sc0; lsum[1] *= sc1;
#pragma unroll
        for (int v = 0; v < 8; ++v) { O[0][v] *= sc0; O[1][v] *= sc1; }
      }
#pragma unroll
      for (int qi = 0; qi < 2; ++qi) {
        const float mn = mrun[qi];
        float ps = 0.f;
#pragma unroll
        for (int sf = 0; sf < 4; ++sf)
#pragma unroll
          for (int j = 0; j < 4; ++j) { s[qi][sf][j] = ex2(s[qi][sf][j] - mn); ps += s[qi][sf][j]; }
        lsum[qi] += ps;
#pragma unroll
        for (int k2 = 0; k2 < 2; ++k2) {
          union { bf16x8 v; unsigned u[4]; } t;
          t.u[0] = pk2(s[qi][2 * k2][0], s[qi][2 * k2][1]); t.u[1] = pk2(s[qi][2 * k2][2], s[qi][2 * k2][3]);
          t.u[2] = pk2(s[qi][2 * k2 + 1][0], s[qi][2 * k2 + 1][1]); t.u[3] = pk2(s[qi][2 * k2 + 1][2], s[qi][2 * k2 + 1][3]);
          pb[qi][k2] = t.v;
        }
      }
#pragma unroll
      for (int vb = 0; vb < 8; vb += 4) {
        bf16x8 a0[4], a1[4];
#pragma unroll
        for (int i = 0; i < 4; ++i) {
          const int dv = (vb + i) * 16 + fr;
          a0[i] = *(const bf16x8*)(cur + 16384 + swz128(dv, fq));
          a1[i] = *(const bf16x8*)(cur + 16384 + swz128(dv, 4 + fq));
        }
        __builtin_amdgcn_sched_barrier(0);
#pragma unroll
        for (int i = 0; i < 4; ++i) {
          O[0][vb + i] = mfma16(a0[i], pb[0][0], O[0][vb + i]);
          O[1][vb + i] = mfma16(a0[i], pb[1][0], O[1][vb + i]);
          O[0][vb + i] = mfma16(a1[i], pb[0][1], O[0][vb + i]);
          O[1][vb + i] = mfma16(a1[i], pb[1][1], O[1][vb + i]);
        }
        __builtin_amdgcn_sched_barrier(0);
      }
    }
    float* xch = (float*)smem + (size_t)pr * 4096;
    __syncthreads();
#pragma unroll
    for (int qi = 0; qi < 2; ++qi) {
      const float lq = xor_sum(xor_sum(lsum[qi], 16), 32);
      const float sc = (m ? lam : 1.f) / lq;
#pragma unroll
      for (int v = 0; v < 8; ++v) O[qi][v] *= sc;
    }
    if (m) {
#pragma unroll
      for (int qi = 0; qi < 2; ++qi)
#pragma unroll
        for (int v = 0; v < 8; ++v)
#pragma unroll
          for (int j = 0; j < 4; ++j) xch[((qi * 8 + v) * 4 + j) * 64 + lane] = O[qi][v][j];
    }
    __syncthreads();
    if (!m) {
#pragma unroll
      for (int qi = 0; qi < 2; ++qi) {
        float ssq = 0.f;
#pragma unroll
        for (int v = 0; v < 8; ++v)
#pragma unroll
          for (int j = 0; j < 4; ++j) { float o = O[qi][v][j] - xch[((qi * 8 + v) * 4 + j) * 64 + lane]; O[qi][v][j] = o; ssq += o * o; }
        ssq = xor_sum(xor_sum(ssq, 16), 32);
        const float rs = rsqrtf(ssq * (1.f / 128.f) + 1e-6f) * (1.f - lam_init);
        u16* op = MIX + (size_t)(qrow0 + pr * 32 + qi * 16 + fr) * D + h * 128;
#pragma unroll
        for (int v = 0; v < 8; ++v) {
          int dv = v * 16 + fq * 4;
          float4 sw = *(const float4*)(subw + dv);
          uint2 o = {pk2(O[qi][v][0] * rs * sw.x, O[qi][v][1] * rs * sw.y), pk2(O[qi][v][2] * rs * sw.z, O[qi][v][3] * rs * sw.w)};
          *(uint2*)(op + dv) = o;
        }
      }
    }
  }
}

__device__ __forceinline__ void chunk_rows(int b, int cc_seq, int& row0, int& pos0) {
  if (cc_seq < 4) { row0 = ML + b * 256 + cc_seq * 64; pos0 = cc_seq * 64; }
  else { row0 = b * 4096 + (cc_seq - 4) * 64; pos0 = CTX + (cc_seq - 4) * 64; }
}
__device__ __forceinline__ int scan2tok(int c, int dir) {
  if (!dir) return c;
  return c < 4 ? 3 - c : 4 + 63 - (c - 4);
}

__device__ void hg_u_item(const P& p, int e, int item, char* smem) {
  const int tid = get_tid(), lane = tid & 63, wid = tid >> 6, wr = wid >> 1, wc = wid & 1, fr = lane & 15, fq = lane >> 4;
  const u16* PROJ = (const u16*)(p.ws + OFF_PROJ);
  const u16* IT = (const u16*)(p.ws + OFF_VT);
  u16* U = (u16*)(p.ws + OFF_U);
  float* DEC = (float*)(p.ws + OFF_DEC);
  const float* LB = (const float*)(p.ws + OFF_LB);
  const int c = item % NCH, seq = item / NCH, dir = seq & 1, h = (seq >> 1) & 3, b = seq >> 3;
  int row0, pos0;
  chunk_rows(b, scan2tok(c, dir), row0, pos0);
  float* tot = (float*)(smem + 16384);
  const int d = tid & 127, half = tid >> 7;
  const float lb = LB[(e * 2 + dir) * 512 + h * 128 + d];
  const u16* zp = PROJ + (size_t)row0 * 3072 + 1536 + dir * 512 + h * 128 + d;
  __syncthreads();
  float sum = 0.f;
#pragma unroll 8
  for (int i = 0; i < 32; ++i) {
    int tau = half * 32 + i, t = dir ? 63 - tau : tau;
    float f = lb + (1.f - lb) * sigm(bf2f(zp[(size_t)t * 3072]));
    sum += __logf(fmaxf(f, 1e-20f));
  }
  tot[half * 128 + d] = sum;
  __syncthreads();
  float rel = half ? 0.f : tot[128 + d];
#pragma unroll 8
  for (int i = 31; i >= 0; --i) {
    int tau = half * 32 + i, t = dir ? 63 - tau : tau;
    float f = lb + (1.f - lb) * sigm(bf2f(zp[(size_t)t * 3072]));
    float lf = __logf(fmaxf(f, 1e-20f));
    { const int tp = kperm(t); *(u16*)(smem + swz128(d, tp >> 3) + (tp & 7) * 2) = f2bf((1.f - f) * __expf(rel)); }
    rel += lf;
  }
  if (!half) DEC[(size_t)(seq * NCH + c) * 128 + d] = __expf(rel);
  __syncthreads();
  f32x4 acc[4][4];
#pragma unroll
  for (int m = 0; m < 4; ++m)
#pragma unroll
    for (int n = 0; n < 4; ++n) acc[m][n] = f32x4{0.f, 0.f, 0.f, 0.f};
  const u16* vb = IT + (size_t)((b * 4 + h) * 128) * TK + pos0;
#pragma unroll
  for (int ks = 0; ks < 2; ++ks) {
    bf16x8 a[4], bb[4];
#pragma unroll
    for (int m = 0; m < 4; ++m) a[m] = *(const bf16x8*)(vb + (size_t)(wr * 64 + m * 16 + fr) * TK + ks * 32 + fq * 8);
#pragma unroll
    for (int n = 0; n < 4; ++n) bb[n] = *(const bf16x8*)(smem + swz128(wc * 64 + n * 16 + fr, ks * 4 + fq));
#pragma unroll
    for (int m = 0; m < 4; ++m)
#pragma unroll
      for (int n = 0; n < 4; ++n) acc[m][n] = mfma16(bb[n], a[m], acc[m][n]);
  }
  u16* up = U + (size_t)(seq * NCH + c) * 16384;
#pragma unroll
  for (int m = 0; m < 4; ++m)
#pragma unroll
    for (int n = 0; n < 4; ++n)
      *(uint2*)(up + (wr * 64 + m * 16 + fr) * 128 + wc * 64 + n * 16 + fq * 4) =
          uint2{pk2(acc[m][n][0], acc[m][n][1]), pk2(acc[m][n][2], acc[m][n][3])};
}

__device__ void pool_item(const P& p, int item) {
  const int tid = get_tid();
  const u16* PROJ = (const u16*)(p.ws + OFF_PROJ);
  u16* PO = (u16*)(p.ws + OFF_POOLED);
  const int ch = tid * 2, g = ch >> 7, hw = 1 << g;
  const int row0 = item * 32;
  int base, n, pos0;
  if (row0 < ML) { base = row0 & ~4095; n = 4096; pos0 = row0 & 4095; }
  else { base = ML + ((row0 - ML) & ~255); n = 256; pos0 = (row0 - ML) & 255; }
  const u16* up = PROJ + (size_t)base * 3072 + 2560 + ch;
  float s0 = 0.f, s1 = 0.f;
  {
    const int lo = max(pos0 - hw, 0), hi = min(pos0 + hw, n);
    for (int r = lo; r < hi; ++r) {
      unsigned v = *(const unsigned*)(up + (size_t)r * 3072);
      s0 += __uint_as_float(v << 16); s1 += __uint_as_float(v & 0xffff0000u);
    }
  }
  for (int i0 = 0; i0 < 32; i0 += 16) {
    unsigned ce[16], en[16], le[16];
#pragma unroll
    for (int i = 0; i < 16; ++i) {
      const int pos = pos0 + i0 + i;
      ce[i] = *(const unsigned*)(up + (size_t)pos * 3072);
      en[i] = (pos + hw < n) ? *(const unsigned*)(up + (size_t)(pos + hw) * 3072) : 0u;
      le[i] = (pos - hw >= 0) ? *(const unsigned*)(up + (size_t)(pos - hw) * 3072) : 0u;
    }
#pragma unroll
    for (int i = 0; i < 16; ++i) {
      const int pos = pos0 + i0 + i;
      const int lo = max(pos - hw, 0), hi = min(pos + hw, n);
      const float ic = 1.f / (float)(hi - lo);
      *(unsigned*)(PO + (size_t)(base + pos) * 512 + ch) =
          pk2(s0 * ic - __uint_as_float(ce[i] << 16), s1 * ic - __uint_as_float(ce[i] & 0xffff0000u));
      s0 += __uint_as_float(en[i] << 16) - __uint_as_float(le[i] << 16);
      s1 += __uint_as_float(en[i] & 0xffff0000u) - __uint_as_float(le[i] & 0xffff0000u);
    }
  }
}

__device__ void hg_scan_item(const P& p, int item) {
  unsigned* U = (unsigned*)(p.ws + OFF_U);
  const float* DEC = (const float*)(p.ws + OFF_DEC);
  const int ei = item * 256 + get_tid(), seq = ei >> 13, vd2 = ei & 8191, d = (vd2 & 63) * 2;
  unsigned* up = U + (size_t)seq * NCH * 8192 + vd2;
  const float* dp = DEC + (size_t)seq * NCH * 128 + d;
  float s0 = 0.f, s1 = 0.f;
  for (int c0 = 0; c0 < NCH; c0 += 17) {
    unsigned u[17]; float2 dd[17];
#pragma unroll
    for (int i = 0; i < 17; ++i) { u[i] = up[(size_t)(c0 + i) * 8192]; dd[i] = *(const float2*)(dp + (c0 + i) * 128); }
#pragma unroll
    for (int i = 0; i < 17; ++i) {
      up[(size_t)(c0 + i) * 8192] = pk2(s0, s1);
      s0 = dd[i].x * s0 + __uint_as_float(u[i] << 16);
      s1 = dd[i].y * s1 + __uint_as_float(u[i] & 0xffff0000u);
    }
  }
}

__device__ void hg_o_item(const P& p, int e, int item, char* smem) {
  const int tid = get_tid(), lane = tid & 63, w = tid >> 6, fr = lane & 15, fq = lane >> 4;
  const u16* PROJ = (const u16*)(p.ws + OFF_PROJ);
  const u16* IT = (const u16*)(p.ws + OFF_VT);
  const u16* S = (const u16*)(p.ws + OFF_U);
  const float* LB = (const float*)(p.ws + OFF_LB);
  u16* MIX = (u16*)(p.ws + OFF_MIX);
  const int tc = item % NCH, bh = item / NCH, h = bh & 3, b = bh >> 2;
  int row0, pos0;
  chunk_rows(b, tc, row0, pos0);
  char* qh = smem;
  char* kh = smem + 16384;
  char* vt = smem + 32768;
  float* eref = (float*)(smem + 49152);
  __syncthreads();
  {
    const u16* vb = IT + (size_t)((b * 4 + h) * 128) * TK + pos0;
#pragma unroll
    for (int i = 0; i < 4; ++i) {
      int q = tid + i * 256, dv = q >> 3, c2 = (q & 7) ^ ((dv >> 1) & 7);
      glds16(vb + (size_t)dv * TK + c2 * 8, vt + q * 16);
    }
  }
  f32x4 O[8];
#pragma unroll
  for (int v = 0; v < 8; ++v) O[v] = f32x4{0.f, 0.f, 0.f, 0.f};
  const int d = tid & 127, half = tid >> 7;
  for (int dir = 0; dir < 2; ++dir) {
    const int c = dir ? (tc < 4 ? 3 - tc : 4 + 63 - (tc - 4)) : tc;
    const int seq = (b * 4 + h) * 2 + dir;
    const float lb = LB[(e * 2 + dir) * 512 + h * 128 + d];
    const u16* zp = PROJ + (size_t)row0 * 3072 + 1536 + dir * 512 + h * 128 + d;
    const u16* qp = PROJ + (size_t)row0 * 3072 + h * 128 + d;
    if (dir) __syncthreads();
    float rel = 0.f;
    if (!half) {
#pragma unroll 8
      for (int tau = 31; tau >= 0; --tau) {
        int t = dir ? 63 - tau : tau;
        float f = lb + (1.f - lb) * sigm(bf2f(zp[(size_t)t * 3072]));
        float lf = __logf(fmaxf(f, 1e-20f));
        float q = bf2f(qp[(size_t)t * 3072]);
        int off = swz256(t, d >> 3) + (d & 7) * 2;
        *(u16*)(qh + off) = f2bf(q * __expf(rel));
        *(u16*)(kh + off) = f2bf((1.f - f) * __expf(-rel));
        rel -= lf;
      }
      eref[d] = __expf(-rel);
    } else {
#pragma unroll 8
      for (int tau = 32; tau < 64; ++tau) {
        int t = dir ? 63 - tau : tau;
        float f = lb + (1.f - lb) * sigm(bf2f(zp[(size_t)t * 3072]));
        float lf = __logf(fmaxf(f, 1e-20f));
        float q = bf2f(qp[(size_t)t * 3072]);
        rel += lf;
        int off = swz256(t, d >> 3) + (d & 7) * 2;
        *(u16*)(qh + off) = f2bf(q * __expf(rel));
        *(u16*)(kh + off) = f2bf((1.f - f) * __expf(-rel));
      }
    }
    __syncthreads();
    bf16x8 qf[4];
#pragma unroll
    for (int ks = 0; ks < 4; ++ks) qf[ks] = *(const bf16x8*)(qh + swz256(w * 16 + fr, ks * 4 + fq));
    f32x4 s[4];
#pragma unroll
    for (int sf = 0; sf < 4; ++sf) {
      s[sf] = f32x4{0.f, 0.f, 0.f, 0.f};
#pragma unroll
      for (int ks = 0; ks < 4; ++ks) {
        bf16x8 a = *(const bf16x8*)(kh + swz256(sf * 16 + fr, ks * 4 + fq));
        s[sf] = mfma16(a, qf[ks], s[sf]);
      }
    }
    const int tq = w * 16 + fr;
#pragma unroll
    for (int sf = 0; sf < 4; ++sf)
#pragma unroll
      for (int j = 0; j < 4; ++j) {
        int ss = sf * 16 + fq * 4 + j;
        bool keep = dir ? (ss >= tq) : (ss <= tq);
        s[sf][j] = keep ? s[sf][j] : 0.f;
      }
    bf16x8 pb[2];
#pragma unroll
    for (int k2 = 0; k2 < 2; ++k2) {
      union { bf16x8 v; unsigned u[4]; } t;
      t.u[0] = pk2(s[2 * k2][0], s[2 * k2][1]); t.u[1] = pk2(s[2 * k2][2], s[2 * k2][3]);
      t.u[2] = pk2(s[2 * k2 + 1][0], s[2 * k2 + 1][1]); t.u[3] = pk2(s[2 * k2 + 1][2], s[2 * k2 + 1][3]);
      pb[k2] = t.v;
    }
#pragma unroll
    for (int v = 0; v < 8; ++v)
#pragma unroll
      for (int k2 = 0; k2 < 2; ++k2) {
        const int dv = v * 16 + fr;
        union { bf16x8 v; uint2 u[2]; } a;
        a.v = *(const bf16x8*)(vt + swz128(dv, k2 * 4 + fq));
        O[v] = mfma16(a.v, pb[k2], O[v]);
      }
    const u16* sp = S + (size_t)(seq * NCH + c) * 16384;
#pragma unroll
    for (int ks = 0; ks < 4; ++ks) {
      union { bf16x8 v; u16 h[8]; unsigned u[4]; } qq, qs;
      qq.v = qf[ks];
      const float* er = eref + ks * 32 + fq * 8;
#pragma unroll
      for (int i = 0; i < 4; ++i) qs.u[i] = pk2(bf2f(qq.h[2 * i]) * er[2 * i], bf2f(qq.h[2 * i + 1]) * er[2 * i + 1]);
#pragma unroll
      for (int v = 0; v < 8; ++v) {
        const bf16x8 av = *(const bf16x8*)(sp + (v * 16 + fr) * 128 + ks * 32 + fq * 8);
        O[v] = mfma16(av, qs.v, O[v]);
      }
    }
  }
  float ssq = 0.f;
#pragma unroll
  for (int v = 0; v < 8; ++v)
#pragma unroll
    for (int j = 0; j < 4; ++j) ssq += O[v][j] * O[v][j];
  ssq = xor_sum(xor_sum(ssq, 16), 32);
  const float rs = rsqrtf(ssq * (1.f / 128.f) + 1e-6f);
  const int row = row0 + w * 16 + fr;
  const float* nw = p.hg_norm_w + e * 128;
#pragma unroll
  for (int v = 0; v < 8; ++v) {
    int dv = v * 16 + fq * 4;
    uint2 gv = *(const uint2*)(PROJ + (size_t)row * 3072 + 1024 + h * 128 + dv);
    float4 n4 = *(const float4*)(nw + dv);
    float g0 = bf2f((u16)(gv.x & 0xffff)), g1 = bf2f((u16)(gv.x >> 16)), g2 = bf2f((u16)(gv.y & 0xffff)), g3 = bf2f((u16)(gv.y >> 16));
    uint2 o = {pk2(O[v][0] * rs * n4.x * silu(g0), O[v][1] * rs * n4.y * silu(g1)),
               pk2(O[v][2] * rs * n4.z * silu(g2), O[v][3] * rs * n4.w * silu(g3))};
    *(uint2*)(MIX + (size_t)row * D + h * 128 + dv) = o;
  }
}

#define XB_TMO      128
#define XB_XCNT(j)  (256  + 64 * (j))
#define XB_XSUB(j)  (1280 + 64 * (j))
#define XB_XGEN(j)  (2304 + 64 * (j))
#define XB_TOP      3328
#define XB_TOPGEN   3392
#define XCD_BAR_WORDS 3456
#define XB_SPIN_CAP (1u << 18)
__device__ __forceinline__ unsigned xb_ld(unsigned* p) { return __hip_atomic_load(p, __ATOMIC_RELAXED, __HIP_MEMORY_SCOPE_AGENT); }
__device__ __forceinline__ unsigned xb_add(unsigned* p, unsigned v) { return __hip_atomic_fetch_add(p, v, __ATOMIC_RELAXED, __HIP_MEMORY_SCOPE_AGENT); }
__device__ __forceinline__ unsigned xb_xcc_id() { return (unsigned)__builtin_amdgcn_s_getreg((3 << 11) | 20) & 0xFu; }
#define XB_SPIN(cond, bar) do { unsigned _sp = 0; while (cond) { __builtin_amdgcn_s_sleep(1); \
    if ((++_sp & 255u) == 0u) { if (xb_ld(&(bar)[XB_TMO])) break; if (_sp > XB_SPIN_CAP) { atomicAdd(&(bar)[XB_TMO], 1u); break; } } } } while (0)
struct GB { unsigned* bar; unsigned x; volatile unsigned* st; };
__device__ __forceinline__ void gb_complete(unsigned* bar, unsigned x, unsigned& nloc, unsigned& nx) {
  const unsigned G = gridDim.x;
  unsigned sum, cnt, mine, sp = 0u;
  for (;;) {
    sum = 0u; cnt = 0u; mine = 0u;
#pragma unroll
    for (unsigned j = 0; j < 16; ++j) { const unsigned c = xb_ld(&bar[XB_XCNT(j)]); sum += c; cnt += (c > 0u) ? 1u : 0u; mine = (j == x) ? c : mine; }
    if (sum == G) break;
    __builtin_amdgcn_s_sleep(1);
    if ((++sp & 255u) == 0u) { if (xb_ld(&bar[XB_TMO])) break; if (sp > XB_SPIN_CAP) { atomicAdd(&bar[XB_TMO], 1u); break; } }
  }
  nloc = mine > 0u ? mine : 1u; nx = cnt > 0u ? cnt : 1u;
}
__device__ __forceinline__ void gbar(GB& b) {
  asm volatile("s_waitcnt vmcnt(0)" ::: "memory");
  __syncthreads();
  if (threadIdx.x == 0) {
    unsigned* bar = b.bar;
    __builtin_amdgcn_s_waitcnt(0);
    unsigned nloc = b.st[0], nx = b.st[1];
    if (nloc == 0u) { gb_complete(bar, b.x, nloc, nx); b.st[0] = nloc; b.st[1] = nx; }
    const unsigned old = xb_add(&bar[XB_XSUB(b.x)], 1u);
    const unsigned gen = old / nloc;
    if (old + 1u == (gen + 1u) * nloc) {
      __builtin_amdgcn_fence(__ATOMIC_RELEASE, "agent");
      asm volatile("s_waitcnt vmcnt(0)" ::: "memory");
      const unsigned og = xb_add(&bar[XB_TOP], 1u);
      const unsigned tg = og / nx;
      if (og + 1u == (tg + 1u) * nx) xb_add(&bar[XB_TOPGEN], 1u);
      else XB_SPIN(xb_ld(&bar[XB_TOPGEN]) == tg, bar);
      __builtin_amdgcn_fence(__ATOMIC_ACQUIRE, "agent");
      xb_add(&bar[XB_XGEN(b.x)], 1u);
      asm volatile("s_waitcnt vmcnt(0)" ::: "memory");
    } else {
      XB_SPIN(xb_ld(&bar[XB_XGEN(b.x)]) == gen, bar);
      __builtin_amdgcn_fence(__ATOMIC_ACQUIRE, "agent");
      asm volatile("s_waitcnt vmcnt(0)" ::: "memory");
    }
  }
  __syncthreads();
}

template <int K>
__device__ __forceinline__ void n1024_phase(const P& p, const u16* A, const u16* Wt, bool with_ctx, bool ksplit, char* smem) {
  u16* Y = (u16*)(p.ws + OFF_Y);
  u16* YC = (u16*)(p.ws + OFF_YC);
  gemm8<1024, K>(A, Wt, ML, smem, BlkY{Y});
  if (!with_ctx) return;
  const int vb = get_vb();
  char* vsm = smem + vb * 65536;
  if (ksplit) {
    for (int it = blockIdx.x; it < 128; it += gridDim.x) {
      const int u = 2 * it + vb, ks = u & 3, ct = u >> 2, pm = ct >> 3, pn = ct & 7;
      gemm_tile(A + ks * 704, K, Wt + ks * 704, K, 704, ML + pm * 128, pn * 128, vsm,
                Epi4<BlkY>{BlkY{YC + ((size_t)ks * MC - ML) * D}});
    }
  } else {
    for (int it = blockIdx.x; it < 32; it += gridDim.x) {
      const int u = 2 * it + vb, pm = u >> 3, pn = u & 7;
      gemm_tile(A, K, Wt, K, K, ML + pm * 128, pn * 128, vsm, Epi4<BlkY>{BlkY{Y}});
    }
  }
}

constexpr int PH_PER_EVEN = 12, PH_PER_ODD = 10;
constexpr int N_PHASES = 2 + 2 * PH_PER_EVEN + 2 * PH_PER_ODD;

__device__ __forceinline__ void run_phase(const P& pin, int ph, char* smem) {
  P p = pin;
  asm volatile("" : "+s"(p.ws));
  asm volatile("" : "+s"(p.out));
  const int vb = get_vb();
  char* vsm = smem + vb * 65536;
  u16* H = (u16*)(p.ws + OFF_H);
  u16* HID = (u16*)(p.ws + OFF_HID);
  u16* PROJ = (u16*)(p.ws + OFF_PROJ);
  u16* VT = (u16*)(p.ws + OFF_VT);
  u16* MIX = (u16*)(p.ws + OFF_MIX);
  if (ph == 0) { phase_prep(p, vsm); return; }
  if (ph == 1) { phase_rows(p, 0, 0, 0, MT, false); return; }
  int q = ph - 2, l;
  if (q < PH_PER_EVEN) l = 0;
  else if (q < PH_PER_EVEN + PH_PER_ODD) { l = 1; q -= PH_PER_EVEN; }
  else if (q < 2 * PH_PER_EVEN + PH_PER_ODD) { l = 2; q -= PH_PER_EVEN + PH_PER_ODD; }
  else { l = 3; q -= 2 * PH_PER_EVEN + PH_PER_ODD; }
  const bool even = !(l & 1), last = (l == 3);
  int step = q;
  if (!even && q >= 5) step = q + 2;
  const int Mpost = last ? ML : MT;
  const u16* WFI = (const u16*)(p.ws + OFF_WFI);
  const u16* WFO = (const u16*)(p.ws + OFF_WFO);
  const u16* WMI = (const u16*)(p.ws + OFF_WMI) + (size_t)l * 3072 * 1024;
  switch (step) {
    case 0:
    case 9: {
      const int f = (step == 9) ? 1 : 0;
      gemm8<5632, 1024>(H, WFI + (size_t)(l * 2 + f) * 5632 * 1024, f ? Mpost : MT, smem, BlkSwiglu{HID});
    } break;
    case 1:
    case 7:
    case 10: {
      if (step == 7) n1024_phase<1024>(p, MIX, (const u16*)(p.ws + OFF_WMO) + (size_t)l * 1024 * 1024, !last, false, smem);
      else n1024_phase<2816>(p, HID, WFO + (size_t)(l * 2 + (step == 10 ? 1 : 0)) * 1024 * 2816, step == 1 || !last, true, smem);
    } break;
    case 2: phase_rows(p, 1, l, 0, MT, false); break;
    case 3:
      if (even) {
        gemm8<3072, 1024>(H, WMI, ML, smem, BlkProjEven{PROJ, VT});
        for (int it = blockIdx.x; it < 96; it += gridDim.x) {
          const int u = 2 * it + vb, pm = u / 24, pn = u % 24;
          gemm_tile(H, D, WMI, D, 1024, ML + pm * 128, pn * 128, vsm, Epi4<BlkProjEven>{BlkProjEven{PROJ, VT}});
        }
      } else {
        const float* rope = (const float*)(p.ws + OFF_ROPE);
        gemm8<3072, 1024>(H, WMI, ML, smem, BlkProjOdd{PROJ, VT, rope});
        for (int it = blockIdx.x; it < 96; it += gridDim.x) {
          const int u = 2 * it + vb, pm = u / 24, pn = u % 24;
          gemm_tile(H, D, WMI, D, 1024, ML + pm * 128, pn * 128, vsm, Epi4<BlkProjOdd>{BlkProjOdd{PROJ, VT, rope}});
        }
      }
      break;
    case 4:
      if (even) {
        for (int itp = blockIdx.x; itp < (32 * NCH + MT / 32) / 2; itp += gridDim.x) {
          const int it = 2 * itp + vb;
          if (it < 32 * NCH) hg_u_item(p, l >> 1, it, vsm);
          else pool_item(p, it - 32 * NCH);
        }
      } else phase_attn(p, l, smem);
      break;
    case 5: {
      for (int itp = blockIdx.x; itp < (1024 + 4 * (MT / 128)) / 2; itp += gridDim.x) {
        const int it = 2 * itp + vb;
        if (it < 1024) hg_scan_item(p, it);
        else {
          int t = it - 1024, g = t / (MT / 128), mt = t % (MT / 128);
          gemm_tile((const u16*)(p.ws + OFF_POOLED) + g * 128, 512,
                    (const u16*)(p.ws + OFF_WPL) + (size_t)((l >> 1) * 4 + g) * 128 * 128, 128, 128, mt * 128, 0, vsm,
                    Epi4<BlkPool>{BlkPool{MIX, p.pool_scale + (l >> 1) * 512, g}});
        }
      }
    } break;
    case 6:
      for (int itp = blockIdx.x; itp < 8 * NCH; itp += gridDim.x) hg_o_item(p, l >> 1, 2 * itp + vb, vsm);
      break;
    case 8: phase_rows(p, 1, l, 1, Mpost, false); break;
    case 11: phase_rows(p, 1, l, 2, Mpost, last); break;
  }
}

constexpr int DYN_LDS = 131072 + 16;
__global__ void __launch_bounds__(512, 2) mega(P p, int ph_lo, int ph_hi) {
  extern __shared__ __attribute__((aligned(16))) char smem[];
  GB gb;
  gb.bar = (unsigned*)(p.ws + OFF_BAR); gb.x = xb_xcc_id(); gb.st = (volatile unsigned*)(smem + 131072);
  if (threadIdx.x == 0) { gb.st[0] = 0u; gb.st[1] = 0u; (void)xb_add(&gb.bar[XB_XCNT(gb.x)], 1u); }
  __syncthreads();
  for (int ph = ph_lo; ph < ph_hi; ++ph) {
    run_phase(p, ph, smem);
#ifdef PROBE_GEMM
    if (ph >= 2) {
      int q = ph - 2, l = 0;
      if (q < 12) l = 0; else if (q < 22) { l = 1; q -= 12; } else if (q < 34) { l = 2; q -= 22; } else { l = 3; q -= 34; }
      int step = q; if ((l & 1) && q >= 5) step = q + 2;
      if (step == 0 || step == 1 || step == 3 || step == 7 || step == 9 || step == 10) { __syncthreads(); run_phase(p, ph, smem); }
    }
#endif
#ifdef PROBE_ATT
    if (ph == 2 + 12 + 4 || ph == 2 + 34 + 4) { __syncthreads(); run_phase(p, ph, smem); }
#endif
    if (ph + 1 < ph_hi) {
      if (ph_hi < 0) cg::this_grid().sync();
      gbar(gb);
    }
  }
}

extern "C" void kernel_launch(void* const* d_in, const int* in_sizes, int n_in, void* d_out, int out_size, void* d_ws,
                              size_t ws_size, hipStream_t stream) {
  static int grid_blocks = 0;
  if (!grid_blocks) {
    int dev = 0, cus = 0, per_cu = 0;
    hipGetDevice(&dev);
    hipDeviceGetAttribute(&cus, hipDeviceAttributeMultiprocessorCount, dev);
    hipFuncSetAttribute((const void*)mega, hipFuncAttributeMaxDynamicSharedMemorySize, DYN_LDS);
    hipOccupancyMaxActiveBlocksPerMultiprocessor(&per_cu, mega, 512, DYN_LDS);
    if (per_cu > 1) per_cu = 1;
    grid_blocks = cus * per_cu;
  }
  if (ws_size < OFF_END2) { fprintf(stderr, "workspace too small: %zu < %zu\n", ws_size, (size_t)OFF_END); return; }
  P p{};
  const float** f = (const float**)&p;
  for (int i = 0; i < 20; ++i) f[i] = (const float*)d_in[i];
  p.out = (float*)d_out;
  p.ws = (char*)d_ws;
#if MULTI_LAUNCH
  for (int ph = 0; ph < N_PHASES; ++ph) hipLaunchKernelGGL(mega, dim3(grid_blocks), dim3(512), DYN_LDS, stream, p, ph, ph + 1);
#else
  hipMemsetAsync((char*)d_ws + OFF_BAR, 0, XCD_BAR_WORDS * 4, stream);
  int lo = 0, hi = N_PHASES;
  void* args[] = {&p, &lo, &hi};
  hipError_t e = hipLaunchCooperativeKernel((void*)mega, dim3(grid_blocks), dim3(512), args, DYN_LDS, stream);
  if (e != hipSuccess) fprintf(stderr, "cooperative launch failed: %s (grid %d)\n", hipGetErrorString(e), grid_blocks);
#endif
}
```

```cpp
#include <hip/hip_runtime.h>
#include <hip/hip_cooperative_groups.h>
#include <cstdio>
namespace cg = cooperative_groups;

typedef __attribute__((ext_vector_type(8))) short bf16x8;
typedef __attribute__((ext_vector_type(4))) float f32x4;
typedef unsigned short u16;

#ifndef MULTI_LAUNCH
#define MULTI_LAUNCH 0
#endif

constexpr int D = 1024, NB = 4, SEQ = 4096, CTX = 256, FH = 2816;
constexpr int ML = NB * SEQ, MC = NB * CTX, MT = ML + MC;
constexpr int TK = CTX + SEQ;
constexpr int NCH = TK / 64;
constexpr float ALPHA = 1.6817928305074290f;
constexpr float LOG2E = 1.4426950408889634f;

constexpr size_t al256(size_t x) { return (x + 255) & ~(size_t)255; }
constexpr size_t OFF_WFI = 0;
constexpr size_t OFF_WFO = OFF_WFI + al256((size_t)4 * 2 * 5632 * 1024 * 2);
constexpr size_t OFF_WMI = OFF_WFO + al256((size_t)4 * 2 * 1024 * 2816 * 2);
constexpr size_t OFF_WMO = OFF_WMI + al256((size_t)4 * 3072 * 1024 * 2);
constexpr size_t OFF_WPL = OFF_WMO + al256((size_t)4 * 1024 * 1024 * 2);
constexpr size_t OFF_MODS = OFF_WPL + al256((size_t)2 * 4 * 128 * 128 * 2);
constexpr size_t OFF_LB = OFF_MODS + al256((size_t)4 * 5 * 9216 * 4);
constexpr size_t OFF_LAM = OFF_LB + al256((size_t)2 * 2 * 512 * 4);
constexpr size_t OFF_ROPE = OFF_LAM + 256;
constexpr size_t OFF_DEC = OFF_ROPE + al256((size_t)64 * 16 * 2 * 4);
constexpr size_t OFF_X = OFF_DEC + al256((size_t)32 * NCH * 128 * 4);
constexpr size_t OFF_H = OFF_X + al256((size_t)MT * 1024 * 4);
constexpr size_t OFF_PROJ = OFF_H + al256((size_t)MT * 1024 * 2);
constexpr size_t OFF_VT = OFF_PROJ + al256((size_t)MT * 3072 * 2);
constexpr size_t OFF_MIX = OFF_VT + al256((size_t)NB * 8 * 128 * TK * 2);
constexpr size_t OFF_POOLED = OFF_MIX + al256((size_t)MT * 1024 * 2);
constexpr size_t OFF_HID = OFF_POOLED + al256((size_t)MT * 512 * 2);
constexpr size_t OFF_Y = OFF_HID + al256((size_t)MT * FH * 2);
constexpr size_t OFF_END = OFF_Y + al256((size_t)MT * 1024 * 4);
constexpr size_t OFF_YC = OFF_END;
constexpr size_t OFF_BAR = OFF_YC + al256((size_t)4 * MC * 1024 * 2);
constexpr size_t OFF_END2 = OFF_BAR + al256((size_t)3456 * 4);
constexpr size_t OFF_U = OFF_HID;
static_assert((size_t)32 * NCH * 16384 * 4 <= OFF_END - OFF_HID, "U alias too big");

struct P {
  const float *x, *c, *ctx, *c_ctx, *w_ada, *b_ada, *ln_g, *ln_b, *w_ffn_in, *w_ffn_out, *w_in_even, *w_out_even,
      *hg_lb, *hg_norm_w, *pool_w, *pool_scale, *w_in_odd, *w_out_odd, *da_lambda, *da_sub_w;
  float* out;
  char* ws;
};

typedef __attribute__((ext_vector_type(2))) __bf16 bf16v2;
typedef __attribute__((ext_vector_type(2))) float f32v2;
__device__ __forceinline__ unsigned pk2(float a, float b) {
  f32v2 v = {a, b};
  bf16v2 r = __builtin_convertvector(v, bf16v2);
  return *(unsigned*)&r;
}
__device__ __forceinline__ u16 f2bf(float f) { return (u16)(pk2(f, 0.f) & 0xffffu); }
__device__ __forceinline__ float bf2f(u16 h) { return __uint_as_float(((unsigned)h) << 16); }
__device__ __forceinline__ float sigm(float z) { return __builtin_amdgcn_rcpf(1.f + __expf(-z)); }
__device__ __forceinline__ float silu(float z) { return z * __builtin_amdgcn_rcpf(1.f + __expf(-z)); }
__device__ __forceinline__ float ex2(float x) { return __builtin_amdgcn_exp2f(x); }
__device__ __forceinline__ void glds16(const void* g, void* l) {
  __builtin_amdgcn_global_load_lds((const unsigned*)g, (unsigned*)l, 16, 0, 0);
}
__device__ __forceinline__ int get_tid() { int t = threadIdx.x & 255; asm volatile("" : "+v"(t)); return t; }
__device__ __forceinline__ int get_vb() { return __builtin_amdgcn_readfirstlane((int)(threadIdx.x >> 8)); }
__device__ __forceinline__ int swz128(int row, int ch) { return row * 128 + ((ch ^ ((row >> 1) & 7)) << 4); }
__device__ __forceinline__ int swz256(int row, int ch) { return row * 256 + ((ch ^ (row & 15)) << 4); }
__device__ __forceinline__ f32x4 mfma16(bf16x8 a, bf16x8 b, f32x4 c) {
  return __builtin_amdgcn_mfma_f32_16x16x32_bf16(a, b, c, 0, 0, 0);
}
__device__ __forceinline__ float xor_sum(float v, int m) { return v + __shfl_xor(v, m, 64); }
__device__ __forceinline__ float xor_max(float v, int m) { return fmaxf(v, __shfl_xor(v, m, 64)); }
__device__ __forceinline__ int kperm(int pos) { return (pos & ~31) | ((pos & 12) << 1) | ((pos & 16) >> 2) | (pos & 3); }
__device__ __forceinline__ void row_bpos(int row, int& b, int& pos) {
  if (row < ML) { b = row >> 12; pos = CTX + (row & 4095); }
  else { int r = row - ML; b = r >> 8; pos = r & 255; }
}
__device__ __forceinline__ int mod_row(int row) { return row < ML ? (row >> 12) : 4; }

constexpr int BM = 128, BN = 128, BK = 64;

template <class Epi>
__device__ __forceinline__ void gemm_tile(const u16* __restrict__ A, int lda, const u16* __restrict__ Bt, int ldb, int K,
                                          int m0, int n0, char* smem, const Epi& epi) {
  const int tid = get_tid(), lane = tid & 63, wid = tid >> 6, wr = wid >> 1, wc = wid & 1, fr = lane & 15, fq = lane >> 4;
  f32x4 acc[4][4];
#pragma unroll
  for (int m = 0; m < 4; ++m)
#pragma unroll
    for (int n = 0; n < 4; ++n) acc[m][n] = f32x4{0.f, 0.f, 0.f, 0.f};
  const int nk = K / BK;
  const u16* ga[4];
  const u16* gb[4];
#pragma unroll
  for (int i = 0; i < 4; ++i) {
    int q = tid + i * 256, row = q >> 3, ch = (q & 7) ^ ((row >> 1) & 7);
    ga[i] = A + (size_t)(m0 + row) * lda + ch * 8;
    gb[i] = Bt + (size_t)(n0 + row) * ldb + ch * 8;
  }
  __syncthreads();
#pragma unroll
  for (int i = 0; i < 4; ++i) {
    glds16(ga[i], smem + (tid + i * 256) * 16);
    glds16(gb[i], smem + 16384 + (tid + i * 256) * 16);
  }
  for (int kt = 0; kt < nk; ++kt) {
    __syncthreads();
    char* cur = smem + (kt & 1) * 32768;
    bf16x8 a[2][4], b[2][4];
#pragma unroll
    for (int ks = 0; ks < 2; ++ks) {
#pragma unroll
      for (int n = 0; n < 4; ++n) b[ks][n] = *(const bf16x8*)(cur + 16384 + swz128(wc * 64 + n * 16 + fr, ks * 4 + fq));
#pragma unroll
      for (int m = 0; m < 4; ++m) a[ks][m] = *(const bf16x8*)(cur + swz128(wr * 64 + m * 16 + fr, ks * 4 + fq));
    }
    __builtin_amdgcn_sched_barrier(0);
    if (kt + 1 < nk) {
      char* nxt = smem + ((kt + 1) & 1) * 32768;
#pragma unroll
      for (int i = 0; i < 4; ++i) {
        glds16(ga[i] + (kt + 1) * BK, nxt + (tid + i * 256) * 16);
        glds16(gb[i] + (kt + 1) * BK, nxt + 16384 + (tid + i * 256) * 16);
      }
    }
    __builtin_amdgcn_sched_barrier(0);
    __builtin_amdgcn_s_setprio(1);
#pragma unroll
    for (int ks = 0; ks < 2; ++ks)
#pragma unroll
      for (int m = 0; m < 4; ++m)
#pragma unroll
        for (int n = 0; n < 4; ++n) acc[m][n] = mfma16(b[ks][n], a[ks][m], acc[m][n]);
    __builtin_amdgcn_s_setprio(0);
  }
  epi(acc, m0 + wr * 64, n0 + wc * 64, fr, fq);
}

struct BlkSwiglu {
  u16* hid;
  __device__ __forceinline__ void operator()(const f32x4& f0, const f32x4& f1, int row, int cg, int fq) const {
    uint2 v = {pk2(silu(f0[0]) * f1[0], silu(f0[1]) * f1[1]), pk2(silu(f0[2]) * f1[2], silu(f0[3]) * f1[3])};
    *(uint2*)(hid + (size_t)row * FH + (cg >> 1) + fq * 4) = v;
  }
};
struct BlkY {
  u16* y;
  __device__ __forceinline__ void operator()(const f32x4& f0, const f32x4& f1, int row, int cg, int fq) const {
    u16* o = y + (size_t)row * D + cg + fq * 4;
    *(uint2*)o = uint2{pk2(f0[0], f0[1]), pk2(f0[2], f0[3])};
    *(uint2*)(o + 16) = uint2{pk2(f1[0], f1[1]), pk2(f1[2], f1[3])};
  }
};
struct BlkPool {
  u16* mix; const float* scale; int g;
  __device__ __forceinline__ void operator()(const f32x4& f0, const f32x4& f1, int row, int cg, int fq) const {
    const int col = g * 128 + cg + fq * 4;
    float4 s0 = *(const float4*)(scale + col), s1 = *(const float4*)(scale + col + 16);
    u16* o = mix + (size_t)row * D + 512 + col;
    *(uint2*)o = uint2{pk2(f0[0] * s0.x, f0[1] * s0.y), pk2(f0[2] * s0.z, f0[3] * s0.w)};
    *(uint2*)(o + 16) = uint2{pk2(f1[0] * s1.x, f1[1] * s1.y), pk2(f1[2] * s1.z, f1[3] * s1.w)};
  }
};
__device__ __forceinline__ void store_vt_blk(u16* vt, int nh, const f32x4& f0, const f32x4& f1, int row, int fc0, int fq) {
  int b, pos;
  row_bpos(row, b, pos);
  pos = kperm(pos);
  const int fc = fc0 + fq * 4, h = fc >> 7, f = fc & 127;
  u16* o = vt + ((size_t)((b * nh + h) * 128 + f)) * TK + pos;
#pragma unroll
  for (int j = 0; j < 4; ++j) { o[(size_t)j * TK] = f2bf(f0[j]); o[(size_t)(j + 16) * TK] = f2bf(f1[j]); }
}
struct BlkProjEven {
  u16* proj; u16* vt;
  __device__ __forceinline__ void operator()(const f32x4& f0, const f32x4& f1, int row, int cg, int fq) const {
    if (cg >= 512 && cg < 1024) { store_vt_blk(vt, 4, f0, f1, row, cg - 512, fq); return; }
    const float sc = (cg < 512) ? 0.08838834764831845f : 1.f;
    u16* o = proj + (size_t)row * 3072 + cg + fq * 4;
    *(uint2*)o = uint2{pk2(f0[0] * sc, f0[1] * sc), pk2(f0[2] * sc, f0[3] * sc)};
    *(uint2*)(o + 16) = uint2{pk2(f1[0] * sc, f1[1] * sc), pk2(f1[2] * sc, f1[3] * sc)};
  }
};
struct BlkProjOdd {
  u16* proj; u16* vt; const float* rope;
  __device__ __forceinline__ void operator()(const f32x4& f0, const f32x4& f1, int row, int cg, int fq) const {
    if (cg >= 2048) { store_vt_blk(vt, 8, f0, f1, row, cg - 2048, fq); return; }
    const float sc = (cg < 1024) ? 0.125f * LOG2E : 1.f;
    f32x4 v0 = f0, v1 = f1;
    if (row < ML) {
      const int t = row & 4095, pos = ((cg >> 5) & 1) ? (t & 63) : (t >> 6);
      const float* rr = rope + (pos * 16 + fq * 4) * 2;
      float4 r0 = *(const float4*)rr, r1 = *(const float4*)(rr + 4);
      float cs[4] = {r0.x, r0.z, r1.x, r1.z}, sn[4] = {r0.y, r0.w, r1.y, r1.w};
#pragma unroll
      for (int j = 0; j < 4; ++j) {
        float a0 = f0[j] * cs[j] - f1[j] * sn[j], a1 = f1[j] * cs[j] + f0[j] * sn[j];
        v0[j] = a0; v1[j] = a1;
      }
    }
    u16* o = proj + (size_t)row * 3072 + cg + fq * 4;
    *(uint2*)o = uint2{pk2(v0[0] * sc, v0[1] * sc), pk2(v0[2] * sc, v0[3] * sc)};
    *(uint2*)(o + 16) = uint2{pk2(v1[0] * sc, v1[1] * sc), pk2(v1[2] * sc, v1[3] * sc)};
  }
};
template <class Blk> struct Epi4 {
  Blk blk;
  __device__ __forceinline__ void operator()(f32x4 (&acc)[4][4], int rb, int cb, int fr, int fq) const {
#pragma unroll
    for (int m = 0; m < 4; ++m) {
      blk(acc[m][0], acc[m][1], rb + m * 16 + fr, cb, fq);
      blk(acc[m][2], acc[m][3], rb + m * 16 + fr, cb + 32, fq);
    }
  }
};

namespace pg8 {
#define PG8_LAS __attribute__((address_space(3)))
typedef unsigned short bf16_t;
typedef short bf16x8 __attribute__((ext_vector_type(8)));
typedef float f32x4 __attribute__((ext_vector_type(4)));
typedef unsigned u32x4 __attribute__((ext_vector_type(4)));
constexpr int BM = 256, BK = 64, HALF = 128, HTB = HALF * BK * 2  , STAGE_BYTES = 8 * HTB, NXCD = 8, WGM = 8;

__host__ __device__ __forceinline__ int lds_byte(int r, int c) { const int st = (r >> 4) * 2 + (c >> 5), rr = r & 15, cc = c & 31, ob = rr * 64 + cc * 2; return st * 1024 + (ob ^ (((ob >> 9) & 1) << 5)); }
__host__ __device__ __forceinline__ void stage_rc(int b, int& R, int& C) { const int st = b / 1024, sb = b % 1024, swz = sb ^ (((sb >> 9) & 1) << 5); R = (st >> 1) * 16 + swz / 64; C = (st & 1) * 32 + (swz % 64) / 2; }
__host__ __device__ __forceinline__ int perm32(int rho) { const int n = rho >> 4, i = rho & 15; return 8 * (i >> 2) + 4 * n + (i & 3); }

struct Unit { int pm, pn; };
struct Gemm { const bf16_t* A; const bf16_t* Bt; int M, N, K; };

struct StaticOrder {
    int nM, nN, nwg, G, c;
    __host__ __device__ void init(int M, int N, int G_, int c_) { nM = M / BM; nN = N / BM; nwg = nM * nN; G = G_; c = c_; }
    __host__ __device__ bool next(int i, Unit& u) const {
        const long L = (long)i * G + c; if (L >= nwg) return false;
        int wgid = (int)L; { const int q = nwg / NXCD, r = nwg % NXCD, xcd = wgid % NXCD, off = wgid / NXCD; wgid = (xcd < r ? xcd * (q + 1) : r * (q + 1) + (xcd - r) * q) + off; }
        const int nig = WGM * nN, gid = wgid / nig, fm = gid * WGM, gsz = (nM - fm) < WGM ? (nM - fm) : WGM;
        u.pm = fm + ((wgid % nig) % gsz); u.pn = (wgid % nig) / gsz; return true;
    }
    __device__ __forceinline__ void a_ready(const Unit&) const {}
    __device__ __forceinline__ void done(const Unit&) const {}
};

template <class Epi, class Sched, bool STAMP = false>
__device__ __forceinline__ void gemm_phase(PG8_LAS unsigned char* lds, const Gemm g, const Sched& S, const Epi& E, unsigned long long* stamps) {
    int tid = threadIdx.x; asm volatile("" : "+v"(tid));
    const int wid = __builtin_amdgcn_readfirstlane(tid >> 6), lane = tid & 63, wr = wid >> 2, wc = wid & 3, fr = lane & 15, fq = lane >> 4;
    const int K = g.K, nt = K / BK;
    int ts_lo = 0, ts_hi = 0, nts = 0; const unsigned long long rt_entry = STAMP ? (unsigned long long)wall_clock64() : 0ull;
#define PG8_STAMP() do { if (STAMP && wid == 0 && nts < 64) { const unsigned long long _c = (unsigned long long)clock64(); \
        ts_lo = (lane == nts) ? (int)(unsigned)_c : ts_lo; ts_hi = (lane == nts) ? (int)(unsigned)(_c >> 32) : ts_hi; ++nts; } } while (0)
    PG8_STAMP();
    unsigned voffA[2], voffB[2];
#pragma unroll
    for (int i = 0; i < 2; ++i) { int R, C; stage_rc(tid * 16 + i * 8192, R, C); const int Rb = Epi::PERM ? ((R & ~31) + perm32(R & 31)) : R;
        voffA[i] = (unsigned)(R * K + C) * 2u; voffB[i] = (unsigned)(Rb * K + C) * 2u; }
    const size_t kstep = (size_t)(BK * 2);
    const size_t hstep = (size_t)HALF * K * 2;
    const size_t tstep = 2 * hstep;
    const unsigned ldsw = (unsigned)wid * 1024u;
    const int aoff = lds_byte(wr * 64 + fr, fq * 8), boff = lds_byte(wc * 32 + fr, fq * 8);
#define PG8_SA(b, h) (((b) * 2 + (h)) * HTB)
#define PG8_SB(b, h) ((4 + (b) * 2 + (h)) * HTB)
#define PG8_STAGE(bufoff, gbase, voff) do { _Pragma("unroll") for (int _i = 0; _i < 2; ++_i) \
        __builtin_amdgcn_global_load_lds((const unsigned*)((const char*)(gbase) + (voff)[_i]), (PG8_LAS unsigned*)(lds + (bufoff) + ldsw + _i * 8192), 16, 0, 0); } while (0)
#define PG8_LDA(dst, b, h) do { _Pragma("unroll") for (int m = 0; m < 4; ++m) _Pragma("unroll") for (int k = 0; k < 2; ++k) dst[m][k] = *(const PG8_LAS bf16x8*)(lds + PG8_SA(b, h) + aoff + m * 2048 + k * 1024); } while (0)
#define PG8_LDB(dst, b, h) do { _Pragma("unroll") for (int n = 0; n < 2; ++n) _Pragma("unroll") for (int k = 0; k < 2; ++k) dst[n][k] = *(const PG8_LAS bf16x8*)(lds + PG8_SB(b, h) + boff + n * 2048 + k * 1024); } while (0)
#define PG8_MMA(ai, bj, At, Bt) do { __builtin_amdgcn_s_setprio(1); _Pragma("unroll") for (int m = 0; m < 4; ++m) _Pragma("unroll") for (int n = 0; n < 2; ++n) _Pragma("unroll") for (int k = 0; k < 2; ++k) \
        acc[ai][bj][m][n] = __builtin_amdgcn_mfma_f32_16x16x32_bf16(Bt[n][k], At[m][k], acc[ai][bj][m][n], 0, 0, 0); __builtin_amdgcn_s_setprio(0); } while (0)
#define PG8_WAIT_V(n) asm volatile("s_waitcnt vmcnt(" #n ")" ::: "memory")
#define PG8_WAIT_L(n) asm volatile("s_waitcnt lgkmcnt(" #n ")" ::: "memory")
#define PG8_BAR __builtin_amdgcn_s_barrier()
#define PG8_SCHED __builtin_amdgcn_sched_barrier(0)
    Unit cur, nxt; int ui = 0;
    if (!S.next(0, cur)) return;
    f32x4 acc[2][2][4][2];
#pragma unroll
    for (int a = 0; a < 2; ++a)
#pragma unroll
        for (int b = 0; b < 2; ++b)
#pragma unroll
            for (int m = 0; m < 4; ++m)
#pragma unroll
                for (int n = 0; n < 2; ++n) acc[a][b][m][n] = (f32x4){0.f, 0.f, 0.f, 0.f};
    bf16x8 At[4][2], B0[2][2], B1[2][2];
    const char* cA = (const char*)g.A + (size_t)cur.pm * tstep; const char* cB = (const char*)g.Bt + (size_t)cur.pn * tstep;
    S.a_ready(cur);
    PG8_STAGE(PG8_SB(0, 0), cB, voffB); PG8_STAGE(PG8_SA(0, 0), cA, voffA); PG8_STAGE(PG8_SB(0, 1), cB + hstep, voffB); PG8_STAGE(PG8_SA(0, 1), cA + hstep, voffA);
    if (wr == 1) PG8_BAR;
    PG8_WAIT_V(4); PG8_BAR;
    PG8_STAGE(PG8_SB(1, 0), cB + kstep, voffB); PG8_STAGE(PG8_SA(1, 0), cA + kstep, voffA); PG8_STAGE(PG8_SB(1, 1), cB + hstep + kstep, voffB);
    PG8_WAIT_V(6); PG8_BAR;
    PG8_STAMP();
    for (;;) {
        const bool has_next = S.next(ui + 1, nxt);
        const char* nA = has_next ? (const char*)g.A + (size_t)nxt.pm * tstep : cA; const char* nB = has_next ? (const char*)g.Bt + (size_t)nxt.pn * tstep : cB;
        for (int t = 0; t < nt; t += 2) {
            const bool last = (t == nt - 2);
            const char* a1 = cA + (size_t)(t + 1) * kstep;
            const char* a2 = last ? nA : cA + (size_t)(t + 2) * kstep; const char* b2 = last ? nB : cB + (size_t)(t + 2) * kstep;
            const char* a3 = a2 + kstep; const char* b3 = b2 + kstep;
            if (last && has_next) S.a_ready(nxt);
            PG8_LDB(B0, 0, 0); PG8_SCHED; PG8_LDA(At, 0, 0); PG8_STAGE(PG8_SA(1, 1), a1 + hstep, voffA);
            PG8_WAIT_L(8); PG8_BAR; PG8_WAIT_L(0); PG8_MMA(0, 0, At, B0); PG8_BAR; PG8_SCHED;
            PG8_LDB(B1, 0, 1); PG8_STAGE(PG8_SB(0, 0), b2, voffB);
            PG8_BAR; PG8_WAIT_L(0); PG8_MMA(0, 1, At, B1); PG8_BAR;
            PG8_LDA(At, 0, 1); PG8_STAGE(PG8_SA(0, 0), a2, voffA);
            PG8_BAR; PG8_WAIT_L(0); PG8_MMA(1, 0, At, B0); PG8_BAR; PG8_SCHED;
            PG8_STAGE(PG8_SB(0, 1), b2 + hstep, voffB);
            PG8_WAIT_V(6); PG8_BAR; PG8_MMA(1, 1, At, B1); PG8_BAR;
            PG8_LDB(B0, 1, 0); PG8_SCHED; PG8_LDA(At, 1, 0); PG8_STAGE(PG8_SA(0, 1), a2 + hstep, voffA);
            PG8_WAIT_L(8); PG8_BAR; PG8_WAIT_L(0); PG8_MMA(0, 0, At, B0); PG8_BAR; PG8_SCHED;
            PG8_LDB(B1, 1, 1); PG8_STAGE(PG8_SB(1, 0), b3, voffB);
            PG8_BAR; PG8_WAIT_L(0); PG8_MMA(0, 1, At, B1); PG8_BAR;
            PG8_LDA(At, 1, 1); PG8_STAGE(PG8_SA(1, 0), a3, voffA);
            PG8_BAR; PG8_WAIT_L(0); PG8_MMA(1, 0, At, B0); PG8_BAR; PG8_SCHED;
            PG8_STAGE(PG8_SB(1, 1), b3 + hstep, voffB);
            PG8_WAIT_V(6); PG8_BAR; PG8_MMA(1, 1, At, B1); PG8_BAR;
        }
        PG8_STAMP();
        if constexpr (!Epi::AFTER_DRAIN) { E(acc, cur, wr, wc, fr, fq); S.done(cur); }
        PG8_STAMP();
        if (!has_next) break;
#pragma unroll
        for (int a = 0; a < 2; ++a)
#pragma unroll
            for (int b = 0; b < 2; ++b)
#pragma unroll
                for (int m = 0; m < 4; ++m)
#pragma unroll
                    for (int n = 0; n < 2; ++n) acc[a][b][m][n] = (f32x4){0.f, 0.f, 0.f, 0.f};
        cur = nxt; cA = nA; cB = nB; ++ui;
    }
    PG8_WAIT_V(0);
    if (wr == 0) PG8_BAR;
    PG8_BAR;
    if constexpr (Epi::AFTER_DRAIN) { E.fused(acc, cur, wr, wc, fr, fq, lds, wid, lane); S.done(cur); }
    PG8_STAMP();
    if (STAMP && wid == 0) { stamps[lane] = lane < nts ? (((unsigned long long)(unsigned)ts_hi << 32) | (unsigned)ts_lo) : 0ull;
        if (lane == 62) stamps[62] = rt_entry; if (lane == 63) stamps[63] = (unsigned long long)wall_clock64(); }
#undef PG8_STAMP
#undef PG8_SA
#undef PG8_SB
#undef PG8_STAGE
#undef PG8_LDA
#undef PG8_LDB
#undef PG8_MMA
#undef PG8_WAIT_V
#undef PG8_WAIT_L
#undef PG8_BAR
#undef PG8_SCHED
}
}

template <class Blk> struct Epi8 {
  static constexpr bool PERM = false, AFTER_DRAIN = false;
  Blk blk;
  __device__ __forceinline__ void operator()(const f32x4 (&acc)[2][2][4][2], const pg8::Unit& u, int wr, int wc, int fr, int fq) const {
#pragma unroll
    for (int ai = 0; ai < 2; ++ai)
#pragma unroll
      for (int m = 0; m < 4; ++m) {
        const int row = u.pm * 256 + ai * 128 + wr * 64 + m * 16 + fr;
#pragma unroll
        for (int bj = 0; bj < 2; ++bj) blk(acc[ai][bj][m][0], acc[ai][bj][m][1], row, u.pn * 256 + bj * 128 + wc * 32, fq);
      }
  }
};
template <int N, int K, class Blk>
__device__ __forceinline__ void gemm8(const u16* A, const u16* Bt, int M, char* smem, const Blk& blk) {
  pg8::Gemm g{A, Bt, M, N, K};
  pg8::StaticOrder S;
  S.init(M, N, (int)gridDim.x, (int)blockIdx.x);
  pg8::gemm_phase<Epi8<Blk>, pg8::StaticOrder, false>((PG8_LAS unsigned char*)smem, g, S, Epi8<Blk>{blk}, nullptr);
  __syncthreads();
}

__device__ __forceinline__ void convert_tile(const float* __restrict__ src, int K, int N, u16* __restrict__ dst, int tile,
                                             bool swiglu, char* smem) {
  float* t = (float*)smem;
  const int tid = get_tid();
  const int nN = N / 64, nt = tile % nN, kt = tile / nN, k0 = kt * 64, n0 = nt * 64;
  __syncthreads();
#pragma unroll
  for (int i = 0; i < 4; ++i) {
    int k = (tid >> 4) + 16 * i, n4 = (tid & 15) * 4;
    float4 v = *(const float4*)(src + (size_t)(k0 + k) * N + n0 + n4);
    t[k * 65 + n4] = v.x; t[k * 65 + n4 + 1] = v.y; t[k * 65 + n4 + 2] = v.z; t[k * 65 + n4 + 3] = v.w;
  }
  __syncthreads();
#pragma unroll
  for (int i = 0; i < 2; ++i) {
    int q = tid + i * 256, n = q >> 3, kc = (q & 7) * 8;
    int c = n0 + n, nr = c;
    if (swiglu) nr = (c < FH) ? (32 * (c >> 4) + (c & 15)) : (32 * ((c - FH) >> 4) + 16 + ((c - FH) & 15));
    uint4 o = {pk2(t[kc * 65 + n], t[(kc + 1) * 65 + n]), pk2(t[(kc + 2) * 65 + n], t[(kc + 3) * 65 + n]),
               pk2(t[(kc + 4) * 65 + n], t[(kc + 5) * 65 + n]), pk2(t[(kc + 6) * 65 + n], t[(kc + 7) * 65 + n])};
    *(uint4*)(dst + (size_t)nr * K + k0 + kc) = o;
  }
}

__device__ void phase_prep(const P& p, char* smem) {
  const int tid = get_tid();
  constexpr int N_ADA = 1152, N_TR = 4 * 5248 + 32;
  const int vb = get_vb();
  for (int itp = blockIdx.x; itp < (N_ADA + N_TR) / 2 + 1; itp += gridDim.x) {
    const int item = (itp < (N_ADA + N_TR) / 2) ? 2 * itp + vb : (vb == 0 ? N_ADA + N_TR : -1);
    if (item < 0) continue;
    if (item < N_ADA) {
      float* act = (float*)smem;
      float* red = (float*)(smem + 20480);
      const int l = item / 288, cb = (item % 288) * 32;
      __syncthreads();
      for (int i = tid; i < 5120; i += 256) {
        int r = i >> 10, k = i & 1023;
        float v = r < 4 ? p.c[r * 1024 + k] : p.c_ctx[k];
        act[i] = silu(v);
      }
      __syncthreads();
      const int tx = tid & 31, kg = tid >> 5;
      float a0 = 0, a1 = 0, a2 = 0, a3 = 0, a4 = 0;
      const float* w = p.w_ada + ((size_t)l * 1024 + kg * 128) * 9216 + cb + tx;
      for (int k0 = 0; k0 < 128; k0 += 16) {
        float wv[16];
#pragma unroll
        for (int k = 0; k < 16; ++k) wv[k] = w[(size_t)(k0 + k) * 9216];
#pragma unroll
        for (int k = 0; k < 16; ++k) {
          int kk = kg * 128 + k0 + k;
          a0 += act[kk] * wv[k]; a1 += act[1024 + kk] * wv[k]; a2 += act[2048 + kk] * wv[k]; a3 += act[3072 + kk] * wv[k];
          a4 += act[4096 + kk] * wv[k];
        }
      }
      red[(kg * 5 + 0) * 32 + tx] = a0; red[(kg * 5 + 1) * 32 + tx] = a1; red[(kg * 5 + 2) * 32 + tx] = a2;
      red[(kg * 5 + 3) * 32 + tx] = a3; red[(kg * 5 + 4) * 32 + tx] = a4;
      __syncthreads();
      if (tid < 160) {
        int r = tid >> 5, x = tid & 31;
        float sacc = 0.f;
#pragma unroll
        for (int g8 = 0; g8 < 8; ++g8) sacc += red[(g8 * 5 + r) * 32 + x];
        ((float*)(p.ws + OFF_MODS))[(size_t)(l * 5 + r) * 9216 + cb + x] = sacc + p.b_ada[l * 9216 + cb + x];
      }
    } else if (item < N_ADA + N_TR) {
      int idx = item - N_ADA;
      if (idx < 4 * 5248) {
        int l = idx / 5248, r = idx % 5248;
        if (r < 2816) {
          int f = r / 1408, tile = r % 1408;
          convert_tile(p.w_ffn_in + (size_t)(l * 2 + f) * 1024 * 5632, 1024, 5632,
                       (u16*)(p.ws + OFF_WFI) + (size_t)(l * 2 + f) * 5632 * 1024, tile, true, smem);
        } else if (r < 4224) {
          int f = (r - 2816) / 704, tile = (r - 2816) % 704;
          convert_tile(p.w_ffn_out + (size_t)(l * 2 + f) * 2816 * 1024, 2816, 1024,
                       (u16*)(p.ws + OFF_WFO) + (size_t)(l * 2 + f) * 1024 * 2816, tile, false, smem);
        } else if (r < 4992) {
          const float* src = (l & 1) ? p.w_in_odd + (size_t)(l >> 1) * 1024 * 3072 : p.w_in_even + (size_t)(l >> 1) * 1024 * 3072;
          convert_tile(src, 1024, 3072, (u16*)(p.ws + OFF_WMI) + (size_t)l * 3072 * 1024, r - 4224, false, smem);
        } else {
          const float* src = (l & 1) ? p.w_out_odd + (size_t)(l >> 1) * 1024 * 1024 : p.w_out_even + (size_t)(l >> 1) * 1024 * 1024;
          convert_tile(src, 1024, 1024, (u16*)(p.ws + OFF_WMO) + (size_t)l * 1024 * 1024, r - 4992, false, smem);
        }
      } else {
        int i2 = idx - 4 * 5248, eg = i2 >> 2, tile = i2 & 3;
        convert_tile(p.pool_w + (size_t)eg * 128 * 128, 128, 128, (u16*)(p.ws + OFF_WPL) + (size_t)eg * 128 * 128, tile, false, smem);
      }
    } else {
      float* LB = (float*)(p.ws + OFF_LB);
      for (int i = tid; i < 1024; i += 256) {
        float a0 = p.hg_lb[i], a1 = p.hg_lb[1024 + i];
        float mx = fmaxf(a0, a1), e0 = __expf(a0 - mx), e1 = __expf(a1 - mx);
        LB[i] = 0.f;
        LB[1024 + i] = e1 / (e0 + e1);
      }
      if (tid < 2) {
        const float* lv = p.da_lambda + tid * 256;
        float s0 = 0, s1 = 0;
        for (int i = 0; i < 64; ++i) { s0 += lv[i] * lv[64 + i]; s1 += lv[128 + i] * lv[192 + i]; }
        float li = 0.8f - 0.6f * expf(-0.3f * (float)(2 * tid + 1));
        ((float*)(p.ws + OFF_LAM))[tid] = expf(s0) - expf(s1) + li;
      }
      float* rope = (float*)(p.ws + OFF_ROPE);
      for (int i = tid; i < 1024; i += 256) {
        int pos = i >> 4, fi = i & 15;
        float inv = exp2f(-(float)fi * (13.287712379549449f / 16.f));
        float ang = (float)pos * inv;
        float k = rintf(ang * 0.15915494309189535f);
        float r = fmaf(-k, 6.28125f, ang);
        r = fmaf(-k, 1.9353071795864769e-3f, r);
        rope[i * 2] = cosf(r);
        rope[i * 2 + 1] = sinf(r);
      }
    }
  }
}

__device__ void phase_rows(const P& p, int mode, int l, int sub, int M, bool final_out) {
  const int tid = get_tid(), lane = tid & 63, wid = tid >> 6;
  float* X = (float*)(p.ws + OFF_X);
  const u16* Y = (const u16*)(p.ws + OFF_Y);
  u16* H = (u16*)(p.ws + OFF_H);
  const float* MODS = (const float*)(p.ws + OFF_MODS);
  int nl, si;
  if (mode == 0) { nl = 0; si = 0; }
  else if (sub == 0) { nl = l; si = 3; }
  else if (sub == 1) { nl = l; si = 6; }
  else { nl = l + 1; si = 0; }
  const float gs = (sub == 1) ? 1.f : 0.5f;
  const float* lg = p.ln_g + (size_t)(l * 3 + sub) * D;
  const float* lbp = p.ln_b + (size_t)(l * 3 + sub) * D;
  for (int row0 = ((blockIdx.x * 2 + get_vb()) * 4 + wid) * 2; row0 < M; row0 += gridDim.x * 16) {
    const int mr = mod_row(row0);
    const bool ksplit = (mode == 1) && (sub != 1) && (row0 >= ML);
    float v[2][16];
    if (mode == 0) {
#pragma unroll
      for (int r = 0; r < 2; ++r) {
        const int row = row0 + r;
        const float* src = row < ML ? p.x + (size_t)row * D : p.ctx + (size_t)(row - ML) * D;
#pragma unroll
        for (int i = 0; i < 4; ++i) {
          float4 t = *(const float4*)(src + i * 256 + lane * 4);
          v[r][i * 4] = t.x; v[r][i * 4 + 1] = t.y; v[r][i * 4 + 2] = t.z; v[r][i * 4 + 3] = t.w;
        }
      }
    } else {
      const float* gate = MODS + (size_t)(l * 5 + mr) * 9216 + (2 + 3 * sub) * 1024;
      float4 xv[2][4]; uint2 yv[2][4]; float4 gv[4];
#pragma unroll
      for (int r = 0; r < 2; ++r)
#pragma unroll
        for (int i = 0; i < 4; ++i) {
          int c = i * 256 + lane * 4;
          xv[r][i] = *(const float4*)(X + (size_t)(row0 + r) * D + c);
          if (!ksplit) yv[r][i] = *(const uint2*)(Y + (size_t)(row0 + r) * D + c);
        }
      float ysum[2][16];
      if (ksplit) {
        const u16* YC = (const u16*)(p.ws + OFF_YC);
#pragma unroll
        for (int r = 0; r < 2; ++r)
#pragma unroll
          for (int i = 0; i < 4; ++i) {
            int c = i * 256 + lane * 4;
            uint2 t0 = *(const uint2*)(YC + ((size_t)0 * MC + row0 + r - ML) * D + c), t1 = *(const uint2*)(YC + ((size_t)1 * MC + row0 + r - ML) * D + c);
            uint2 t2 = *(const uint2*)(YC + ((size_t)2 * MC + row0 + r - ML) * D + c), t3 = *(const uint2*)(YC + ((size_t)3 * MC + row0 + r - ML) * D + c);
            ysum[r][i * 4] = __uint_as_float(t0.x << 16) + __uint_as_float(t1.x << 16) + __uint_as_float(t2.x << 16) + __uint_as_float(t3.x << 16);
            ysum[r][i * 4 + 1] = __uint_as_float(t0.x & 0xffff0000u) + __uint_as_float(t1.x & 0xffff0000u) + __uint_as_float(t2.x & 0xffff0000u) + __uint_as_float(t3.x & 0xffff0000u);
            ysum[r][i * 4 + 2] = __uint_as_float(t0.y << 16) + __uint_as_float(t1.y << 16) + __uint_as_float(t2.y << 16) + __uint_as_float(t3.y << 16);
            ysum[r][i * 4 + 3] = __uint_as_float(t0.y & 0xffff0000u) + __uint_as_float(t1.y & 0xffff0000u) + __uint_as_float(t2.y & 0xffff0000u) + __uint_as_float(t3.y & 0xffff0000u);
          }
      }
#pragma unroll
      for (int i = 0; i < 4; ++i) gv[i] = *(const float4*)(gate + i * 256 + lane * 4);
      float s[2] = {0.f, 0.f};
#pragma unroll
      for (int r = 0; r < 2; ++r)
#pragma unroll
        for (int i = 0; i < 4; ++i) {
          float y0, y1, y2, y3;
          if (ksplit) { y0 = ysum[r][i * 4]; y1 = ysum[r][i * 4 + 1]; y2 = ysum[r][i * 4 + 2]; y3 = ysum[r][i * 4 + 3]; }
          else {
            y0 = bf2f((u16)(yv[r][i].x & 0xffff)); y1 = bf2f((u16)(yv[r][i].x >> 16));
            y2 = bf2f((u16)(yv[r][i].y & 0xffff)); y3 = bf2f((u16)(yv[r][i].y >> 16));
          }
          v[r][i * 4] = ALPHA * xv[r][i].x + gs * gv[i].x * y0; v[r][i * 4 + 1] = ALPHA * xv[r][i].y + gs * gv[i].y * y1;
          v[r][i * 4 + 2] = ALPHA * xv[r][i].z + gs * gv[i].z * y2; v[r][i * 4 + 3] = ALPHA * xv[r][i].w + gs * gv[i].w * y3;
          s[r] += v[r][i * 4] + v[r][i * 4 + 1] + v[r][i * 4 + 2] + v[r][i * 4 + 3];
        }
#pragma unroll
      for (int o = 1; o < 64; o <<= 1) { s[0] = xor_sum(s[0], o); s[1] = xor_sum(s[1], o); }
      float q[2] = {0.f, 0.f};
#pragma unroll
      for (int r = 0; r < 2; ++r) {
        const float mu = s[r] * (1.f / 1024.f);
#pragma unroll
        for (int i = 0; i < 16; ++i) { v[r][i] -= mu; q[r] += v[r][i] * v[r][i]; }
      }
#pragma unroll
      for (int o = 1; o < 64; o <<= 1) { q[0] = xor_sum(q[0], o); q[1] = xor_sum(q[1], o); }
#pragma unroll
      for (int i = 0; i < 4; ++i) {
        int c = i * 256 + lane * 4;
        float4 g4 = *(const float4*)(lg + c), b4 = *(const float4*)(lbp + c);
#pragma unroll
        for (int r = 0; r < 2; ++r) {
          const float rstd = rsqrtf(q[r] * (1.f / 1024.f) + 1e-5f);
          v[r][i * 4] = v[r][i * 4] * rstd * g4.x + b4.x; v[r][i * 4 + 1] = v[r][i * 4 + 1] * rstd * g4.y + b4.y;
          v[r][i * 4 + 2] = v[r][i * 4 + 2] * rstd * g4.z + b4.z; v[r][i * 4 + 3] = v[r][i * 4 + 3] * rstd * g4.w + b4.w;
        }
      }
    }
    if (final_out) {
#pragma unroll
      for (int r = 0; r < 2; ++r)
#pragma unroll
        for (int i = 0; i < 4; ++i)
          *(float4*)(p.out + (size_t)(row0 + r) * D + i * 256 + lane * 4) =
              float4{v[r][i * 4], v[r][i * 4 + 1], v[r][i * 4 + 2], v[r][i * 4 + 3]};
      continue;
    }
    const float* sh = MODS + (size_t)(nl * 5 + mr) * 9216 + si * 1024;
#pragma unroll
    for (int i = 0; i < 4; ++i) {
      int c = i * 256 + lane * 4;
      float4 s4 = *(const float4*)(sh + c), c4 = *(const float4*)(sh + 1024 + c);
#pragma unroll
      for (int r = 0; r < 2; ++r) {
        *(float4*)(X + (size_t)(row0 + r) * D + c) = float4{v[r][i * 4], v[r][i * 4 + 1], v[r][i * 4 + 2], v[r][i * 4 + 3]};
        uint2 hv = {pk2(v[r][i * 4] * (1.f + c4.x) + s4.x, v[r][i * 4 + 1] * (1.f + c4.y) + s4.y),
                    pk2(v[r][i * 4 + 2] * (1.f + c4.z) + s4.z, v[r][i * 4 + 3] * (1.f + c4.w) + s4.w)};
        *(uint2*)(H + (size_t)(row0 + r) * D + c) = hv;
      }
    }
  }
}

__device__ void phase_attn(const P& p, int l, char* smem) {
  int tid = threadIdx.x; asm volatile("" : "+v"(tid));
  const int lane = tid & 63, w = tid >> 6, fr = lane & 15, fq = lane >> 4;
  const int m = w & 1, pr = w >> 1;
  const u16* PROJ = (const u16*)(p.ws + OFF_PROJ);
  const u16* VT = (const u16*)(p.ws + OFF_VT);
  u16* MIX = (u16*)(p.ws + OFF_MIX);
  const float lam = ((const float*)(p.ws + OFF_LAM))[l >> 1];
  const float lam_init = 0.8f - 0.6f * expf(-0.3f * (float)l);
  const float* subw = p.da_sub_w + (l >> 1) * 128;
  const int xcd = blockIdx.x & 7, slot = blockIdx.x >> 3, nslot = gridDim.x >> 3;
  const int n_virt = (l == 3) ? 128 : 136;
  for (int idx = slot; idx < n_virt; idx += nslot) {
    int b, h, qrow0, nkt;
    if (idx < 128) {
      const int bh = (idx >> 5) * 8 + xcd;
      b = bh >> 3; h = bh & 7; qrow0 = b * 4096 + (idx & 31) * 128; nkt = 68;
    } else {
      const int cs = idx - 128, bh = (cs >> 1) * 8 + xcd;
      b = bh >> 3; h = bh & 7; qrow0 = ML + b * 256 + (cs & 1) * 128; nkt = 4;
    }
    bf16x8 qf[2][2];
#pragma unroll
    for (int qi = 0; qi < 2; ++qi) {
      const u16* qp = PROJ + (size_t)(qrow0 + pr * 32 + qi * 16 + fr) * 3072 + h * 128 + m * 64 + fq * 8;
#pragma unroll
      for (int ks = 0; ks < 2; ++ks) qf[qi][ks] = *(const bf16x8*)(qp + ks * 32);
    }
    f32x4 O[2][8];
#pragma unroll
    for (int qi = 0; qi < 2; ++qi)
#pragma unroll
      for (int v = 0; v < 8; ++v) O[qi][v] = f32x4{0.f, 0.f, 0.f, 0.f};
    float mrun[2] = {-1e30f, -1e30f}, lsum[2] = {0.f, 0.f};
    const u16* vbase = VT + (size_t)((b * 8 + h) * 128) * TK;
    auto stage = [&](int kt2) {
#pragma unroll
      for (int hf = 0; hf < 2; ++hf) {
        const int kt = kt2 * 2 + hf;
        char* buf = smem + (kt2 & 1) * 65536 + hf * 32768;
        const int krow0 = kt < 4 ? ML + b * 256 + kt * 64 : b * 4096 + (kt - 4) * 64;
#pragma unroll
        for (int i = 0; i < 2; ++i) {
          int q = tid + i * 512;
          int key = q >> 4, ch = (q & 15) ^ (key & 15);
          glds16(PROJ + (size_t)(krow0 + key) * 3072 + 1024 + h * 128 + ch * 8, buf + q * 16);
          int dv = q >> 3, c2 = (q & 7) ^ ((dv >> 1) & 7);
          glds16(vbase + (size_t)dv * TK + kt * 64 + c2 * 8, buf + 16384 + q * 16);
        }
      }
    };
    asm volatile("s_waitcnt vmcnt(0)" ::: "memory");
    __syncthreads();
    stage(0);
    for (int kt = 0; kt < nkt; ++kt) {
      if (!(kt & 1)) {
        asm volatile("s_waitcnt vmcnt(0)" ::: "memory");
        asm volatile("s_waitcnt lgkmcnt(0)" ::: "memory");
        __builtin_amdgcn_s_barrier();
        if (kt + 2 < nkt) stage((kt >> 1) + 1);
      }
      const char* cur = smem + ((kt >> 1) & 1) * 65536 + (kt & 1) * 32768;
      bf16x8 pb[2][2];
      f32x4 s[2][4];
      {
        bf16x8 kf[4][2];
#pragma unroll
        for (int sf = 0; sf < 4; ++sf)
#pragma unroll
          for (int ks = 0; ks < 2; ++ks) kf[sf][ks] = *(const bf16x8*)(cur + swz256(sf * 16 + fr, m * 8 + ks * 4 + fq));
        __builtin_amdgcn_sched_barrier(0);
#pragma unroll
        for (int sf = 0; sf < 4; ++sf) {
          s[0][sf] = f32x4{0.f, 0.f, 0.f, 0.f};
          s[1][sf] = f32x4{0.f, 0.f, 0.f, 0.f};
#pragma unroll
          for (int ks = 0; ks < 2; ++ks) {
            s[0][sf] = mfma16(kf[sf][ks], qf[0][ks], s[0][sf]);
            s[1][sf] = mfma16(kf[sf][ks], qf[1][ks], s[1][sf]);
          }
        }
      }
      float tm0 = -1e30f, tm1 = -1e30f;
#pragma unroll
      for (int sf = 0; sf < 4; ++sf)
#pragma unroll
        for (int j = 0; j < 4; ++j) { tm0 = fmaxf(tm0, s[0][sf][j]); tm1 = fmaxf(tm1, s[1][sf][j]); }
      if (__any(fmaxf(tm0 - mrun[0], tm1 - mrun[1]) > 6.f)) {
        tm0 = xor_max(tm0, 16); tm1 = xor_max(tm1, 16);
        tm0 = xor_max(tm0, 32); tm1 = xor_max(tm1, 32);
        const float mn0 = fmaxf(mrun[0], tm0), sc0 = ex2(mrun[0] - mn0);
        const float mn1 = fmaxf(mrun[1], tm1), sc1 = ex2(mrun[1] - mn1);
        mrun[0] = mn0; mrun[1] = mn1;
        lsum[0] *= sc0; lsum[1] *= sc1;
#pragma unroll
        for (int v = 0; v < 8; ++v) { O[0][v] *= sc0; O[1][v] *= sc1; }
      }
#pragma unroll
      for (int qi = 0; qi < 2; ++qi) {
        const float mn = mrun[qi];
        float ps = 0.f;
#pragma unroll
        for (int sf = 0; sf < 4; ++sf)
#pragma unroll
          for (int j = 0; j < 4; ++j) { s[qi][sf][j] = ex2(s[qi][sf][j] - mn); ps += s[qi][sf][j]; }
        lsum[qi] += ps;
#pragma unroll
        for (int k2 = 0; k2 < 2; ++k2) {
          union { bf16x8 v; unsigned u[4]; } t;
          t.u[0] = pk2(s[qi][2 * k2][0], s[qi][2 * k2][1]); t.u[1] = pk2(s[qi][2 * k2][2], s[qi][2 * k2][3]);
          t.u[2] = pk2(s[qi][2 * k2 + 1][0], s[qi][2 * k2 + 1][1]); t.u[3] = pk2(s[qi][2 * k2 + 1][2], s[qi][2 * k2 + 1][3]);
          pb[qi][k2] = t.v;
        }
      }
#pragma unroll
      for (int vb = 0; vb < 8; vb += 4) {
        bf16x8 a0[4], a1[4];
#pragma unroll
        for (int i = 0; i < 4; ++i) {
          const int dv = (vb + i) * 16 + fr;
          a0[i] = *(const bf16x8*)(cur + 16384 + swz128(dv, fq));
          a1[i] = *(const bf16x8*)(cur + 16384 + swz128(dv, 4 + fq));
        }
        __builtin_amdgcn_sched_barrier(0);
        __builtin_amdgcn_s_setprio(1);
#pragma unroll
        for (int i = 0; i < 4; ++i) {
          O[0][vb + i] = mfma16(a0[i], pb[0][0], O[0][vb + i]);
          O[1][vb + i] = mfma16(a0[i], pb[1][0], O[1][vb + i]);
          O[0][vb + i] = mfma16(a1[i], pb[0][1], O[0][vb + i]);
          O[1][vb + i] = mfma16(a1[i], pb[1][1], O[1][vb + i]);
        }
        __builtin_amdgcn_s_setprio(0);
        __builtin_amdgcn_sched_barrier(0);
      }
    }
    float* xch = (float*)smem + (size_t)pr * 4096;
    __syncthreads();
#pragma unroll
    for (int qi = 0; qi < 2; ++qi) {
      const float lq = xor_sum(xor_sum(lsum[qi], 16), 32);
      const float sc = (m ? lam : 1.f) / lq;
#pragma unroll
      for (int v = 0; v < 8; ++v) O[qi][v] *= sc;
    }
    if (m) {
#pragma unroll
      for (int qi = 0; qi < 2; ++qi)
#pragma unroll
        for (int v = 0; v < 8; ++v)
#pragma unroll
          for (int j = 0; j < 4; ++j) xch[((qi * 8 + v) * 4 + j) * 64 + lane] = O[qi][v][j];
    }
    __syncthreads();
    if (!m) {
#pragma unroll
      for (int qi = 0; qi < 2; ++qi) {
        float ssq = 0.f;
#pragma unroll
        for (int v = 0; v < 8; ++v)
#pragma unroll
          for (int j = 0; j < 4; ++j) { float o = O[qi][v][j] - xch[((qi * 8 + v) * 4 + j) * 64 + lane]; O[qi][v][j] = o; ssq += o * o; }
        ssq = xor_sum(xor_sum(ssq, 16), 32);
        const float rs = rsqrtf(ssq * (1.f / 128.f) + 1e-6f) * (1.f - lam_init);
        u16* op = MIX + (size_t)(qrow0 + pr * 32 + qi * 16 + fr) * D + h * 128;
#pragma unroll
        for (int v = 0; v < 8; ++v) {
          int dv = v * 16 + fq * 4;
          float4 sw = *(const float4*)(subw + dv);
          uint2 o = {pk2(O[qi][v][0] * rs * sw.x, O[qi][v][1] * rs * sw.y), pk2(O[qi][v][2] * rs * sw.z, O[qi][v][3] * rs * sw.w)};
          *(uint2*)(op + dv) = o;
        }
      }
    }
  }
}

__device__ __forceinline__ void chunk_rows(int b, int cc_seq, int& row0, int& pos0) {
  if (cc_seq < 4) { row0 = ML + b * 256 + cc_seq * 64; pos0 = cc_seq * 64; }
  else { row0 = b * 4096 + (cc_seq - 4) * 64; pos0 = CTX + (cc_seq - 4) * 64; }
}
__device__ __forceinline__ int scan2tok(int c, int dir) {
  if (!dir) return c;
  return c < 4 ? 3 - c : 4 + 63 - (c - 4);
}

__device__ void hg_u_item(const P& p, int e, int item, char* smem) {
  const int tid = get_tid(), lane = tid & 63, wid = tid >> 6, wr = wid >> 1, wc = wid & 1, fr = lane & 15, fq = lane >> 4;
  const u16* PROJ = (const u16*)(p.ws + OFF_PROJ);
  const u16* IT = (const u16*)(p.ws + OFF_VT);
  u16* U = (u16*)(p.ws + OFF_U);
  float* DEC = (float*)(p.ws + OFF_DEC);
  const float* LB = (const float*)(p.ws + OFF_LB);
  const int c = item % NCH, seq = item / NCH, dir = seq & 1, h = (seq >> 1) & 3, b = seq >> 3;
  int row0, pos0;
  chunk_rows(b, scan2tok(c, dir), row0, pos0);
  float* tot = (float*)(smem + 16384);
  const int d = tid & 127, half = tid >> 7;
  const float lb = LB[(e * 2 + dir) * 512 + h * 128 + d];
  const u16* zl = (const u16*)(smem + 32768) + d;
  __syncthreads();
  {
    const u16* zg = PROJ + (size_t)row0 * 3072 + 1536 + dir * 512 + h * 128;
#pragma unroll
    for (int i = 0; i < 4; ++i) {
      int q = tid + i * 256;
      glds16(zg + (size_t)(q >> 4) * 3072 + (q & 15) * 8, smem + 32768 + q * 16);
    }
  }
  asm volatile("s_waitcnt vmcnt(0)" ::: "memory");
  __syncthreads();
  float sum = 0.f;
#pragma unroll 8
  for (int i = 0; i < 32; ++i) {
    int tau = half * 32 + i, t = dir ? 63 - tau : tau;
    float f = lb + (1.f - lb) * sigm(bf2f(zl[t * 128]));
    sum += __logf(fmaxf(f, 1e-20f));
  }
  tot[half * 128 + d] = sum;
  __syncthreads();
  float rel = half ? 0.f : tot[128 + d];
#pragma unroll 8
  for (int i = 31; i >= 0; --i) {
    int tau = half * 32 + i, t = dir ? 63 - tau : tau;
    float f = lb + (1.f - lb) * sigm(bf2f(zl[t * 128]));
    float lf = __logf(fmaxf(f, 1e-20f));
    { const int tp = kperm(t); *(u16*)(smem + swz128(d, tp >> 3) + (tp & 7) * 2) = f2bf((1.f - f) * __expf(rel)); }
    rel += lf;
  }
  if (!half) DEC[(size_t)(seq * NCH + c) * 128 + d] = __expf(rel);
  __syncthreads();
  f32x4 acc[4][4];
#pragma unroll
  for (int m = 0; m < 4; ++m)
#pragma unroll
    for (int n = 0; n < 4; ++n) acc[m][n] = f32x4{0.f, 0.f, 0.f, 0.f};
  const u16* vb = IT + (size_t)((b * 4 + h) * 128) * TK + pos0;
#pragma unroll
  for (int ks = 0; ks < 2; ++ks) {
    bf16x8 a[4], bb[4];
#pragma unroll
    for (int m = 0; m < 4; ++m) a[m] = *(const bf16x8*)(vb + (size_t)(wr * 64 + m * 16 + fr) * TK + ks * 32 + fq * 8);
#pragma unroll
    for (int n = 0; n < 4; ++n) bb[n] = *(const bf16x8*)(smem + swz128(wc * 64 + n * 16 + fr, ks * 4 + fq));
#pragma unroll
    for (int m = 0; m < 4; ++m)
#pragma unroll
      for (int n = 0; n < 4; ++n) acc[m][n] = mfma16(bb[n], a[m], acc[m][n]);
  }
  u16* up = U + (size_t)(seq * NCH + c) * 16384;
#pragma unroll
  for (int m = 0; m < 4; ++m)
#pragma unroll
    for (int n = 0; n < 4; ++n)
      *(uint2*)(up + (wr * 64 + m * 16 + fr) * 128 + wc * 64 + n * 16 + fq * 4) =
          uint2{pk2(acc[m][n][0], acc[m][n][1]), pk2(acc[m][n][2], acc[m][n][3])};
}

__device__ void pool_item(const P& p, int item) {
  const int tid = get_tid();
  const u16* PROJ = (const u16*)(p.ws + OFF_PROJ);
  u16* PO = (u16*)(p.ws + OFF_POOLED);
  const int ch = tid * 2, g = ch >> 7, hw = 1 << g;
  const int row0 = item * 32;
  int base, n, pos0;
  if (row0 < ML) { base = row0 & ~4095; n = 4096; pos0 = row0 & 4095; }
  else { base = ML + ((row0 - ML) & ~255); n = 256; pos0 = (row0 - ML) & 255; }
  const u16* up = PROJ + (size_t)base * 3072 + 2560 + ch;
  float s0 = 0.f, s1 = 0.f;
  {
    const int lo = max(pos0 - hw, 0), hi = min(pos0 + hw, n);
    for (int r = lo; r < hi; ++r) {
      unsigned v = *(const unsigned*)(up + (size_t)r * 3072);
      s0 += __uint_as_float(v << 16); s1 += __uint_as_float(v & 0xffff0000u);
    }
  }
  for (int i0 = 0; i0 < 32; i0 += 16) {
    unsigned ce[16], en[16], le[16];
#pragma unroll
    for (int i = 0; i < 16; ++i) {
      const int pos = pos0 + i0 + i;
      ce[i] = *(const unsigned*)(up + (size_t)pos * 3072);
      en[i] = (pos + hw < n) ? *(const unsigned*)(up + (size_t)(pos + hw) * 3072) : 0u;
      le[i] = (pos - hw >= 0) ? *(const unsigned*)(up + (size_t)(pos - hw) * 3072) : 0u;
    }
#pragma unroll
    for (int i = 0; i < 16; ++i) {
      const int pos = pos0 + i0 + i;
      const int lo = max(pos - hw, 0), hi = min(pos + hw, n);
      const float ic = 1.f / (float)(hi - lo);
      *(unsigned*)(PO + (size_t)(base + pos) * 512 + ch) =
          pk2(s0 * ic - __uint_as_float(ce[i] << 16), s1 * ic - __uint_as_float(ce[i] & 0xffff0000u));
      s0 += __uint_as_float(en[i] << 16) - __uint_as_float(le[i] << 16);
      s1 += __uint_as_float(en[i] & 0xffff0000u) - __uint_as_float(le[i] & 0xffff0000u);
    }
  }
}

__device__ void hg_scan_item(const P& p, int item) {
  unsigned* U = (unsigned*)(p.ws + OFF_U);
  const float* DEC = (const float*)(p.ws + OFF_DEC);
  const int ei = item * 256 + get_tid(), seq = ei >> 13, vd2 = ei & 8191, d = (vd2 & 63) * 2;
  unsigned* up = U + (size_t)seq * NCH * 8192 + vd2;
  const float* dp = DEC + (size_t)seq * NCH * 128 + d;
  float s0 = 0.f, s1 = 0.f;
  for (int c0 = 0; c0 < NCH; c0 += 17) {
    unsigned u[17]; float2 dd[17];
#pragma unroll
    for (int i = 0; i < 17; ++i) { u[i] = up[(size_t)(c0 + i) * 8192]; dd[i] = *(const float2*)(dp + (c0 + i) * 128); }
#pragma unroll
    for (int i = 0; i < 17; ++i) {
      up[(size_t)(c0 + i) * 8192] = pk2(s0, s1);
      s0 = dd[i].x * s0 + __uint_as_float(u[i] << 16);
      s1 = dd[i].y * s1 + __uint_as_float(u[i] & 0xffff0000u);
    }
  }
}

__device__ void hg_o_item(const P& p, int e, int item, char* smem) {
  const int tid = get_tid(), lane = tid & 63, w = tid >> 6, fr = lane & 15, fq = lane >> 4;
  const u16* PROJ = (const u16*)(p.ws + OFF_PROJ);
  const u16* IT = (const u16*)(p.ws + OFF_VT);
  const u16* S = (const u16*)(p.ws + OFF_U);
  const float* LB = (const float*)(p.ws + OFF_LB);
  u16* MIX = (u16*)(p.ws + OFF_MIX);
  const int tc = item % NCH, bh = item / NCH, h = bh & 3, b = bh >> 2;
  int row0, pos0;
  chunk_rows(b, tc, row0, pos0);
  char* qh = smem;
  char* kh = smem + 16384;
  char* vt = smem + 32768;
  float* eref = (float*)(smem + 49152);
  __syncthreads();
  {
    const u16* vb = IT + (size_t)((b * 4 + h) * 128) * TK + pos0;
#pragma unroll
    for (int i = 0; i < 4; ++i) {
      int q = tid + i * 256, dv = q >> 3, c2 = (q & 7) ^ ((dv >> 1) & 7);
      glds16(vb + (size_t)dv * TK + c2 * 8, vt + q * 16);
    }
  }
  f32x4 O[8];
#pragma unroll
  for (int v = 0; v < 8; ++v) O[v] = f32x4{0.f, 0.f, 0.f, 0.f};
  const int d = tid & 127, half = tid >> 7;
  for (int dir = 0; dir < 2; ++dir) {
    const int c = dir ? (tc < 4 ? 3 - tc : 4 + 63 - (tc - 4)) : tc;
    const int seq = (b * 4 + h) * 2 + dir;
    const float lb = LB[(e * 2 + dir) * 512 + h * 128 + d];
    if (dir) __syncthreads();
    {
      const u16* zg = PROJ + (size_t)row0 * 3072 + 1536 + dir * 512 + h * 128;
      const u16* qg = PROJ + (size_t)row0 * 3072 + h * 128;
#pragma unroll
      for (int i = 0; i < 4; ++i) {
        int q = tid + i * 256, row = q >> 4, ch = (q & 15) ^ (row & 15);
        glds16(zg + (size_t)row * 3072 + ch * 8, kh + q * 16);
        glds16(qg + (size_t)row * 3072 + ch * 8, qh + q * 16);
      }
    }
    asm volatile("s_waitcnt vmcnt(0)" ::: "memory");
    __syncthreads();
    float rel = 0.f;
    if (!half) {
#pragma unroll 8
      for (int tau = 31; tau >= 0; --tau) {
        int t = dir ? 63 - tau : tau;
        int off = swz256(t, d >> 3) + (d & 7) * 2;
        float f = lb + (1.f - lb) * sigm(bf2f(*(const u16*)(kh + off)));
        float lf = __logf(fmaxf(f, 1e-20f));
        float q = bf2f(*(const u16*)(qh + off));
        *(u16*)(qh + off) = f2bf(q * __expf(rel));
        *(u16*)(kh + off) = f2bf((1.f - f) * __expf(-rel));
        rel -= lf;
      }
      eref[d] = __expf(-rel);
    } else {
#pragma unroll 8
      for (int tau = 32; tau < 64; ++tau) {
        int t = dir ? 63 - tau : tau;
        int off = swz256(t, d >> 3) + (d & 7) * 2;
        float f = lb + (1.f - lb) * sigm(bf2f(*(const u16*)(kh + off)));
        float lf = __logf(fmaxf(f, 1e-20f));
        float q = bf2f(*(const u16*)(qh + off));
        rel += lf;
        *(u16*)(qh + off) = f2bf(q * __expf(rel));
        *(u16*)(kh + off) = f2bf((1.f - f) * __expf(-rel));
      }
    }
    __syncthreads();
    bf16x8 qf[4];
#pragma unroll
    for (int ks = 0; ks < 4; ++ks) qf[ks] = *(const bf16x8*)(qh + swz256(w * 16 + fr, ks * 4 + fq));
    f32x4 s[4];
#pragma unroll
    for (int sf = 0; sf < 4; ++sf) {
      s[sf] = f32x4{0.f, 0.f, 0.f, 0.f};
#pragma unroll
      for (int ks = 0; ks < 4; ++ks) {
        bf16x8 a = *(const bf16x8*)(kh + swz256(sf * 16 + fr, ks * 4 + fq));
        s[sf] = mfma16(a, qf[ks], s[sf]);
      }
    }
    const int tq = w * 16 + fr;
#pragma unroll
    for (int sf = 0; sf < 4; ++sf)
#pragma unroll
      for (int j = 0; j < 4; ++j) {
        int ss = sf * 16 + fq * 4 + j;
        bool keep = dir ? (ss >= tq) : (ss <= tq);
        s[sf][j] = keep ? s[sf][j] : 0.f;
      }
    bf16x8 pb[2];
#pragma unroll
    for (int k2 = 0; k2 < 2; ++k2) {
      union { bf16x8 v; unsigned u[4]; } t;
      t.u[0] = pk2(s[2 * k2][0], s[2 * k2][1]); t.u[1] = pk2(s[2 * k2][2], s[2 * k2][3]);
      t.u[2] = pk2(s[2 * k2 + 1][0], s[2 * k2 + 1][1]); t.u[3] = pk2(s[2 * k2 + 1][2], s[2 * k2 + 1][3]);
      pb[k2] = t.v;
    }
#pragma unroll
    for (int v = 0; v < 8; ++v)
#pragma unroll
      for (int k2 = 0; k2 < 2; ++k2) {
        const int dv = v * 16 + fr;
        union { bf16x8 v; uint2 u[2]; } a;
        a.v = *(const bf16x8*)(vt + swz128(dv, k2 * 4 + fq));
        O[v] = mfma16(a.v, pb[k2], O[v]);
      }
    const u16* sp = S + (size_t)(seq * NCH + c) * 16384;
#pragma unroll
    for (int ks = 0; ks < 4; ++ks) {
      union { bf16x8 v; u16 h[8]; unsigned u[4]; } qq, qs;
      qq.v = qf[ks];
      const float* er = eref + ks * 32 + fq * 8;
#pragma unroll
      for (int i = 0; i < 4; ++i) qs.u[i] = pk2(bf2f(qq.h[2 * i]) * er[2 * i], bf2f(qq.h[2 * i + 1]) * er[2 * i + 1]);
#pragma unroll
      for (int v = 0; v < 8; ++v) {
        const bf16x8 av = *(const bf16x8*)(sp + (v * 16 + fr) * 128 + ks * 32 + fq * 8);
        O[v] = mfma16(av, qs.v, O[v]);
      }
    }
  }
  float ssq = 0.f;
#pragma unroll
  for (int v = 0; v < 8; ++v)
#pragma unroll
    for (int j = 0; j < 4; ++j) ssq += O[v][j] * O[v][j];
  ssq = xor_sum(xor_sum(ssq, 16), 32);
  const float rs = rsqrtf(ssq * (1.f / 128.f) + 1e-6f);
  const int row = row0 + w * 16 + fr;
  const float* nw = p.hg_norm_w + e * 128;
#pragma unroll
  for (int v = 0; v < 8; ++v) {
    int dv = v * 16 + fq * 4;
    uint2 gv = *(const uint2*)(PROJ + (size_t)row * 3072 + 1024 + h * 128 + dv);
    float4 n4 = *(const float4*)(nw + dv);
    float g0 = bf2f((u16)(gv.x & 0xffff)), g1 = bf2f((u16)(gv.x >> 16)), g2 = bf2f((u16)(gv.y & 0xffff)), g3 = bf2f((u16)(gv.y >> 16));
    uint2 o = {pk2(O[v][0] * rs * n4.x * silu(g0), O[v][1] * rs * n4.y * silu(g1)),
               pk2(O[v][2] * rs * n4.z * silu(g2), O[v][3] * rs * n4.w * silu(g3))};
    *(uint2*)(MIX + (size_t)row * D + h * 128 + dv) = o;
  }
}

#define XB_TMO      128
#define XB_XCNT(j)  (256  + 64 * (j))
#define XB_XSUB(j)  (1280 + 64 * (j))
#define XB_XGEN(j)  (2304 + 64 * (j))
#define XB_TOP      3328
#define XB_TOPGEN   3392
#define XCD_BAR_WORDS 3456
#define XB_SPIN_CAP (1u << 18)
__device__ __forceinline__ unsigned xb_ld(unsigned* p) { return __hip_atomic_load(p, __ATOMIC_RELAXED, __HIP_MEMORY_SCOPE_AGENT); }
__device__ __forceinline__ unsigned xb_add(unsigned* p, unsigned v) { return __hip_atomic_fetch_add(p, v, __ATOMIC_RELAXED, __HIP_MEMORY_SCOPE_AGENT); }
__device__ __forceinline__ unsigned xb_xcc_id() { return (unsigned)__builtin_amdgcn_s_getreg((3 << 11) | 20) & 0xFu; }
#define XB_SPIN(cond, bar) do { unsigned _sp = 0; while (cond) { __builtin_amdgcn_s_sleep(1); \
    if ((++_sp & 255u) == 0u) { if (xb_ld(&(bar)[XB_TMO])) break; if (_sp > XB_SPIN_CAP) { atomicAdd(&(bar)[XB_TMO], 1u); break; } } } } while (0)
struct GB { unsigned* bar; unsigned x; volatile unsigned* st; };
__device__ __forceinline__ void gb_complete(unsigned* bar, unsigned x, unsigned& nloc, unsigned& nx) {
  const unsigned G = gridDim.x;
  unsigned sum, cnt, mine, sp = 0u;
  for (;;) {
    sum = 0u; cnt = 0u; mine = 0u;
#pragma unroll
    for (unsigned j = 0; j < 16; ++j) { const unsigned c = xb_ld(&bar[XB_XCNT(j)]); sum += c; cnt += (c > 0u) ? 1u : 0u; mine = (j == x) ? c : mine; }
    if (sum == G) break;
    __builtin_amdgcn_s_sleep(1);
    if ((++sp & 255u) == 0u) { if (xb_ld(&bar[XB_TMO])) break; if (sp > XB_SPIN_CAP) { atomicAdd(&bar[XB_TMO], 1u); break; } }
  }
  nloc = mine > 0u ? mine : 1u; nx = cnt > 0u ? cnt : 1u;
}
__device__ __forceinline__ void gbar(GB& b) {
  asm volatile("s_waitcnt vmcnt(0)" ::: "memory");
  __syncthreads();
  if (threadIdx.x == 0) {
    unsigned* bar = b.bar;
    __builtin_amdgcn_s_waitcnt(0);
    unsigned nloc = b.st[0], nx = b.st[1];
    if (nloc == 0u) { gb_complete(bar, b.x, nloc, nx); b.st[0] = nloc; b.st[1] = nx; }
    const unsigned old = xb_add(&bar[XB_XSUB(b.x)], 1u);
    const unsigned gen = old / nloc;
    if (old + 1u == (gen + 1u) * nloc) {
      __builtin_amdgcn_fence(__ATOMIC_RELEASE, "agent");
      asm volatile("s_waitcnt vmcnt(0)" ::: "memory");
      const unsigned og = xb_add(&bar[XB_TOP], 1u);
      const unsigned tg = og / nx;
      if (og + 1u == (tg + 1u) * nx) xb_add(&bar[XB_TOPGEN], 1u);
      else XB_SPIN(xb_ld(&bar[XB_TOPGEN]) == tg, bar);
      __builtin_amdgcn_fence(__ATOMIC_ACQUIRE, "agent");
      xb_add(&bar[XB_XGEN(b.x)], 1u);
      asm volatile("s_waitcnt vmcnt(0)" ::: "memory");
    } else {
      XB_SPIN(xb_ld(&bar[XB_XGEN(b.x)]) == gen, bar);
      __builtin_amdgcn_fence(__ATOMIC_ACQUIRE, "agent");
      asm volatile("s_waitcnt vmcnt(0)" ::: "memory");
    }
  }
  __syncthreads();
}

template <int K>
__device__ __forceinline__ void n1024_phase(const P& p, const u16* A, const u16* Wt, bool with_ctx, bool ksplit, char* smem) {
  u16* Y = (u16*)(p.ws + OFF_Y);
  u16* YC = (u16*)(p.ws + OFF_YC);
  gemm8<1024, K>(A, Wt, ML, smem, BlkY{Y});
  if (!with_ctx) return;
  const int vb = get_vb();
  char* vsm = smem + vb * 65536;
  if (ksplit) {
    for (int it = blockIdx.x; it < 128; it += gridDim.x) {
      const int u = 2 * it + vb, ks = u & 3, ct = u >> 2, pm = ct >> 3, pn = ct & 7;
      gemm_tile(A + ks * 704, K, Wt + ks * 704, K, 704, ML + pm * 128, pn * 128, vsm,
                Epi4<BlkY>{BlkY{YC + ((size_t)ks * MC - ML) * D}});
    }
  } else {
    for (int it = blockIdx.x; it < 32; it += gridDim.x) {
      const int u = 2 * it + vb, pm = u >> 3, pn = u & 7;
      gemm_tile(A, K, Wt, K, K, ML + pm * 128, pn * 128, vsm, Epi4<BlkY>{BlkY{Y}});
    }
  }
}

constexpr int PH_PER_EVEN = 12, PH_PER_ODD = 10;
constexpr int N_PHASES = 2 + 2 * PH_PER_EVEN + 2 * PH_PER_ODD;

__device__ __forceinline__ void run_phase(const P& pin, int ph, char* smem) {
  P p = pin;
  asm volatile("" : "+s"(p.ws));
  asm volatile("" : "+s"(p.out));
  const int vb = get_vb();
  char* vsm = smem + vb * 65536;
  u16* H = (u16*)(p.ws + OFF_H);
  u16* HID = (u16*)(p.ws + OFF_HID);
  u16* PROJ = (u16*)(p.ws + OFF_PROJ);
  u16* VT = (u16*)(p.ws + OFF_VT);
  u16* MIX = (u16*)(p.ws + OFF_MIX);
  if (ph == 0) { phase_prep(p, vsm); return; }
  if (ph == 1) { phase_rows(p, 0, 0, 0, MT, false); return; }
  int q = ph - 2, l;
  if (q < PH_PER_EVEN) l = 0;
  else if (q < PH_PER_EVEN + PH_PER_ODD) { l = 1; q -= PH_PER_EVEN; }
  else if (q < 2 * PH_PER_EVEN + PH_PER_ODD) { l = 2; q -= PH_PER_EVEN + PH_PER_ODD; }
  else { l = 3; q -= 2 * PH_PER_EVEN + PH_PER_ODD; }
  const bool even = !(l & 1), last = (l == 3);
  int step = q;
  if (!even && q >= 5) step = q + 2;
  const int Mpost = last ? ML : MT;
  const u16* WFI = (const u16*)(p.ws + OFF_WFI);
  const u16* WFO = (const u16*)(p.ws + OFF_WFO);
  const u16* WMI = (const u16*)(p.ws + OFF_WMI) + (size_t)l * 3072 * 1024;
  switch (step) {
    case 0:
    case 9: {
      const int f = (step == 9) ? 1 : 0;
      gemm8<5632, 1024>(H, WFI + (size_t)(l * 2 + f) * 5632 * 1024, f ? Mpost : MT, smem, BlkSwiglu{HID});
    } break;
    case 1:
    case 7:
    case 10: {
      if (step == 7) n1024_phase<1024>(p, MIX, (const u16*)(p.ws + OFF_WMO) + (size_t)l * 1024 * 1024, !last, false, smem);
      else n1024_phase<2816>(p, HID, WFO + (size_t)(l * 2 + (step == 10 ? 1 : 0)) * 1024 * 2816, step == 1 || !last, true, smem);
    } break;
    case 2: phase_rows(p, 1, l, 0, MT, false); break;
    case 3:
      if (even) {
        gemm8<3072, 1024>(H, WMI, ML, smem, BlkProjEven{PROJ, VT});
        for (int it = blockIdx.x; it < 96; it += gridDim.x) {
          const int u = 2 * it + vb, pm = u / 24, pn = u % 24;
          gemm_tile(H, D, WMI, D, 1024, ML + pm * 128, pn * 128, vsm, Epi4<BlkProjEven>{BlkProjEven{PROJ, VT}});
        }
      } else {
        const float* rope = (const float*)(p.ws + OFF_ROPE);
        gemm8<3072, 1024>(H, WMI, ML, smem, BlkProjOdd{PROJ, VT, rope});
        for (int it = blockIdx.x; it < 96; it += gridDim.x) {
          const int u = 2 * it + vb, pm = u / 24, pn = u % 24;
          gemm_tile(H, D, WMI, D, 1024, ML + pm * 128, pn * 128, vsm, Epi4<BlkProjOdd>{BlkProjOdd{PROJ, VT, rope}});
        }
      }
      break;
    case 4:
      if (even) {
        for (int itp = blockIdx.x; itp < (32 * NCH + MT / 32) / 2; itp += gridDim.x) {
          const int it = 2 * itp + vb;
          if (it < 32 * NCH) hg_u_item(p, l >> 1, it, vsm);
          else pool_item(p, it - 32 * NCH);
        }
      } else phase_attn(p, l, smem);
      break;
    case 5: {
      for (int itp = blockIdx.x; itp < (1024 + 4 * (MT / 128)) / 2; itp += gridDim.x) {
        const int it = 2 * itp + vb;
        if (it < 1024) hg_scan_item(p, it);
        else {
          int t = it - 1024, g = t / (MT / 128), mt = t % (MT / 128);
          gemm_tile((const u16*)(p.ws + OFF_POOLED) + g * 128, 512,
                    (const u16*)(p.ws + OFF_WPL) + (size_t)((l >> 1) * 4 + g) * 128 * 128, 128, 128, mt * 128, 0, vsm,
                    Epi4<BlkPool>{BlkPool{MIX, p.pool_scale + (l >> 1) * 512, g}});
        }
      }
    } break;
    case 6:
      for (int itp = blockIdx.x; itp < 8 * NCH; itp += gridDim.x) hg_o_item(p, l >> 1, 2 * itp + vb, vsm);
      break;
    case 8: phase_rows(p, 1, l, 1, Mpost, false); break;
    case 11: phase_rows(p, 1, l, 2, Mpost, last); break;
  }
}

constexpr int DYN_LDS = 131072 + 16;
__global__ void __launch_bounds__(512, 2) mega(P p, int ph_lo, int ph_hi) {
  extern __shared__ __attribute__((aligned(16))) char smem[];
  GB gb;
  gb.bar = (unsigned*)(p.ws + OFF_BAR); gb.x = xb_xcc_id(); gb.st = (volatile unsigned*)(smem + 131072);
  if (threadIdx.x == 0) { gb.st[0] = 0u; gb.st[1] = 0u; (void)xb_add(&gb.bar[XB_XCNT(gb.x)], 1u); }
  __syncthreads();
  for (int ph = ph_lo; ph < ph_hi; ++ph) {
    run_phase(p, ph, smem);
#ifdef PROBE_GEMM
    if (ph >= 2) {
      int q = ph - 2, l = 0;
      if (q < 12) l = 0; else if (q < 22) { l = 1; q -= 12; } else if (q < 34) { l = 2; q -= 22; } else { l = 3; q -= 34; }
      int step = q; if ((l & 1) && q >= 5) step = q + 2;
      if (step == 0 || step == 1 || step == 3 || step == 7 || step == 9 || step == 10) { __syncthreads(); run_phase(p, ph, smem); }
    }
#endif
#ifdef PROBE_ATT
    if (ph == 2 + 12 + 4 || ph == 2 + 34 + 4) { __syncthreads(); run_phase(p, ph, smem); }
#endif
    if (ph + 1 < ph_hi) {
      if (ph_hi < 0) cg::this_grid().sync();
      gbar(gb);
    }
  }
}

extern "C" void kernel_launch(void* const* d_in, const int* in_sizes, int n_in, void* d_out, int out_size, void* d_ws,
                              size_t ws_size, hipStream_t stream) {
  static int grid_blocks = 0;
  if (!grid_blocks) {
    int dev = 0, cus = 0, per_cu = 0;
    hipGetDevice(&dev);
    hipDeviceGetAttribute(&cus, hipDeviceAttributeMultiprocessorCount, dev);
    hipFuncSetAttribute((const void*)mega, hipFuncAttributeMaxDynamicSharedMemorySize, DYN_LDS);
    hipOccupancyMaxActiveBlocksPerMultiprocessor(&per_cu, mega, 512, DYN_LDS);
    if (per_cu > 1) per_cu = 1;
    grid_blocks = cus * per_cu;
  }
  if (ws_size < OFF_END2) { fprintf(stderr, "workspace too small: %zu < %zu\n", ws_size, (size_t)OFF_END); return; }
  P p{};
  const float** f = (const float**)&p;
  for (int i = 0; i < 20; ++i) f[i] = (const float*)d_in[i];
  p.out = (float*)d_out;
  p.ws = (char*)d_ws;
#if MULTI_LAUNCH
  for (int ph = 0; ph < N_PHASES; ++ph) hipLaunchKernelGGL(mega, dim3(grid_blocks), dim3(512), DYN_LDS, stream, p, ph, ph + 1);
#else
  hipMemsetAsync((char*)d_ws + OFF_BAR, 0, XCD_BAR_WORDS * 4, stream);
  int lo = 0, hi = N_PHASES;
  void* args[] = {&p, &lo, &hi};
  hipError_t e = hipLaunchCooperativeKernel((void*)mega, dim3(grid_blocks), dim3(512), args, DYN_LDS, stream);
  if (e != hipSuccess) fprintf(stderr, "cooperative launch failed: %s (grid %d)\n", hipGetErrorString(e), grid_blocks);
#endif
}
```

```cpp
#include <hip/hip_runtime.h>
#include <hip/hip_cooperative_groups.h>
#include <cstdio>
namespace cg = cooperative_groups;

typedef __attribute__((ext_vector_type(8))) short bf16x8;
typedef __attribute__((ext_vector_type(4))) float f32x4;
typedef unsigned short u16;

#ifndef MULTI_LAUNCH
#define MULTI_LAUNCH 0
#endif

constexpr int D = 1024, NB = 4, SEQ = 4096, CTX = 256, FH = 2816;
constexpr int ML = NB * SEQ, MC = NB * CTX, MT = ML + MC;
constexpr int TK = CTX + SEQ;
constexpr int NCH = TK / 64;
constexpr float ALPHA = 1.6817928305074290f;
constexpr float LOG2E = 1.4426950408889634f;

constexpr size_t al256(size_t x) { return (x + 255) & ~(size_t)255; }
constexpr size_t OFF_WFI = 0;
constexpr size_t OFF_WFO = OFF_WFI + al256((size_t)4 * 2 * 5632 * 1024 * 2);
constexpr size_t OFF_WMI = OFF_WFO + al256((size_t)4 * 2 * 1024 * 2816 * 2);
constexpr size_t OFF_WMO = OFF_WMI + al256((size_t)4 * 3072 * 1024 * 2);
constexpr size_t OFF_WPL = OFF_WMO + al256((size_t)4 * 1024 * 1024 * 2);
constexpr size_t OFF_MODS = OFF_WPL + al256((size_t)2 * 4 * 128 * 128 * 2);
constexpr size_t OFF_LB = OFF_MODS + al256((size_t)4 * 5 * 9216 * 4);
constexpr size_t OFF_LAM = OFF_LB + al256((size_t)2 * 2 * 512 * 4);
constexpr size_t OFF_ROPE = OFF_LAM + 256;
constexpr size_t OFF_DEC = OFF_ROPE + al256((size_t)64 * 16 * 2 * 4);
constexpr size_t OFF_X = OFF_DEC + al256((size_t)32 * NCH * 128 * 4);
constexpr size_t OFF_H = OFF_X + al256((size_t)MT * 1024 * 4);
constexpr size_t OFF_PROJ = OFF_H + al256((size_t)MT * 1024 * 2);
constexpr size_t OFF_VT = OFF_PROJ + al256((size_t)MT * 3072 * 2);
constexpr size_t OFF_MIX = OFF_VT + al256((size_t)NB * 8 * 128 * TK * 2);
constexpr size_t OFF_POOLED = OFF_MIX + al256((size_t)MT * 1024 * 2);
constexpr size_t OFF_HID = OFF_POOLED + al256((size_t)MT * 512 * 2);
constexpr size_t OFF_Y = OFF_HID + al256((size_t)MT * FH * 2);
constexpr size_t OFF_END = OFF_Y + al256((size_t)MT * 1024 * 4);
constexpr size_t OFF_YC = OFF_END;
constexpr size_t OFF_BAR = OFF_YC + al256((size_t)4 * MC * 1024 * 2);
constexpr size_t OFF_END2 = OFF_BAR + al256((size_t)3456 * 4);
constexpr size_t OFF_U = OFF_HID;
static_assert((size_t)32 * NCH * 16384 * 4 <= OFF_END - OFF_HID, "U alias too big");

struct P {
  const float *x, *c, *ctx, *c_ctx, *w_ada, *b_ada, *ln_g, *ln_b, *w_ffn_in, *w_ffn_out, *w_in_even, *w_out_even,
      *hg_lb, *hg_norm_w, *pool_w, *pool_scale, *w_in_odd, *w_out_odd, *da_lambda, *da_sub_w;
  float* out;
  char* ws;
};

typedef __attribute__((ext_vector_type(2))) __bf16 bf16v2;
typedef __attribute__((ext_vector_type(2))) float f32v2;
__device__ __forceinline__ unsigned pk2(float a, float b) {
  f32v2 v = {a, b};
  bf16v2 r = __builtin_convertvector(v, bf16v2);
  return *(unsigned*)&r;
}
__device__ __forceinline__ u16 f2bf(float f) { return (u16)(pk2(f, 0.f) & 0xffffu); }
__device__ __forceinline__ float bf2f(u16 h) { return __uint_as_float(((unsigned)h) << 16); }
__device__ __forceinline__ float sigm(float z) { return __builtin_amdgcn_rcpf(1.f + __expf(-z)); }
__device__ __forceinline__ float silu(float z) { return z * __builtin_amdgcn_rcpf(1.f + __expf(-z)); }
__device__ __forceinline__ float ex2(float x) { return __builtin_amdgcn_exp2f(x); }
__device__ __forceinline__ void glds16(const void* g, void* l) {
  __builtin_amdgcn_global_load_lds((const unsigned*)g, (unsigned*)l, 16, 0, 0);
}
__device__ __forceinline__ int get_tid() { int t = threadIdx.x & 255; asm volatile("" : "+v"(t)); return t; }
__device__ __forceinline__ int get_vb() { return __builtin_amdgcn_readfirstlane((int)(threadIdx.x >> 8)); }
__device__ __forceinline__ int swz128(int row, int ch) { return row * 128 + ((ch ^ ((row >> 1) & 7)) << 4); }
__device__ __forceinline__ int swz256(int row, int ch) { return row * 256 + ((ch ^ (row & 15)) << 4); }
__device__ __forceinline__ f32x4 mfma16(bf16x8 a, bf16x8 b, f32x4 c) {
  return __builtin_amdgcn_mfma_f32_16x16x32_bf16(a, b, c, 0, 0, 0);
}
__device__ __forceinline__ float xor_sum(float v, int m) { return v + __shfl_xor(v, m, 64); }
__device__ __forceinline__ float xor_max(float v, int m) { return fmaxf(v, __shfl_xor(v, m, 64)); }
__device__ __forceinline__ int kperm(int pos) { return (pos & ~31) | ((pos & 12) << 1) | ((pos & 16) >> 2) | (pos & 3); }
__device__ __forceinline__ void row_bpos(int row, int& b, int& pos) {
  if (row < ML) { b = row >> 12; pos = CTX + (row & 4095); }
  else { int r = row - ML; b = r >> 8; pos = r & 255; }
}
__device__ __forceinline__ int mod_row(int row) { return row < ML ? (row >> 12) : 4; }

constexpr int BM = 128, BN = 128, BK = 64;

template <class Epi>
__device__ __forceinline__ void gemm_tile(const u16* __restrict__ A, int lda, const u16* __restrict__ Bt, int ldb, int K,
                                          int m0, int n0, char* smem, const Epi& epi) {
  const int tid = get_tid(), lane = tid & 63, wid = tid >> 6, wr = wid >> 1, wc = wid & 1, fr = lane & 15, fq = lane >> 4;
  f32x4 acc[4][4];
#pragma unroll
  for (int m = 0; m < 4; ++m)
#pragma unroll
    for (int n = 0; n < 4; ++n) acc[m][n] = f32x4{0.f, 0.f, 0.f, 0.f};
  const int nk = K / BK;
  const u16* ga[4];
  const u16* gb[4];
#pragma unroll
  for (int i = 0; i < 4; ++i) {
    int q = tid + i * 256, row = q >> 3, ch = (q & 7) ^ ((row >> 1) & 7);
    ga[i] = A + (size_t)(m0 + row) * lda + ch * 8;
    gb[i] = Bt + (size_t)(n0 + row) * ldb + ch * 8;
  }
  __syncthreads();
#pragma unroll
  for (int i = 0; i < 4; ++i) {
    glds16(ga[i], smem + (tid + i * 256) * 16);
    glds16(gb[i], smem + 16384 + (tid + i * 256) * 16);
  }
  for (int kt = 0; kt < nk; ++kt) {
    __syncthreads();
    char* cur = smem + (kt & 1) * 32768;
    bf16x8 a[2][4], b[2][4];
#pragma unroll
    for (int ks = 0; ks < 2; ++ks) {
#pragma unroll
      for (int n = 0; n < 4; ++n) b[ks][n] = *(const bf16x8*)(cur + 16384 + swz128(wc * 64 + n * 16 + fr, ks * 4 + fq));
#pragma unroll
      for (int m = 0; m < 4; ++m) a[ks][m] = *(const bf16x8*)(cur + swz128(wr * 64 + m * 16 + fr, ks * 4 + fq));
    }
    __builtin_amdgcn_sched_barrier(0);
    if (kt + 1 < nk) {
      char* nxt = smem + ((kt + 1) & 1) * 32768;
#pragma unroll
      for (int i = 0; i < 4; ++i) {
        glds16(ga[i] + (kt + 1) * BK, nxt + (tid + i * 256) * 16);
        glds16(gb[i] + (kt + 1) * BK, nxt + 16384 + (tid + i * 256) * 16);
      }
    }
    __builtin_amdgcn_sched_barrier(0);
    __builtin_amdgcn_s_setprio(1);
#pragma unroll
    for (int ks = 0; ks < 2; ++ks)
#pragma unroll
      for (int m = 0; m < 4; ++m)
#pragma unroll
        for (int n = 0; n < 4; ++n) acc[m][n] = mfma16(b[ks][n], a[ks][m], acc[m][n]);
    __builtin_amdgcn_s_setprio(0);
  }
  epi(acc, m0 + wr * 64, n0 + wc * 64, fr, fq);
}

struct BlkSwiglu {
  u16* hid;
  __device__ __forceinline__ void operator()(const f32x4& f0, const f32x4& f1, int row, int cg, int fq) const {
    uint2 v = {pk2(silu(f0[0]) * f1[0], silu(f0[1]) * f1[1]), pk2(silu(f0[2]) * f1[2], silu(f0[3]) * f1[3])};
    *(uint2*)(hid + (size_t)row * FH + (cg >> 1) + fq * 4) = v;
  }
};
struct BlkY {
  u16* y;
  __device__ __forceinline__ void operator()(const f32x4& f0, const f32x4& f1, int row, int cg, int fq) const {
    u16* o = y + (size_t)row * D + cg + fq * 4;
    *(uint2*)o = uint2{pk2(f0[0], f0[1]), pk2(f0[2], f0[3])};
    *(uint2*)(o + 16) = uint2{pk2(f1[0], f1[1]), pk2(f1[2], f1[3])};
  }
};
struct BlkPool {
  u16* mix; const float* scale; int g;
  __device__ __forceinline__ void operator()(const f32x4& f0, const f32x4& f1, int row, int cg, int fq) const {
    const int col = g * 128 + cg + fq * 4;
    float4 s0 = *(const float4*)(scale + col), s1 = *(const float4*)(scale + col + 16);
    u16* o = mix + (size_t)row * D + 512 + col;
    *(uint2*)o = uint2{pk2(f0[0] * s0.x, f0[1] * s0.y), pk2(f0[2] * s0.z, f0[3] * s0.w)};
    *(uint2*)(o + 16) = uint2{pk2(f1[0] * s1.x, f1[1] * s1.y), pk2(f1[2] * s1.z, f1[3] * s1.w)};
  }
};
__device__ __forceinline__ float dpp_q(float v, int ctrl_b1) {
  int r = ctrl_b1 ? __builtin_amdgcn_mov_dpp(__float_as_int(v), 0x4E, 0xF, 0xF, true)
                  : __builtin_amdgcn_mov_dpp(__float_as_int(v), 0xB1, 0xF, 0xF, true);
  return __int_as_float(r);
}
__device__ __forceinline__ void quad_transpose(f32x4& x, int i) {
  const bool b0 = i & 1, b1 = i & 2;
  float s, r;
  s = b0 ? x[0] : x[1]; r = dpp_q(s, 0); if (b0) x[0] = r; else x[1] = r;
  s = b0 ? x[2] : x[3]; r = dpp_q(s, 0); if (b0) x[2] = r; else x[3] = r;
  s = b1 ? x[0] : x[2]; r = dpp_q(s, 1); if (b1) x[0] = r; else x[2] = r;
  s = b1 ? x[1] : x[3]; r = dpp_q(s, 1); if (b1) x[1] = r; else x[3] = r;
}
__device__ __forceinline__ void store_vt_blk(u16* vt, int nh, const f32x4& f0, const f32x4& f1, int row, int fc0, int fq) {
  const int i = row & 3;
  f32x4 y0 = f0, y1 = f1;
  quad_transpose(y0, i);
  quad_transpose(y1, i);
  int b, pos;
  row_bpos(row & ~3, b, pos);
  pos = kperm(pos);
  const int fc = fc0 + fq * 4 + i, h = fc >> 7, f = fc & 127;
  u16* o = vt + ((size_t)((b * nh + h) * 128 + f)) * TK + pos;
  *(uint2*)o = uint2{pk2(y0[0], y0[1]), pk2(y0[2], y0[3])};
  *(uint2*)(o + (size_t)16 * TK) = uint2{pk2(y1[0], y1[1]), pk2(y1[2], y1[3])};
}
struct BlkProjEven {
  u16* proj; u16* vt;
  __device__ __forceinline__ void operator()(const f32x4& f0, const f32x4& f1, int row, int cg, int fq) const {
    if (cg >= 512 && cg < 1024) { store_vt_blk(vt, 4, f0, f1, row, cg - 512, fq); return; }
    const float sc = (cg < 512) ? 0.08838834764831845f : 1.f;
    u16* o = proj + (size_t)row * 3072 + cg + fq * 4;
    *(uint2*)o = uint2{pk2(f0[0] * sc, f0[1] * sc), pk2(f0[2] * sc, f0[3] * sc)};
    *(uint2*)(o + 16) = uint2{pk2(f1[0] * sc, f1[1] * sc), pk2(f1[2] * sc, f1[3] * sc)};
  }
};
struct BlkProjOdd {
  u16* proj; u16* vt; const float* rope;
  __device__ __forceinline__ void operator()(const f32x4& f0, const f32x4& f1, int row, int cg, int fq) const {
    if (cg >= 2048) { store_vt_blk(vt, 8, f0, f1, row, cg - 2048, fq); return; }
    const float sc = (cg < 1024) ? 0.125f * LOG2E : 1.f;
    f32x4 v0 = f0, v1 = f1;
    if (row < ML) {
      const int t = row & 4095, pos = ((cg >> 5) & 1) ? (t & 63) : (t >> 6);
      const float* rr = rope + (pos * 16 + fq * 4) * 2;
      float4 r0 = *(const float4*)rr, r1 = *(const float4*)(rr + 4);
      float cs[4] = {r0.x, r0.z, r1.x, r1.z}, sn[4] = {r0.y, r0.w, r1.y, r1.w};
#pragma unroll
      for (int j = 0; j < 4; ++j) {
        float a0 = f0[j] * cs[j] - f1[j] * sn[j], a1 = f1[j] * cs[j] + f0[j] * sn[j];
        v0[j] = a0; v1[j] = a1;
      }
    }
    u16* o = proj + (size_t)row * 3072 + cg + fq * 4;
    *(uint2*)o = uint2{pk2(v0[0] * sc, v0[1] * sc), pk2(v0[2] * sc, v0[3] * sc)};
    *(uint2*)(o + 16) = uint2{pk2(v1[0] * sc, v1[1] * sc), pk2(v1[2] * sc, v1[3] * sc)};
  }
};
template <class Blk> struct Epi4 {
  Blk blk;
  __device__ __forceinline__ void operator()(f32x4 (&acc)[4][4], int rb, int cb, int fr, int fq) const {
#pragma unroll
    for (int m = 0; m < 4; ++m) {
      blk(acc[m][0], acc[m][1], rb + m * 16 + fr, cb, fq);
      blk(acc[m][2], acc[m][3], rb + m * 16 + fr, cb + 32, fq);
    }
  }
};

namespace pg8 {
#define PG8_LAS __attribute__((address_space(3)))
typedef unsigned short bf16_t;
typedef short bf16x8 __attribute__((ext_vector_type(8)));
typedef float f32x4 __attribute__((ext_vector_type(4)));
typedef unsigned u32x4 __attribute__((ext_vector_type(4)));
constexpr int BM = 256, BK = 64, HALF = 128, HTB = HALF * BK * 2  , STAGE_BYTES = 8 * HTB, NXCD = 8, WGM = 8;

__host__ __device__ __forceinline__ int lds_byte(int r, int c) { const int st = (r >> 4) * 2 + (c >> 5), rr = r & 15, cc = c & 31, ob = rr * 64 + cc * 2; return st * 1024 + (ob ^ (((ob >> 9) & 1) << 5)); }
__host__ __device__ __forceinline__ void stage_rc(int b, int& R, int& C) { const int st = b / 1024, sb = b % 1024, swz = sb ^ (((sb >> 9) & 1) << 5); R = (st >> 1) * 16 + swz / 64; C = (st & 1) * 32 + (swz % 64) / 2; }
__host__ __device__ __forceinline__ int perm32(int rho) { const int n = rho >> 4, i = rho & 15; return 8 * (i >> 2) + 4 * n + (i & 3); }

struct Unit { int pm, pn; };
struct Gemm { const bf16_t* A; const bf16_t* Bt; int M, N, K; };

struct StaticOrder {
    int nM, nN, nwg, G, c;
    __host__ __device__ void init(int M, int N, int G_, int c_) { nM = M / BM; nN = N / BM; nwg = nM * nN; G = G_; c = c_; }
    __host__ __device__ bool next(int i, Unit& u) const {
        const long L = (long)i * G + c; if (L >= nwg) return false;
        int wgid = (int)L; { const int q = nwg / NXCD, r = nwg % NXCD, xcd = wgid % NXCD, off = wgid / NXCD; wgid = (xcd < r ? xcd * (q + 1) : r * (q + 1) + (xcd - r) * q) + off; }
        const int nig = WGM * nN, gid = wgid / nig, fm = gid * WGM, gsz = (nM - fm) < WGM ? (nM - fm) : WGM;
        u.pm = fm + ((wgid % nig) % gsz); u.pn = (wgid % nig) / gsz; return true;
    }
    __device__ __forceinline__ void a_ready(const Unit&) const {}
    __device__ __forceinline__ void done(const Unit&) const {}
};

template <class Epi, class Sched, bool STAMP = false>
__device__ __forceinline__ void gemm_phase(PG8_LAS unsigned char* lds, const Gemm g, const Sched& S, const Epi& E, unsigned long long* stamps) {
    int tid = threadIdx.x; asm volatile("" : "+v"(tid));
    const int wid = __builtin_amdgcn_readfirstlane(tid >> 6), lane = tid & 63, wr = wid >> 2, wc = wid & 3, fr = lane & 15, fq = lane >> 4;
    const int K = g.K, nt = K / BK;
    int ts_lo = 0, ts_hi = 0, nts = 0; const unsigned long long rt_entry = STAMP ? (unsigned long long)wall_clock64() : 0ull;
#define PG8_STAMP() do { if (STAMP && wid == 0 && nts < 64) { const unsigned long long _c = (unsigned long long)clock64(); \
        ts_lo = (lane == nts) ? (int)(unsigned)_c : ts_lo; ts_hi = (lane == nts) ? (int)(unsigned)(_c >> 32) : ts_hi; ++nts; } } while (0)
    PG8_STAMP();
    unsigned voffA[2], voffB[2];
#pragma unroll
    for (int i = 0; i < 2; ++i) { int R, C; stage_rc(tid * 16 + i * 8192, R, C); const int Rb = Epi::PERM ? ((R & ~31) + perm32(R & 31)) : R;
        voffA[i] = (unsigned)(R * K + C) * 2u; voffB[i] = (unsigned)(Rb * K + C) * 2u; }
    const size_t kstep = (size_t)(BK * 2);
    const size_t hstep = (size_t)HALF * K * 2;
    const size_t tstep = 2 * hstep;
    const unsigned ldsw = (unsigned)wid * 1024u;
    const int aoff = lds_byte(wr * 64 + fr, fq * 8), boff = lds_byte(wc * 32 + fr, fq * 8);
#define PG8_SA(b, h) (((b) * 2 + (h)) * HTB)
#define PG8_SB(b, h) ((4 + (b) * 2 + (h)) * HTB)
#define PG8_STAGE(bufoff, gbase, voff) do { _Pragma("unroll") for (int _i = 0; _i < 2; ++_i) \
        __builtin_amdgcn_global_load_lds((const unsigned*)((const char*)(gbase) + (voff)[_i]), (PG8_LAS unsigned*)(lds + (bufoff) + ldsw + _i * 8192), 16, 0, 0); } while (0)
#define PG8_LDA(dst, b, h) do { _Pragma("unroll") for (int m = 0; m < 4; ++m) _Pragma("unroll") for (int k = 0; k < 2; ++k) dst[m][k] = *(const PG8_LAS bf16x8*)(lds + PG8_SA(b, h) + aoff + m * 2048 + k * 1024); } while (0)
#define PG8_LDB(dst, b, h) do { _Pragma("unroll") for (int n = 0; n < 2; ++n) _Pragma("unroll") for (int k = 0; k < 2; ++k) dst[n][k] = *(const PG8_LAS bf16x8*)(lds + PG8_SB(b, h) + boff + n * 2048 + k * 1024); } while (0)
#define PG8_MMA(ai, bj, At, Bt) do { __builtin_amdgcn_s_setprio(1); _Pragma("unroll") for (int m = 0; m < 4; ++m) _Pragma("unroll") for (int n = 0; n < 2; ++n) _Pragma("unroll") for (int k = 0; k < 2; ++k) \
        acc[ai][bj][m][n] = __builtin_amdgcn_mfma_f32_16x16x32_bf16(Bt[n][k], At[m][k], acc[ai][bj][m][n], 0, 0, 0); __builtin_amdgcn_s_setprio(0); } while (0)
#define PG8_WAIT_V(n) asm volatile("s_waitcnt vmcnt(" #n ")" ::: "memory")
#define PG8_WAIT_L(n) asm volatile("s_waitcnt lgkmcnt(" #n ")" ::: "memory")
#define PG8_BAR __builtin_amdgcn_s_barrier()
#define PG8_SCHED __builtin_amdgcn_sched_barrier(0)
    Unit cur, nxt; int ui = 0;
    if (!S.next(0, cur)) return;
    f32x4 acc[2][2][4][2];
#pragma unroll
    for (int a = 0; a < 2; ++a)
#pragma unroll
        for (int b = 0; b < 2; ++b)
#pragma unroll
            for (int m = 0; m < 4; ++m)
#pragma unroll
                for (int n = 0; n < 2; ++n) acc[a][b][m][n] = (f32x4){0.f, 0.f, 0.f, 0.f};
    bf16x8 At[4][2], B0[2][2], B1[2][2];
    const char* cA = (const char*)g.A + (size_t)cur.pm * tstep; const char* cB = (const char*)g.Bt + (size_t)cur.pn * tstep;
    S.a_ready(cur);
    PG8_STAGE(PG8_SB(0, 0), cB, voffB); PG8_STAGE(PG8_SA(0, 0), cA, voffA); PG8_STAGE(PG8_SB(0, 1), cB + hstep, voffB); PG8_STAGE(PG8_SA(0, 1), cA + hstep, voffA);
    if (wr == 1) PG8_BAR;
    PG8_WAIT_V(4); PG8_BAR;
    PG8_STAGE(PG8_SB(1, 0), cB + kstep, voffB); PG8_STAGE(PG8_SA(1, 0), cA + kstep, voffA); PG8_STAGE(PG8_SB(1, 1), cB + hstep + kstep, voffB);
    PG8_WAIT_V(6); PG8_BAR;
    PG8_STAMP();
    for (;;) {
        const bool has_next = S.next(ui + 1, nxt);
        const char* nA = has_next ? (const char*)g.A + (size_t)nxt.pm * tstep : cA; const char* nB = has_next ? (const char*)g.Bt + (size_t)nxt.pn * tstep : cB;
        for (int t = 0; t < nt; t += 2) {
            const bool last = (t == nt - 2);
            const char* a1 = cA + (size_t)(t + 1) * kstep;
            const char* a2 = last ? nA : cA + (size_t)(t + 2) * kstep; const char* b2 = last ? nB : cB + (size_t)(t + 2) * kstep;
            const char* a3 = a2 + kstep; const char* b3 = b2 + kstep;
            if (last && has_next) S.a_ready(nxt);
            PG8_LDB(B0, 0, 0); PG8_SCHED; PG8_LDA(At, 0, 0); PG8_STAGE(PG8_SA(1, 1), a1 + hstep, voffA);
            PG8_WAIT_L(8); PG8_BAR; PG8_WAIT_L(0); PG8_MMA(0, 0, At, B0); PG8_BAR; PG8_SCHED;
            PG8_LDB(B1, 0, 1); PG8_STAGE(PG8_SB(0, 0), b2, voffB);
            PG8_BAR; PG8_WAIT_L(0); PG8_MMA(0, 1, At, B1); PG8_BAR;
            PG8_LDA(At, 0, 1); PG8_STAGE(PG8_SA(0, 0), a2, voffA);
            PG8_BAR; PG8_WAIT_L(0); PG8_MMA(1, 0, At, B0); PG8_BAR; PG8_SCHED;
            PG8_STAGE(PG8_SB(0, 1), b2 + hstep, voffB);
            PG8_WAIT_V(6); PG8_BAR; PG8_MMA(1, 1, At, B1); PG8_BAR;
            PG8_LDB(B0, 1, 0); PG8_SCHED; PG8_LDA(At, 1, 0); PG8_STAGE(PG8_SA(0, 1), a2 + hstep, voffA);
            PG8_WAIT_L(8); PG8_BAR; PG8_WAIT_L(0); PG8_MMA(0, 0, At, B0); PG8_BAR; PG8_SCHED;
            PG8_LDB(B1, 1, 1); PG8_STAGE(PG8_SB(1, 0), b3, voffB);
            PG8_BAR; PG8_WAIT_L(0); PG8_MMA(0, 1, At, B1); PG8_BAR;
            PG8_LDA(At, 1, 1); PG8_STAGE(PG8_SA(1, 0), a3, voffA);
            PG8_BAR; PG8_WAIT_L(0); PG8_MMA(1, 0, At, B0); PG8_BAR; PG8_SCHED;
            PG8_STAGE(PG8_SB(1, 1), b3 + hstep, voffB);
            PG8_WAIT_V(6); PG8_BAR; PG8_MMA(1, 1, At, B1); PG8_BAR;
        }
        PG8_STAMP();
        if constexpr (!Epi::AFTER_DRAIN) { E(acc, cur, wr, wc, fr, fq); S.done(cur); }
        PG8_STAMP();
        if (!has_next) break;
#pragma unroll
        for (int a = 0; a < 2; ++a)
#pragma unroll
            for (int b = 0; b < 2; ++b)
#pragma unroll
                for (int m = 0; m < 4; ++m)
#pragma unroll
                    for (int n = 0; n < 2; ++n) acc[a][b][m][n] = (f32x4){0.f, 0.f, 0.f, 0.f};
        cur = nxt; cA = nA; cB = nB; ++ui;
    }
    PG8_WAIT_V(0);
    if (wr == 0) PG8_BAR;
    PG8_BAR;
    if constexpr (Epi::AFTER_DRAIN) { E.fused(acc, cur, wr, wc, fr, fq, lds, wid, lane); S.done(cur); }
    PG8_STAMP();
    if (STAMP && wid == 0) { stamps[lane] = lane < nts ? (((unsigned long long)(unsigned)ts_hi << 32) | (unsigned)ts_lo) : 0ull;
        if (lane == 62) stamps[62] = rt_entry; if (lane == 63) stamps[63] = (unsigned long long)wall_clock64(); }
#undef PG8_STAMP
#undef PG8_SA
#undef PG8_SB
#undef PG8_STAGE
#undef PG8_LDA
#undef PG8_LDB
#undef PG8_MMA
#undef PG8_WAIT_V
#undef PG8_WAIT_L
#undef PG8_BAR
#undef PG8_SCHED
}
}

template <class Blk> struct Epi8 {
  static constexpr bool PERM = false, AFTER_DRAIN = false;
  Blk blk;
  __device__ __forceinline__ void operator()(const f32x4 (&acc)[2][2][4][2], const pg8::Unit& u, int wr, int wc, int fr, int fq) const {
#pragma unroll
    for (int ai = 0; ai < 2; ++ai)
#pragma unroll
      for (int m = 0; m < 4; ++m) {
        const int row = u.pm * 256 + ai * 128 + wr * 64 + m * 16 + fr;
#pragma unroll
        for (int bj = 0; bj < 2; ++bj) blk(acc[ai][bj][m][0], acc[ai][bj][m][1], row, u.pn * 256 + bj * 128 + wc * 32, fq);
      }
  }
};
template <int N, int K, class Blk>
__device__ __forceinline__ void gemm8(const u16* A, const u16* Bt, int M, char* smem, const Blk& blk) {
  pg8::Gemm g{A, Bt, M, N, K};
  pg8::StaticOrder S;
  S.init(M, N, (int)gridDim.x, (int)blockIdx.x);
  pg8::gemm_phase<Epi8<Blk>, pg8::StaticOrder, false>((PG8_LAS unsigned char*)smem, g, S, Epi8<Blk>{blk}, nullptr);
  __syncthreads();
}

__device__ __forceinline__ void convert_tile(const float* __restrict__ src, int K, int N, u16* __restrict__ dst, int tile,
                                             bool swiglu, char* smem) {
  float* t = (float*)smem;
  const int tid = get_tid();
  const int nN = N / 64, nt = tile % nN, kt = tile / nN, k0 = kt * 64, n0 = nt * 64;
  __syncthreads();
#pragma unroll
  for (int i = 0; i < 4; ++i) {
    int k = (tid >> 4) + 16 * i, n4 = (tid & 15) * 4;
    float4 v = *(const float4*)(src + (size_t)(k0 + k) * N + n0 + n4);
    t[k * 65 + n4] = v.x; t[k * 65 + n4 + 1] = v.y; t[k * 65 + n4 + 2] = v.z; t[k * 65 + n4 + 3] = v.w;
  }
  __syncthreads();
#pragma unroll
  for (int i = 0; i < 2; ++i) {
    int q = tid + i * 256, n = q >> 3, kc = (q & 7) * 8;
    int c = n0 + n, nr = c;
    if (swiglu) nr = (c < FH) ? (32 * (c >> 4) + (c & 15)) : (32 * ((c - FH) >> 4) + 16 + ((c - FH) & 15));
    uint4 o = {pk2(t[kc * 65 + n], t[(kc + 1) * 65 + n]), pk2(t[(kc + 2) * 65 + n], t[(kc + 3) * 65 + n]),
               pk2(t[(kc + 4) * 65 + n], t[(kc + 5) * 65 + n]), pk2(t[(kc + 6) * 65 + n], t[(kc + 7) * 65 + n])};
    *(uint4*)(dst + (size_t)nr * K + k0 + kc) = o;
  }
}

__device__ void phase_prep(const P& p, char* smem) {
  const int tid = get_tid();
  constexpr int N_ADA = 1152, N_TR = 4 * 5248 + 32;
  const int vb = get_vb();
  for (int itp = blockIdx.x; itp < (N_ADA + N_TR) / 2 + 1; itp += gridDim.x) {
    const int item = (itp < (N_ADA + N_TR) / 2) ? 2 * itp + vb : (vb == 0 ? N_ADA + N_TR : -1);
    if (item < 0) continue;
    if (item < N_ADA) {
      float* act = (float*)smem;
      float* red = (float*)(smem + 20480);
      const int l = item / 288, cb = (item % 288) * 32;
      __syncthreads();
      for (int i = tid; i < 5120; i += 256) {
        int r = i >> 10, k = i & 1023;
        float v = r < 4 ? p.c[r * 1024 + k] : p.c_ctx[k];
        act[i] = silu(v);
      }
      __syncthreads();
      const int tx = tid & 31, kg = tid >> 5;
      float a0 = 0, a1 = 0, a2 = 0, a3 = 0, a4 = 0;
      const float* w = p.w_ada + ((size_t)l * 1024 + kg * 128) * 9216 + cb + tx;
      for (int k0 = 0; k0 < 128; k0 += 16) {
        float wv[16];
#pragma unroll
        for (int k = 0; k < 16; ++k) wv[k] = w[(size_t)(k0 + k) * 9216];
#pragma unroll
        for (int k = 0; k < 16; ++k) {
          int kk = kg * 128 + k0 + k;
          a0 += act[kk] * wv[k]; a1 += act[1024 + kk] * wv[k]; a2 += act[2048 + kk] * wv[k]; a3 += act[3072 + kk] * wv[k];
          a4 += act[4096 + kk] * wv[k];
        }
      }
      red[(kg * 5 + 0) * 32 + tx] = a0; red[(kg * 5 + 1) * 32 + tx] = a1; red[(kg * 5 + 2) * 32 + tx] = a2;
      red[(kg * 5 + 3) * 32 + tx] = a3; red[(kg * 5 + 4) * 32 + tx] = a4;
      __syncthreads();
      if (tid < 160) {
        int r = tid >> 5, x = tid & 31;
        float sacc = 0.f;
#pragma unroll
        for (int g8 = 0; g8 < 8; ++g8) sacc += red[(g8 * 5 + r) * 32 + x];
        ((float*)(p.ws + OFF_MODS))[(size_t)(l * 5 + r) * 9216 + cb + x] = sacc + p.b_ada[l * 9216 + cb + x];
      }
    } else if (item < N_ADA + N_TR) {
      int idx = item - N_ADA;
      if (idx < 4 * 5248) {
        int l = idx / 5248, r = idx % 5248;
        if (r < 2816) {
          int f = r / 1408, tile = r % 1408;
          convert_tile(p.w_ffn_in + (size_t)(l * 2 + f) * 1024 * 5632, 1024, 5632,
                       (u16*)(p.ws + OFF_WFI) + (size_t)(l * 2 + f) * 5632 * 1024, tile, true, smem);
        } else if (r < 4224) {
          int f = (r - 2816) / 704, tile = (r - 2816) % 704;
          convert_tile(p.w_ffn_out + (size_t)(l * 2 + f) * 2816 * 1024, 2816, 1024,
                       (u16*)(p.ws + OFF_WFO) + (size_t)(l * 2 + f) * 1024 * 2816, tile, false, smem);
        } else if (r < 4992) {
          const float* src = (l & 1) ? p.w_in_odd + (size_t)(l >> 1) * 1024 * 3072 : p.w_in_even + (size_t)(l >> 1) * 1024 * 3072;
          convert_tile(src, 1024, 3072, (u16*)(p.ws + OFF_WMI) + (size_t)l * 3072 * 1024, r - 4224, false, smem);
        } else {
          const float* src = (l & 1) ? p.w_out_odd + (size_t)(l >> 1) * 1024 * 1024 : p.w_out_even + (size_t)(l >> 1) * 1024 * 1024;
          convert_tile(src, 1024, 1024, (u16*)(p.ws + OFF_WMO) + (size_t)l * 1024 * 1024, r - 4992, false, smem);
        }
      } else {
        int i2 = idx - 4 * 5248, eg = i2 >> 2, tile = i2 & 3;
        convert_tile(p.pool_w + (size_t)eg * 128 * 128, 128, 128, (u16*)(p.ws + OFF_WPL) + (size_t)eg * 128 * 128, tile, false, smem);
      }
    } else {
      float* LB = (float*)(p.ws + OFF_LB);
      for (int i = tid; i < 1024; i += 256) {
        float a0 = p.hg_lb[i], a1 = p.hg_lb[1024 + i];
        float mx = fmaxf(a0, a1), e0 = __expf(a0 - mx), e1 = __expf(a1 - mx);
        LB[i] = 0.f;
        LB[1024 + i] = e1 / (e0 + e1);
      }
      if (tid < 2) {
        const float* lv = p.da_lambda + tid * 256;
        float s0 = 0, s1 = 0;
        for (int i = 0; i < 64; ++i) { s0 += lv[i] * lv[64 + i]; s1 += lv[128 + i] * lv[192 + i]; }
        float li = 0.8f - 0.6f * expf(-0.3f * (float)(2 * tid + 1));
        ((float*)(p.ws + OFF_LAM))[tid] = expf(s0) - expf(s1) + li;
      }
      float* rope = (float*)(p.ws + OFF_ROPE);
      for (int i = tid; i < 1024; i += 256) {
        int pos = i >> 4, fi = i & 15;
        float inv = exp2f(-(float)fi * (13.287712379549449f / 16.f));
        float ang = (float)pos * inv;
        float k = rintf(ang * 0.15915494309189535f);
        float r = fmaf(-k, 6.28125f, ang);
        r = fmaf(-k, 1.9353071795864769e-3f, r);
        rope[i * 2] = cosf(r);
        rope[i * 2 + 1] = sinf(r);
      }
    }
  }
}

__device__ void phase_rows(const P& p, int mode, int l, int sub, int M, bool final_out) {
  const int tid = get_tid(), lane = tid & 63, wid = tid >> 6;
  float* X = (float*)(p.ws + OFF_X);
  const u16* Y = (const u16*)(p.ws + OFF_Y);
  u16* H = (u16*)(p.ws + OFF_H);
  const float* MODS = (const float*)(p.ws + OFF_MODS);
  int nl, si;
  if (mode == 0) { nl = 0; si = 0; }
  else if (sub == 0) { nl = l; si = 3; }
  else if (sub == 1) { nl = l; si = 6; }
  else { nl = l + 1; si = 0; }
  const float gs = (sub == 1) ? 1.f : 0.5f;
  const float* lg = p.ln_g + (size_t)(l * 3 + sub) * D;
  const float* lbp = p.ln_b + (size_t)(l * 3 + sub) * D;
  for (int row0 = ((blockIdx.x * 2 + get_vb()) * 4 + wid) * 2; row0 < M; row0 += gridDim.x * 16) {
    const int mr = mod_row(row0);
    const bool ksplit = (mode == 1) && (sub != 1) && (row0 >= ML);
    float v[2][16];
    if (mode == 0) {
#pragma unroll
      for (int r = 0; r < 2; ++r) {
        const int row = row0 + r;
        const float* src = row < ML ? p.x + (size_t)row * D : p.ctx + (size_t)(row - ML) * D;
#pragma unroll
        for (int i = 0; i < 4; ++i) {
          float4 t = *(const float4*)(src + i * 256 + lane * 4);
          v[r][i * 4] = t.x; v[r][i * 4 + 1] = t.y; v[r][i * 4 + 2] = t.z; v[r][i * 4 + 3] = t.w;
        }
      }
    } else {
      const float* gate = MODS + (size_t)(l * 5 + mr) * 9216 + (2 + 3 * sub) * 1024;
      float4 xv[2][4]; uint2 yv[2][4]; float4 gv[4];
#pragma unroll
      for (int r = 0; r < 2; ++r)
#pragma unroll
        for (int i = 0; i < 4; ++i) {
          int c = i * 256 + lane * 4;
          xv[r][i] = *(const float4*)(X + (size_t)(row0 + r) * D + c);
          if (!ksplit) yv[r][i] = *(const uint2*)(Y + (size_t)(row0 + r) * D + c);
        }
      float ysum[2][16];
      if (ksplit) {
        const u16* YC = (const u16*)(p.ws + OFF_YC);
#pragma unroll
        for (int r = 0; r < 2; ++r)
#pragma unroll
          for (int i = 0; i < 4; ++i) {
            int c = i * 256 + lane * 4;
            uint2 t0 = *(const uint2*)(YC + ((size_t)0 * MC + row0 + r - ML) * D + c), t1 = *(const uint2*)(YC + ((size_t)1 * MC + row0 + r - ML) * D + c);
            uint2 t2 = *(const uint2*)(YC + ((size_t)2 * MC + row0 + r - ML) * D + c), t3 = *(const uint2*)(YC + ((size_t)3 * MC + row0 + r - ML) * D + c);
            ysum[r][i * 4] = __uint_as_float(t0.x << 16) + __uint_as_float(t1.x << 16) + __uint_as_float(t2.x << 16) + __uint_as_float(t3.x << 16);
            ysum[r][i * 4 + 1] = __uint_as_float(t0.x & 0xffff0000u) + __uint_as_float(t1.x & 0xffff0000u) + __uint_as_float(t2.x & 0xffff0000u) + __uint_as_float(t3.x & 0xffff0000u);
            ysum[r][i * 4 + 2] = __uint_as_float(t0.y << 16) + __uint_as_float(t1.y << 16) + __uint_as_float(t2.y << 16) + __uint_as_float(t3.y << 16);
            ysum[r][i * 4 + 3] = __uint_as_float(t0.y & 0xffff0000u) + __uint_as_float(t1.y & 0xffff0000u) + __uint_as_float(t2.y & 0xffff0000u) + __uint_as_float(t3.y & 0xffff0000u);
          }
      }
#pragma unroll
      for (int i = 0; i < 4; ++i) gv[i] = *(const float4*)(gate + i * 256 + lane * 4);
      float s[2] = {0.f, 0.f};
#pragma unroll
      for (int r = 0; r < 2; ++r)
#pragma unroll
        for (int i = 0; i < 4; ++i) {
          float y0, y1, y2, y3;
          if (ksplit) { y0 = ysum[r][i * 4]; y1 = ysum[r][i * 4 + 1]; y2 = ysum[r][i * 4 + 2]; y3 = ysum[r][i * 4 + 3]; }
          else {
            y0 = bf2f((u16)(yv[r][i].x & 0xffff)); y1 = bf2f((u16)(yv[r][i].x >> 16));
            y2 = bf2f((u16)(yv[r][i].y & 0xffff)); y3 = bf2f((u16)(yv[r][i].y >> 16));
          }
          v[r][i * 4] = ALPHA * xv[r][i].x + gs * gv[i].x * y0; v[r][i * 4 + 1] = ALPHA * xv[r][i].y + gs * gv[i].y * y1;
          v[r][i * 4 + 2] = ALPHA * xv[r][i].z + gs * gv[i].z * y2; v[r][i * 4 + 3] = ALPHA * xv[r][i].w + gs * gv[i].w * y3;
          s[r] += v[r][i * 4] + v[r][i * 4 + 1] + v[r][i * 4 + 2] + v[r][i * 4 + 3];
        }
#pragma unroll
      for (int o = 1; o < 64; o <<= 1) { s[0] = xor_sum(s[0], o); s[1] = xor_sum(s[1], o); }
      float q[2] = {0.f, 0.f};
#pragma unroll
      for (int r = 0; r < 2; ++r) {
        const float mu = s[r] * (1.f / 1024.f);
#pragma unroll
        for (int i = 0; i < 16; ++i) { v[r][i] -= mu; q[r] += v[r][i] * v[r][i]; }
      }
#pragma unroll
      for (int o = 1; o < 64; o <<= 1) { q[0] = xor_sum(q[0], o); q[1] = xor_sum(q[1], o); }
#pragma unroll
      for (int i = 0; i < 4; ++i) {
        int c = i * 256 + lane * 4;
        float4 g4 = *(const float4*)(lg + c), b4 = *(const float4*)(lbp + c);
#pragma unroll
        for (int r = 0; r < 2; ++r) {
          const float rstd = rsqrtf(q[r] * (1.f / 1024.f) + 1e-5f);
          v[r][i * 4] = v[r][i * 4] * rstd * g4.x + b4.x; v[r][i * 4 + 1] = v[r][i * 4 + 1] * rstd * g4.y + b4.y;
          v[r][i * 4 + 2] = v[r][i * 4 + 2] * rstd * g4.z + b4.z; v[r][i * 4 + 3] = v[r][i * 4 + 3] * rstd * g4.w + b4.w;
        }
      }
    }
    if (final_out) {
#pragma unroll
      for (int r = 0; r < 2; ++r)
#pragma unroll
        for (int i = 0; i < 4; ++i)
          *(float4*)(p.out + (size_t)(row0 + r) * D + i * 256 + lane * 4) =
              float4{v[r][i * 4], v[r][i * 4 + 1], v[r][i * 4 + 2], v[r][i * 4 + 3]};
      continue;
    }
    const float* sh = MODS + (size_t)(nl * 5 + mr) * 9216 + si * 1024;
#pragma unroll
    for (int i = 0; i < 4; ++i) {
      int c = i * 256 + lane * 4;
      float4 s4 = *(const float4*)(sh + c), c4 = *(const float4*)(sh + 1024 + c);
#pragma unroll
      for (int r = 0; r < 2; ++r) {
        *(float4*)(X + (size_t)(row0 + r) * D + c) = float4{v[r][i * 4], v[r][i * 4 + 1], v[r][i * 4 + 2], v[r][i * 4 + 3]};
        uint2 hv = {pk2(v[r][i * 4] * (1.f + c4.x) + s4.x, v[r][i * 4 + 1] * (1.f + c4.y) + s4.y),
                    pk2(v[r][i * 4 + 2] * (1.f + c4.z) + s4.z, v[r][i * 4 + 3] * (1.f + c4.w) + s4.w)};
        *(uint2*)(H + (size_t)(row0 + r) * D + c) = hv;
      }
    }
  }
}

__device__ void phase_attn(const P& p, int l, char* smem) {
  int tid = threadIdx.x; asm volatile("" : "+v"(tid));
  const int lane = tid & 63, w = tid >> 6, fr = lane & 15, fq = lane >> 4;
  const int m = w & 1, pr = w >> 1;
  const u16* PROJ = (const u16*)(p.ws + OFF_PROJ);
  const u16* VT = (const u16*)(p.ws + OFF_VT);
  u16* MIX = (u16*)(p.ws + OFF_MIX);
  const float lam = ((const float*)(p.ws + OFF_LAM))[l >> 1];
  const float lam_init = 0.8f - 0.6f * expf(-0.3f * (float)l);
  const float* subw = p.da_sub_w + (l >> 1) * 128;
  const int xcd = blockIdx.x & 7, slot = blockIdx.x >> 3, nslot = gridDim.x >> 3;
  const int n_virt = (l == 3) ? 128 : 136;
  for (int idx = slot; idx < n_virt; idx += nslot) {
    int b, h, qrow0, nkt;
    if (idx < 128) {
      const int bh = (idx >> 5) * 8 + xcd;
      b = bh >> 3; h = bh & 7; qrow0 = b * 4096 + (idx & 31) * 128; nkt = 68;
    } else {
      const int cs = idx - 128, bh = (cs >> 1) * 8 + xcd;
      b = bh >> 3; h = bh & 7; qrow0 = ML + b * 256 + (cs & 1) * 128; nkt = 4;
    }
    bf16x8 qf[2][2];
#pragma unroll
    for (int qi = 0; qi < 2; ++qi) {
      const u16* qp = PROJ + (size_t)(qrow0 + pr * 32 + qi * 16 + fr) * 3072 + h * 128 + m * 64 + fq * 8;
#pragma unroll
      for (int ks = 0; ks < 2; ++ks) qf[qi][ks] = *(const bf16x8*)(qp + ks * 32);
    }
    f32x4 O[2][8];
#pragma unroll
    for (int qi = 0; qi < 2; ++qi)
#pragma unroll
      for (int v = 0; v < 8; ++v) O[qi][v] = f32x4{0.f, 0.f, 0.f, 0.f};
    float mrun[2] = {-1e30f, -1e30f}, lsum[2] = {0.f, 0.f};
    const u16* vbase = VT + (size_t)((b * 8 + h) * 128) * TK;
    auto stage = [&](int kt2) {
#pragma unroll
      for (int hf = 0; hf < 2; ++hf) {
        const int kt = kt2 * 2 + hf;
        char* buf = smem + (kt2 & 1) * 65536 + hf * 32768;
        const int krow0 = kt < 4 ? ML + b * 256 + kt * 64 : b * 4096 + (kt - 4) * 64;
#pragma unroll
        for (int i = 0; i < 2; ++i) {
          int q = tid + i * 512;
          int key = q >> 4, ch = (q & 15) ^ (key & 15);
          glds16(PROJ + (size_t)(krow0 + key) * 3072 + 1024 + h * 128 + ch * 8, buf + q * 16);
          int dv = q >> 3, c2 = (q & 7) ^ ((dv >> 1) & 7);
          glds16(vbase + (size_t)dv * TK + kt * 64 + c2 * 8, buf + 16384 + q * 16);
        }
      }
    };
    asm volatile("s_waitcnt vmcnt(0)" ::: "memory");
    __syncthreads();
    stage(0);
    for (int kt = 0; kt < nkt; ++kt) {
      if (!(kt & 1)) {
        asm volatile("s_waitcnt vmcnt(0)" ::: "memory");
        asm volatile("s_waitcnt lgkmcnt(0)" ::: "memory");
        __builtin_amdgcn_s_barrier();
        if (kt + 2 < nkt) stage((kt >> 1) + 1);
      }
      const char* cur = smem + ((kt >> 1) & 1) * 65536 + (kt & 1) * 32768;
      bf16x8 pb[2][2];
      f32x4 s[2][4];
      {
        bf16x8 kf[4][2];
#pragma unroll
        for (int sf = 0; sf < 4; ++sf)
#pragma unroll
          for (int ks = 0; ks < 2; ++ks) kf[sf][ks] = *(const bf16x8*)(cur + swz256(sf * 16 + fr, m * 8 + ks * 4 + fq));
        __builtin_amdgcn_sched_barrier(0);
#pragma unroll
        for (int sf = 0; sf < 4; ++sf) {
          s[0][sf] = f32x4{0.f, 0.f, 0.f, 0.f};
          s[1][sf] = f32x4{0.f, 0.f, 0.f, 0.f};
#pragma unroll
          for (int ks = 0; ks < 2; ++ks) {
            s[0][sf] = mfma16(kf[sf][ks], qf[0][ks], s[0][sf]);
            s[1][sf] = mfma16(kf[sf][ks], qf[1][ks], s[1][sf]);
          }
        }
      }
      float tm0 = -1e30f, tm1 = -1e30f;
#pragma unroll
      for (int sf = 0; sf < 4; ++sf)
#pragma unroll
        for (int j = 0; j < 4; ++j) { tm0 = fmaxf(tm0, s[0][sf][j]); tm1 = fmaxf(tm1, s[1][sf][j]); }
      if (__any(fmaxf(tm0 - mrun[0], tm1 - mrun[1]) > 6.f)) {
        tm0 = xor_max(tm0, 16); tm1 = xor_max(tm1, 16);
        tm0 = xor_max(tm0, 32); tm1 = xor_max(tm1, 32);
        const float mn0 = fmaxf(mrun[0], tm0), sc0 = ex2(mrun[0] - mn0);
        const float mn1 = fmaxf(mrun[1], tm1), sc1 = ex2(mrun[1] - mn1);
        mrun[0] = mn0; mrun[1] = mn1;
        lsum[0] *= sc0; lsum[1] *= sc1;
#pragma unroll
        for (int v = 0; v < 8; ++v) { O[0][v] *= sc0; O[1][v] *= sc1; }
      }
#pragma unroll
      for (int qi = 0; qi < 2; ++qi) {
        const float mn = mrun[qi];
        float ps = 0.f;
#pragma unroll
        for (int sf = 0; sf < 4; ++sf)
#pragma unroll
          for (int j = 0; j < 4; ++j) { s[qi][sf][j] = ex2(s[qi][sf][j] - mn); ps += s[qi][sf][j]; }
        lsum[qi] += ps;
#pragma unroll
        for (int k2 = 0; k2 < 2; ++k2) {
          union { bf16x8 v; unsigned u[4]; } t;
          t.u[0] = pk2(s[qi][2 * k2][0], s[qi][2 * k2][1]); t.u[1] = pk2(s[qi][2 * k2][2], s[qi][2 * k2][3]);
          t.u[2] = pk2(s[qi][2 * k2 + 1][0], s[qi][2 * k2 + 1][1]); t.u[3] = pk2(s[qi][2 * k2 + 1][2], s[qi][2 * k2 + 1][3]);
          pb[qi][k2] = t.v;
        }
      }
#pragma unroll
      for (int vb = 0; vb < 8; vb += 4) {
        bf16x8 a0[4], a1[4];
#pragma unroll
        for (int i = 0; i < 4; ++i) {
          const int dv = (vb + i) * 16 + fr;
          a0[i] = *(const bf16x8*)(cur + 16384 + swz128(dv, fq));
          a1[i] = *(const bf16x8*)(cur + 16384 + swz128(dv, 4 + fq));
        }
        __builtin_amdgcn_sched_barrier(0);
        __builtin_amdgcn_s_setprio(1);
#pragma unroll
        for (int i = 0; i < 4; ++i) {
          O[0][vb + i] = mfma16(a0[i], pb[0][0], O[0][vb + i]);
          O[1][vb + i] = mfma16(a0[i], pb[1][0], O[1][vb + i]);
          O[0][vb + i] = mfma16(a1[i], pb[0][1], O[0][vb + i]);
          O[1][vb + i] = mfma16(a1[i], pb[1][1], O[1][vb + i]);
        }
        __builtin_amdgcn_s_setprio(0);
        __builtin_amdgcn_sched_barrier(0);
      }
    }
    float* xch = (float*)smem + (size_t)pr * 4096;
    __syncthreads();
#pragma unroll
    for (int qi = 0; qi < 2; ++qi) {
      const float lq = xor_sum(xor_sum(lsum[qi], 16), 32);
      const float sc = (m ? lam : 1.f) / lq;
#pragma unroll
      for (int v = 0; v < 8; ++v) O[qi][v] *= sc;
    }
    if (m) {
#pragma unroll
      for (int qi = 0; qi < 2; ++qi)
#pragma unroll
        for (int v = 0; v < 8; ++v)
#pragma unroll
          for (int j = 0; j < 4; ++j) xch[((qi * 8 + v) * 4 + j) * 64 + lane] = O[qi][v][j];
    }
    __syncthreads();
    if (!m) {
#pragma unroll
      for (int qi = 0; qi < 2; ++qi) {
        float ssq = 0.f;
#pragma unroll
        for (int v = 0; v < 8; ++v)
#pragma unroll
          for (int j = 0; j < 4; ++j) { float o = O[qi][v][j] - xch[((qi * 8 + v) * 4 + j) * 64 + lane]; O[qi][v][j] = o; ssq += o * o; }
        ssq = xor_sum(xor_sum(ssq, 16), 32);
        const float rs = rsqrtf(ssq * (1.f / 128.f) + 1e-6f) * (1.f - lam_init);
        u16* op = MIX + (size_t)(qrow0 + pr * 32 + qi * 16 + fr) * D + h * 128;
#pragma unroll
        for (int v = 0; v < 8; ++v) {
          int dv = v * 16 + fq * 4;
          float4 sw = *(const float4*)(subw + dv);
          uint2 o = {pk2(O[qi][v][0] * rs * sw.x, O[qi][v][1] * rs * sw.y), pk2(O[qi][v][2] * rs * sw.z, O[qi][v][3] * rs * sw.w)};
          *(uint2*)(op + dv) = o;
        }
      }
    }
  }
}

__device__ __forceinline__ void chunk_rows(int b, int cc_seq, int& row0, int& pos0) {
  if (cc_seq < 4) { row0 = ML + b * 256 + cc_seq * 64; pos0 = cc_seq * 64; }
  else { row0 = b * 4096 + (cc_seq - 4) * 64; pos0 = CTX + (cc_seq - 4) * 64; }
}
__device__ __forceinline__ int scan2tok(int c, int dir) {
  if (!dir) return c;
  return c < 4 ? 3 - c : 4 + 63 - (c - 4);
}

__device__ void hg_u_item(const P& p, int e, int item, char* smem) {
  const int tid = get_tid(), lane = tid & 63, wid = tid >> 6, wr = wid >> 1, wc = wid & 1, fr = lane & 15, fq = lane >> 4;
  const u16* PROJ = (const u16*)(p.ws + OFF_PROJ);
  const u16* IT = (const u16*)(p.ws + OFF_VT);
  u16* U = (u16*)(p.ws + OFF_U);
  float* DEC = (float*)(p.ws + OFF_DEC);
  const float* LB = (const float*)(p.ws + OFF_LB);
  const int c = item % NCH, seq = item / NCH, dir = seq & 1, h = (seq >> 1) & 3, b = seq >> 3;
  int row0, pos0;
  chunk_rows(b, scan2tok(c, dir), row0, pos0);
  float* tot = (float*)(smem + 16384);
  const int d = tid & 127, half = tid >> 7;
  const float lb = LB[(e * 2 + dir) * 512 + h * 128 + d];
  const u16* zl = (const u16*)(smem + 32768) + d;
  __syncthreads();
  {
    const u16* zg = PROJ + (size_t)row0 * 3072 + 1536 + dir * 512 + h * 128;
#pragma unroll
    for (int i = 0; i < 4; ++i) {
      int q = tid + i * 256;
      glds16(zg + (size_t)(q >> 4) * 3072 + (q & 15) * 8, smem + 32768 + q * 16);
    }
  }
  asm volatile("s_waitcnt vmcnt(0)" ::: "memory");
  __syncthreads();
  float sum = 0.f;
#pragma unroll 8
  for (int i = 0; i < 32; ++i) {
    int tau = half * 32 + i, t = dir ? 63 - tau : tau;
    float f = lb + (1.f - lb) * sigm(bf2f(zl[t * 128]));
    sum += __logf(fmaxf(f, 1e-20f));
  }
  tot[half * 128 + d] = sum;
  __syncthreads();
  float rel = half ? 0.f : tot[128 + d];
#pragma unroll 8
  for (int i = 31; i >= 0; --i) {
    int tau = half * 32 + i, t = dir ? 63 - tau : tau;
    float f = lb + (1.f - lb) * sigm(bf2f(zl[t * 128]));
    float lf = __logf(fmaxf(f, 1e-20f));
    { const int tp = kperm(t); *(u16*)(smem + swz128(d, tp >> 3) + (tp & 7) * 2) = f2bf((1.f - f) * __expf(rel)); }
    rel += lf;
  }
  if (!half) DEC[(size_t)(seq * NCH + c) * 128 + d] = __expf(rel);
  __syncthreads();
  f32x4 acc[4][4];
#pragma unroll
  for (int m = 0; m < 4; ++m)
#pragma unroll
    for (int n = 0; n < 4; ++n) acc[m][n] = f32x4{0.f, 0.f, 0.f, 0.f};
  const u16* vb = IT + (size_t)((b * 4 + h) * 128) * TK + pos0;
#pragma unroll
  for (int ks = 0; ks < 2; ++ks) {
    bf16x8 a[4], bb[4];
#pragma unroll
    for (int m = 0; m < 4; ++m) a[m] = *(const bf16x8*)(vb + (size_t)(wr * 64 + m * 16 + fr) * TK + ks * 32 + fq * 8);
#pragma unroll
    for (int n = 0; n < 4; ++n) bb[n] = *(const bf16x8*)(smem + swz128(wc * 64 + n * 16 + fr, ks * 4 + fq));
#pragma unroll
    for (int m = 0; m < 4; ++m)
#pragma unroll
      for (int n = 0; n < 4; ++n) acc[m][n] = mfma16(bb[n], a[m], acc[m][n]);
  }
  u16* up = U + (size_t)(seq * NCH + c) * 16384;
#pragma unroll
  for (int m = 0; m < 4; ++m)
#pragma unroll
    for (int n = 0; n < 4; ++n)
      *(uint2*)(up + (wr * 64 + m * 16 + fr) * 128 + wc * 64 + n * 16 + fq * 4) =
          uint2{pk2(acc[m][n][0], acc[m][n][1]), pk2(acc[m][n][2], acc[m][n][3])};
}

__device__ void pool_item(const P& p, int item) {
  const int tid = get_tid();
  const u16* PROJ = (const u16*)(p.ws + OFF_PROJ);
  u16* PO = (u16*)(p.ws + OFF_POOLED);
  const int ch = tid * 2, g = ch >> 7, hw = 1 << g;
  const int row0 = item * 32;
  int base, n, pos0;
  if (row0 < ML) { base = row0 & ~4095; n = 4096; pos0 = row0 & 4095; }
  else { base = ML + ((row0 - ML) & ~255); n = 256; pos0 = (row0 - ML) & 255; }
  const u16* up = PROJ + (size_t)base * 3072 + 2560 + ch;
  float s0 = 0.f, s1 = 0.f;
  {
    const int lo = max(pos0 - hw, 0), hi = min(pos0 + hw, n);
    for (int r = lo; r < hi; ++r) {
      unsigned v = *(const unsigned*)(up + (size_t)r * 3072);
      s0 += __uint_as_float(v << 16); s1 += __uint_as_float(v & 0xffff0000u);
    }
  }
  for (int i0 = 0; i0 < 32; i0 += 16) {
    unsigned ce[16], en[16], le[16];
#pragma unroll
    for (int i = 0; i < 16; ++i) {
      const int pos = pos0 + i0 + i;
      ce[i] = *(const unsigned*)(up + (size_t)pos * 3072);
      en[i] = (pos + hw < n) ? *(const unsigned*)(up + (size_t)(pos + hw) * 3072) : 0u;
      le[i] = (pos - hw >= 0) ? *(const unsigned*)(up + (size_t)(pos - hw) * 3072) : 0u;
    }
#pragma unroll
    for (int i = 0; i < 16; ++i) {
      const int pos = pos0 + i0 + i;
      const int lo = max(pos - hw, 0), hi = min(pos + hw, n);
      const float ic = 1.f / (float)(hi - lo);
      *(unsigned*)(PO + (size_t)(base + pos) * 512 + ch) =
          pk2(s0 * ic - __uint_as_float(ce[i] << 16), s1 * ic - __uint_as_float(ce[i] & 0xffff0000u));
      s0 += __uint_as_float(en[i] << 16) - __uint_as_float(le[i] << 16);
      s1 += __uint_as_float(en[i] & 0xffff0000u) - __uint_as_float(le[i] & 0xffff0000u);
    }
  }
}

__device__ void hg_scan_item(const P& p, int item) {
  unsigned* U = (unsigned*)(p.ws + OFF_U);
  const float* DEC = (const float*)(p.ws + OFF_DEC);
  const int ei = item * 256 + get_tid(), seq = ei >> 13, vd2 = ei & 8191, d = (vd2 & 63) * 2;
  unsigned* up = U + (size_t)seq * NCH * 8192 + vd2;
  const float* dp = DEC + (size_t)seq * NCH * 128 + d;
  float s0 = 0.f, s1 = 0.f;
  for (int c0 = 0; c0 < NCH; c0 += 17) {
    unsigned u[17]; float2 dd[17];
#pragma unroll
    for (int i = 0; i < 17; ++i) { u[i] = up[(size_t)(c0 + i) * 8192]; dd[i] = *(const float2*)(dp + (c0 + i) * 128); }
#pragma unroll
    for (int i = 0; i < 17; ++i) {
      up[(size_t)(c0 + i) * 8192] = pk2(s0, s1);
      s0 = dd[i].x * s0 + __uint_as_float(u[i] << 16);
      s1 = dd[i].y * s1 + __uint_as_float(u[i] & 0xffff0000u);
    }
  }
}

__device__ void hg_o_item(const P& p, int e, int item, char* smem) {
  const int tid = get_tid(), lane = tid & 63, w = tid >> 6, fr = lane & 15, fq = lane >> 4;
  const u16* PROJ = (const u16*)(p.ws + OFF_PROJ);
  const u16* IT = (const u16*)(p.ws + OFF_VT);
  const u16* S = (const u16*)(p.ws + OFF_U);
  const float* LB = (const float*)(p.ws + OFF_LB);
  u16* MIX = (u16*)(p.ws + OFF_MIX);
  const int tc = item % NCH, bh = item / NCH, h = bh & 3, b = bh >> 2;
  int row0, pos0;
  chunk_rows(b, tc, row0, pos0);
  char* qh = smem;
  char* kh = smem + 16384;
  char* vt = smem + 32768;
  float* eref = (float*)(smem + 49152);
  __syncthreads();
  {
    const u16* vb = IT + (size_t)((b * 4 + h) * 128) * TK + pos0;
#pragma unroll
    for (int i = 0; i < 4; ++i) {
      int q = tid + i * 256, dv = q >> 3, c2 = (q & 7) ^ ((dv >> 1) & 7);
      glds16(vb + (size_t)dv * TK + c2 * 8, vt + q * 16);
    }
  }
  f32x4 O[8];
#pragma unroll
  for (int v = 0; v < 8; ++v) O[v] = f32x4{0.f, 0.f, 0.f, 0.f};
  const int d = tid & 127, half = tid >> 7;
  for (int dir = 0; dir < 2; ++dir) {
    const int c = dir ? (tc < 4 ? 3 - tc : 4 + 63 - (tc - 4)) : tc;
    const int seq = (b * 4 + h) * 2 + dir;
    const float lb = LB[(e * 2 + dir) * 512 + h * 128 + d];
    if (dir) __syncthreads();
    {
      const u16* zg = PROJ + (size_t)row0 * 3072 + 1536 + dir * 512 + h * 128;
      const u16* qg = PROJ + (size_t)row0 * 3072 + h * 128;
#pragma unroll
      for (int i = 0; i < 4; ++i) {
        int q = tid + i * 256, row = q >> 4, ch = (q & 15) ^ (row & 15);
        glds16(zg + (size_t)row * 3072 + ch * 8, kh + q * 16);
        glds16(qg + (size_t)row * 3072 + ch * 8, qh + q * 16);
      }
    }
    asm volatile("s_waitcnt vmcnt(0)" ::: "memory");
    __syncthreads();
    float rel = 0.f;
    if (!half) {
#pragma unroll 8
      for (int tau = 31; tau >= 0; --tau) {
        int t = dir ? 63 - tau : tau;
        int off = swz256(t, d >> 3) + (d & 7) * 2;
        float f = lb + (1.f - lb) * sigm(bf2f(*(const u16*)(kh + off)));
        float lf = __logf(fmaxf(f, 1e-20f));
        float q = bf2f(*(const u16*)(qh + off));
        *(u16*)(qh + off) = f2bf(q * __expf(rel));
        *(u16*)(kh + off) = f2bf((1.f - f) * __expf(-rel));
        rel -= lf;
      }
      eref[d] = __expf(-rel);
    } else {
#pragma unroll 8
      for (int tau = 32; tau < 64; ++tau) {
        int t = dir ? 63 - tau : tau;
        int off = swz256(t, d >> 3) + (d & 7) * 2;
        float f = lb + (1.f - lb) * sigm(bf2f(*(const u16*)(kh + off)));
        float lf = __logf(fmaxf(f, 1e-20f));
        float q = bf2f(*(const u16*)(qh + off));
        rel += lf;
        *(u16*)(qh + off) = f2bf(q * __expf(rel));
        *(u16*)(kh + off) = f2bf((1.f - f) * __expf(-rel));
      }
    }
    __syncthreads();
    bf16x8 qf[4];
#pragma unroll
    for (int ks = 0; ks < 4; ++ks) qf[ks] = *(const bf16x8*)(qh + swz256(w * 16 + fr, ks * 4 + fq));
    f32x4 s[4];
#pragma unroll
    for (int sf = 0; sf < 4; ++sf) {
      s[sf] = f32x4{0.f, 0.f, 0.f, 0.f};
#pragma unroll
      for (int ks = 0; ks < 4; ++ks) {
        bf16x8 a = *(const bf16x8*)(kh + swz256(sf * 16 + fr, ks * 4 + fq));
        s[sf] = mfma16(a, qf[ks], s[sf]);
      }
    }
    const int tq = w * 16 + fr;
#pragma unroll
    for (int sf = 0; sf < 4; ++sf)
#pragma unroll
      for (int j = 0; j < 4; ++j) {
        int ss = sf * 16 + fq * 4 + j;
        bool keep = dir ? (ss >= tq) : (ss <= tq);
        s[sf][j] = keep ? s[sf][j] : 0.f;
      }
    bf16x8 pb[2];
#pragma unroll
    for (int k2 = 0; k2 < 2; ++k2) {
      union { bf16x8 v; unsigned u[4]; } t;
      t.u[0] = pk2(s[2 * k2][0], s[2 * k2][1]); t.u[1] = pk2(s[2 * k2][2], s[2 * k2][3]);
      t.u[2] = pk2(s[2 * k2 + 1][0], s[2 * k2 + 1][1]); t.u[3] = pk2(s[2 * k2 + 1][2], s[2 * k2 + 1][3]);
      pb[k2] = t.v;
    }
#pragma unroll
    for (int v = 0; v < 8; ++v)
#pragma unroll
      for (int k2 = 0; k2 < 2; ++k2) {
        const int dv = v * 16 + fr;
        union { bf16x8 v; uint2 u[2]; } a;
        a.v = *(const bf16x8*)(vt + swz128(dv, k2 * 4 + fq));
        O[v] = mfma16(a.v, pb[k2], O[v]);
      }
    const u16* sp = S + (size_t)(seq * NCH + c) * 16384;
#pragma unroll
    for (int ks = 0; ks < 4; ++ks) {
      union { bf16x8 v; u16 h[8]; unsigned u[4]; } qq, qs;
      qq.v = qf[ks];
      const float* er = eref + ks * 32 + fq * 8;
#pragma unroll
      for (int i = 0; i < 4; ++i) qs.u[i] = pk2(bf2f(qq.h[2 * i]) * er[2 * i], bf2f(qq.h[2 * i + 1]) * er[2 * i + 1]);
#pragma unroll
      for (int v = 0; v < 8; ++v) {
        const bf16x8 av = *(const bf16x8*)(sp + (v * 16 + fr) * 128 + ks * 32 + fq * 8);
        O[v] = mfma16(av, qs.v, O[v]);
      }
    }
  }
  float ssq = 0.f;
#pragma unroll
  for (int v = 0; v < 8; ++v)
#pragma unroll
    for (int j = 0; j < 4; ++j) ssq += O[v][j] * O[v][j];
  ssq = xor_sum(xor_sum(ssq, 16), 32);
  const float rs = rsqrtf(ssq * (1.f / 128.f) + 1e-6f);
  const int row = row0 + w * 16 + fr;
  const float* nw = p.hg_norm_w + e * 128;
#pragma unroll
  for (int v = 0; v < 8; ++v) {
    int dv = v * 16 + fq * 4;
    uint2 gv = *(const uint2*)(PROJ + (size_t)row * 3072 + 1024 + h * 128 + dv);
    float4 n4 = *(const float4*)(nw + dv);
    float g0 = bf2f((u16)(gv.x & 0xffff)), g1 = bf2f((u16)(gv.x >> 16)), g2 = bf2f((u16)(gv.y & 0xffff)), g3 = bf2f((u16)(gv.y >> 16));
    uint2 o = {pk2(O[v][0] * rs * n4.x * silu(g0), O[v][1] * rs * n4.y * silu(g1)),
               pk2(O[v][2] * rs * n4.z * silu(g2), O[v][3] * rs * n4.w * silu(g3))};
    *(uint2*)(MIX + (size_t)row * D + h * 128 + dv) = o;
  }
}

#define XB_TMO      128
#define XB_XCNT(j)  (256  + 64 * (j))
#define XB_XSUB(j)  (1280 + 64 * (j))
#define XB_XGEN(j)  (2304 + 64 * (j))
#define XB_TOP      3328
#define XB_TOPGEN   3392
#define XCD_BAR_WORDS 3456
#define XB_SPIN_CAP (1u << 18)
__device__ __forceinline__ unsigned xb_ld(unsigned* p) { return __hip_atomic_load(p, __ATOMIC_RELAXED, __HIP_MEMORY_SCOPE_AGENT); }
__device__ __forceinline__ unsigned xb_add(unsigned* p, unsigned v) { return __hip_atomic_fetch_add(p, v, __ATOMIC_RELAXED, __HIP_MEMORY_SCOPE_AGENT); }
__device__ __forceinline__ unsigned xb_xcc_id() { return (unsigned)__builtin_amdgcn_s_getreg((3 << 11) | 20) & 0xFu; }
#define XB_SPIN(cond, bar) do { unsigned _sp = 0; while (cond) { __builtin_amdgcn_s_sleep(1); \
    if ((++_sp & 255u) == 0u) { if (xb_ld(&(bar)[XB_TMO])) break; if (_sp > XB_SPIN_CAP) { atomicAdd(&(bar)[XB_TMO], 1u); break; } } } } while (0)
struct GB { unsigned* bar; unsigned x; volatile unsigned* st; };
__device__ __forceinline__ void gb_complete(unsigned* bar, unsigned x, unsigned& nloc, unsigned& nx) {
  const unsigned G = gridDim.x;
  unsigned sum, cnt, mine, sp = 0u;
  for (;;) {
    sum = 0u; cnt = 0u; mine = 0u;
#pragma unroll
    for (unsigned j = 0; j < 16; ++j) { const unsigned c = xb_ld(&bar[XB_XCNT(j)]); sum += c; cnt += (c > 0u) ? 1u : 0u; mine = (j == x) ? c : mine; }
    if (sum == G) break;
    __builtin_amdgcn_s_sleep(1);
    if ((++sp & 255u) == 0u) { if (xb_ld(&bar[XB_TMO])) break; if (sp > XB_SPIN_CAP) { atomicAdd(&bar[XB_TMO], 1u); break; } }
  }
  nloc = mine > 0u ? mine : 1u; nx = cnt > 0u ? cnt : 1u;
}
__device__ __forceinline__ void gbar(GB& b) {
  asm volatile("s_waitcnt vmcnt(0)" ::: "memory");
  __syncthreads();
  if (threadIdx.x == 0) {
    unsigned* bar = b.bar;
    __builtin_amdgcn_s_waitcnt(0);
    unsigned nloc = b.st[0], nx = b.st[1];
    if (nloc == 0u) { gb_complete(bar, b.x, nloc, nx); b.st[0] = nloc; b.st[1] = nx; }
    const unsigned old = xb_add(&bar[XB_XSUB(b.x)], 1u);
    const unsigned gen = old / nloc;
    if (old + 1u == (gen + 1u) * nloc) {
      __builtin_amdgcn_fence(__ATOMIC_RELEASE, "agent");
      asm volatile("s_waitcnt vmcnt(0)" ::: "memory");
      const unsigned og = xb_add(&bar[XB_TOP], 1u);
      const unsigned tg = og / nx;
      if (og + 1u == (tg + 1u) * nx) xb_add(&bar[XB_TOPGEN], 1u);
      else XB_SPIN(xb_ld(&bar[XB_TOPGEN]) == tg, bar);
      __builtin_amdgcn_fence(__ATOMIC_ACQUIRE, "agent");
      xb_add(&bar[XB_XGEN(b.x)], 1u);
      asm volatile("s_waitcnt vmcnt(0)" ::: "memory");
    } else {
      XB_SPIN(xb_ld(&bar[XB_XGEN(b.x)]) == gen, bar);
      __builtin_amdgcn_fence(__ATOMIC_ACQUIRE, "agent");
      asm volatile("s_waitcnt vmcnt(0)" ::: "memory");
    }
  }
  __syncthreads();
}

template <int K>
__device__ __forceinline__ void n1024_phase(const P& p, const u16* A, const u16* Wt, bool with_ctx, bool ksplit, char* smem) {
  u16* Y = (u16*)(p.ws + OFF_Y);
  u16* YC = (u16*)(p.ws + OFF_YC);
  gemm8<1024, K>(A, Wt, ML, smem, BlkY{Y});
  if (!with_ctx) return;
  const int vb = get_vb();
  char* vsm = smem + vb * 65536;
  if (ksplit) {
    for (int it = blockIdx.x; it < 128; it += gridDim.x) {
      const int u = 2 * it + vb, ks = u & 3, ct = u >> 2, pm = ct >> 3, pn = ct & 7;
      gemm_tile(A + ks * 704, K, Wt + ks * 704, K, 704, ML + pm * 128, pn * 128, vsm,
                Epi4<BlkY>{BlkY{YC + ((size_t)ks * MC - ML) * D}});
    }
  } else {
    for (int it = blockIdx.x; it < 32; it += gridDim.x) {
      const int u = 2 * it + vb, pm = u >> 3, pn = u & 7;
      gemm_tile(A, K, Wt, K, K, ML + pm * 128, pn * 128, vsm, Epi4<BlkY>{BlkY{Y}});
    }
  }
}

constexpr int PH_PER_EVEN = 12, PH_PER_ODD = 10;
constexpr int N_PHASES = 2 + 2 * PH_PER_EVEN + 2 * PH_PER_ODD;

__device__ __forceinline__ void run_phase(const P& pin, int ph, char* smem) {
  P p = pin;
  asm volatile("" : "+s"(p.ws));
  asm volatile("" : "+s"(p.out));
  const int vb = get_vb();
  char* vsm = smem + vb * 65536;
  u16* H = (u16*)(p.ws + OFF_H);
  u16* HID = (u16*)(p.ws + OFF_HID);
  u16* PROJ = (u16*)(p.ws + OFF_PROJ);
  u16* VT = (u16*)(p.ws + OFF_VT);
  u16* MIX = (u16*)(p.ws + OFF_MIX);
  if (ph == 0) { phase_prep(p, vsm); return; }
  if (ph == 1) { phase_rows(p, 0, 0, 0, MT, false); return; }
  int q = ph - 2, l;
  if (q < PH_PER_EVEN) l = 0;
  else if (q < PH_PER_EVEN + PH_PER_ODD) { l = 1; q -= PH_PER_EVEN; }
  else if (q < 2 * PH_PER_EVEN + PH_PER_ODD) { l = 2; q -= PH_PER_EVEN + PH_PER_ODD; }
  else { l = 3; q -= 2 * PH_PER_EVEN + PH_PER_ODD; }
  const bool even = !(l & 1), last = (l == 3);
  int step = q;
  if (!even && q >= 5) step = q + 2;
  const int Mpost = last ? ML : MT;
  const u16* WFI = (const u16*)(p.ws + OFF_WFI);
  const u16* WFO = (const u16*)(p.ws + OFF_WFO);
  const u16* WMI = (const u16*)(p.ws + OFF_WMI) + (size_t)l * 3072 * 1024;
  switch (step) {
    case 0:
    case 9: {
      const int f = (step == 9) ? 1 : 0;
      gemm8<5632, 1024>(H, WFI + (size_t)(l * 2 + f) * 5632 * 1024, f ? Mpost : MT, smem, BlkSwiglu{HID});
    } break;
    case 1:
    case 7:
    case 10: {
      if (step == 7) n1024_phase<1024>(p, MIX, (const u16*)(p.ws + OFF_WMO) + (size_t)l * 1024 * 1024, !last, false, smem);
      else n1024_phase<2816>(p, HID, WFO + (size_t)(l * 2 + (step == 10 ? 1 : 0)) * 1024 * 2816, step == 1 || !last, true, smem);
    } break;
    case 2: phase_rows(p, 1, l, 0, MT, false); break;
    case 3:
      if (even) {
        gemm8<3072, 1024>(H, WMI, ML, smem, BlkProjEven{PROJ, VT});
        for (int it = blockIdx.x; it < 96; it += gridDim.x) {
          const int u = 2 * it + vb, pm = u / 24, pn = u % 24;
          gemm_tile(H, D, WMI, D, 1024, ML + pm * 128, pn * 128, vsm, Epi4<BlkProjEven>{BlkProjEven{PROJ, VT}});
        }
      } else {
        const float* rope = (const float*)(p.ws + OFF_ROPE);
        gemm8<3072, 1024>(H, WMI, ML, smem, BlkProjOdd{PROJ, VT, rope});
        for (int it = blockIdx.x; it < 96; it += gridDim.x) {
          const int u = 2 * it + vb, pm = u / 24, pn = u % 24;
          gemm_tile(H, D, WMI, D, 1024, ML + pm * 128, pn * 128, vsm, Epi4<BlkProjOdd>{BlkProjOdd{PROJ, VT, rope}});
        }
      }
      break;
    case 4:
      if (even) {
        for (int itp = blockIdx.x; itp < (32 * NCH + MT / 32) / 2; itp += gridDim.x) {
          const int it = 2 * itp + vb;
          if (it < 32 * NCH) hg_u_item(p, l >> 1, it, vsm);
          else pool_item(p, it - 32 * NCH);
        }
      } else phase_attn(p, l, smem);
      break;
    case 5: {
      for (int itp = blockIdx.x; itp < (1024 + 4 * (MT / 128)) / 2; itp += gridDim.x) {
        const int it = 2 * itp + vb;
        if (it < 1024) hg_scan_item(p, it);
        else {
          int t = it - 1024, g = t / (MT / 128), mt = t % (MT / 128);
          gemm_tile((const u16*)(p.ws + OFF_POOLED) + g * 128, 512,
                    (const u16*)(p.ws + OFF_WPL) + (size_t)((l >> 1) * 4 + g) * 128 * 128, 128, 128, mt * 128, 0, vsm,
                    Epi4<BlkPool>{BlkPool{MIX, p.pool_scale + (l >> 1) * 512, g}});
        }
      }
    } break;
    case 6:
      for (int itp = blockIdx.x; itp < 8 * NCH; itp += gridDim.x) hg_o_item(p, l >> 1, 2 * itp + vb, vsm);
      break;
    case 8: phase_rows(p, 1, l, 1, Mpost, false); break;
    case 11: phase_rows(p, 1, l, 2, Mpost, last); break;
  }
}

constexpr int DYN_LDS = 131072 + 16;
__global__ void __launch_bounds__(512, 2) mega(P p, int ph_lo, int ph_hi) {
  extern __shared__ __attribute__((aligned(16))) char smem[];
  GB gb;
  gb.bar = (unsigned*)(p.ws + OFF_BAR); gb.x = xb_xcc_id(); gb.st = (volatile unsigned*)(smem + 131072);
  if (threadIdx.x == 0) { gb.st[0] = 0u; gb.st[1] = 0u; (void)xb_add(&gb.bar[XB_XCNT(gb.x)], 1u); }
  __syncthreads();
  for (int ph = ph_lo; ph < ph_hi; ++ph) {
    run_phase(p, ph, smem);
#ifdef PROBE_GEMM
    if (ph >= 2) {
      int q = ph - 2, l = 0;
      if (q < 12) l = 0; else if (q < 22) { l = 1; q -= 12; } else if (q < 34) { l = 2; q -= 22; } else { l = 3; q -= 34; }
      int step = q; if ((l & 1) && q >= 5) step = q + 2;
      if (step == 0 || step == 1 || step == 3 || step == 7 || step == 9 || step == 10) { __syncthreads(); run_phase(p, ph, smem); }
    }
#endif
#ifdef PROBE_ATT
    if (ph == 2 + 12 + 4 || ph == 2 + 34 + 4) { __syncthreads(); run_phase(p, ph, smem); }
#endif
    if (ph + 1 < ph_hi) {
      if (ph_hi < 0) cg::this_grid().sync();
      gbar(gb);
    }
  }
}

extern "C" void kernel_launch(void* const* d_in, const int* in_sizes, int n_in, void* d_out, int out_size, void* d_ws,
                              size_t ws_size, hipStream_t stream) {
  static int grid_blocks = 0;
  if (!grid_blocks) {
    int dev = 0, cus = 0, per_cu = 0;
    hipGetDevice(&dev);
    hipDeviceGetAttribute(&cus, hipDeviceAttributeMultiprocessorCount, dev);
    hipFuncSetAttribute((const void*)mega, hipFuncAttributeMaxDynamicSharedMemorySize, DYN_LDS);
    hipOccupancyMaxActiveBlocksPerMultiprocessor(&per_cu, mega, 512, DYN_LDS);
    if (per_cu > 1) per_cu = 1;
    grid_blocks = cus * per_cu;
  }
  if (ws_size < OFF_END2) { fprintf(stderr, "workspace too small: %zu < %zu\n", ws_size, (size_t)OFF_END); return; }
  P p{};
  const float** f = (const float**)&p;
  for (int i = 0; i < 20; ++i) f[i] = (const float*)d_in[i];
  p.out = (float*)d_out;
  p.ws = (char*)d_ws;
#if MULTI_LAUNCH
  for (int ph = 0; ph < N_PHASES; ++ph) hipLaunchKernelGGL(mega, dim3(grid_blocks), dim3(512), DYN_LDS, stream, p, ph, ph + 1);
#else
  hipMemsetAsync((char*)d_ws + OFF_BAR, 0, XCD_BAR_WORDS * 4, stream);
  int lo = 0, hi = N_PHASES;
  void* args[] = {&p, &lo, &hi};
  hipError_t e = hipLaunchCooperativeKernel((void*)mega, dim3(grid_blocks), dim3(512), args, DYN_LDS, stream);
  if (e != hipSuccess) fprintf(stderr, "cooperative launch failed: %s (grid %d)\n", hipGetErrorString(e), grid_blocks);
#endif
}
```

```cpp
#include <hip/hip_runtime.h>
#include <hip/hip_cooperative_groups.h>
#include <cstdio>
namespace cg = cooperative_groups;

typedef __attribute__((ext_vector_type(8))) short bf16x8;
typedef __attribute__((ext_vector_type(4))) float f32x4;
typedef unsigned short u16;

#ifndef MULTI_LAUNCH
#define MULTI_LAUNCH 0
#endif

constexpr int D = 1024, NB = 4, SEQ = 4096, CTX = 256, FH = 2816;
constexpr int ML = NB * SEQ, MC = NB * CTX, MT = ML + MC;
constexpr int TK = CTX + SEQ;
constexpr int NCH = TK / 64;
constexpr float ALPHA = 1.6817928305074290f;
constexpr float LOG2E = 1.4426950408889634f;

constexpr size_t al256(size_t x) { return (x + 255) & ~(size_t)255; }
constexpr size_t OFF_WFI = 0;
constexpr size_t OFF_WFO = OFF_WFI + al256((size_t)4 * 2 * 5632 * 1024 * 2);
constexpr size_t OFF_WMI = OFF_WFO + al256((size_t)4 * 2 * 1024 * 2816 * 2);
constexpr size_t OFF_WMO = OFF_WMI + al256((size_t)4 * 3072 * 1024 * 2);
constexpr size_t OFF_WPL = OFF_WMO + al256((size_t)4 * 1024 * 1024 * 2);
constexpr size_t OFF_MODS = OFF_WPL + al256((size_t)2 * 4 * 128 * 128 * 2);
constexpr size_t OFF_LB = OFF_MODS + al256((size_t)4 * 5 * 9216 * 4);
constexpr size_t OFF_LAM = OFF_LB + al256((size_t)2 * 2 * 512 * 4);
constexpr size_t OFF_ROPE = OFF_LAM + 256;
constexpr size_t OFF_DEC = OFF_ROPE + al256((size_t)64 * 16 * 2 * 4);
constexpr size_t OFF_X = OFF_DEC + al256((size_t)32 * NCH * 128 * 4);
constexpr size_t OFF_H = OFF_X + al256((size_t)MT * 1024 * 4);
constexpr size_t OFF_PROJ = OFF_H + al256((size_t)MT * 1024 * 2);
constexpr size_t OFF_VT = OFF_PROJ + al256((size_t)MT * 3072 * 2);
constexpr size_t OFF_MIX = OFF_VT + al256((size_t)NB * 8 * 128 * TK * 2);
constexpr size_t OFF_POOLED = OFF_MIX + al256((size_t)MT * 1024 * 2);
constexpr size_t OFF_HID = OFF_POOLED + al256((size_t)MT * 512 * 2);
constexpr size_t OFF_Y = OFF_HID + al256((size_t)MT * FH * 2);
constexpr size_t OFF_END = OFF_Y + al256((size_t)MT * 1024 * 4);
constexpr size_t OFF_YC = OFF_END;
constexpr size_t OFF_BAR = OFF_YC + al256((size_t)4 * MC * 1024 * 2);
constexpr size_t OFF_END2 = OFF_BAR + al256((size_t)3456 * 4);
constexpr size_t OFF_U = OFF_HID;
static_assert((size_t)32 * NCH * 16384 * 4 <= OFF_END - OFF_HID, "U alias too big");

struct P {
  const float *x, *c, *ctx, *c_ctx, *w_ada, *b_ada, *ln_g, *ln_b, *w_ffn_in, *w_ffn_out, *w_in_even, *w_out_even,
      *hg_lb, *hg_norm_w, *pool_w, *pool_scale, *w_in_odd, *w_out_odd, *da_lambda, *da_sub_w;
  float* out;
  char* ws;
};

typedef __attribute__((ext_vector_type(2))) __bf16 bf16v2;
typedef __attribute__((ext_vector_type(2))) float f32v2;
__device__ __forceinline__ unsigned pk2(float a, float b) {
  f32v2 v = {a, b};
  bf16v2 r = __builtin_convertvector(v, bf16v2);
  return *(unsigned*)&r;
}
__device__ __forceinline__ u16 f2bf(float f) { return (u16)(pk2(f, 0.f) & 0xffffu); }
__device__ __forceinline__ float bf2f(u16 h) { return __uint_as_float(((unsigned)h) << 16); }
__device__ __forceinline__ float sigm(float z) { return __builtin_amdgcn_rcpf(1.f + __expf(-z)); }
__device__ __forceinline__ float silu(float z) { return z * __builtin_amdgcn_rcpf(1.f + __expf(-z)); }
__device__ __forceinline__ float ex2(float x) { return __builtin_amdgcn_exp2f(x); }
__device__ __forceinline__ void glds16(const void* g, void* l) {
  __builtin_amdgcn_global_load_lds((const unsigned*)g, (unsigned*)l, 16, 0, 0);
}
__device__ __forceinline__ int get_tid() { int t = threadIdx.x & 255; asm volatile("" : "+v"(t)); return t; }
__device__ __forceinline__ int get_vb() { return __builtin_amdgcn_readfirstlane((int)(threadIdx.x >> 8)); }
__device__ __forceinline__ int swz128(int row, int ch) { return row * 128 + ((ch ^ ((row >> 1) & 7)) << 4); }
__device__ __forceinline__ int swz256(int row, int ch) { return row * 256 + ((ch ^ (row & 15)) << 4); }
__device__ __forceinline__ f32x4 mfma16(bf16x8 a, bf16x8 b, f32x4 c) {
  return __builtin_amdgcn_mfma_f32_16x16x32_bf16(a, b, c, 0, 0, 0);
}
__device__ __forceinline__ float xor_sum(float v, int m) { return v + __shfl_xor(v, m, 64); }
__device__ __forceinline__ float xor_max(float v, int m) { return fmaxf(v, __shfl_xor(v, m, 64)); }
__device__ __forceinline__ int kperm(int pos) { return (pos & ~31) | ((pos & 12) << 1) | ((pos & 16) >> 2) | (pos & 3); }
__device__ __forceinline__ void row_bpos(int row, int& b, int& pos) {
  if (row < ML) { b = row >> 12; pos = CTX + (row & 4095); }
  else { int r = row - ML; b = r >> 8; pos = r & 255; }
}
__device__ __forceinline__ int mod_row(int row) { return row < ML ? (row >> 12) : 4; }

constexpr int BM = 128, BN = 128, BK = 64;

template <class Epi>
__device__ __forceinline__ void gemm_tile(const u16* __restrict__ A, int lda, const u16* __restrict__ Bt, int ldb, int K,
                                          int m0, int n0, char* smem, const Epi& epi) {
  const int tid = get_tid(), lane = tid & 63, wid = tid >> 6, wr = wid >> 1, wc = wid & 1, fr = lane & 15, fq = lane >> 4;
  f32x4 acc[4][4];
#pragma unroll
  for (int m = 0; m < 4; ++m)
#pragma unroll
    for (int n = 0; n < 4; ++n) acc[m][n] = f32x4{0.f, 0.f, 0.f, 0.f};
  const int nk = K / BK;
  const u16* ga[4];
  const u16* gb[4];
#pragma unroll
  for (int i = 0; i < 4; ++i) {
    int q = tid + i * 256, row = q >> 3, ch = (q & 7) ^ ((row >> 1) & 7);
    ga[i] = A + (size_t)(m0 + row) * lda + ch * 8;
    gb[i] = Bt + (size_t)(n0 + row) * ldb + ch * 8;
  }
  __syncthreads();
#pragma unroll
  for (int i = 0; i < 4; ++i) {
    glds16(ga[i], smem + (tid + i * 256) * 16);
    glds16(gb[i], smem + 16384 + (tid + i * 256) * 16);
  }
  for (int kt = 0; kt < nk; ++kt) {
    __syncthreads();
    char* cur = smem + (kt & 1) * 32768;
    bf16x8 a[2][4], b[2][4];
#pragma unroll
    for (int ks = 0; ks < 2; ++ks) {
#pragma unroll
      for (int n = 0; n < 4; ++n) b[ks][n] = *(const bf16x8*)(cur + 16384 + swz128(wc * 64 + n * 16 + fr, ks * 4 + fq));
#pragma unroll
      for (int m = 0; m < 4; ++m) a[ks][m] = *(const bf16x8*)(cur + swz128(wr * 64 + m * 16 + fr, ks * 4 + fq));
    }
    __builtin_amdgcn_sched_barrier(0);
    if (kt + 1 < nk) {
      char* nxt = smem + ((kt + 1) & 1) * 32768;
#pragma unroll
      for (int i = 0; i < 4; ++i) {
        glds16(ga[i] + (kt + 1) * BK, nxt + (tid + i * 256) * 16);
        glds16(gb[i] + (kt + 1) * BK, nxt + 16384 + (tid + i * 256) * 16);
      }
    }
    __builtin_amdgcn_sched_barrier(0);
    __builtin_amdgcn_s_setprio(1);
#pragma unroll
    for (int ks = 0; ks < 2; ++ks)
#pragma unroll
      for (int m = 0; m < 4; ++m)
#pragma unroll
        for (int n = 0; n < 4; ++n) acc[m][n] = mfma16(b[ks][n], a[ks][m], acc[m][n]);
    __builtin_amdgcn_s_setprio(0);
  }
  epi(acc, m0 + wr * 64, n0 + wc * 64, fr, fq);
}

struct BlkSwiglu {
  u16* hid;
  __device__ __forceinline__ void operator()(const f32x4& f0, const f32x4& f1, int row, int cg, int fq) const {
    uint2 v = {pk2(silu(f0[0]) * f1[0], silu(f0[1]) * f1[1]), pk2(silu(f0[2]) * f1[2], silu(f0[3]) * f1[3])};
    *(uint2*)(hid + (size_t)row * FH + (cg >> 1) + fq * 4) = v;
  }
};
struct BlkY {
  u16* y;
  __device__ __forceinline__ void operator()(const f32x4& f0, const f32x4& f1, int row, int cg, int fq) const {
    u16* o = y + (size_t)row * D + cg + fq * 4;
    *(uint2*)o = uint2{pk2(f0[0], f0[1]), pk2(f0[2], f0[3])};
    *(uint2*)(o + 16) = uint2{pk2(f1[0], f1[1]), pk2(f1[2], f1[3])};
  }
};
struct BlkPool {
  u16* mix; const float* scale; int g;
  __device__ __forceinline__ void operator()(const f32x4& f0, const f32x4& f1, int row, int cg, int fq) const {
    const int col = g * 128 + cg + fq * 4;
    float4 s0 = *(const float4*)(scale + col), s1 = *(const float4*)(scale + col + 16);
    u16* o = mix + (size_t)row * D + 512 + col;
    *(uint2*)o = uint2{pk2(f0[0] * s0.x, f0[1] * s0.y), pk2(f0[2] * s0.z, f0[3] * s0.w)};
    *(uint2*)(o + 16) = uint2{pk2(f1[0] * s1.x, f1[1] * s1.y), pk2(f1[2] * s1.z, f1[3] * s1.w)};
  }
};
__device__ __forceinline__ float dpp_q(float v, int ctrl_b1) {
  int r = ctrl_b1 ? __builtin_amdgcn_mov_dpp(__float_as_int(v), 0x4E, 0xF, 0xF, true)
                  : __builtin_amdgcn_mov_dpp(__float_as_int(v), 0xB1, 0xF, 0xF, true);
  return __int_as_float(r);
}
__device__ __forceinline__ void quad_transpose(f32x4& x, int i) {
  const bool b0 = i & 1, b1 = i & 2;
  float s, r;
  s = b0 ? x[0] : x[1]; r = dpp_q(s, 0); if (b0) x[0] = r; else x[1] = r;
  s = b0 ? x[2] : x[3]; r = dpp_q(s, 0); if (b0) x[2] = r; else x[3] = r;
  s = b1 ? x[0] : x[2]; r = dpp_q(s, 1); if (b1) x[0] = r; else x[2] = r;
  s = b1 ? x[1] : x[3]; r = dpp_q(s, 1); if (b1) x[1] = r; else x[3] = r;
}
__device__ __forceinline__ void store_vt_blk(u16* vt, int nh, const f32x4& f0, const f32x4& f1, int row, int fc0, int fq) {
  const int i = row & 3;
  f32x4 y0 = f0, y1 = f1;
  quad_transpose(y0, i);
  quad_transpose(y1, i);
  int b, pos;
  row_bpos(row & ~3, b, pos);
  pos = kperm(pos);
  const int fc = fc0 + fq * 4 + i, h = fc >> 7, f = fc & 127;
  u16* o = vt + ((size_t)((b * nh + h) * 128 + f)) * TK + pos;
  *(uint2*)o = uint2{pk2(y0[0], y0[1]), pk2(y0[2], y0[3])};
  *(uint2*)(o + (size_t)16 * TK) = uint2{pk2(y1[0], y1[1]), pk2(y1[2], y1[3])};
}
struct BlkProjEven {
  u16* proj; u16* vt;
  __device__ __forceinline__ void operator()(const f32x4& f0, const f32x4& f1, int row, int cg, int fq) const {
    if (cg >= 512 && cg < 1024) { store_vt_blk(vt, 4, f0, f1, row, cg - 512, fq); return; }
    const float sc = (cg < 512) ? 0.08838834764831845f : 1.f;
    u16* o = proj + (size_t)row * 3072 + cg + fq * 4;
    *(uint2*)o = uint2{pk2(f0[0] * sc, f0[1] * sc), pk2(f0[2] * sc, f0[3] * sc)};
    *(uint2*)(o + 16) = uint2{pk2(f1[0] * sc, f1[1] * sc), pk2(f1[2] * sc, f1[3] * sc)};
  }
};
struct BlkProjOdd {
  u16* proj; u16* vt; const float* rope;
  __device__ __forceinline__ void operator()(const f32x4& f0, const f32x4& f1, int row, int cg, int fq) const {
    if (cg >= 2048) { store_vt_blk(vt, 8, f0, f1, row, cg - 2048, fq); return; }
    const float sc = (cg < 1024) ? 0.125f * LOG2E : 1.f;
    f32x4 v0 = f0, v1 = f1;
    if (row < ML) {
      const int t = row & 4095, pos = ((cg >> 5) & 1) ? (t & 63) : (t >> 6);
      const float* rr = rope + (pos * 16 + fq * 4) * 2;
      float4 r0 = *(const float4*)rr, r1 = *(const float4*)(rr + 4);
      float cs[4] = {r0.x, r0.z, r1.x, r1.z}, sn[4] = {r0.y, r0.w, r1.y, r1.w};
#pragma unroll
      for (int j = 0; j < 4; ++j) {
        float a0 = f0[j] * cs[j] - f1[j] * sn[j], a1 = f1[j] * cs[j] + f0[j] * sn[j];
        v0[j] = a0; v1[j] = a1;
      }
    }
    u16* o = proj + (size_t)row * 3072 + cg + fq * 4;
    *(uint2*)o = uint2{pk2(v0[0] * sc, v0[1] * sc), pk2(v0[2] * sc, v0[3] * sc)};
    *(uint2*)(o + 16) = uint2{pk2(v1[0] * sc, v1[1] * sc), pk2(v1[2] * sc, v1[3] * sc)};
  }
};
template <class Blk> struct Epi4 {
  Blk blk;
  __device__ __forceinline__ void operator()(f32x4 (&acc)[4][4], int rb, int cb, int fr, int fq) const {
#pragma unroll
    for (int m = 0; m < 4; ++m) {
      blk(acc[m][0], acc[m][1], rb + m * 16 + fr, cb, fq);
      blk(acc[m][2], acc[m][3], rb + m * 16 + fr, cb + 32, fq);
    }
  }
};

namespace pg8 {
#define PG8_LAS __attribute__((address_space(3)))
typedef unsigned short bf16_t;
typedef short bf16x8 __attribute__((ext_vector_type(8)));
typedef float f32x4 __attribute__((ext_vector_type(4)));
typedef unsigned u32x4 __attribute__((ext_vector_type(4)));
constexpr int BM = 256, BK = 64, HALF = 128, HTB = HALF * BK * 2  , STAGE_BYTES = 8 * HTB, NXCD = 8, WGM = 8;

__host__ __device__ __forceinline__ int lds_byte(int r, int c) { const int st = (r >> 4) * 2 + (c >> 5), rr = r & 15, cc = c & 31, ob = rr * 64 + cc * 2; return st * 1024 + (ob ^ (((ob >> 9) & 1) << 5)); }
__host__ __device__ __forceinline__ void stage_rc(int b, int& R, int& C) { const int st = b / 1024, sb = b % 1024, swz = sb ^ (((sb >> 9) & 1) << 5); R = (st >> 1) * 16 + swz / 64; C = (st & 1) * 32 + (swz % 64) / 2; }
__host__ __device__ __forceinline__ int perm32(int rho) { const int n = rho >> 4, i = rho & 15; return 8 * (i >> 2) + 4 * n + (i & 3); }

struct Unit { int pm, pn; };
struct Gemm { const bf16_t* A; const bf16_t* Bt; int M, N, K; };

struct StaticOrder {
    int nM, nN, nwg, G, c;
    __host__ __device__ void init(int M, int N, int G_, int c_) { nM = M / BM; nN = N / BM; nwg = nM * nN; G = G_; c = c_; }
    __host__ __device__ bool next(int i, Unit& u) const {
        const long L = (long)i * G + c; if (L >= nwg) return false;
        int wgid = (int)L; { const int q = nwg / NXCD, r = nwg % NXCD, xcd = wgid % NXCD, off = wgid / NXCD; wgid = (xcd < r ? xcd * (q + 1) : r * (q + 1) + (xcd - r) * q) + off; }
        const int nig = WGM * nN, gid = wgid / nig, fm = gid * WGM, gsz = (nM - fm) < WGM ? (nM - fm) : WGM;
        u.pm = fm + ((wgid % nig) % gsz); u.pn = (wgid % nig) / gsz; return true;
    }
    __device__ __forceinline__ void a_ready(const Unit&) const {}
    __device__ __forceinline__ void done(const Unit&) const {}
};

template <class Epi, class Sched, bool STAMP = false>
__device__ __forceinline__ void gemm_phase(PG8_LAS unsigned char* lds, const Gemm g, const Sched& S, const Epi& E, unsigned long long* stamps) {
    int tid = threadIdx.x; asm volatile("" : "+v"(tid));
    const int wid = __builtin_amdgcn_readfirstlane(tid >> 6), lane = tid & 63, wr = wid >> 2, wc = wid & 3, fr = lane & 15, fq = lane >> 4;
    const int K = g.K, nt = K / BK;
    int ts_lo = 0, ts_hi = 0, nts = 0; const unsigned long long rt_entry = STAMP ? (unsigned long long)wall_clock64() : 0ull;
#define PG8_STAMP() do { if (STAMP && wid == 0 && nts < 64) { const unsigned long long _c = (unsigned long long)clock64(); \
        ts_lo = (lane == nts) ? (int)(unsigned)_c : ts_lo; ts_hi = (lane == nts) ? (int)(unsigned)(_c >> 32) : ts_hi; ++nts; } } while (0)
    PG8_STAMP();
    unsigned voffA[2], voffB[2];
#pragma unroll
    for (int i = 0; i < 2; ++i) { int R, C; stage_rc(tid * 16 + i * 8192, R, C); const int Rb = Epi::PERM ? ((R & ~31) + perm32(R & 31)) : R;
        voffA[i] = (unsigned)(R * K + C) * 2u; voffB[i] = (unsigned)(Rb * K + C) * 2u; }
    const size_t kstep = (size_t)(BK * 2);
    const size_t hstep = (size_t)HALF * K * 2;
    const size_t tstep = 2 * hstep;
    const unsigned ldsw = (unsigned)wid * 1024u;
    const int aoff = lds_byte(wr * 64 + fr, fq * 8), boff = lds_byte(wc * 32 + fr, fq * 8);
#define PG8_SA(b, h) (((b) * 2 + (h)) * HTB)
#define PG8_SB(b, h) ((4 + (b) * 2 + (h)) * HTB)
#define PG8_STAGE(bufoff, gbase, voff) do { _Pragma("unroll") for (int _i = 0; _i < 2; ++_i) \
        __builtin_amdgcn_global_load_lds((const unsigned*)((const char*)(gbase) + (voff)[_i]), (PG8_LAS unsigned*)(lds + (bufoff) + ldsw + _i * 8192), 16, 0, 0); } while (0)
#define PG8_LDA(dst, b, h) do { _Pragma("unroll") for (int m = 0; m < 4; ++m) _Pragma("unroll") for (int k = 0; k < 2; ++k) dst[m][k] = *(const PG8_LAS bf16x8*)(lds + PG8_SA(b, h) + aoff + m * 2048 + k * 1024); } while (0)
#define PG8_LDB(dst, b, h) do { _Pragma("unroll") for (int n = 0; n < 2; ++n) _Pragma("unroll") for (int k = 0; k < 2; ++k) dst[n][k] = *(const PG8_LAS bf16x8*)(lds + PG8_SB(b, h) + boff + n * 2048 + k * 1024); } while (0)
#define PG8_MMA(ai, bj, At, Bt) do { __builtin_amdgcn_s_setprio(1); _Pragma("unroll") for (int m = 0; m < 4; ++m) _Pragma("unroll") for (int n = 0; n < 2; ++n) _Pragma("unroll") for (int k = 0; k < 2; ++k) \
        acc[ai][bj][m][n] = __builtin_amdgcn_mfma_f32_16x16x32_bf16(Bt[n][k], At[m][k], acc[ai][bj][m][n], 0, 0, 0); __builtin_amdgcn_s_setprio(0); } while (0)
#define PG8_WAIT_V(n) asm volatile("s_waitcnt vmcnt(" #n ")" ::: "memory")
#define PG8_WAIT_L(n) asm volatile("s_waitcnt lgkmcnt(" #n ")" ::: "memory")
#define PG8_BAR __builtin_amdgcn_s_barrier()
#define PG8_SCHED __builtin_amdgcn_sched_barrier(0)
    Unit cur, nxt; int ui = 0;
    if (!S.next(0, cur)) return;
    f32x4 acc[2][2][4][2];
#pragma unroll
    for (int a = 0; a < 2; ++a)
#pragma unroll
        for (int b = 0; b < 2; ++b)
#pragma unroll
            for (int m = 0; m < 4; ++m)
#pragma unroll
                for (int n = 0; n < 2; ++n) acc[a][b][m][n] = (f32x4){0.f, 0.f, 0.f, 0.f};
    bf16x8 At[4][2], B0[2][2], B1[2][2];
    const char* cA = (const char*)g.A + (size_t)cur.pm * tstep; const char* cB = (const char*)g.Bt + (size_t)cur.pn * tstep;
    S.a_ready(cur);
    PG8_STAGE(PG8_SB(0, 0), cB, voffB); PG8_STAGE(PG8_SA(0, 0), cA, voffA); PG8_STAGE(PG8_SB(0, 1), cB + hstep, voffB); PG8_STAGE(PG8_SA(0, 1), cA + hstep, voffA);
    if (wr == 1) PG8_BAR;
    PG8_WAIT_V(4); PG8_BAR;
    PG8_STAGE(PG8_SB(1, 0), cB + kstep, voffB); PG8_STAGE(PG8_SA(1, 0), cA + kstep, voffA); PG8_STAGE(PG8_SB(1, 1), cB + hstep + kstep, voffB);
    PG8_WAIT_V(6); PG8_BAR;
    PG8_STAMP();
    for (;;) {
        const bool has_next = S.next(ui + 1, nxt);
        const char* nA = has_next ? (const char*)g.A + (size_t)nxt.pm * tstep : cA; const char* nB = has_next ? (const char*)g.Bt + (size_t)nxt.pn * tstep : cB;
        for (int t = 0; t < nt; t += 2) {
            const bool last = (t == nt - 2);
            const char* a1 = cA + (size_t)(t + 1) * kstep;
            const char* a2 = last ? nA : cA + (size_t)(t + 2) * kstep; const char* b2 = last ? nB : cB + (size_t)(t + 2) * kstep;
            const char* a3 = a2 + kstep; const char* b3 = b2 + kstep;
            if (last && has_next) S.a_ready(nxt);
            PG8_LDB(B0, 0, 0); PG8_SCHED; PG8_LDA(At, 0, 0); PG8_STAGE(PG8_SA(1, 1), a1 + hstep, voffA);
            PG8_WAIT_L(8); PG8_BAR; PG8_WAIT_L(0); PG8_MMA(0, 0, At, B0); PG8_BAR; PG8_SCHED;
            PG8_LDB(B1, 0, 1); PG8_STAGE(PG8_SB(0, 0), b2, voffB);
            PG8_BAR; PG8_WAIT_L(0); PG8_MMA(0, 1, At, B1); PG8_BAR;
            PG8_LDA(At, 0, 1); PG8_STAGE(PG8_SA(0, 0), a2, voffA);
            PG8_BAR; PG8_WAIT_L(0); PG8_MMA(1, 0, At, B0); PG8_BAR; PG8_SCHED;
            PG8_STAGE(PG8_SB(0, 1), b2 + hstep, voffB);
            PG8_WAIT_V(6); PG8_BAR; PG8_MMA(1, 1, At, B1); PG8_BAR;
            PG8_LDB(B0, 1, 0); PG8_SCHED; PG8_LDA(At, 1, 0); PG8_STAGE(PG8_SA(0, 1), a2 + hstep, voffA);
            PG8_WAIT_L(8); PG8_BAR; PG8_WAIT_L(0); PG8_MMA(0, 0, At, B0); PG8_BAR; PG8_SCHED;
            PG8_LDB(B1, 1, 1); PG8_STAGE(PG8_SB(1, 0), b3, voffB);
            PG8_BAR; PG8_WAIT_L(0); PG8_MMA(0, 1, At, B1); PG8_BAR;
            PG8_LDA(At, 1, 1); PG8_STAGE(PG8_SA(1, 0), a3, voffA);
            PG8_BAR; PG8_WAIT_L(0); PG8_MMA(1, 0, At, B0); PG8_BAR; PG8_SCHED;
            PG8_STAGE(PG8_SB(1, 1), b3 + hstep, voffB);
            PG8_WAIT_V(6); PG8_BAR; PG8_MMA(1, 1, At, B1); PG8_BAR;
        }
        PG8_STAMP();
        if constexpr (!Epi::AFTER_DRAIN) { E(acc, cur, wr, wc, fr, fq); S.done(cur); }
        PG8_STAMP();
        if (!has_next) break;
#pragma unroll
        for (int a = 0; a < 2; ++a)
#pragma unroll
            for (int b = 0; b < 2; ++b)
#pragma unroll
                for (int m = 0; m < 4; ++m)
#pragma unroll
                    for (int n = 0; n < 2; ++n) acc[a][b][m][n] = (f32x4){0.f, 0.f, 0.f, 0.f};
        cur = nxt; cA = nA; cB = nB; ++ui;
    }
    PG8_WAIT_V(0);
    if (wr == 0) PG8_BAR;
    PG8_BAR;
    if constexpr (Epi::AFTER_DRAIN) { E.fused(acc, cur, wr, wc, fr, fq, lds, wid, lane); S.done(cur); }
    PG8_STAMP();
    if (STAMP && wid == 0) { stamps[lane] = lane < nts ? (((unsigned long long)(unsigned)ts_hi << 32) | (unsigned)ts_lo) : 0ull;
        if (lane == 62) stamps[62] = rt_entry; if (lane == 63) stamps[63] = (unsigned long long)wall_clock64(); }
#undef PG8_STAMP
#undef PG8_SA
#undef PG8_SB
#undef PG8_STAGE
#undef PG8_LDA
#undef PG8_LDB
#undef PG8_MMA
#undef PG8_WAIT_V
#undef PG8_WAIT_L
#undef PG8_BAR
#undef PG8_SCHED
}
}

template <class Blk> struct Epi8 {
  static constexpr bool PERM = false, AFTER_DRAIN = false;
  Blk blk;
  __device__ __forceinline__ void operator()(const f32x4 (&acc)[2][2][4][2], const pg8::Unit& u, int wr, int wc, int fr, int fq) const {
#pragma unroll
    for (int ai = 0; ai < 2; ++ai)
#pragma unroll
      for (int m = 0; m < 4; ++m) {
        const int row = u.pm * 256 + ai * 128 + wr * 64 + m * 16 + fr;
#pragma unroll
        for (int bj = 0; bj < 2; ++bj) blk(acc[ai][bj][m][0], acc[ai][bj][m][1], row, u.pn * 256 + bj * 128 + wc * 32, fq);
      }
  }
};
struct Epi8Swiglu {
  static constexpr bool PERM = false, AFTER_DRAIN = false;
  u16* hid;
  __device__ __forceinline__ void operator()(const f32x4 (&acc)[2][2][4][2], const pg8::Unit& u, int wr, int wc, int fr, int fq) const {
#pragma unroll
    for (int ai = 0; ai < 2; ++ai)
#pragma unroll
      for (int m = 0; m < 4; ++m) {
        const int row = u.pm * 256 + ai * 128 + wr * 64 + m * 16 + fr;
        const f32x4 a0 = acc[ai][0][m][0], b0 = acc[ai][0][m][1], a1 = acc[ai][1][m][0], b1 = acc[ai][1][m][1];
        uint4 o = {pk2(silu(a0[0]) * b0[0], silu(a0[1]) * b0[1]), pk2(silu(a0[2]) * b0[2], silu(a0[3]) * b0[3]),
                   pk2(silu(a1[0]) * b1[0], silu(a1[1]) * b1[1]), pk2(silu(a1[2]) * b1[2], silu(a1[3]) * b1[3])};
        *(uint4*)(hid + (size_t)row * FH + u.pn * 128 + wc * 32 + fq * 8) = o;
      }
  }
};
struct Epi8Y {
  static constexpr bool PERM = true, AFTER_DRAIN = false;
  u16* y;
  __device__ __forceinline__ void operator()(const f32x4 (&acc)[2][2][4][2], const pg8::Unit& u, int wr, int wc, int fr, int fq) const {
#pragma unroll
    for (int ai = 0; ai < 2; ++ai)
#pragma unroll
      for (int m = 0; m < 4; ++m) {
        const int row = u.pm * 256 + ai * 128 + wr * 64 + m * 16 + fr;
#pragma unroll
        for (int bj = 0; bj < 2; ++bj) {
          const f32x4 f0 = acc[ai][bj][m][0], f1 = acc[ai][bj][m][1];
          uint4 o = {pk2(f0[0], f0[1]), pk2(f0[2], f0[3]), pk2(f1[0], f1[1]), pk2(f1[2], f1[3])};
          *(uint4*)(y + (size_t)row * D + u.pn * 256 + bj * 128 + wc * 32 + fq * 8) = o;
        }
      }
  }
};
template <int N, int K, class E>
__device__ __forceinline__ void gemm8e(const u16* A, const u16* Bt, int M, char* smem, const E& e) {
  pg8::Gemm g{A, Bt, M, N, K};
  pg8::StaticOrder S;
  S.init(M, N, (int)gridDim.x, (int)blockIdx.x);
  pg8::gemm_phase<E, pg8::StaticOrder, false>((PG8_LAS unsigned char*)smem, g, S, e, nullptr);
  __syncthreads();
}
template <int N, int K, class Blk>
__device__ __forceinline__ void gemm8(const u16* A, const u16* Bt, int M, char* smem, const Blk& blk) {
  pg8::Gemm g{A, Bt, M, N, K};
  pg8::StaticOrder S;
  S.init(M, N, (int)gridDim.x, (int)blockIdx.x);
  pg8::gemm_phase<Epi8<Blk>, pg8::StaticOrder, false>((PG8_LAS unsigned char*)smem, g, S, Epi8<Blk>{blk}, nullptr);
  __syncthreads();
}

__device__ __forceinline__ void convert_tile(const float* __restrict__ src, int K, int N, u16* __restrict__ dst, int tile,
                                             bool swiglu, char* smem) {
  float* t = (float*)smem;
  const int tid = get_tid();
  const int nN = N / 64, nt = tile % nN, kt = tile / nN, k0 = kt * 64, n0 = nt * 64;
  __syncthreads();
#pragma unroll
  for (int i = 0; i < 4; ++i) {
    int k = (tid >> 4) + 16 * i, n4 = (tid & 15) * 4;
    float4 v = *(const float4*)(src + (size_t)(k0 + k) * N + n0 + n4);
    t[k * 65 + n4] = v.x; t[k * 65 + n4 + 1] = v.y; t[k * 65 + n4 + 2] = v.z; t[k * 65 + n4 + 3] = v.w;
  }
  __syncthreads();
#pragma unroll
  for (int i = 0; i < 2; ++i) {
    int q = tid + i * 256, n = q >> 3, kc = (q & 7) * 8;
    int c = n0 + n, nr = c;
    if (swiglu) {
      const int sb = (c < FH) ? 0 : 1, u = sb ? c - FH : c, uu = u & 127, r5 = uu & 31;
      nr = (u >> 7) * 256 + ((r5 >> 2) & 1) * 128 + (uu >> 5) * 32 + sb * 16 + (r5 >> 3) * 4 + (r5 & 3);
    }
    uint4 o = {pk2(t[kc * 65 + n], t[(kc + 1) * 65 + n]), pk2(t[(kc + 2) * 65 + n], t[(kc + 3) * 65 + n]),
               pk2(t[(kc + 4) * 65 + n], t[(kc + 5) * 65 + n]), pk2(t[(kc + 6) * 65 + n], t[(kc + 7) * 65 + n])};
    *(uint4*)(dst + (size_t)nr * K + k0 + kc) = o;
  }
}

__device__ void phase_prep(const P& p, char* smem) {
  const int tid = get_tid();
  constexpr int N_ADA = 1152, N_TR = 4 * 5248 + 32;
  const int vb = get_vb();
  for (int itp = blockIdx.x; itp < (N_ADA + N_TR) / 2 + 1; itp += gridDim.x) {
    const int item = (itp < (N_ADA + N_TR) / 2) ? 2 * itp + vb : (vb == 0 ? N_ADA + N_TR : -1);
    if (item < 0) continue;
    if (item < N_ADA) {
      float* act = (float*)smem;
      float* red = (float*)(smem + 20480);
      const int l = item / 288, cb = (item % 288) * 32;
      __syncthreads();
      for (int i = tid; i < 5120; i += 256) {
        int r = i >> 10, k = i & 1023;
        float v = r < 4 ? p.c[r * 1024 + k] : p.c_ctx[k];
        act[i] = silu(v);
      }
      __syncthreads();
      const int tx = tid & 31, kg = tid >> 5;
      float a0 = 0, a1 = 0, a2 = 0, a3 = 0, a4 = 0;
      const float* w = p.w_ada + ((size_t)l * 1024 + kg * 128) * 9216 + cb + tx;
      for (int k0 = 0; k0 < 128; k0 += 16) {
        float wv[16];
#pragma unroll
        for (int k = 0; k < 16; ++k) wv[k] = w[(size_t)(k0 + k) * 9216];
#pragma unroll
        for (int k = 0; k < 16; ++k) {
          int kk = kg * 128 + k0 + k;
          a0 += act[kk] * wv[k]; a1 += act[1024 + kk] * wv[k]; a2 += act[2048 + kk] * wv[k]; a3 += act[3072 + kk] * wv[k];
          a4 += act[4096 + kk] * wv[k];
        }
      }
      red[(kg * 5 + 0) * 32 + tx] = a0; red[(kg * 5 + 1) * 32 + tx] = a1; red[(kg * 5 + 2) * 32 + tx] = a2;
      red[(kg * 5 + 3) * 32 + tx] = a3; red[(kg * 5 + 4) * 32 + tx] = a4;
      __syncthreads();
      if (tid < 160) {
        int r = tid >> 5, x = tid & 31;
        float sacc = 0.f;
#pragma unroll
        for (int g8 = 0; g8 < 8; ++g8) sacc += red[(g8 * 5 + r) * 32 + x];
        ((float*)(p.ws + OFF_MODS))[(size_t)(l * 5 + r) * 9216 + cb + x] = sacc + p.b_ada[l * 9216 + cb + x];
      }
    } else if (item < N_ADA + N_TR) {
      int idx = item - N_ADA;
      if (idx < 4 * 5248) {
        int l = idx / 5248, r = idx % 5248;
        if (r < 2816) {
          int f = r / 1408, tile = r % 1408;
          convert_tile(p.w_ffn_in + (size_t)(l * 2 + f) * 1024 * 5632, 1024, 5632,
                       (u16*)(p.ws + OFF_WFI) + (size_t)(l * 2 + f) * 5632 * 1024, tile, true, smem);
        } else if (r < 4224) {
          int f = (r - 2816) / 704, tile = (r - 2816) % 704;
          convert_tile(p.w_ffn_out + (size_t)(l * 2 + f) * 2816 * 1024, 2816, 1024,
                       (u16*)(p.ws + OFF_WFO) + (size_t)(l * 2 + f) * 1024 * 2816, tile, false, smem);
        } else if (r < 4992) {
          const float* src = (l & 1) ? p.w_in_odd + (size_t)(l >> 1) * 1024 * 3072 : p.w_in_even + (size_t)(l >> 1) * 1024 * 3072;
          convert_tile(src, 1024, 3072, (u16*)(p.ws + OFF_WMI) + (size_t)l * 3072 * 1024, r - 4224, false, smem);
        } else {
          const float* src = (l & 1) ? p.w_out_odd + (size_t)(l >> 1) * 1024 * 1024 : p.w_out_even + (size_t)(l >> 1) * 1024 * 1024;
          convert_tile(src, 1024, 1024, (u16*)(p.ws + OFF_WMO) + (size_t)l * 1024 * 1024, r - 4992, false, smem);
        }
      } else {
        int i2 = idx - 4 * 5248, eg = i2 >> 2, tile = i2 & 3;
        convert_tile(p.pool_w + (size_t)eg * 128 * 128, 128, 128, (u16*)(p.ws + OFF_WPL) + (size_t)eg * 128 * 128, tile, false, smem);
      }
    } else {
      float* LB = (float*)(p.ws + OFF_LB);
      for (int i = tid; i < 1024; i += 256) {
        float a0 = p.hg_lb[i], a1 = p.hg_lb[1024 + i];
        float mx = fmaxf(a0, a1), e0 = __expf(a0 - mx), e1 = __expf(a1 - mx);
        LB[i] = 0.f;
        LB[1024 + i] = e1 / (e0 + e1);
      }
      if (tid < 2) {
        const float* lv = p.da_lambda + tid * 256;
        float s0 = 0, s1 = 0;
        for (int i = 0; i < 64; ++i) { s0 += lv[i] * lv[64 + i]; s1 += lv[128 + i] * lv[192 + i]; }
        float li = 0.8f - 0.6f * expf(-0.3f * (float)(2 * tid + 1));
        ((float*)(p.ws + OFF_LAM))[tid] = expf(s0) - expf(s1) + li;
      }
      float* rope = (float*)(p.ws + OFF_ROPE);
      for (int i = tid; i < 1024; i += 256) {
        int pos = i >> 4, fi = i & 15;
        float inv = exp2f(-(float)fi * (13.287712379549449f / 16.f));
        float ang = (float)pos * inv;
        float k = rintf(ang * 0.15915494309189535f);
        float r = fmaf(-k, 6.28125f, ang);
        r = fmaf(-k, 1.9353071795864769e-3f, r);
        rope[i * 2] = cosf(r);
        rope[i * 2 + 1] = sinf(r);
      }
    }
  }
}

__device__ void phase_rows(const P& p, int mode, int l, int sub, int M, bool final_out) {
  const int tid = get_tid(), lane = tid & 63, wid = tid >> 6;
  float* X = (float*)(p.ws + OFF_X);
  const u16* Y = (const u16*)(p.ws + OFF_Y);
  u16* H = (u16*)(p.ws + OFF_H);
  const float* MODS = (const float*)(p.ws + OFF_MODS);
  int nl, si;
  if (mode == 0) { nl = 0; si = 0; }
  else if (sub == 0) { nl = l; si = 3; }
  else if (sub == 1) { nl = l; si = 6; }
  else { nl = l + 1; si = 0; }
  const float gs = (sub == 1) ? 1.f : 0.5f;
  const float* lg = p.ln_g + (size_t)(l * 3 + sub) * D;
  const float* lbp = p.ln_b + (size_t)(l * 3 + sub) * D;
  for (int row0 = ((blockIdx.x * 2 + get_vb()) * 4 + wid) * 2; row0 < M; row0 += gridDim.x * 16) {
    const int mr = mod_row(row0);
    const bool ksplit = (mode == 1) && (sub != 1) && (row0 >= ML);
    float v[2][16];
    if (mode == 0) {
#pragma unroll
      for (int r = 0; r < 2; ++r) {
        const int row = row0 + r;
        const float* src = row < ML ? p.x + (size_t)row * D : p.ctx + (size_t)(row - ML) * D;
#pragma unroll
        for (int i = 0; i < 4; ++i) {
          float4 t = *(const float4*)(src + i * 256 + lane * 4);
          v[r][i * 4] = t.x; v[r][i * 4 + 1] = t.y; v[r][i * 4 + 2] = t.z; v[r][i * 4 + 3] = t.w;
        }
      }
    } else {
      const float* gate = MODS + (size_t)(l * 5 + mr) * 9216 + (2 + 3 * sub) * 1024;
      float4 xv[2][4]; uint2 yv[2][4]; float4 gv[4];
#pragma unroll
      for (int r = 0; r < 2; ++r)
#pragma unroll
        for (int i = 0; i < 4; ++i) {
          int c = i * 256 + lane * 4;
          xv[r][i] = *(const float4*)(X + (size_t)(row0 + r) * D + c);
          if (!ksplit) yv[r][i] = *(const uint2*)(Y + (size_t)(row0 + r) * D + c);
        }
      float ysum[2][16];
      if (ksplit) {
        const u16* YC = (const u16*)(p.ws + OFF_YC);
#pragma unroll
        for (int r = 0; r < 2; ++r)
#pragma unroll
          for (int i = 0; i < 4; ++i) {
            int c = i * 256 + lane * 4;
            uint2 t0 = *(const uint2*)(YC + ((size_t)0 * MC + row0 + r - ML) * D + c), t1 = *(const uint2*)(YC + ((size_t)1 * MC + row0 + r - ML) * D + c);
            uint2 t2 = *(const uint2*)(YC + ((size_t)2 * MC + row0 + r - ML) * D + c), t3 = *(const uint2*)(YC + ((size_t)3 * MC + row0 + r - ML) * D + c);
            ysum[r][i * 4] = __uint_as_float(t0.x << 16) + __uint_as_float(t1.x << 16) + __uint_as_float(t2.x << 16) + __uint_as_float(t3.x << 16);
            ysum[r][i * 4 + 1] = __uint_as_float(t0.x & 0xffff0000u) + __uint_as_float(t1.x & 0xffff0000u) + __uint_as_float(t2.x & 0xffff0000u) + __uint_as_float(t3.x & 0xffff0000u);
            ysum[r][i * 4 + 2] = __uint_as_float(t0.y << 16) + __uint_as_float(t1.y << 16) + __uint_as_float(t2.y << 16) + __uint_as_float(t3.y << 16);
            ysum[r][i * 4 + 3] = __uint_as_float(t0.y & 0xffff0000u) + __uint_as_float(t1.y & 0xffff0000u) + __uint_as_float(t2.y & 0xffff0000u) + __uint_as_float(t3.y & 0xffff0000u);
          }
      }
#pragma unroll
      for (int i = 0; i < 4; ++i) gv[i] = *(const float4*)(gate + i * 256 + lane * 4);
      float s[2] = {0.f, 0.f};
#pragma unroll
      for (int r = 0; r < 2; ++r)
#pragma unroll
        for (int i = 0; i < 4; ++i) {
          float y0, y1, y2, y3;
          if (ksplit) { y0 = ysum[r][i * 4]; y1 = ysum[r][i * 4 + 1]; y2 = ysum[r][i * 4 + 2]; y3 = ysum[r][i * 4 + 3]; }
          else {
            y0 = bf2f((u16)(yv[r][i].x & 0xffff)); y1 = bf2f((u16)(yv[r][i].x >> 16));
            y2 = bf2f((u16)(yv[r][i].y & 0xffff)); y3 = bf2f((u16)(yv[r][i].y >> 16));
          }
          v[r][i * 4] = ALPHA * xv[r][i].x + gs * gv[i].x * y0; v[r][i * 4 + 1] = ALPHA * xv[r][i].y + gs * gv[i].y * y1;
          v[r][i * 4 + 2] = ALPHA * xv[r][i].z + gs * gv[i].z * y2; v[r][i * 4 + 3] = ALPHA * xv[r][i].w + gs * gv[i].w * y3;
          s[r] += v[r][i * 4] + v[r][i * 4 + 1] + v[r][i * 4 + 2] + v[r][i * 4 + 3];
        }
#pragma unroll
      for (int o = 1; o < 64; o <<= 1) { s[0] = xor_sum(s[0], o); s[1] = xor_sum(s[1], o); }
      float q[2] = {0.f, 0.f};
#pragma unroll
      for (int r = 0; r < 2; ++r) {
        const float mu = s[r] * (1.f / 1024.f);
#pragma unroll
        for (int i = 0; i < 16; ++i) { v[r][i] -= mu; q[r] += v[r][i] * v[r][i]; }
      }
#pragma unroll
      for (int o = 1; o < 64; o <<= 1) { q[0] = xor_sum(q[0], o); q[1] = xor_sum(q[1], o); }
#pragma unroll
      for (int i = 0; i < 4; ++i) {
        int c = i * 256 + lane * 4;
        float4 g4 = *(const float4*)(lg + c), b4 = *(const float4*)(lbp + c);
#pragma unroll
        for (int r = 0; r < 2; ++r) {
          const float rstd = rsqrtf(q[r] * (1.f / 1024.f) + 1e-5f);
          v[r][i * 4] = v[r][i * 4] * rstd * g4.x + b4.x; v[r][i * 4 + 1] = v[r][i * 4 + 1] * rstd * g4.y + b4.y;
          v[r][i * 4 + 2] = v[r][i * 4 + 2] * rstd * g4.z + b4.z; v[r][i * 4 + 3] = v[r][i * 4 + 3] * rstd * g4.w + b4.w;
        }
      }
    }
    if (final_out) {
#pragma unroll
      for (int r = 0; r < 2; ++r)
#pragma unroll
        for (int i = 0; i < 4; ++i)
          *(float4*)(p.out + (size_t)(row0 + r) * D + i * 256 + lane * 4) =
              float4{v[r][i * 4], v[r][i * 4 + 1], v[r][i * 4 + 2], v[r][i * 4 + 3]};
      continue;
    }
    const float* sh = MODS + (size_t)(nl * 5 + mr) * 9216 + si * 1024;
#pragma unroll
    for (int i = 0; i < 4; ++i) {
      int c = i * 256 + lane * 4;
      float4 s4 = *(const float4*)(sh + c), c4 = *(const float4*)(sh + 1024 + c);
#pragma unroll
      for (int r = 0; r < 2; ++r) {
        *(float4*)(X + (size_t)(row0 + r) * D + c) = float4{v[r][i * 4], v[r][i * 4 + 1], v[r][i * 4 + 2], v[r][i * 4 + 3]};
        uint2 hv = {pk2(v[r][i * 4] * (1.f + c4.x) + s4.x, v[r][i * 4 + 1] * (1.f + c4.y) + s4.y),
                    pk2(v[r][i * 4 + 2] * (1.f + c4.z) + s4.z, v[r][i * 4 + 3] * (1.f + c4.w) + s4.w)};
        *(uint2*)(H + (size_t)(row0 + r) * D + c) = hv;
      }
    }
  }
}

__device__ void phase_attn(const P& p, int l, char* smem) {
  int tid = threadIdx.x; asm volatile("" : "+v"(tid));
  const int lane = tid & 63, w = tid >> 6, fr = lane & 15, fq = lane >> 4;
  const int m = w & 1, pr = w >> 1;
  const u16* PROJ = (const u16*)(p.ws + OFF_PROJ);
  const u16* VT = (const u16*)(p.ws + OFF_VT);
  u16* MIX = (u16*)(p.ws + OFF_MIX);
  const float lam = ((const float*)(p.ws + OFF_LAM))[l >> 1];
  const float lam_init = 0.8f - 0.6f * expf(-0.3f * (float)l);
  const float* subw = p.da_sub_w + (l >> 1) * 128;
  const int xcd = blockIdx.x & 7, slot = blockIdx.x >> 3, nslot = gridDim.x >> 3;
  const int n_virt = (l == 3) ? 128 : 136;
  for (int idx = slot; idx < n_virt; idx += nslot) {
    int b, h, qrow0, nkt;
    if (idx < 128) {
      const int bh = (idx >> 5) * 8 + xcd;
      b = bh >> 3; h = bh & 7; qrow0 = b * 4096 + (idx & 31) * 128; nkt = 68;
    } else {
      const int cs = idx - 128, bh = (cs >> 1) * 8 + xcd;
      b = bh >> 3; h = bh & 7; qrow0 = ML + b * 256 + (cs & 1) * 128; nkt = 4;
    }
    bf16x8 qf[2][2];
#pragma unroll
    for (int qi = 0; qi < 2; ++qi) {
      const u16* qp = PROJ + (size_t)(qrow0 + pr * 32 + qi * 16 + fr) * 3072 + h * 128 + m * 64 + fq * 8;
#pragma unroll
      for (int ks = 0; ks < 2; ++ks) qf[qi][ks] = *(const bf16x8*)(qp + ks * 32);
    }
    f32x4 O[2][8];
#pragma unroll
    for (int qi = 0; qi < 2; ++qi)
#pragma unroll
      for (int v = 0; v < 8; ++v) O[qi][v] = f32x4{0.f, 0.f, 0.f, 0.f};
    float mrun[2] = {-1e30f, -1e30f}, lsum[2] = {0.f, 0.f};
    const u16* vbase = VT + (size_t)((b * 8 + h) * 128) * TK;
    auto stage = [&](int kt2) {
#pragma unroll
      for (int hf = 0; hf < 2; ++hf) {
        const int kt = kt2 * 2 + hf;
        char* buf = smem + (kt2 & 1) * 65536 + hf * 32768;
        const int krow0 = kt < 4 ? ML + b * 256 + kt * 64 : b * 4096 + (kt - 4) * 64;
#pragma unroll
        for (int i = 0; i < 2; ++i) {
          int q = tid + i * 512;
          int key = q >> 4, ch = (q & 15) ^ (key & 15);
          glds16(PROJ + (size_t)(krow0 + key) * 3072 + 1024 + h * 128 + ch * 8, buf + q * 16);
          int dv = q >> 3, c2 = (q & 7) ^ ((dv >> 1) & 7);
          glds16(vbase + (size_t)dv * TK + kt * 64 + c2 * 8, buf + 16384 + q * 16);
        }
      }
    };
    asm volatile("s_waitcnt vmcnt(0)" ::: "memory");
    __syncthreads();
    stage(0);
    for (int kt = 0; kt < nkt; ++kt) {
      if (!(kt & 1)) {
        asm volatile("s_waitcnt vmcnt(0)" ::: "memory");
        asm volatile("s_waitcnt lgkmcnt(0)" ::: "memory");
        __builtin_amdgcn_s_barrier();
        if (kt + 2 < nkt) stage((kt >> 1) + 1);
      }
      const char* cur = smem + ((kt >> 1) & 1) * 65536 + (kt & 1) * 32768;
      bf16x8 pb[2][2];
      f32x4 s[2][4];
      {
        bf16x8 kf[4][2];
#pragma unroll
        for (int sf = 0; sf < 4; ++sf)
#pragma unroll
          for (int ks = 0; ks < 2; ++ks) kf[sf][ks] = *(const bf16x8*)(cur + swz256(sf * 16 + fr, m * 8 + ks * 4 + fq));
        __builtin_amdgcn_sched_barrier(0);
#pragma unroll
        for (int sf = 0; sf < 4; ++sf) {
          s[0][sf] = f32x4{0.f, 0.f, 0.f, 0.f};
          s[1][sf] = f32x4{0.f, 0.f, 0.f, 0.f};
#pragma unroll
          for (int ks = 0; ks < 2; ++ks) {
            s[0][sf] = mfma16(kf[sf][ks], qf[0][ks], s[0][sf]);
            s[1][sf] = mfma16(kf[sf][ks], qf[1][ks], s[1][sf]);
          }
        }
      }
      float tm0 = -1e30f, tm1 = -1e30f;
#pragma unroll
      for (int sf = 0; sf < 4; ++sf)
#pragma unroll
        for (int j = 0; j < 4; ++j) { tm0 = fmaxf(tm0, s[0][sf][j]); tm1 = fmaxf(tm1, s[1][sf][j]); }
      if (__any(fmaxf(tm0 - mrun[0], tm1 - mrun[1]) > 6.f)) {
        tm0 = xor_max(tm0, 16); tm1 = xor_max(tm1, 16);
        tm0 = xor_max(tm0, 32); tm1 = xor_max(tm1, 32);
        const float mn0 = fmaxf(mrun[0], tm0), sc0 = ex2(mrun[0] - mn0);
        const float mn1 = fmaxf(mrun[1], tm1), sc1 = ex2(mrun[1] - mn1);
        mrun[0] = mn0; mrun[1] = mn1;
        lsum[0] *= sc0; lsum[1] *= sc1;
#pragma unroll
        for (int v = 0; v < 8; ++v) { O[0][v] *= sc0; O[1][v] *= sc1; }
      }
#pragma unroll
      for (int qi = 0; qi < 2; ++qi) {
        const float mn = mrun[qi];
        float ps = 0.f;
#pragma unroll
        for (int sf = 0; sf < 4; ++sf)
#pragma unroll
          for (int j = 0; j < 4; ++j) { s[qi][sf][j] = ex2(s[qi][sf][j] - mn); ps += s[qi][sf][j]; }
        lsum[qi] += ps;
#pragma unroll
        for (int k2 = 0; k2 < 2; ++k2) {
          union { bf16x8 v; unsigned u[4]; } t;
          t.u[0] = pk2(s[qi][2 * k2][0], s[qi][2 * k2][1]); t.u[1] = pk2(s[qi][2 * k2][2], s[qi][2 * k2][3]);
          t.u[2] = pk2(s[qi][2 * k2 + 1][0], s[qi][2 * k2 + 1][1]); t.u[3] = pk2(s[qi][2 * k2 + 1][2], s[qi][2 * k2 + 1][3]);
          pb[qi][k2] = t.v;
        }
      }
#pragma unroll
      for (int vb = 0; vb < 8; vb += 4) {
        bf16x8 a0[4], a1[4];
#pragma unroll
        for (int i = 0; i < 4; ++i) {
          const int dv = (vb + i) * 16 + fr;
          a0[i] = *(const bf16x8*)(cur + 16384 + swz128(dv, fq));
          a1[i] = *(const bf16x8*)(cur + 16384 + swz128(dv, 4 + fq));
        }
        __builtin_amdgcn_sched_barrier(0);
        __builtin_amdgcn_s_setprio(1);
#pragma unroll
        for (int i = 0; i < 4; ++i) {
          O[0][vb + i] = mfma16(a0[i], pb[0][0], O[0][vb + i]);
          O[1][vb + i] = mfma16(a0[i], pb[1][0], O[1][vb + i]);
          O[0][vb + i] = mfma16(a1[i], pb[0][1], O[0][vb + i]);
          O[1][vb + i] = mfma16(a1[i], pb[1][1], O[1][vb + i]);
        }
        __builtin_amdgcn_s_setprio(0);
        __builtin_amdgcn_sched_barrier(0);
      }
    }
    float* xch = (float*)smem + (size_t)pr * 4096;
    __syncthreads();
#pragma unroll
    for (int qi = 0; qi < 2; ++qi) {
      const float lq = xor_sum(xor_sum(lsum[qi], 16), 32);
      const float sc = (m ? lam : 1.f) / lq;
#pragma unroll
      for (int v = 0; v < 8; ++v) O[qi][v] *= sc;
    }
    if (m) {
#pragma unroll
      for (int qi = 0; qi < 2; ++qi)
#pragma unroll
        for (int v = 0; v < 8; ++v)
#pragma unroll
          for (int j = 0; j < 4; ++j) xch[((qi * 8 + v) * 4 + j) * 64 + lane] = O[qi][v][j];
    }
    __syncthreads();
    if (!m) {
#pragma unroll
      for (int qi = 0; qi < 2; ++qi) {
        float ssq = 0.f;
#pragma unroll
        for (int v = 0; v < 8; ++v)
#pragma unroll
          for (int j = 0; j < 4; ++j) { float o = O[qi][v][j] - xch[((qi * 8 + v) * 4 + j) * 64 + lane]; O[qi][v][j] = o; ssq += o * o; }
        ssq = xor_sum(xor_sum(ssq, 16), 32);
        const float rs = rsqrtf(ssq * (1.f / 128.f) + 1e-6f) * (1.f - lam_init);
        u16* op = MIX + (size_t)(qrow0 + pr * 32 + qi * 16 + fr) * D + h * 128;
#pragma unroll
        for (int v = 0; v < 8; ++v) {
          int dv = v * 16 + fq * 4;
          float4 sw = *(const float4*)(subw + dv);
          uint2 o = {pk2(O[qi][v][0] * rs * sw.x, O[qi][v][1] * rs * sw.y), pk2(O[qi][v][2] * rs * sw.z, O[qi][v][3] * rs * sw.w)};
          *(uint2*)(op + dv) = o;
        }
      }
    }
  }
}

__device__ __forceinline__ void chunk_rows(int b, int cc_seq, int& row0, int& pos0) {
  if (cc_seq < 4) { row0 = ML + b * 256 + cc_seq * 64; pos0 = cc_seq * 64; }
  else { row0 = b * 4096 + (cc_seq - 4) * 64; pos0 = CTX + (cc_seq - 4) * 64; }
}
__device__ __forceinline__ int scan2tok(int c, int dir) {
  if (!dir) return c;
  return c < 4 ? 3 - c : 4 + 63 - (c - 4);
}

__device__ void hg_u_item(const P& p, int e, int item, char* smem) {
  const int tid = get_tid(), lane = tid & 63, wid = tid >> 6, wr = wid >> 1, wc = wid & 1, fr = lane & 15, fq = lane >> 4;
  const u16* PROJ = (const u16*)(p.ws + OFF_PROJ);
  const u16* IT = (const u16*)(p.ws + OFF_VT);
  u16* U = (u16*)(p.ws + OFF_U);
  float* DEC = (float*)(p.ws + OFF_DEC);
  const float* LB = (const float*)(p.ws + OFF_LB);
  const int c = item % NCH, seq = item / NCH, dir = seq & 1, h = (seq >> 1) & 3, b = seq >> 3;
  int row0, pos0;
  chunk_rows(b, scan2tok(c, dir), row0, pos0);
  float* tot = (float*)(smem + 16384);
  const int d = tid & 127, half = tid >> 7;
  const float lb = LB[(e * 2 + dir) * 512 + h * 128 + d];
  const u16* zl = (const u16*)(smem + 32768) + d;
  __syncthreads();
  {
    const u16* zg = PROJ + (size_t)row0 * 3072 + 1536 + dir * 512 + h * 128;
#pragma unroll
    for (int i = 0; i < 4; ++i) {
      int q = tid + i * 256;
      glds16(zg + (size_t)(q >> 4) * 3072 + (q & 15) * 8, smem + 32768 + q * 16);
    }
  }
  asm volatile("s_waitcnt vmcnt(0)" ::: "memory");
  __syncthreads();
  float sum = 0.f;
#pragma unroll 8
  for (int i = 0; i < 32; ++i) {
    int tau = half * 32 + i, t = dir ? 63 - tau : tau;
    float f = lb + (1.f - lb) * sigm(bf2f(zl[t * 128]));
    sum += __logf(fmaxf(f, 1e-20f));
  }
  tot[half * 128 + d] = sum;
  __syncthreads();
  float rel = half ? 0.f : tot[128 + d];
#pragma unroll 8
  for (int i = 31; i >= 0; --i) {
    int tau = half * 32 + i, t = dir ? 63 - tau : tau;
    float f = lb + (1.f - lb) * sigm(bf2f(zl[t * 128]));
    float lf = __logf(fmaxf(f, 1e-20f));
    { const int tp = kperm(t); *(u16*)(smem + swz128(d, tp >> 3) + (tp & 7) * 2) = f2bf((1.f - f) * __expf(rel)); }
    rel += lf;
  }
  if (!half) DEC[(size_t)(seq * NCH + c) * 128 + d] = __expf(rel);
  __syncthreads();
  f32x4 acc[4][4];
#pragma unroll
  for (int m = 0; m < 4; ++m)
#pragma unroll
    for (int n = 0; n < 4; ++n) acc[m][n] = f32x4{0.f, 0.f, 0.f, 0.f};
  const u16* vb = IT + (size_t)((b * 4 + h) * 128) * TK + pos0;
#pragma unroll
  for (int ks = 0; ks < 2; ++ks) {
    bf16x8 a[4], bb[4];
#pragma unroll
    for (int m = 0; m < 4; ++m) a[m] = *(const bf16x8*)(vb + (size_t)(wr * 64 + m * 16 + fr) * TK + ks * 32 + fq * 8);
#pragma unroll
    for (int n = 0; n < 4; ++n) bb[n] = *(const bf16x8*)(smem + swz128(wc * 64 + n * 16 + fr, ks * 4 + fq));
#pragma unroll
    for (int m = 0; m < 4; ++m)
#pragma unroll
      for (int n = 0; n < 4; ++n) acc[m][n] = mfma16(bb[n], a[m], acc[m][n]);
  }
  u16* up = U + (size_t)(seq * NCH + c) * 16384;
#pragma unroll
  for (int m = 0; m < 4; ++m)
#pragma unroll
    for (int n = 0; n < 4; ++n)
      *(uint2*)(up + (wr * 64 + m * 16 + fr) * 128 + wc * 64 + n * 16 + fq * 4) =
          uint2{pk2(acc[m][n][0], acc[m][n][1]), pk2(acc[m][n][2], acc[m][n][3])};
}

__device__ void pool_item(const P& p, int item) {
  const int tid = get_tid();
  const u16* PROJ = (const u16*)(p.ws + OFF_PROJ);
  u16* PO = (u16*)(p.ws + OFF_POOLED);
  const int ch = tid * 2, g = ch >> 7, hw = 1 << g;
  const int row0 = item * 32;
  int base, n, pos0;
  if (row0 < ML) { base = row0 & ~4095; n = 4096; pos0 = row0 & 4095; }
  else { base = ML + ((row0 - ML) & ~255); n = 256; pos0 = (row0 - ML) & 255; }
  const u16* up = PROJ + (size_t)base * 3072 + 2560 + ch;
  float s0 = 0.f, s1 = 0.f;
  {
    const int lo = max(pos0 - hw, 0), hi = min(pos0 + hw, n);
    for (int r = lo; r < hi; ++r) {
      unsigned v = *(const unsigned*)(up + (size_t)r * 3072);
      s0 += __uint_as_float(v << 16); s1 += __uint_as_float(v & 0xffff0000u);
    }
  }
  for (int i0 = 0; i0 < 32; i0 += 16) {
    unsigned ce[16], en[16], le[16];
#pragma unroll
    for (int i = 0; i < 16; ++i) {
      const int pos = pos0 + i0 + i;
      ce[i] = *(const unsigned*)(up + (size_t)pos * 3072);
      en[i] = (pos + hw < n) ? *(const unsigned*)(up + (size_t)(pos + hw) * 3072) : 0u;
      le[i] = (pos - hw >= 0) ? *(const unsigned*)(up + (size_t)(pos - hw) * 3072) : 0u;
    }
#pragma unroll
    for (int i = 0; i < 16; ++i) {
      const int pos = pos0 + i0 + i;
      const int lo = max(pos - hw, 0), hi = min(pos + hw, n);
      const float ic = 1.f / (float)(hi - lo);
      *(unsigned*)(PO + (size_t)(base + pos) * 512 + ch) =
          pk2(s0 * ic - __uint_as_float(ce[i] << 16), s1 * ic - __uint_as_float(ce[i] & 0xffff0000u));
      s0 += __uint_as_float(en[i] << 16) - __uint_as_float(le[i] << 16);
      s1 += __uint_as_float(en[i] & 0xffff0000u) - __uint_as_float(le[i] & 0xffff0000u);
    }
  }
}

__device__ void hg_scan_item(const P& p, int item) {
  unsigned* U = (unsigned*)(p.ws + OFF_U);
  const float* DEC = (const float*)(p.ws + OFF_DEC);
  const int ei = item * 256 + get_tid(), seq = ei >> 13, vd2 = ei & 8191, d = (vd2 & 63) * 2;
  unsigned* up = U + (size_t)seq * NCH * 8192 + vd2;
  const float* dp = DEC + (size_t)seq * NCH * 128 + d;
  float s0 = 0.f, s1 = 0.f;
  for (int c0 = 0; c0 < NCH; c0 += 17) {
    unsigned u[17]; float2 dd[17];
#pragma unroll
    for (int i = 0; i < 17; ++i) { u[i] = up[(size_t)(c0 + i) * 8192]; dd[i] = *(const float2*)(dp + (c0 + i) * 128); }
#pragma unroll
    for (int i = 0; i < 17; ++i) {
      up[(size_t)(c0 + i) * 8192] = pk2(s0, s1);
      s0 = dd[i].x * s0 + __uint_as_float(u[i] << 16);
      s1 = dd[i].y * s1 + __uint_as_float(u[i] & 0xffff0000u);
    }
  }
}

__device__ void hg_o_item(const P& p, int e, int item, char* smem) {
  const int tid = get_tid(), lane = tid & 63, w = tid >> 6, fr = lane & 15, fq = lane >> 4;
  const u16* PROJ = (const u16*)(p.ws + OFF_PROJ);
  const u16* IT = (const u16*)(p.ws + OFF_VT);
  const u16* S = (const u16*)(p.ws + OFF_U);
  const float* LB = (const float*)(p.ws + OFF_LB);
  u16* MIX = (u16*)(p.ws + OFF_MIX);
  const int tc = item % NCH, bh = item / NCH, h = bh & 3, b = bh >> 2;
  int row0, pos0;
  chunk_rows(b, tc, row0, pos0);
  char* qh = smem;
  char* kh = smem + 16384;
  char* vt = smem + 32768;
  float* eref = (float*)(smem + 49152);
  __syncthreads();
  {
    const u16* vb = IT + (size_t)((b * 4 + h) * 128) * TK + pos0;
#pragma unroll
    for (int i = 0; i < 4; ++i) {
      int q = tid + i * 256, dv = q >> 3, c2 = (q & 7) ^ ((dv >> 1) & 7);
      glds16(vb + (size_t)dv * TK + c2 * 8, vt + q * 16);
    }
  }
  f32x4 O[8];
#pragma unroll
  for (int v = 0; v < 8; ++v) O[v] = f32x4{0.f, 0.f, 0.f, 0.f};
  const int d = tid & 127, half = tid >> 7;
  for (int dir = 0; dir < 2; ++dir) {
    const int c = dir ? (tc < 4 ? 3 - tc : 4 + 63 - (tc - 4)) : tc;
    const int seq = (b * 4 + h) * 2 + dir;
    const float lb = LB[(e * 2 + dir) * 512 + h * 128 + d];
    if (dir) __syncthreads();
    {
      const u16* zg = PROJ + (size_t)row0 * 3072 + 1536 + dir * 512 + h * 128;
      const u16* qg = PROJ + (size_t)row0 * 3072 + h * 128;
#pragma unroll
      for (int i = 0; i < 4; ++i) {
        int q = tid + i * 256, row = q >> 4, ch = (q & 15) ^ (row & 15);
        glds16(zg + (size_t)row * 3072 + ch * 8, kh + q * 16);
        glds16(qg + (size_t)row * 3072 + ch * 8, qh + q * 16);
      }
    }
    asm volatile("s_waitcnt vmcnt(0)" ::: "memory");
    __syncthreads();
    float rel = 0.f;
    if (!half) {
#pragma unroll 8
      for (int tau = 31; tau >= 0; --tau) {
        int t = dir ? 63 - tau : tau;
        int off = swz256(t, d >> 3) + (d & 7) * 2;
        float f = lb + (1.f - lb) * sigm(bf2f(*(const u16*)(kh + off)));
        float lf = __logf(fmaxf(f, 1e-20f));
        float q = bf2f(*(const u16*)(qh + off));
        *(u16*)(qh + off) = f2bf(q * __expf(rel));
        *(u16*)(kh + off) = f2bf((1.f - f) * __expf(-rel));
        rel -= lf;
      }
      eref[d] = __expf(-rel);
    } else {
#pragma unroll 8
      for (int tau = 32; tau < 64; ++tau) {
        int t = dir ? 63 - tau : tau;
        int off = swz256(t, d >> 3) + (d & 7) * 2;
        float f = lb + (1.f - lb) * sigm(bf2f(*(const u16*)(kh + off)));
        float lf = __logf(fmaxf(f, 1e-20f));
        float q = bf2f(*(const u16*)(qh + off));
        rel += lf;
        *(u16*)(qh + off) = f2bf(q * __expf(rel));
        *(u16*)(kh + off) = f2bf((1.f - f) * __expf(-rel));
      }
    }
    __syncthreads();
    bf16x8 qf[4];
#pragma unroll
    for (int ks = 0; ks < 4; ++ks) qf[ks] = *(const bf16x8*)(qh + swz256(w * 16 + fr, ks * 4 + fq));
    f32x4 s[4];
#pragma unroll
    for (int sf = 0; sf < 4; ++sf) {
      s[sf] = f32x4{0.f, 0.f, 0.f, 0.f};
#pragma unroll
      for (int ks = 0; ks < 4; ++ks) {
        bf16x8 a = *(const bf16x8*)(kh + swz256(sf * 16 + fr, ks * 4 + fq));
        s[sf] = mfma16(a, qf[ks], s[sf]);
      }
    }
    const int tq = w * 16 + fr;
#pragma unroll
    for (int sf = 0; sf < 4; ++sf)
#pragma unroll
      for (int j = 0; j < 4; ++j) {
        int ss = sf * 16 + fq * 4 + j;
        bool keep = dir ? (ss >= tq) : (ss <= tq);
        s[sf][j] = keep ? s[sf][j] : 0.f;
      }
    bf16x8 pb[2];
#pragma unroll
    for (int k2 = 0; k2 < 2; ++k2) {
      union { bf16x8 v; unsigned u[4]; } t;
      t.u[0] = pk2(s[2 * k2][0], s[2 * k2][1]); t.u[1] = pk2(s[2 * k2][2], s[2 * k2][3]);
      t.u[2] = pk2(s[2 * k2 + 1][0], s[2 * k2 + 1][1]); t.u[3] = pk2(s[2 * k2 + 1][2], s[2 * k2 + 1][3]);
      pb[k2] = t.v;
    }
#pragma unroll
    for (int v = 0; v < 8; ++v)
#pragma unroll
      for (int k2 = 0; k2 < 2; ++k2) {
        const int dv = v * 16 + fr;
        union { bf16x8 v; uint2 u[2]; } a;
        a.v = *(const bf16x8*)(vt + swz128(dv, k2 * 4 + fq));
        O[v] = mfma16(a.v, pb[k2], O[v]);
      }
    const u16* sp = S + (size_t)(seq * NCH + c) * 16384;
#pragma unroll
    for (int ks = 0; ks < 4; ++ks) {
      union { bf16x8 v; u16 h[8]; unsigned u[4]; } qq, qs;
      qq.v = qf[ks];
      const float* er = eref + ks * 32 + fq * 8;
#pragma unroll
      for (int i = 0; i < 4; ++i) qs.u[i] = pk2(bf2f(qq.h[2 * i]) * er[2 * i], bf2f(qq.h[2 * i + 1]) * er[2 * i + 1]);
#pragma unroll
      for (int v = 0; v < 8; ++v) {
        const bf16x8 av = *(const bf16x8*)(sp + (v * 16 + fr) * 128 + ks * 32 + fq * 8);
        O[v] = mfma16(av, qs.v, O[v]);
      }
    }
  }
  float ssq = 0.f;
#pragma unroll
  for (int v = 0; v < 8; ++v)
#pragma unroll
    for (int j = 0; j < 4; ++j) ssq += O[v][j] * O[v][j];
  ssq = xor_sum(xor_sum(ssq, 16), 32);
  const float rs = rsqrtf(ssq * (1.f / 128.f) + 1e-6f);
  const int row = row0 + w * 16 + fr;
  const float* nw = p.hg_norm_w + e * 128;
#pragma unroll
  for (int v = 0; v < 8; ++v) {
    int dv = v * 16 + fq * 4;
    uint2 gv = *(const uint2*)(PROJ + (size_t)row * 3072 + 1024 + h * 128 + dv);
    float4 n4 = *(const float4*)(nw + dv);
    float g0 = bf2f((u16)(gv.x & 0xffff)), g1 = bf2f((u16)(gv.x >> 16)), g2 = bf2f((u16)(gv.y & 0xffff)), g3 = bf2f((u16)(gv.y >> 16));
    uint2 o = {pk2(O[v][0] * rs * n4.x * silu(g0), O[v][1] * rs * n4.y * silu(g1)),
               pk2(O[v][2] * rs * n4.z * silu(g2), O[v][3] * rs * n4.w * silu(g3))};
    *(uint2*)(MIX + (size_t)row * D + h * 128 + dv) = o;
  }
}

#define XB_TMO      128
#define XB_XCNT(j)  (256  + 64 * (j))
#define XB_XSUB(j)  (1280 + 64 * (j))
#define XB_XGEN(j)  (2304 + 64 * (j))
#define XB_TOP      3328
#define XB_TOPGEN   3392
#define XCD_BAR_WORDS 3456
#define XB_SPIN_CAP (1u << 18)
__device__ __forceinline__ unsigned xb_ld(unsigned* p) { return __hip_atomic_load(p, __ATOMIC_RELAXED, __HIP_MEMORY_SCOPE_AGENT); }
__device__ __forceinline__ unsigned xb_add(unsigned* p, unsigned v) { return __hip_atomic_fetch_add(p, v, __ATOMIC_RELAXED, __HIP_MEMORY_SCOPE_AGENT); }
__device__ __forceinline__ unsigned xb_xcc_id() { return (unsigned)__builtin_amdgcn_s_getreg((3 << 11) | 20) & 0xFu; }
#define XB_SPIN(cond, bar) do { unsigned _sp = 0; while (cond) { __builtin_amdgcn_s_sleep(1); \
    if ((++_sp & 255u) == 0u) { if (xb_ld(&(bar)[XB_TMO])) break; if (_sp > XB_SPIN_CAP) { atomicAdd(&(bar)[XB_TMO], 1u); break; } } } } while (0)
struct GB { unsigned* bar; unsigned x; volatile unsigned* st; };
__device__ __forceinline__ void gb_complete(unsigned* bar, unsigned x, unsigned& nloc, unsigned& nx) {
  const unsigned G = gridDim.x;
  unsigned sum, cnt, mine, sp = 0u;
  for (;;) {
    sum = 0u; cnt = 0u; mine = 0u;
#pragma unroll
    for (unsigned j = 0; j < 16; ++j) { const unsigned c = xb_ld(&bar[XB_XCNT(j)]); sum += c; cnt += (c > 0u) ? 1u : 0u; mine = (j == x) ? c : mine; }
    if (sum == G) break;
    __builtin_amdgcn_s_sleep(1);
    if ((++sp & 255u) == 0u) { if (xb_ld(&bar[XB_TMO])) break; if (sp > XB_SPIN_CAP) { atomicAdd(&bar[XB_TMO], 1u); break; } }
  }
  nloc = mine > 0u ? mine : 1u; nx = cnt > 0u ? cnt : 1u;
}
__device__ __forceinline__ void gbar(GB& b) {
  asm volatile("s_waitcnt vmcnt(0)" ::: "memory");
  __syncthreads();
  if (threadIdx.x == 0) {
    unsigned* bar = b.bar;
    __builtin_amdgcn_s_waitcnt(0);
    unsigned nloc = b.st[0], nx = b.st[1];
    if (nloc == 0u) { gb_complete(bar, b.x, nloc, nx); b.st[0] = nloc; b.st[1] = nx; }
    const unsigned old = xb_add(&bar[XB_XSUB(b.x)], 1u);
    const unsigned gen = old / nloc;
    if (old + 1u == (gen + 1u) * nloc) {
      __builtin_amdgcn_fence(__ATOMIC_RELEASE, "agent");
      asm volatile("s_waitcnt vmcnt(0)" ::: "memory");
      const unsigned og = xb_add(&bar[XB_TOP], 1u);
      const unsigned tg = og / nx;
      if (og + 1u == (tg + 1u) * nx) xb_add(&bar[XB_TOPGEN], 1u);
      else XB_SPIN(xb_ld(&bar[XB_TOPGEN]) == tg, bar);
      __builtin_amdgcn_fence(__ATOMIC_ACQUIRE, "agent");
      xb_add(&bar[XB_XGEN(b.x)], 1u);
      asm volatile("s_waitcnt vmcnt(0)" ::: "memory");
    } else {
      XB_SPIN(xb_ld(&bar[XB_XGEN(b.x)]) == gen, bar);
      __builtin_amdgcn_fence(__ATOMIC_ACQUIRE, "agent");
      asm volatile("s_waitcnt vmcnt(0)" ::: "memory");
    }
  }
  __syncthreads();
}

template <int K>
__device__ __forceinline__ void n1024_phase(const P& p, const u16* A, const u16* Wt, bool with_ctx, bool ksplit, char* smem) {
  u16* Y = (u16*)(p.ws + OFF_Y);
  u16* YC = (u16*)(p.ws + OFF_YC);
  gemm8e<1024, K>(A, Wt, ML, smem, Epi8Y{Y});
  if (!with_ctx) return;
  const int vb = get_vb();
  char* vsm = smem + vb * 65536;
  if (ksplit) {
    for (int it = blockIdx.x; it < 128; it += gridDim.x) {
      const int u = 2 * it + vb, ks = u & 3, ct = u >> 2, pm = ct >> 3, pn = ct & 7;
      gemm_tile(A + ks * 704, K, Wt + ks * 704, K, 704, ML + pm * 128, pn * 128, vsm,
                Epi4<BlkY>{BlkY{YC + ((size_t)ks * MC - ML) * D}});
    }
  } else {
    for (int it = blockIdx.x; it < 32; it += gridDim.x) {
      const int u = 2 * it + vb, pm = u >> 3, pn = u & 7;
      gemm_tile(A, K, Wt, K, K, ML + pm * 128, pn * 128, vsm, Epi4<BlkY>{BlkY{Y}});
    }
  }
}

constexpr int PH_PER_EVEN = 12, PH_PER_ODD = 10;
constexpr int N_PHASES = 2 + 2 * PH_PER_EVEN + 2 * PH_PER_ODD;

__device__ __forceinline__ void run_phase(const P& pin, int ph, char* smem) {
  P p = pin;
  asm volatile("" : "+s"(p.ws));
  asm volatile("" : "+s"(p.out));
  const int vb = get_vb();
  char* vsm = smem + vb * 65536;
  u16* H = (u16*)(p.ws + OFF_H);
  u16* HID = (u16*)(p.ws + OFF_HID);
  u16* PROJ = (u16*)(p.ws + OFF_PROJ);
  u16* VT = (u16*)(p.ws + OFF_VT);
  u16* MIX = (u16*)(p.ws + OFF_MIX);
  if (ph == 0) { phase_prep(p, vsm); return; }
  if (ph == 1) { phase_rows(p, 0, 0, 0, MT, false); return; }
  int q = ph - 2, l;
  if (q < PH_PER_EVEN) l = 0;
  else if (q < PH_PER_EVEN + PH_PER_ODD) { l = 1; q -= PH_PER_EVEN; }
  else if (q < 2 * PH_PER_EVEN + PH_PER_ODD) { l = 2; q -= PH_PER_EVEN + PH_PER_ODD; }
  else { l = 3; q -= 2 * PH_PER_EVEN + PH_PER_ODD; }
  const bool even = !(l & 1), last = (l == 3);
  int step = q;
  if (!even && q >= 5) step = q + 2;
  const int Mpost = last ? ML : MT;
  const u16* WFI = (const u16*)(p.ws + OFF_WFI);
  const u16* WFO = (const u16*)(p.ws + OFF_WFO);
  const u16* WMI = (const u16*)(p.ws + OFF_WMI) + (size_t)l * 3072 * 1024;
  switch (step) {
    case 0:
    case 9: {
      const int f = (step == 9) ? 1 : 0;
      gemm8e<5632, 1024>(H, WFI + (size_t)(l * 2 + f) * 5632 * 1024, f ? Mpost : MT, smem, Epi8Swiglu{HID});
    } break;
    case 1:
    case 7:
    case 10: {
      if (step == 7) n1024_phase<1024>(p, MIX, (const u16*)(p.ws + OFF_WMO) + (size_t)l * 1024 * 1024, !last, false, smem);
      else n1024_phase<2816>(p, HID, WFO + (size_t)(l * 2 + (step == 10 ? 1 : 0)) * 1024 * 2816, step == 1 || !last, true, smem);
    } break;
    case 2: phase_rows(p, 1, l, 0, MT, false); break;
    case 3:
      if (even) {
        gemm8<3072, 1024>(H, WMI, ML, smem, BlkProjEven{PROJ, VT});
        for (int it = blockIdx.x; it < 96; it += gridDim.x) {
          const int u = 2 * it + vb, pm = u / 24, pn = u % 24;
          gemm_tile(H, D, WMI, D, 1024, ML + pm * 128, pn * 128, vsm, Epi4<BlkProjEven>{BlkProjEven{PROJ, VT}});
        }
      } else {
        const float* rope = (const float*)(p.ws + OFF_ROPE);
        gemm8<3072, 1024>(H, WMI, ML, smem, BlkProjOdd{PROJ, VT, rope});
        for (int it = blockIdx.x; it < 96; it += gridDim.x) {
          const int u = 2 * it + vb, pm = u / 24, pn = u % 24;
          gemm_tile(H, D, WMI, D, 1024, ML + pm * 128, pn * 128, vsm, Epi4<BlkProjOdd>{BlkProjOdd{PROJ, VT, rope}});
        }
      }
      break;
    case 4:
      if (even) {
        for (int itp = blockIdx.x; itp < (32 * NCH + MT / 32) / 2; itp += gridDim.x) {
          const int it = 2 * itp + vb;
          if (it < 32 * NCH) hg_u_item(p, l >> 1, it, vsm);
          else pool_item(p, it - 32 * NCH);
        }
      } else phase_attn(p, l, smem);
      break;
    case 5: {
      for (int itp = blockIdx.x; itp < (1024 + 4 * (MT / 128)) / 2; itp += gridDim.x) {
        const int it = 2 * itp + vb;
        if (it < 1024) hg_scan_item(p, it);
        else {
          int t = it - 1024, g = t / (MT / 128), mt = t % (MT / 128);
          gemm_tile((const u16*)(p.ws + OFF_POOLED) + g * 128, 512,
                    (const u16*)(p.ws + OFF_WPL) + (size_t)((l >> 1) * 4 + g) * 128 * 128, 128, 128, mt * 128, 0, vsm,
                    Epi4<BlkPool>{BlkPool{MIX, p.pool_scale + (l >> 1) * 512, g}});
        }
      }
    } break;
    case 6:
      for (int itp = blockIdx.x; itp < 8 * NCH; itp += gridDim.x) hg_o_item(p, l >> 1, 2 * itp + vb, vsm);
      break;
    case 8: phase_rows(p, 1, l, 1, Mpost, false); break;
    case 11: phase_rows(p, 1, l, 2, Mpost, last); break;
  }
}

constexpr int DYN_LDS = 131072 + 16;
__global__ void __launch_bounds__(512, 2) mega(P p, int ph_lo, int ph_hi) {
  extern __shared__ __attribute__((aligned(16))) char smem[];
  GB gb;
  gb.bar = (unsigned*)(p.ws + OFF_BAR); gb.x = xb_xcc_id(); gb.st = (volatile unsigned*)(smem + 131072);
  if (threadIdx.x == 0) { gb.st[0] = 0u; gb.st[1] = 0u; (void)xb_add(&gb.bar[XB_XCNT(gb.x)], 1u); }
  __syncthreads();
  for (int ph = ph_lo; ph < ph_hi; ++ph) {
    run_phase(p, ph, smem);
#ifdef PROBE_GEMM
    if (ph >= 2) {
      int q = ph - 2, l = 0;
      if (q < 12) l = 0; else if (q < 22) { l = 1; q -= 12; } else if (q < 34) { l = 2; q -= 22; } else { l = 3; q -= 34; }
      int step = q; if ((l & 1) && q >= 5) step = q + 2;
      if (step == 0 || step == 1 || step == 3 || step == 7 || step == 9 || step == 10) { __syncthreads(); run_phase(p, ph, smem); }
    }
#endif
#ifdef PROBE_ATT
    if (ph == 2 + 12 + 4 || ph == 2 + 34 + 4) { __syncthreads(); run_phase(p, ph, smem); }
#endif
    if (ph + 1 < ph_hi) {
      if (ph_hi < 0) cg::this_grid().sync();
      gbar(gb);
    }
  }
}

extern "C" void kernel_launch(void* const* d_in, const int* in_sizes, int n_in, void* d_out, int out_size, void* d_ws,
                              size_t ws_size, hipStream_t stream) {
  static int grid_blocks = 0;
  if (!grid_blocks) {
    int dev = 0, cus = 0, per_cu = 0;
    hipGetDevice(&dev);
    hipDeviceGetAttribute(&cus, hipDeviceAttributeMultiprocessorCount, dev);
    hipFuncSetAttribute((const void*)mega, hipFuncAttributeMaxDynamicSharedMemorySize, DYN_LDS);
    hipOccupancyMaxActiveBlocksPerMultiprocessor(&per_cu, mega, 512, DYN_LDS);
    if (per_cu > 1) per_cu = 1;
    grid_blocks = cus * per_cu;
  }
  if (ws_size < OFF_END2) { fprintf(stderr, "workspace too small: %zu < %zu\n", ws_size, (size_t)OFF_END); return; }
  P p{};
  const float** f = (const float**)&p;
  for (int i = 0; i < 20; ++i) f[i] = (const float*)d_in[i];
  p.out = (float*)d_out;
  p.ws = (char*)d_ws;
#if MULTI_LAUNCH
  for (int ph = 0; ph < N_PHASES; ++ph) hipLaunchKernelGGL(mega, dim3(grid_blocks), dim3(512), DYN_LDS, stream, p, ph, ph + 1);
#else
  hipMemsetAsync((char*)d_ws + OFF_BAR, 0, XCD_BAR_WORDS * 4, stream);
  int lo = 0, hi = N_PHASES;
  void* args[] = {&p, &lo, &hi};
  hipError_t e = hipLaunchCooperativeKernel((void*)mega, dim3(grid_blocks), dim3(512), args, DYN_LDS, stream);
  if (e != hipSuccess) fprintf(stderr, "cooperative launch failed: %s (grid %d)\n", hipGetErrorString(e), grid_blocks);
#endif
}
```
